# Optimizing an MI355X kernel written in HIP

```python
import math
import jax
import jax.numpy as jnp
from jax import lax
import numpy as np

D_MODEL = 1024
BATCH = 4
SEQ = 8192
DEPTH = 2

GRID_W = 64
CTX_LEN = 256
EPS = 1e-6
F32 = jnp.float32

MIX_WIDTH = D_MODEL
GROUP_W = MIX_WIDTH // 4
A_WIDTH = GROUP_W
A_HD = 64
A_HEADS = A_WIDTH // A_HD
MLP_CHUNK = 128
B_WIDTH = GROUP_W
B_HD = 64
B_HEADS = B_WIDTH // B_HD
GATE_RANK = 16
GATE_TEMP = 16.0
GLA_CHUNK = 64
C_WIDTH = GROUP_W
S5_IN = 16
S5_GROUPS = C_WIDTH // S5_IN
S5_STATE = 64
DT_MIN = 1e-3
DT_MAX = 1e-1
D_WIDTH = GROUP_W
MLA_HEADS = 4
MLA_NOPE = 64
MLA_ROPE = 32
MLA_V = D_WIDTH // MLA_HEADS
MLA_Q_RANK = 224
MLA_KV_RANK = 96
ROPE_BASE = 10000.0
Q_BLOCK = 128
D_FF = 2816
CONV_W = 3

A_COLS = 2 * A_WIDTH
B_COLS = 4 * B_WIDTH + 2 * GATE_RANK
C_COLS = C_WIDTH
D_COLS = MLA_Q_RANK + MLA_KV_RANK + MLA_ROPE
IN_COLS = A_COLS + B_COLS + C_COLS + D_COLS
SPLITS = (A_COLS, A_COLS + B_COLS, A_COLS + B_COLS + C_COLS)

kernel_name = "hybrid_headgroup_diffusion_block"


def rmsnorm(x, g):
    xf = x.astype(F32)
    y = xf * lax.rsqrt(jnp.mean(xf * xf, axis=-1, keepdims=True) + EPS)
    return (y * g.astype(F32)).astype(x.dtype)


def _ident(t):
    return t


def _flip(t):
    return jnp.flip(t, axis=1)


def _rotate(t, pos):
    nf = t.shape[-1] // 2
    inv = ROPE_BASE ** (-jnp.arange(nf, dtype=F32) / nf)
    ang = pos[:, None] * inv[None, :]
    cos = jnp.cos(ang)[None, :, None, :].astype(t.dtype)
    sin = jnp.sin(ang)[None, :, None, :].astype(t.dtype)
    t1, t2 = t[..., :nf], t[..., nf:]
    return jnp.concatenate([t1 * cos - t2 * sin, t1 * sin + t2 * cos], axis=-1)


def axial_rope(t, row, col):
    half = t.shape[-1] // 2
    return jnp.concatenate([_rotate(t[..., :half], row), _rotate(t[..., half:], col)], axis=-1)


def attend(q, k, v):
    b, nq, h, dh = q.shape
    scale = dh ** -0.5
    qb = q.reshape(b, nq // Q_BLOCK, Q_BLOCK, h, dh).swapaxes(0, 1)

    def block(qblk):
        s = jnp.einsum('bqhd,bkhd->bhqk', qblk, k).astype(F32) * scale
        p = jax.nn.softmax(s, axis=-1).astype(v.dtype)
        return jnp.einsum('bhqk,bkhd->bqhd', p, v)

    o = lax.map(block, qb)
    return o.swapaxes(0, 1).reshape(b, nq, h, v.shape[-1])


def dwconv_centred(h, w, bias):
    n = h.shape[1]
    pad = CONV_W // 2
    hp = jnp.pad(h, ((0, 0), (pad, pad), (0, 0)))
    out = bias
    for j in range(CONV_W):
        out = out + hp[:, j:j + n] * w[j]
    return out


def conv_ffn(h, w_up, conv_w, conv_b, w_down):
    z = dwconv_centred(h @ w_up, conv_w, conv_b)
    a, g = jnp.split(z, 2, axis=-1)
    return (jax.nn.gelu(a) * g) @ w_down


def chunk_mlp(p, g_norm, w_sp, b_sp):
    b, n, _ = p.shape
    u, v = jnp.split(jax.nn.gelu(p), 2, axis=-1)
    v = rmsnorm(v.reshape(b, n, A_HEADS, A_HD), g_norm)
    v = v.reshape(b, n // MLP_CHUNK, MLP_CHUNK, A_HEADS, A_HD)
    s = jnp.einsum('hts,bcshd->bcthd', w_sp, v) + b_sp.T[:, :, None]
    return u * s.reshape(b, n, A_WIDTH)


def gla_chunked(q, k, v, g, s0):
    b, n, h, dk = q.shape
    nc = n // GLA_CHUNK

    def rs(t):
        return t.reshape(b, nc, GLA_CHUNK, h, t.shape[-1])

    q, k, v, g = rs(q), rs(k), rs(v), rs(g)
    cum = jnp.cumsum(g, axis=2)
    tot = cum[:, :, -1:]
    q_in = q * jnp.exp(cum)
    k_in = k * jnp.exp(-cum)
    k_end = k * jnp.exp(tot - cum)
    tri = jnp.tril(jnp.ones((GLA_CHUNK, GLA_CHUNK), dtype=bool))
    scores = jnp.where(tri, jnp.einsum('bcthk,bcshk->bchts', q_in, k_in), 0.0)
    o_intra = jnp.einsum('bchts,bcshv->bcthv', scores, v)
    kv_chunk = jnp.einsum('bcshk,bcshv->bchkv', k_end, v)
    decay = jnp.exp(tot[:, :, 0])

    def step(s, inp):
        dec, kv = inp
        return dec[..., None] * s + kv, s

    s_fin, s_start = lax.scan(step, s0, (decay.swapaxes(0, 1), kv_chunk.swapaxes(0, 1)))
    o_inter = jnp.einsum('bcthk,bchkv->bcthv', q_in, s_start.swapaxes(0, 1))
    return (o_intra + o_inter).reshape(b, n, h, v.shape[-1]), s_fin


def gla_final_state(k, v, g):
    cum = jnp.cumsum(g, axis=1)
    w = jnp.exp(cum[:, -1:] - cum)
    return jnp.einsum('bnhk,bnhv->bhkv', k * w, v)


def gla_inputs(p, w_gate, b_gate):
    b, n, _ = p.shape
    q, k, v, r, gl = jnp.split(p, [B_WIDTH, 2 * B_WIDTH, 3 * B_WIDTH, 4 * B_WIDTH], axis=-1)

    def heads(t):
        return t.reshape(b, n, B_HEADS, B_HD).astype(F32)

    z = jnp.einsum('bndr,drc->bndc', gl.reshape(b, n, 2, GATE_RANK), w_gate) + b_gate
    logg = (jax.nn.log_sigmoid(z.astype(F32)) / GATE_TEMP).reshape(b, n, 2, B_HEADS, B_HD)
    return heads(q) * (B_HD ** -0.5), heads(k), heads(v), r, logg


def gla_mixer(pc, px, w_gate, b_gate, g_norm, ctx_out):
    qc, kc, vc, rc, gc = gla_inputs(pc, w_gate, b_gate)
    qx, kx, vx, rx, gx = gla_inputs(px, w_gate, b_gate)
    s_zero = jnp.zeros((px.shape[0], B_HEADS, B_HD, B_HD), F32)
    outs_c, outs_x = [], []
    for d, f in enumerate((_ident, _flip)):
        if ctx_out:
            oc_d, s_ctx = gla_chunked(f(qc), f(kc), f(vc), f(gc[:, :, d]), s_zero)
            outs_c.append(f(oc_d))
        else:
            s_ctx = gla_final_state(f(kc), f(vc), f(gc[:, :, d]))
        ox_d, _ = gla_chunked(f(qx), f(kx), f(vx), f(gx[:, :, d]), s_ctx)
        outs_x.append(f(ox_d))

    def finish(outs, r):
        o = rmsnorm(outs[0] + outs[1], g_norm).astype(r.dtype)
        return o.reshape(r.shape) * jax.nn.silu(r)

    return (finish(outs_c, rc) if ctx_out else None), finish(outs_x, rx)


def s5_discretize(a_re, a_im, log_dt, b_re, b_im):
    lam = lax.complex(a_re.astype(F32), a_im.astype(F32))
    dt = jnp.exp(log_dt.astype(F32))[:, None]
    lam_bar = jnp.exp(lam * dt)
    b = lax.complex(b_re.astype(F32), b_im.astype(F32))
    b_bar = ((lam_bar - 1.0) / lam)[..., None] * b
    return lam_bar, b_bar


def _linear_recurrence(e1, e2):
    a1, b1 = e1
    a2, b2 = e2
    return a1 * a2, a2 * b1 + b2


def s5_scan(u, lam_bar, b_bar, h0=None):
    bu = jnp.einsum('bngi,gpi->bngp', u.astype(jnp.complex64), b_bar)
    a = jnp.broadcast_to(lam_bar, bu.shape)
    a_cum, h = lax.associative_scan(_linear_recurrence, (a, bu), axis=1)
    if h0 is not None:
        h = h + a_cum * h0[:, None]
    return h


def s5_mixer(uc, ux, a_re, a_im, log_dt, b_re, b_im, c_re, c_im, d_skip, w_glu, b_glu, ctx_out):
    def groups(u):
        return u.reshape(u.shape[0], u.shape[1], S5_GROUPS, S5_IN).astype(F32)

    gu_c, gu_x = groups(uc), groups(ux)
    d32 = d_skip.astype(F32)
    ys_c, ys_x = [gu_c * d32], [gu_x * d32]
    for d, f in enumerate((_ident, _flip)):
        lam_bar, b_bar = s5_discretize(a_re[d], a_im[d], log_dt[d], b_re[d], b_im[d])
        cmat = lax.complex(c_re[d].astype(F32), c_im[d].astype(F32))
        hc = s5_scan(f(gu_c), lam_bar, b_bar)
        hx = s5_scan(f(gu_x), lam_bar, b_bar, hc[:, -1])
        ys_x.append(f(jnp.einsum('bngp,gop->bngo', hx, cmat).real))
        if ctx_out:
            ys_c.append(f(jnp.einsum('bngp,gop->bngo', hc, cmat).real))

    def finish(ys, like):
        y = jax.nn.gelu(sum(ys).reshape(like.shape)).astype(like.dtype)
        return y * jax.nn.sigmoid(y @ w_glu + b_glu)

    return (finish(ys_c, uc) if ctx_out else None), finish(ys_x, ux)


def mla_mixer(pc, px, q_norm, w_uq, kv_norm, w_ukv, row, col, ctx_out):
    def split(p):
        return jnp.split(p, [MLA_Q_RANK, MLA_Q_RANK + MLA_KV_RANK], axis=-1)

    def queries(cq, rope):
        b, n, _ = cq.shape
        q = (rmsnorm(cq, q_norm) @ w_uq).reshape(b, n, MLA_HEADS, MLA_NOPE + MLA_ROPE)
        if rope:
            q = jnp.concatenate([q[..., :MLA_NOPE], axial_rope(q[..., MLA_NOPE:], row, col)], axis=-1)
        return q

    def keys_values(ckv, kr, rope):
        b, n, _ = ckv.shape
        kv = (rmsnorm(ckv, kv_norm) @ w_ukv).reshape(b, n, MLA_HEADS, MLA_NOPE + MLA_V)
        kr = kr[:, :, None, :]
        if rope:
            kr = axial_rope(kr, row, col)
        k = jnp.concatenate([kv[..., :MLA_NOPE], jnp.broadcast_to(kr, (b, n, MLA_HEADS, MLA_ROPE))], axis=-1)
        return k, kv[..., MLA_NOPE:]

    cq_c, ckv_c, kr_c = split(pc)
    cq_x, ckv_x, kr_x = split(px)
    kc, vc = keys_values(ckv_c, kr_c, False)
    kx, vx = keys_values(ckv_x, kr_x, True)
    ox = attend(queries(cq_x, True), jnp.concatenate([kc, kx], axis=1), jnp.concatenate([vc, vx], axis=1))
    ox = ox.reshape(px.shape[0], px.shape[1], D_WIDTH)
    if ctx_out:
        oc = attend(queries(cq_c, False), kc, vc).reshape(pc.shape[0], pc.shape[1], D_WIDTH)
        return oc, ox
    return None, ox


def setup_inputs(seed: int = 0) -> dict:
    key = jax.random.key(seed)
    ks = iter(jax.random.split(key, 40))
    L = DEPTH

    def nrm(shape, scale):
        return jax.random.normal(next(ks), shape, F32) * scale

    def gain(shape):
        return 1.0 + nrm(shape, 0.05)

    inputs = {
        'x': nrm((BATCH, SEQ, D_MODEL), 1.0),
        'c': nrm((BATCH, D_MODEL), 1.0),
        'ctx': nrm((BATCH, CTX_LEN, D_MODEL), 1.0),
        'c_ctx': nrm((D_MODEL,), 1.0),
        'w_mod': nrm((L, D_MODEL, 6 * D_MODEL), 0.5 * D_MODEL ** -0.5),
        'b_mod': nrm((L, 6 * D_MODEL), 0.02),
        'g_pre_mix': gain((L, D_MODEL)),
        'g_post_mix': gain((L, D_MODEL)),
        'g_pre_ffn': gain((L, D_MODEL)),
        'g_post_ffn': gain((L, D_MODEL)),
        'w_in': nrm((L, D_MODEL, IN_COLS), D_MODEL ** -0.5),
        'sgu_norm': gain((L, A_HEADS, A_HD)),
        'sgu_w': nrm((L, A_HEADS, MLP_CHUNK, MLP_CHUNK), MLP_CHUNK ** -0.5),
        'sgu_b': 1.0 + nrm((L, A_HEADS, MLP_CHUNK), 0.02),
        'gla_w_gate': nrm((L, 2, GATE_RANK, B_WIDTH), GATE_RANK ** -0.5),
        'gla_b_gate': nrm((L, 2, B_WIDTH), 0.02),
        'gla_norm': gain((L, B_HEADS, B_HD)),
        's5_a_re': -0.5 + nrm((L, 2, S5_GROUPS, S5_STATE), 0.01),
        's5_a_im': math.pi * jnp.arange(S5_STATE, dtype=F32) + nrm((L, 2, S5_GROUPS, S5_STATE), 0.01),
        's5_log_dt': jax.random.uniform(next(ks), (L, 2, S5_GROUPS), F32, math.log(DT_MIN), math.log(DT_MAX)),
        's5_b_re': nrm((L, 2, S5_GROUPS, S5_STATE, S5_IN), (2 * S5_IN) ** -0.5),
        's5_b_im': nrm((L, 2, S5_GROUPS, S5_STATE, S5_IN), (2 * S5_IN) ** -0.5),
        's5_c_re': nrm((L, 2, S5_GROUPS, S5_IN, S5_STATE), (2 * S5_STATE) ** -0.5),
        's5_c_im': nrm((L, 2, S5_GROUPS, S5_IN, S5_STATE), (2 * S5_STATE) ** -0.5),
        's5_d': nrm((L, S5_GROUPS, S5_IN), 1.0),
        's5_w_glu': nrm((L, C_WIDTH, C_WIDTH), C_WIDTH ** -0.5),
        's5_b_glu': nrm((L, C_WIDTH), 0.02),
        'mla_q_norm': gain((L, MLA_Q_RANK)),
        'mla_w_uq': nrm((L, MLA_Q_RANK, MLA_HEADS * (MLA_NOPE + MLA_ROPE)), MLA_Q_RANK ** -0.5),
        'mla_kv_norm': gain((L, MLA_KV_RANK)),
        'mla_w_ukv': nrm((L, MLA_KV_RANK, MLA_HEADS * (MLA_NOPE + MLA_V)), MLA_KV_RANK ** -0.5),
        'w_out': nrm((L, MIX_WIDTH, D_MODEL), MIX_WIDTH ** -0.5),
        'ffn_w_up': nrm((L, D_MODEL, 2 * D_FF), D_MODEL ** -0.5),
        'ffn_conv_w': nrm((L, CONV_W, 2 * D_FF), CONV_W ** -0.5),
        'ffn_conv_b': nrm((L, 2 * D_FF), 0.02),
        'ffn_w_down': nrm((L, D_FF, D_MODEL), D_FF ** -0.5),
    }
    return inputs


def reference(x, c, ctx, c_ctx, w_mod, b_mod, g_pre_mix, g_post_mix, g_pre_ffn, g_post_ffn, w_in,
              sgu_norm, sgu_w, sgu_b, gla_w_gate, gla_b_gate, gla_norm,
              s5_a_re, s5_a_im, s5_log_dt, s5_b_re, s5_b_im, s5_c_re, s5_c_im, s5_d, s5_w_glu, s5_b_glu,
              mla_q_norm, mla_w_uq, mla_kv_norm, mla_w_ukv, w_out,
              ffn_w_up, ffn_conv_w, ffn_conv_b, ffn_w_down):
    n = x.shape[1]
    rows = n // GRID_W
    row = jnp.repeat(jnp.arange(rows, dtype=F32), GRID_W)
    col = jnp.tile(jnp.arange(GRID_W, dtype=F32), rows)
    silu_c = jax.nn.silu(c)
    silu_cc = jax.nn.silu(c_ctx)

    for l in range(DEPTH):
        ctx_out = l < DEPTH - 1
        mod_x = (silu_c @ w_mod[l] + b_mod[l])[:, None, :]
        mod_c = silu_cc @ w_mod[l] + b_mod[l]
        sh1x, sc1x, gt1x, sh2x, sc2x, gt2x = jnp.split(mod_x, 6, axis=-1)
        sh1c, sc1c, gt1c, sh2c, sc2c, gt2c = jnp.split(mod_c, 6, axis=-1)

        hx = rmsnorm(x, g_pre_mix[l]) * (1.0 + sc1x) + sh1x
        hc = rmsnorm(ctx, g_pre_mix[l]) * (1.0 + sc1c) + sh1c
        in_x = jnp.split(hx @ w_in[l], SPLITS, axis=-1)
        in_c = jnp.split(hc @ w_in[l], SPLITS, axis=-1)

        oa_x = chunk_mlp(in_x[0], sgu_norm[l], sgu_w[l], sgu_b[l])
        ob_c, ob_x = gla_mixer(in_c[1], in_x[1], gla_w_gate[l], gla_b_gate[l], gla_norm[l], ctx_out)
        oc_c, oc_x = s5_mixer(in_c[2], in_x[2], s5_a_re[l], s5_a_im[l], s5_log_dt[l], s5_b_re[l], s5_b_im[l],
                              s5_c_re[l], s5_c_im[l], s5_d[l], s5_w_glu[l], s5_b_glu[l], ctx_out)
        od_c, od_x = mla_mixer(in_c[3], in_x[3], mla_q_norm[l], mla_w_uq[l], mla_kv_norm[l], mla_w_ukv[l],
                               row, col, ctx_out)

        mix_x = jnp.concatenate([oa_x, ob_x, oc_x, od_x], axis=-1) @ w_out[l]
        x = x + gt1x * rmsnorm(mix_x, g_post_mix[l])

        hx = rmsnorm(x, g_pre_ffn[l]) * (1.0 + sc2x) + sh2x
        x = x + gt2x * rmsnorm(conv_ffn(hx, ffn_w_up[l], ffn_conv_w[l], ffn_conv_b[l], ffn_w_down[l]), g_post_ffn[l])

        if ctx_out:
            oa_c = chunk_mlp(in_c[0], sgu_norm[l], sgu_w[l], sgu_b[l])
            mix_c = jnp.concatenate([oa_c, ob_c, oc_c, od_c], axis=-1) @ w_out[l]
            ctx = ctx + gt1c * rmsnorm(mix_c, g_post_mix[l])
            hc = rmsnorm(ctx, g_pre_ffn[l]) * (1.0 + sc2c) + sh2c
            ctx = ctx + gt2c * rmsnorm(conv_ffn(hc, ffn_w_up[l], ffn_conv_w[l], ffn_conv_b[l], ffn_w_down[l]), g_post_ffn[l])
    return x
```

```cpp
#include <hip/hip_runtime.h>
#include <hip/hip_cooperative_groups.h>
#include <cstdio>
#include <cstdint>
namespace cg = cooperative_groups;

typedef unsigned short us;
using bf16x8 = __attribute__((ext_vector_type(8))) short;
using f32x16 = __attribute__((ext_vector_type(16))) float;
using f32x4  = __attribute__((ext_vector_type(4))) float;
using u32x4  = __attribute__((ext_vector_type(4))) unsigned;
using u32x2  = __attribute__((ext_vector_type(2))) unsigned;
#define DI __device__ __forceinline__
#define MFMA(a, b, c) __builtin_amdgcn_mfma_f32_32x32x16_bf16((a), (b), (c), 0, 0, 0)

constexpr int D = 1024, MX = 32768, MC = 1024, MT = MX + MC, INC = 2176, DFF = 2816, DFF2 = 5632;
constexpr int SEQ = 8448, NCHK = 132;
constexpr float EPS = 1e-6f;
constexpr float QSCALE = 0.10206207261596577f * 1.4426950408889634f;

constexpr size_t W_IN = 0, W_OUT = W_IN + (size_t)INC * D, W_UP = W_OUT + (size_t)D * D, W_DN = W_UP + (size_t)DFF2 * D,
                 W_UQ = W_DN + (size_t)D * DFF, W_UKV = W_UQ + 384 * 224, W_GLU = W_UKV + 512 * 96, W_SGU = W_GLU + 256 * 256,
                 W_CM = W_SGU + 4 * 128 * 128, W_LAYER = W_CM + 2 * 16 * 16 * 128;
constexpr size_t S_LAMB = 0, S_LAMT = 4096, S_BBAR = 8192, S_LAYER = 8192 + 65536;

constexpr size_t al256(size_t x) { return (x + 255) / 256 * 256; }
constexpr size_t OFF_WB = 0;
constexpr size_t OFF_S5F = al256(OFF_WB + 2 * W_LAYER * 2);
constexpr size_t OFF_MOD = al256(OFF_S5F + 2 * S_LAYER * 4);
constexpr size_t OFF_ROPE = al256(OFF_MOD + 2 * 5 * 6144 * 4);
constexpr size_t OFF_CTXS = al256(OFF_ROPE + 128 * 8 * 2 * 4);
constexpr size_t OFF_HX = al256(OFF_CTXS + (size_t)MC * D * 4);
constexpr size_t OFF_P = al256(OFF_HX + (size_t)MT * D * 2);
constexpr size_t OFF_MIXIN = al256(OFF_P + (size_t)MT * INC * 2);
constexpr size_t OFF_QB = al256(OFF_MIXIN + (size_t)MT * D * 2);
constexpr size_t OFF_KB = al256(OFF_QB + (size_t)16 * SEQ * 96 * 2);
constexpr size_t OFF_VT = al256(OFF_KB + (size_t)16 * SEQ * 96 * 2);
constexpr size_t OFF_KV = al256(OFF_VT + (size_t)16 * 64 * SEQ * 2);
constexpr size_t OFF_DEC = al256(OFF_KV + (size_t)4 * NCHK * 4 * 2 * 4096 * 4);
constexpr size_t OFF_HL = al256(OFF_DEC + (size_t)4 * NCHK * 4 * 2 * 64 * 4);
constexpr size_t OFF_Y = al256(OFF_HL + (size_t)4 * NCHK * 2 * 16 * 64 * 2 * 4);
constexpr size_t OFF_END = al256(OFF_Y + (size_t)MT * 256 * 2);
constexpr size_t OFF_MIXOUT = OFF_P;
constexpr size_t OFF_ZPRE = OFF_P;
constexpr size_t OFF_ACT = OFF_MIXIN;
constexpr size_t OFF_FFNOUT = OFF_QB;
static_assert((size_t)MT * D * 4 <= (size_t)MT * INC * 2, "mixout alias");
static_assert((size_t)8448 * 1024 * 4 <= 2 * (size_t)16 * SEQ * 96 * 2, "ffnout alias");

struct Params { const float* in[36]; float* out; char* ws; };

DI float bf2f(us v) { return __uint_as_float(((unsigned)v) << 16); }
DI us f2bf(float x) { unsigned u = __float_as_uint(x); u += 0x7fffu + ((u >> 16) & 1u); return (us)(u >> 16); }
DI unsigned pk2(float lo, float hi) { return (unsigned)f2bf(lo) | ((unsigned)f2bf(hi) << 16); }
DI float lo_bf(unsigned w) { return __uint_as_float(w << 16); }
DI float hi_bf(unsigned w) { return __uint_as_float(w & 0xffff0000u); }
DI int tidx() { int t; asm volatile("v_mov_b32 %0, %1" : "=v"(t) : "v"(threadIdx.x)); return t; }
DI int crow(int i, int hh) { return (i & 3) + 8 * (i >> 2) + 4 * hh; }
DI float sigmoidf_(float x) { return 1.f / (1.f + __expf(-x)); }
DI float gelu_t(float x) { float u = 0.7978845608028654f * (x + 0.044715f * x * x * x); return x / (1.f + __expf(-2.f * u)); }
DI float silu_(float x) { return x / (1.f + __expf(-x)); }
DI float logsig(float z) { return fminf(z, 0.f) - log1pf(__expf(-fabsf(z))); }
DI void unpack8(u32x4 w, float* f) {
  f[0] = lo_bf(w[0]); f[1] = hi_bf(w[0]); f[2] = lo_bf(w[1]); f[3] = hi_bf(w[1]);
  f[4] = lo_bf(w[2]); f[5] = hi_bf(w[2]); f[6] = lo_bf(w[3]); f[7] = hi_bf(w[3]);
}
DI u32x4 pack8(const float* f) { u32x4 w = {pk2(f[0], f[1]), pk2(f[2], f[3]), pk2(f[4], f[5]), pk2(f[6], f[7])}; return w; }
DI long seqrow(int b, int s) { return s < 256 ? (long)MX + b * 256 + s : (long)b * 8192 + (s - 256); }
DI float wave_sum(float v) {
  v += __shfl_xor(v, 1); v += __shfl_xor(v, 2); v += __shfl_xor(v, 4); v += __shfl_xor(v, 8); v += __shfl_xor(v, 16); v += __shfl_xor(v, 32);
  return v;
}
DI const us* wl(const Params& p, int l) { return (const us*)(p.ws + OFF_WB) + (size_t)l * W_LAYER; }
DI const float* s5f(const Params& p, int l) { return (const float*)(p.ws + OFF_S5F) + (size_t)l * S_LAYER; }
DI const float* modv(const Params& p, int l, int v, int idx) { return (const float*)(p.ws + OFF_MOD) + ((size_t)(l * 5 + v) * 6 + idx) * 1024; }
DI float* stream_row(const Params& p, long m) { return m < MX ? p.out + m * 1024 : (float*)(p.ws + OFF_CTXS) + (m - MX) * 1024; }
DI const float* input_row(const Params& p, long m) { return m < MX ? p.in[0] + m * 1024 : p.in[2] + (m - MX) * 1024; }

DI void conv_tile(const float* src, us* dst, int K, int N, const float* scale, int tile, char* smem) {
  float* t = (float*)smem;
  const int tid = tidx(), tn = N / 32, tk = tile / tn, tc = tile % tn;
  __syncthreads();
  {
    int k = tid >> 3, c4 = (tid & 7) * 4;
    f32x4 v = *(const f32x4*)(src + (size_t)(tk * 32 + k) * N + tc * 32 + c4);
    float s = scale ? scale[tk * 32 + k] : 1.f;
    t[k * 33 + c4 + 0] = v[0] * s; t[k * 33 + c4 + 1] = v[1] * s; t[k * 33 + c4 + 2] = v[2] * s; t[k * 33 + c4 + 3] = v[3] * s;
  }
  __syncthreads();
  if (tid < 128) {
    int n = tid >> 2, k8 = (tid & 3) * 8; float f[8];
#pragma unroll
    for (int j = 0; j < 8; ++j) f[j] = t[(k8 + j) * 33 + n];
    *(u32x4*)(dst + (size_t)(tc * 32 + n) * K + tk * 32 + k8) = pack8(f);
  }
}
constexpr int NCONV_LAYER = (1024 / 32) * (2176 / 32) + 32 * 32 + 32 * (5632 / 32) + (2816 / 32) * 32 + 7 * 12 + 3 * 16 + 8 * 8;
DI void conv_task(const Params& p, int it, char* smem) {
  int l = it / NCONV_LAYER; it -= l * NCONV_LAYER;
  us* wb = (us*)(p.ws + OFF_WB) + (size_t)l * W_LAYER;
  int nt;
  nt = 32 * 68;  if (it < nt) { conv_tile(p.in[10] + (size_t)l * 1024 * 2176, wb + W_IN, 1024, 2176, nullptr, it, smem); return; } it -= nt;
  nt = 32 * 32;  if (it < nt) { conv_tile(p.in[31] + (size_t)l * 1024 * 1024, wb + W_OUT, 1024, 1024, nullptr, it, smem); return; } it -= nt;
  nt = 32 * 176; if (it < nt) { conv_tile(p.in[32] + (size_t)l * 1024 * 5632, wb + W_UP, 1024, 5632, nullptr, it, smem); return; } it -= nt;
  nt = 88 * 32;  if (it < nt) { conv_tile(p.in[35] + (size_t)l * 2816 * 1024, wb + W_DN, 2816, 1024, nullptr, it, smem); return; } it -= nt;
  nt = 7 * 12;   if (it < nt) { conv_tile(p.in[28] + (size_t)l * 224 * 384, wb + W_UQ, 224, 384, p.in[27] + l * 224, it, smem); return; } it -= nt;
  nt = 3 * 16;   if (it < nt) { conv_tile(p.in[30] + (size_t)l * 96 * 512, wb + W_UKV, 96, 512, p.in[29] + l * 96, it, smem); return; } it -= nt;
  conv_tile(p.in[25] + (size_t)l * 256 * 256, wb + W_GLU, 256, 256, nullptr, it, smem);
}
DI void mod_task(const Params& p, int it, char* smem) {
  float* sc = (float*)smem;
  float* red = sc + 5 * 1024;
  const int tid = tidx(), l = it / 192, jb = it % 192;
  __syncthreads();
  for (int e = tid; e < 5 * 1024; e += 256) {
    int v = e >> 10, k = e & 1023; float c = v < 4 ? p.in[1][v * 1024 + k] : p.in[3][k];
    sc[e] = silu_(c);
  }
  __syncthreads();
  const int col = tid & 31, ks = tid >> 5;
  const float* w = p.in[4] + (size_t)l * 1024 * 6144 + jb * 32 + col;
  float a0 = 0, a1 = 0, a2 = 0, a3 = 0, a4 = 0;
#pragma unroll 8
  for (int k = ks * 128; k < ks * 128 + 128; ++k) {
    float wv = w[(size_t)k * 6144];
    a0 += sc[k] * wv; a1 += sc[1024 + k] * wv; a2 += sc[2048 + k] * wv; a3 += sc[3072 + k] * wv; a4 += sc[4096 + k] * wv;
  }
  float* rp = red + (ks * 32 + col) * 5;
  rp[0] = a0; rp[1] = a1; rp[2] = a2; rp[3] = a3; rp[4] = a4;
  __syncthreads();
  if (tid < 160) {
    int v = tid >> 5, c = tid & 31; float s = 0;
    for (int q = 0; q < 8; ++q) s += red[(q * 32 + c) * 5 + v];
    int j = jb * 32 + c;
    ((float*)(p.ws + OFF_MOD))[(size_t)(l * 5 + v) * 6144 + j] = s + p.in[5][l * 6144 + j];
  }
}
DI void s5pre_task(const Params& p, int it) {
  int gid = it * 256 + tidx();
  int pp = gid & 63, g = (gid >> 6) & 15, d = (gid >> 10) & 1, l = gid >> 11;
  int idx = ((l * 2 + d) * 16 + g) * 64 + pp;
  float are = p.in[17][idx], aim = p.in[18][idx];
  float dt = expf(p.in[19][(l * 2 + d) * 16 + g]);
  float mag = expf(are * dt), lr = mag * cosf(aim * dt), li = mag * sinf(aim * dt);
  float magT = expf(are * dt * 64.f), tr = magT * cosf(aim * dt * 64.f), ti = magT * sinf(aim * dt * 64.f);
  float nr = lr - 1.f, ni = li, den = are * are + aim * aim;
  float cr = (nr * are + ni * aim) / den, ci = (ni * are - nr * aim) / den;
  float* sf = (float*)(p.ws + OFF_S5F) + (size_t)l * S_LAYER;
  int o2 = ((d * 16 + g) * 64 + pp);
  sf[S_LAMB + o2 * 2] = lr; sf[S_LAMB + o2 * 2 + 1] = li;
  sf[S_LAMT + o2 * 2] = tr; sf[S_LAMT + o2 * 2 + 1] = ti;
  for (int i = 0; i < 16; ++i) {
    float br = p.in[20][(size_t)idx * 16 + i], bi = p.in[21][(size_t)idx * 16 + i];
    sf[S_BBAR + ((size_t)o2 * 16 + i) * 2] = cr * br - ci * bi;
    sf[S_BBAR + ((size_t)o2 * 16 + i) * 2 + 1] = cr * bi + ci * br;
  }
  us* cm = (us*)(p.ws + OFF_WB) + (size_t)l * W_LAYER + W_CM;
  for (int o = 0; o < 16; ++o) {
    size_t ci_ = ((size_t)((l * 2 + d) * 16 + g) * 16 + o) * 64 + pp;
    cm[((size_t)(d * 16 + g) * 16 + o) * 128 + pp] = f2bf(p.in[22][ci_]);
    cm[((size_t)(d * 16 + g) * 16 + o) * 128 + 64 + pp] = f2bf(-p.in[23][ci_]);
  }
}
DI void rope_task(const Params& p, int it) {
  int gid = it * 256 + tidx();
  int pos = gid >> 3, f = gid & 7;
  float inv = powf(10000.f, -(float)f / 8.f), ang = (float)pos * inv;
  float* r = (float*)(p.ws + OFF_ROPE);
  r[gid * 2] = cosf(ang); r[gid * 2 + 1] = sinf(ang);
}
DI void sguw_task(const Params& p, int it) {
  int gid = it * 256 + tidx();
  int l = gid >> 14, e = (gid & 16383) * 4;
  f32x4 v = *(const f32x4*)(p.in[12] + (size_t)l * 65536 + e);
  u32x2 w = {pk2(v[0], v[1]), pk2(v[2], v[3])};
  *(u32x2*)((us*)(p.ws + OFF_WB) + (size_t)l * W_LAYER + W_SGU + e) = w;
}

template <int MODE>
DI void row_task(const Params& p, int l, long m, const float* yrow) {
  const int lane = tidx() & 63, v = m < MX ? (int)(m >> 13) : 4;
  float x[16];
  if (MODE == 0) {
    const float* src = input_row(p, m);
#pragma unroll
    for (int j = 0; j < 4; ++j) { f32x4 t = *(const f32x4*)(src + (j * 64 + lane) * 4); x[4 * j] = t[0]; x[4 * j + 1] = t[1]; x[4 * j + 2] = t[2]; x[4 * j + 3] = t[3]; }
  } else {
    float y[16]; float ss = 0;
    const float* xo = (MODE == 1 && l == 0) ? input_row(p, m) : stream_row(p, m);
#pragma unroll
    for (int j = 0; j < 4; ++j) {
      f32x4 t = *(const f32x4*)(yrow + (j * 64 + lane) * 4); y[4 * j] = t[0]; y[4 * j + 1] = t[1]; y[4 * j + 2] = t[2]; y[4 * j + 3] = t[3];
      f32x4 u = *(const f32x4*)(xo + (j * 64 + lane) * 4); x[4 * j] = u[0]; x[4 * j + 1] = u[1]; x[4 * j + 2] = u[2]; x[4 * j + 3] = u[3];
    }
#pragma unroll
    for (int j = 0; j < 16; ++j) ss += y[j] * y[j];
    ss = wave_sum(ss);
    float rstd = rsqrtf(ss * (1.f / 1024.f) + EPS);
    const float* gp = (MODE == 1 ? p.in[7] : p.in[9]) + l * 1024;
    const float* gt = modv(p, l, v, MODE == 1 ? 2 : 5);
    float* dst = stream_row(p, m);
#pragma unroll
    for (int j = 0; j < 4; ++j) {
      int c = (j * 64 + lane) * 4;
      f32x4 g4 = *(const f32x4*)(gp + c), t4 = *(const f32x4*)(gt + c), o;
#pragma unroll
      for (int q = 0; q < 4; ++q) { x[4 * j + q] += t4[q] * (y[4 * j + q] * rstd * g4[q]); o[q] = x[4 * j + q]; }
      *(f32x4*)(dst + c) = o;
    }
    if (MODE == 2 && l == 1) return;
  }
  const int ln = (MODE == 2) ? 1 : l;
  const float* g = (MODE == 1 ? p.in[8] : p.in[6]) + ln * 1024;
  const float* sh = modv(p, ln, v, MODE == 1 ? 3 : 0);
  const float* sc = modv(p, ln, v, MODE == 1 ? 4 : 1);
  float ss = 0;
#pragma unroll
  for (int j = 0; j < 16; ++j) ss += x[j] * x[j];
  ss = wave_sum(ss);
  float rstd = rsqrtf(ss * (1.f / 1024.f) + EPS);
  us* hx = (us*)(p.ws + OFF_HX) + m * 1024;
#pragma unroll
  for (int j = 0; j < 4; ++j) {
    int c = (j * 64 + lane) * 4;
    f32x4 g4 = *(const f32x4*)(g + c), s4 = *(const f32x4*)(sh + c), c4 = *(const f32x4*)(sc + c); float h[4];
#pragma unroll
    for (int q = 0; q < 4; ++q) h[q] = (x[4 * j + q] * rstd * g4[q]) * (1.f + c4[q]) + s4[q];
    u32x2 w = {pk2(h[0], h[1]), pk2(h[2], h[3])};
    *(u32x2*)(hx + c) = w;
  }
}

struct GArgs { const us* A; int lda; const us* W; int K; long m0; int n0; void* out; int ldo; int l; };
template <int BK, int EPI, bool ROWSS>
DI void gemm_tile(const Params& p, const GArgs& g, char* smem) {
  constexpr int LS = BK + 8, CPR = BK / 8, NCH = 128 * CPR / 256;
  us* sA = (us*)smem; us* sB = sA + 2 * 128 * LS; float* rstd = (float*)(sB + 2 * 128 * LS);
  const int tid = tidx(), w = tid >> 6, lane = tid & 63, r = lane & 31, hh = lane >> 5, wm = w >> 1, wn = w & 1;
  __syncthreads();
  if (ROWSS) {
    int row = tid >> 1, half = tid & 1; float ss = 0;
    const us* ap = g.A + (size_t)row * g.lda + half * (g.K / 2);
    for (int c = 0; c < g.K / 16; ++c) { float f[8]; unpack8(*(const u32x4*)(ap + c * 8), f);
#pragma unroll
      for (int j = 0; j < 8; ++j) ss += f[j] * f[j]; }
    ss += __shfl_xor(ss, 1);
    if (!half) rstd[row] = rsqrtf(ss / (float)g.K + EPS);
  }
  u32x4 ra[NCH], rb[NCH];
  f32x16 acc[2][2];
#pragma unroll
  for (int i = 0; i < 2; ++i)
#pragma unroll
    for (int j = 0; j < 2; ++j)
#pragma unroll
      for (int q = 0; q < 16; ++q) acc[i][j][q] = 0.f;
#define GLOAD(kt) _Pragma("unroll") for (int j = 0; j < NCH; ++j) { int q = tid + 256 * j, row = q / CPR, cc = q % CPR; \
    ra[j] = *(const u32x4*)(g.A + (size_t)row * g.lda + (kt) * BK + cc * 8); rb[j] = *(const u32x4*)(g.W + (size_t)row * g.K + (kt) * BK + cc * 8); }
#define SWRITE(buf) _Pragma("unroll") for (int j = 0; j < NCH; ++j) { int q = tid + 256 * j, row = q / CPR, cc = q % CPR; \
    *(u32x4*)(sA + (buf) * 128 * LS + row * LS + cc * 8) = ra[j]; *(u32x4*)(sB + (buf) * 128 * LS + row * LS + cc * 8) = rb[j]; }
  GLOAD(0); SWRITE(0); __syncthreads();
  const int KT = g.K / BK;
  for (int kt = 0; kt < KT; ++kt) {
    if (kt + 1 < KT) { GLOAD(kt + 1); }
    const us* a0 = sA + (kt & 1) * 128 * LS + (wm * 64 + r) * LS + hh * 8;
    const us* b0 = sB + (kt & 1) * 128 * LS + (wn * 64 + r) * LS + hh * 8;
#pragma unroll
    for (int ks = 0; ks < BK / 16; ++ks) {
      bf16x8 af0 = *(const bf16x8*)(a0 + ks * 16), af1 = *(const bf16x8*)(a0 + 32 * LS + ks * 16);
      bf16x8 bf0 = *(const bf16x8*)(b0 + ks * 16), bf1 = *(const bf16x8*)(b0 + 32 * LS + ks * 16);
      acc[0][0] = MFMA(af0, bf0, acc[0][0]); acc[0][1] = MFMA(af0, bf1, acc[0][1]);
      acc[1][0] = MFMA(af1, bf0, acc[1][0]); acc[1][1] = MFMA(af1, bf1, acc[1][1]);
    }
    if (kt + 1 < KT) { SWRITE((kt + 1) & 1); }
    __syncthreads();
  }
#undef GLOAD
#undef SWRITE
#pragma unroll
  for (int si = 0; si < 2; ++si)
#pragma unroll
    for (int sj = 0; sj < 2; ++sj) {
      const int col = wn * 64 + sj * 32 + r, n = g.n0 + col;
#pragma unroll
      for (int i = 0; i < 16; ++i) {
        const int row = wm * 64 + si * 32 + crow(i, hh);
        const long m = g.m0 + row;
        float v = acc[si][sj][i];
        if (EPI == 0) { ((us*)g.out)[m * g.ldo + n] = f2bf(v); }
        else if (EPI == 1) { ((float*)g.out)[m * g.ldo + n] = v; }
        else if (EPI == 2) {
          v *= rstd[row] * QSCALE;
          float pv = __shfl_xor(v, 8);
          const int head = n / 96, j = n - head * 96;
          const bool isx = m < MX; const int t = isx ? (int)(m & 8191) : (int)((m - MX) & 255);
          const int b = isx ? (int)(m >> 13) : (int)((m - MX) >> 8);
          if (isx && j >= 64) {
            int jj = (j - 64) & 15, blk = (j - 64) >> 4, f = jj & 7, pos = blk ? (t & 63) : (t >> 6);
            const float* rp = (const float*)(p.ws + OFF_ROPE) + (pos * 8 + f) * 2; float cs = rp[0], sn = rp[1];
            v = (jj < 8) ? v * cs - pv * sn : pv * sn + v * cs;
          }
          const int s = isx ? 256 + t : t;
          ((us*)(p.ws + OFF_QB))[((size_t)(b * 4 + head) * SEQ + s) * 96 + j] = f2bf(v);
        } else if (EPI == 3) {
          v *= rstd[row];
          const int head = n >> 7, j = n & 127;
          const bool isx = m < MX; const int t = isx ? (int)(m & 8191) : (int)((m - MX) & 255);
          const int b = isx ? (int)(m >> 13) : (int)((m - MX) >> 8);
          const int s = isx ? 256 + t : t;
          if (j < 64) ((us*)(p.ws + OFF_KB))[((size_t)(b * 4 + head) * SEQ + s) * 96 + j] = f2bf(v);
          else ((us*)(p.ws + OFF_VT))[((size_t)(b * 4 + head) * 64 + (j - 64)) * SEQ + s] = f2bf(v);
        } else if (EPI == 4) {
          float y = bf2f(((const us*)(p.ws + OFF_Y))[m * 256 + n]);
          v += p.in[26][g.l * 256 + n];
          ((us*)(p.ws + OFF_MIXIN))[m * 1024 + 512 + n] = f2bf(y * sigmoidf_(v));
        }
      }
    }
}

DI void kr_task(const Params& p, long m0) {
  const int tid = tidx(), row = tid >> 1, blk = tid & 1; const long m = m0 + row;
  const us* src = (const us*)(p.ws + OFF_P) + m * INC + 2144 + blk * 16;
  float v[16], o[16]; unpack8(*(const u32x4*)src, v); unpack8(*(const u32x4*)(src + 8), v + 8);
  const bool isx = m < MX; const int t = isx ? (int)(m & 8191) : (int)((m - MX) & 255);
  const int b = isx ? (int)(m >> 13) : (int)((m - MX) >> 8), s = isx ? 256 + t : t;
  if (isx) {
    int pos = blk ? (t & 63) : (t >> 6);
    const float* rp = (const float*)(p.ws + OFF_ROPE) + pos * 16;
#pragma unroll
    for (int f = 0; f < 8; ++f) { float cs = rp[2 * f], sn = rp[2 * f + 1]; o[f] = v[f] * cs - v[f + 8] * sn; o[f + 8] = v[f] * sn + v[f + 8] * cs; }
  } else {
#pragma unroll
    for (int f = 0; f < 16; ++f) o[f] = v[f];
  }
  u32x4 w0 = pack8(o), w1 = pack8(o + 8);
#pragma unroll
  for (int hd = 0; hd < 4; ++hd) {
    us* dst = (us*)(p.ws + OFF_KB) + ((size_t)(b * 4 + hd) * SEQ + s) * 96 + 64 + blk * 16;
    *(u32x4*)dst = w0; *(u32x4*)(dst + 8) = w1;
  }
}

DI void sgu_task(const Params& p, int l, int chunk, int h, char* smem) {
  us* Vt = (us*)smem;
  const int tid = tidx(), w = tid >> 6, lane = tid & 63, r = lane & 31, hh = lane >> 5;
  const long m0 = (long)chunk * 128;
  const us* P = (const us*)(p.ws + OFF_P);
  __syncthreads();
  {
    int row = tid >> 1, dh = (tid & 1) * 32; float v[32]; float ss = 0;
    const us* src = P + (m0 + row) * INC + 256 + h * 64 + dh;
#pragma unroll
    for (int c = 0; c < 4; ++c) unpack8(*(const u32x4*)(src + c * 8), v + c * 8);
#pragma unroll
    for (int j = 0; j < 32; ++j) { v[j] = gelu_t(v[j]); ss += v[j] * v[j]; }
    ss += __shfl_xor(ss, 1);
    float rstd = rsqrtf(ss * (1.f / 64.f) + EPS);
    const float* gn = p.in[11] + l * 256 + h * 64 + dh;
#pragma unroll
    for (int j = 0; j < 32; ++j) Vt[(dh + j) * 136 + row] = f2bf(v[j] * rstd * gn[j]);
  }
  __syncthreads();
  const us* Wsp = wl(p, l) + W_SGU + (size_t)h * 16384 + (size_t)(w * 32 + r) * 128 + hh * 8;
  f32x16 a0, a1;
#pragma unroll
  for (int q = 0; q < 16; ++q) { a0[q] = 0.f; a1[q] = 0.f; }
#pragma unroll
  for (int ks = 0; ks < 8; ++ks) {
    bf16x8 af = *(const bf16x8*)(Wsp + ks * 16);
    bf16x8 b0 = *(const bf16x8*)(Vt + r * 136 + ks * 16 + hh * 8), b1 = *(const bf16x8*)(Vt + (32 + r) * 136 + ks * 16 + hh * 8);
    a0 = MFMA(af, b0, a0); a1 = MFMA(af, b1, a1);
  }
  us* out = (us*)(p.ws + OFF_MIXIN);
#pragma unroll
  for (int i = 0; i < 16; ++i) {
    int t = w * 32 + crow(i, hh); float bs = p.in[13][l * 512 + h * 128 + t];
    const us* pu = P + (m0 + t) * INC + h * 64;
    float u0 = gelu_t(bf2f(pu[r])), u1 = gelu_t(bf2f(pu[32 + r]));
    out[(m0 + t) * 1024 + h * 64 + r] = f2bf(u0 * (a0[i] + bs));
    out[(m0 + t) * 1024 + h * 64 + 32 + r] = f2bf(u1 * (a1[i] + bs));
  }
}

DI void gla_gate_dir(const Params& p, int l, const us* Prow0, int h, int d, float* sW, float* G) {
  const int tid = tidx();
  const float* wg = p.in[14] + (size_t)l * 2 * 16 * 256;
#pragma unroll
  for (int j = 0; j < 4; ++j) { int e = tid + 256 * j, rr = e >> 6, ch = e & 63; sW[e] = wg[(d * 16 + rr) * 256 + h * 64 + ch]; }
  __syncthreads();
  {
    int t = tid >> 2, q4 = tid & 3; float gl[16];
    const us* src = Prow0 + (size_t)t * INC + 1536 + d * 16;
    unpack8(*(const u32x4*)src, gl); unpack8(*(const u32x4*)(src + 8), gl + 8);
    const float* bg = p.in[15] + l * 512 + d * 256 + h * 64 + q4 * 16;
#pragma unroll
    for (int c = 0; c < 16; ++c) {
      float z = bg[c];
#pragma unroll
      for (int rr = 0; rr < 16; ++rr) z += gl[rr] * sW[rr * 64 + q4 * 16 + c];
      G[t * 64 + q4 * 16 + c] = logsig(z) * (1.f / 16.f);
    }
  }
  __syncthreads();
  if (tid < 64) {
    float run = 0;
    if (d == 0) { for (int t = 0; t < 64; ++t) { run += G[t * 64 + tid]; G[t * 64 + tid] = run; } }
    else { for (int t = 63; t >= 0; --t) { run += G[t * 64 + tid]; G[t * 64 + tid] = run; } }
  }
  __syncthreads();
}
DI size_t gla_idx(int b, int c, int h, int d) { return (size_t)(((b * NCHK + c) * 4 + h) * 2 + d); }

DI void gla1_task(const Params& p, int l, int b, int c, int h, char* smem) {
  float* G0 = (float*)smem; float* G1 = G0 + 4096; float* sW = G1 + 4096;
  us* KeT = (us*)(sW + 1024);
  us* Vt = KeT + 2 * 64 * 72;
  const int tid = tidx(), w = tid >> 6, lane = tid & 63, r = lane & 31, hh = lane >> 5;
  const long m0 = seqrow(b, c * 64);
  const us* P0 = (const us*)(p.ws + OFF_P) + m0 * INC;
  __syncthreads();
  gla_gate_dir(p, l, P0, h, 0, sW, G0);
  gla_gate_dir(p, l, P0, h, 1, sW, G1);
  {
    int t = tid >> 2, q4 = tid & 3; float kk[16], vv[16];
    const us* sk = P0 + (size_t)t * INC + 768 + h * 64 + q4 * 16;
    const us* sv = P0 + (size_t)t * INC + 1024 + h * 64 + q4 * 16;
    unpack8(*(const u32x4*)sk, kk); unpack8(*(const u32x4*)(sk + 8), kk + 8);
    unpack8(*(const u32x4*)sv, vv); unpack8(*(const u32x4*)(sv + 8), vv + 8);
#pragma unroll
    for (int cc = 0; cc < 16; ++cc) {
      int ch = q4 * 16 + cc;
      KeT[ch * 72 + t] = f2bf(kk[cc] * __expf(G0[63 * 64 + ch] - G0[t * 64 + ch]));
      KeT[(64 + ch) * 72 + t] = f2bf(kk[cc] * __expf(G1[ch] - G1[t * 64 + ch]));
      Vt[ch * 72 + t] = f2bf(vv[cc]);
    }
    if (tid < 128) {
      int d = tid >> 6, ch = tid & 63;
      ((float*)(p.ws + OFF_DEC))[gla_idx(b, c, h, d) * 64 + ch] = __expf(d ? G1[ch] : G0[63 * 64 + ch]);
    }
  }
  __syncthreads();
  {
    const int d = w >> 1, mt = w & 1;
    float* kv = (float*)(p.ws + OFF_KV) + gla_idx(b, c, h, d) * 4096;
#pragma unroll
    for (int nt = 0; nt < 2; ++nt) {
      f32x16 acc;
#pragma unroll
      for (int q = 0; q < 16; ++q) acc[q] = 0.f;
#pragma unroll
      for (int ks = 0; ks < 4; ++ks) {
        bf16x8 a = *(const bf16x8*)(Vt + (mt * 32 + r) * 72 + ks * 16 + hh * 8);
        bf16x8 bb = *(const bf16x8*)(KeT + (d * 64 + nt * 32 + r) * 72 + ks * 16 + hh * 8);
        acc = MFMA(a, bb, acc);
      }
#pragma unroll
      for (int i = 0; i < 16; ++i) kv[(mt * 32 + crow(i, hh)) * 64 + nt * 32 + r] = acc[i];
    }
  }
}
DI int gla_order(int d, int j) { return d == 0 ? j : (j < 4 ? 3 - j : 135 - j); }
DI void gla2_task(const Params& p, int it) {
  const int gid = it * 256 + tidx();
  const int e = gid & 4095, d = (gid >> 12) & 1, h = (gid >> 13) & 3, b = gid >> 15, k = e & 63;
  float* KV = (float*)(p.ws + OFF_KV); const float* DEC = (const float*)(p.ws + OFF_DEC);
  float s = 0;
  for (int j0 = 0; j0 < NCHK; j0 += 4) {
    float kv0, kv1, kv2, kv3, dc0, dc1, dc2, dc3;
    const size_t i0 = gla_idx(b, gla_order(d, j0), h, d), i1 = gla_idx(b, gla_order(d, j0 + 1), h, d);
    const size_t i2 = gla_idx(b, gla_order(d, j0 + 2), h, d), i3 = gla_idx(b, gla_order(d, j0 + 3), h, d);
    kv0 = KV[i0 * 4096 + e]; kv1 = KV[i1 * 4096 + e]; kv2 = KV[i2 * 4096 + e]; kv3 = KV[i3 * 4096 + e];
    dc0 = DEC[i0 * 64 + k]; dc1 = DEC[i1 * 64 + k]; dc2 = DEC[i2 * 64 + k]; dc3 = DEC[i3 * 64 + k];
    KV[i0 * 4096 + e] = s; s = dc0 * s + kv0;
    KV[i1 * 4096 + e] = s; s = dc1 * s + kv1;
    KV[i2 * 4096 + e] = s; s = dc2 * s + kv2;
    KV[i3 * 4096 + e] = s; s = dc3 * s + kv3;
  }
}
DI void gla3_task(const Params& p, int l, int b, int c, int h, char* smem) {
  float* G = (float*)smem;
  us* Qin = (us*)(smem + 17408);
  us* Kin = Qin + 64 * 72; us* Vt = Kin + 64 * 72; us* ST = Vt + 64 * 72; us* Sc = ST + 64 * 72;
  float* sW = (float*)Sc;
  const int tid = tidx(), w = tid >> 6, lane = tid & 63, r = lane & 31, hh = lane >> 5;
  const long m0 = seqrow(b, c * 64);
  const us* P0 = (const us*)(p.ws + OFF_P) + m0 * INC;
  const int t_ = tid >> 2, q4 = tid & 3;
  __syncthreads();
  {
    float vv[16]; const us* sv = P0 + (size_t)t_ * INC + 1024 + h * 64 + q4 * 16;
    unpack8(*(const u32x4*)sv, vv); unpack8(*(const u32x4*)(sv + 8), vv + 8);
#pragma unroll
    for (int cc = 0; cc < 16; ++cc) Vt[(q4 * 16 + cc) * 72 + t_] = f2bf(vv[cc]);
  }
  f32x16 oacc;
#pragma unroll
  for (int q = 0; q < 16; ++q) oacc[q] = 0.f;
  const int mt = w >> 1, nt = w & 1;
  for (int d = 0; d < 2; ++d) {
    gla_gate_dir(p, l, P0, h, d, sW, G);
    {
      float qq[16], kk[16], qo[16], ko[16];
      const us* sq = P0 + (size_t)t_ * INC + 512 + h * 64 + q4 * 16;
      const us* sk = P0 + (size_t)t_ * INC + 768 + h * 64 + q4 * 16;
      unpack8(*(const u32x4*)sq, qq); unpack8(*(const u32x4*)(sq + 8), qq + 8);
      unpack8(*(const u32x4*)sk, kk); unpack8(*(const u32x4*)(sk + 8), kk + 8);
#pragma unroll
      for (int cc = 0; cc < 16; ++cc) { float gg = G[t_ * 64 + q4 * 16 + cc]; qo[cc] = qq[cc] * 0.125f * __expf(gg); ko[cc] = kk[cc] * __expf(-gg); }
      *(u32x4*)(Qin + t_ * 72 + q4 * 16) = pack8(qo); *(u32x4*)(Qin + t_ * 72 + q4 * 16 + 8) = pack8(qo + 8);
      *(u32x4*)(Kin + t_ * 72 + q4 * 16) = pack8(ko); *(u32x4*)(Kin + t_ * 72 + q4 * 16 + 8) = pack8(ko + 8);
      const float* ss = (const float*)(p.ws + OFF_KV) + gla_idx(b, c, h, d) * 4096 + tid * 16;
      float sf[16];
#pragma unroll
      for (int j = 0; j < 4; ++j) { f32x4 t4 = *(const f32x4*)(ss + j * 4); sf[4 * j] = t4[0]; sf[4 * j + 1] = t4[1]; sf[4 * j + 2] = t4[2]; sf[4 * j + 3] = t4[3]; }
      const int v_ = tid >> 2, k0 = (tid & 3) * 16;
      *(u32x4*)(ST + v_ * 72 + k0) = pack8(sf); *(u32x4*)(ST + v_ * 72 + k0 + 8) = pack8(sf + 8);
    }
    __syncthreads();
    {
      const int tt = mt, st = nt;
      const bool need = d == 0 ? st <= tt : st >= tt;
      f32x16 sc;
#pragma unroll
      for (int q = 0; q < 16; ++q) sc[q] = 0.f;
      if (need) {
#pragma unroll
        for (int ks = 0; ks < 4; ++ks) {
          bf16x8 a = *(const bf16x8*)(Qin + (tt * 32 + r) * 72 + ks * 16 + hh * 8);
          bf16x8 bb = *(const bf16x8*)(Kin + (st * 32 + r) * 72 + ks * 16 + hh * 8);
          sc = MFMA(a, bb, sc);
        }
      }
#pragma unroll
      for (int i = 0; i < 16; ++i) {
        int trow = tt * 32 + crow(i, hh), scol = st * 32 + r;
        bool keep = d == 0 ? scol <= trow : scol >= trow;
        Sc[trow * 72 + scol] = f2bf(keep ? sc[i] : 0.f);
      }
    }
    __syncthreads();
#pragma unroll
    for (int ks = 0; ks < 4; ++ks) {
      bf16x8 a = *(const bf16x8*)(Sc + (mt * 32 + r) * 72 + ks * 16 + hh * 8);
      bf16x8 bb = *(const bf16x8*)(Vt + (nt * 32 + r) * 72 + ks * 16 + hh * 8);
      oacc = MFMA(a, bb, oacc);
    }
#pragma unroll
    for (int ks = 0; ks < 4; ++ks) {
      bf16x8 a = *(const bf16x8*)(Qin + (mt * 32 + r) * 72 + ks * 16 + hh * 8);
      bf16x8 bb = *(const bf16x8*)(ST + (nt * 32 + r) * 72 + ks * 16 + hh * 8);
      oacc = MFMA(a, bb, oacc);
    }
    __syncthreads();
  }
  float* Ob = (float*)smem;
#pragma unroll
  for (int i = 0; i < 16; ++i) Ob[(mt * 32 + crow(i, hh)) * 68 + nt * 32 + r] = oacc[i];
  __syncthreads();
  {
    float o[16], rr[16]; float ss = 0;
#pragma unroll
    for (int cc = 0; cc < 16; ++cc) { o[cc] = Ob[t_ * 68 + q4 * 16 + cc]; ss += o[cc] * o[cc]; }
    ss += __shfl_xor(ss, 1); ss += __shfl_xor(ss, 2);
    float rstd = rsqrtf(ss * (1.f / 64.f) + EPS);
    const us* sr = P0 + (size_t)t_ * INC + 1280 + h * 64 + q4 * 16;
    unpack8(*(const u32x4*)sr, rr); unpack8(*(const u32x4*)(sr + 8), rr + 8);
    const float* gn = p.in[16] + l * 256 + h * 64 + q4 * 16;
#pragma unroll
    for (int cc = 0; cc < 16; ++cc) o[cc] = o[cc] * rstd * gn[cc] * silu_(rr[cc]);
    us* dst = (us*)(p.ws + OFF_MIXIN) + (m0 + t_) * 1024 + 256 + h * 64 + q4 * 16;
    *(u32x4*)dst = pack8(o); *(u32x4*)(dst + 8) = pack8(o + 8);
  }
}

DI size_t hl_idx(int b, int c, int d, int g, int pp) { return ((size_t)(((b * NCHK + c) * 2 + d) * 16 + g) * 64 + pp) * 2; }
template <bool OUT>
DI void s5_task(const Params& p, int l, int b, int c, int gp, char* smem) {
  float* sU = (float*)smem;
  us* Hb = (us*)(smem + 8192);
  float* Yb = (float*)(smem + 8192 + 4 * 32 * 136 * 2);
  const int tid = tidx(), w = tid >> 6, lane = tid & 63, r = lane & 31, hh = lane >> 5;
  const long m0 = seqrow(b, c * 64);
  const us* P0 = (const us*)(p.ws + OFF_P) + m0 * INC;
  __syncthreads();
  {
    int t = tid >> 2, q4 = tid & 3; float f[8];
    unpack8(*(const u32x4*)(P0 + (size_t)t * INC + 1568 + gp * 32 + q4 * 8), f);
#pragma unroll
    for (int j = 0; j < 8; ++j) sU[t * 32 + q4 * 8 + j] = f[j];
  }
  __syncthreads();
  const int gl = w >> 1, d = w & 1, g = gp * 2 + gl, pp = lane;
  const float* sf = s5f(p, l);
  float Br[16], Bi[16];
  {
    const float* bb = sf + S_BBAR + ((size_t)((d * 16 + g) * 64 + pp) * 16) * 2;
#pragma unroll
    for (int j = 0; j < 8; ++j) { f32x4 t4 = *(const f32x4*)(bb + j * 4); Br[2 * j] = t4[0]; Bi[2 * j] = t4[1]; Br[2 * j + 1] = t4[2]; Bi[2 * j + 1] = t4[3]; }
  }
  const float lr = sf[S_LAMB + ((d * 16 + g) * 64 + pp) * 2], li = sf[S_LAMB + ((d * 16 + g) * 64 + pp) * 2 + 1];
  float hr = 0.f, hi = 0.f;
  float* HL = (float*)(p.ws + OFF_HL) + hl_idx(b, c, d, g, pp);
  if (OUT) { hr = HL[0]; hi = HL[1]; }
  const us* cm = wl(p, l) + W_CM + ((size_t)(d * 16 + g) * 16 + (r & 15)) * 128 + hh * 8;
  for (int half = 0; half < 2; ++half) {
    for (int jj = 0; jj < 32; ++jj) {
      const int j = half * 32 + jj, t = d ? 63 - j : j;
      const float* u = sU + t * 32 + gl * 16;
      float br = 0.f, bi = 0.f;
#pragma unroll
      for (int q = 0; q < 4; ++q) { f32x4 u4 = *(const f32x4*)(u + q * 4);
#pragma unroll
        for (int e = 0; e < 4; ++e) { br += Br[q * 4 + e] * u4[e]; bi += Bi[q * 4 + e] * u4[e]; } }
      float nr = lr * hr - li * hi + br, ni = lr * hi + li * hr + bi; hr = nr; hi = ni;
      if (OUT) { Hb[(w * 32 + (t & 31)) * 136 + pp] = f2bf(hr); Hb[(w * 32 + (t & 31)) * 136 + 64 + pp] = f2bf(hi); }
    }
    if (OUT) {
      __syncthreads();
      f32x16 acc;
#pragma unroll
      for (int q = 0; q < 16; ++q) acc[q] = 0.f;
#pragma unroll
      for (int ks = 0; ks < 8; ++ks) {
        bf16x8 a = *(const bf16x8*)(Hb + (w * 32 + r) * 136 + ks * 16 + hh * 8);
        bf16x8 bb = *(const bf16x8*)(cm + ks * 16);
        if (r >= 16) bb = (bf16x8){0, 0, 0, 0, 0, 0, 0, 0};
        acc = MFMA(a, bb, acc);
      }
      const int tbase = d ? (1 - half) * 32 : half * 32;
      if (r < 16) {
#pragma unroll
        for (int i = 0; i < 16; ++i) Yb[(w * 64 + tbase + crow(i, hh)) * 17 + r] = acc[i];
      }
      __syncthreads();
    }
  }
  if (!OUT) { HL[0] = hr; HL[1] = hi; return; }
  {
    const int gl2 = tid >> 7, t = (tid >> 1) & 63, o8 = (tid & 1) * 8, g2 = gp * 2 + gl2; float y[8];
#pragma unroll
    for (int o = 0; o < 8; ++o) {
      float v = Yb[((gl2 * 2 + 0) * 64 + t) * 17 + o8 + o] + Yb[((gl2 * 2 + 1) * 64 + t) * 17 + o8 + o]
              + p.in[24][l * 256 + g2 * 16 + o8 + o] * sU[t * 32 + gl2 * 16 + o8 + o];
      y[o] = gelu_t(v);
    }
    *(u32x4*)((us*)(p.ws + OFF_Y) + (m0 + t) * 256 + g2 * 16 + o8) = pack8(y);
  }
}
DI void s5b_task(const Params& p, int l, int it) {
  const int gid = it * 256 + tidx();
  const int pp = gid & 63, g = (gid >> 6) & 15, d = (gid >> 10) & 1, b = gid >> 11;
  const float* sf = s5f(p, l);
  const float tr = sf[S_LAMT + ((d * 16 + g) * 64 + pp) * 2], ti = sf[S_LAMT + ((d * 16 + g) * 64 + pp) * 2 + 1];
  float* HL = (float*)(p.ws + OFF_HL);
  float hr = 0.f, hi = 0.f;
  for (int j = 0; j < NCHK; ++j) {
    const size_t ix = hl_idx(b, gla_order(d, j), d, g, pp);
    const float xr = HL[ix], xi = HL[ix + 1];
    HL[ix] = hr; HL[ix + 1] = hi;
    float nr = tr * hr - ti * hi + xr, ni = tr * hi + ti * hr + xi; hr = nr; hi = ni;
  }
}

DI void attn_task(const Params& p, int b, int h, int qs0, int nkeys, char* smem) {
  us* sK = (us*)smem;
  us* sV = sK + 2 * 64 * 104;
  const int tid = tidx(), w = tid >> 6, lane = tid & 63, r = lane & 31, hh = lane >> 5;
  const us* Kg = (const us*)(p.ws + OFF_KB) + (size_t)(b * 4 + h) * SEQ * 96;
  const us* Vg = (const us*)(p.ws + OFF_VT) + (size_t)(b * 4 + h) * 64 * SEQ;
  const us* Qg = (const us*)(p.ws + OFF_QB) + ((size_t)(b * 4 + h) * SEQ + qs0 + w * 32 + r) * 96 + hh * 8;
  bf16x8 qf[6];
#pragma unroll
  for (int ks = 0; ks < 6; ++ks) qf[ks] = *(const bf16x8*)(Qg + ks * 16);
  u32x4 rk[3], rv[2];
#define AGLOAD(kt) { _Pragma("unroll") for (int j = 0; j < 3; ++j) { int q = tid + 256 * j; rk[j] = *(const u32x4*)(Kg + (size_t)(kt) * 64 * 96 + q * 8); } \
    _Pragma("unroll") for (int j = 0; j < 2; ++j) { int q = tid + 256 * j, row = q >> 3, cc = q & 7; rv[j] = *(const u32x4*)(Vg + (size_t)row * SEQ + (kt) * 64 + cc * 8); } }
#define ASWRITE(buf) { _Pragma("unroll") for (int j = 0; j < 3; ++j) { int q = tid + 256 * j, row = q / 12, cc = q % 12; *(u32x4*)(sK + (buf) * 64 * 104 + row * 104 + cc * 8) = rk[j]; } \
    _Pragma("unroll") for (int j = 0; j < 2; ++j) { int q = tid + 256 * j, row = q >> 3, cc = q & 7; us* dv = sV + (buf) * 64 * 68 + row * 68 + cc * 8; \
      u32x2 lo = {rv[j][0], rv[j][1]}, hi2 = {rv[j][2], rv[j][3]}; *(u32x2*)dv = lo; *(u32x2*)(dv + 4) = hi2; } }
  f32x16 o0, o1;
#pragma unroll
  for (int q = 0; q < 16; ++q) { o0[q] = 0.f; o1[q] = 0.f; }
  float m_run = -1e30f, lsum = 0.f;
  const int NT = nkeys / 64;
  __syncthreads();
  AGLOAD(0); ASWRITE(0); __syncthreads();
  for (int kt = 0; kt < NT; ++kt) {
    if (kt + 1 < NT) AGLOAD(kt + 1);
    const us* k0 = sK + (kt & 1) * 64 * 104 + r * 104 + hh * 8;
    const us* v0 = sV + (kt & 1) * 64 * 68 + r * 68 + 4 * hh;
    f32x16 s0, s1;
#pragma unroll
    for (int q = 0; q < 16; ++q) { s0[q] = 0.f; s1[q] = 0.f; }
#pragma unroll
    for (int ks = 0; ks < 6; ++ks) {
      bf16x8 a0 = *(const bf16x8*)(k0 + ks * 16), a1 = *(const bf16x8*)(k0 + 32 * 104 + ks * 16);
      s0 = MFMA(a0, qf[ks], s0); s1 = MFMA(a1, qf[ks], s1);
    }
    float mx = s0[0];
#pragma unroll
    for (int i = 1; i < 16; ++i) mx = fmaxf(mx, s0[i]);
#pragma unroll
    for (int i = 0; i < 16; ++i) mx = fmaxf(mx, s1[i]);
    mx = fmaxf(mx, __shfl_xor(mx, 32));
    const float mn = fmaxf(m_run, mx), alpha = __builtin_amdgcn_exp2f(m_run - mn);
    m_run = mn;
    float ps = 0.f;
#pragma unroll
    for (int i = 0; i < 16; ++i) { s0[i] = __builtin_amdgcn_exp2f(s0[i] - mn); ps += s0[i]; }
#pragma unroll
    for (int i = 0; i < 16; ++i) { s1[i] = __builtin_amdgcn_exp2f(s1[i] - mn); ps += s1[i]; }
    lsum = lsum * alpha + ps;
#pragma unroll
    for (int i = 0; i < 16; ++i) { o0[i] *= alpha; o1[i] *= alpha; }
    bf16x8 pf[4];
    {
      u32x4 t0 = {pk2(s0[0], s0[1]), pk2(s0[2], s0[3]), pk2(s0[4], s0[5]), pk2(s0[6], s0[7])};
      u32x4 t1 = {pk2(s0[8], s0[9]), pk2(s0[10], s0[11]), pk2(s0[12], s0[13]), pk2(s0[14], s0[15])};
      u32x4 t2 = {pk2(s1[0], s1[1]), pk2(s1[2], s1[3]), pk2(s1[4], s1[5]), pk2(s1[6], s1[7])};
      u32x4 t3 = {pk2(s1[8], s1[9]), pk2(s1[10], s1[11]), pk2(s1[12], s1[13]), pk2(s1[14], s1[15])};
      pf[0] = __builtin_bit_cast(bf16x8, t0); pf[1] = __builtin_bit_cast(bf16x8, t1);
      pf[2] = __builtin_bit_cast(bf16x8, t2); pf[3] = __builtin_bit_cast(bf16x8, t3);
    }
#pragma unroll
    for (int kk = 0; kk < 4; ++kk) {
      u32x2 l0 = *(const u32x2*)(v0 + 16 * kk), h0 = *(const u32x2*)(v0 + 16 * kk + 8);
      u32x2 l1 = *(const u32x2*)(v0 + 32 * 68 + 16 * kk), h1 = *(const u32x2*)(v0 + 32 * 68 + 16 * kk + 8);
      u32x4 a0 = {l0[0], l0[1], h0[0], h0[1]}, a1 = {l1[0], l1[1], h1[0], h1[1]};
      o0 = MFMA(__builtin_bit_cast(bf16x8, a0), pf[kk], o0);
      o1 = MFMA(__builtin_bit_cast(bf16x8, a1), pf[kk], o1);
    }
    if (kt + 1 < NT) ASWRITE((kt + 1) & 1);
    __syncthreads();
  }
#undef AGLOAD
#undef ASWRITE
  lsum += __shfl_xor(lsum, 32);
  const float inv = 1.f / lsum;
  const long m = seqrow(b, qs0 + w * 32 + r);
  us* dst = (us*)(p.ws + OFF_MIXIN) + m * 1024 + 768 + h * 64;
#pragma unroll
  for (int gq = 0; gq < 4; ++gq) {
    u32x2 w0 = {pk2(o0[4 * gq] * inv, o0[4 * gq + 1] * inv), pk2(o0[4 * gq + 2] * inv, o0[4 * gq + 3] * inv)};
    u32x2 w1 = {pk2(o1[4 * gq] * inv, o1[4 * gq + 1] * inv), pk2(o1[4 * gq + 2] * inv, o1[4 * gq + 3] * inv)};
    *(u32x2*)(dst + 8 * gq + 4 * hh) = w0;
    *(u32x2*)(dst + 32 + 8 * gq + 4 * hh) = w1;
  }
}

DI void convact_task(const Params& p, int l, int it, int nrows) {
  const int T = it * 256 + tidx();
  if (T >= (nrows / 8) * 352) return;
  const int rb = T / 352, oct = T - rb * 352, c0 = oct * 8, i0 = rb * 8;
  const int slo = i0 < 8192 ? 0 : 8192, shi = i0 < 8192 ? 8192 : 8448;
  const us* Z = (const us*)(p.ws + OFF_ZPRE);
  const float* cw = p.in[33] + (size_t)l * 3 * DFF2; const float* cb = p.in[34] + (size_t)l * DFF2;
  float wa[3][8], wg[3][8], ba[8], bg[8];
#pragma unroll
  for (int j = 0; j < 3; ++j)
#pragma unroll
    for (int q = 0; q < 8; ++q) { wa[j][q] = cw[j * DFF2 + c0 + q]; wg[j][q] = cw[j * DFF2 + DFF + c0 + q]; }
#pragma unroll
  for (int q = 0; q < 8; ++q) { ba[q] = cb[c0 + q]; bg[q] = cb[DFF + c0 + q]; }
  float za[3][8], zg[3][8];
#define LDROW(slot, i) { if ((i) >= slo && (i) < shi) { unpack8(*(const u32x4*)(Z + (size_t)(i) * DFF2 + c0), za[slot]); unpack8(*(const u32x4*)(Z + (size_t)(i) * DFF2 + DFF + c0), zg[slot]); } \
    else { _Pragma("unroll") for (int q = 0; q < 8; ++q) { za[slot][q] = 0.f; zg[slot][q] = 0.f; } } }
  LDROW(0, i0 - 1); LDROW(1, i0);
  us* A = (us*)(p.ws + OFF_ACT);
#pragma unroll
  for (int ii = 0; ii < 8; ++ii) {
    const int i = i0 + ii;
    LDROW(2, i + 1);
    float o[8];
#pragma unroll
    for (int q = 0; q < 8; ++q) {
      float a = ba[q] + wa[0][q] * za[0][q] + wa[1][q] * za[1][q] + wa[2][q] * za[2][q];
      float gg = bg[q] + wg[0][q] * zg[0][q] + wg[1][q] * zg[1][q] + wg[2][q] * zg[2][q];
      o[q] = gelu_t(a) * gg;
    }
    *(u32x4*)(A + (size_t)i * DFF + c0) = pack8(o);
#pragma unroll
    for (int q = 0; q < 8; ++q) { za[0][q] = za[1][q]; za[1][q] = za[2][q]; zg[0][q] = zg[1][q]; zg[1][q] = zg[2][q]; }
  }
#undef LDROW
}

DI long chunk_row(int ch, int i) { return i < 8192 ? (long)ch * 8192 + i : (long)MX + ch * 256 + (i - 8192); }

__global__ void __launch_bounds__(256, 2) fwd_mega(Params p) {
  cg::grid_group grid = cg::this_grid();
  __shared__ __attribute__((aligned(16))) char smem[64512];
  const int G = gridDim.x, bid = blockIdx.x, wv = threadIdx.x >> 6;

  {
    const int n0 = 2 * NCONV_LAYER, n1 = n0 + 384, n2 = n1 + 16, n3 = n2 + 4, n4 = n3 + 128;
    for (int it = bid; it < n4; it += G) {
      if (it < n0) conv_task(p, it, smem);
      else if (it < n1) mod_task(p, it - n0, smem);
      else if (it < n2) s5pre_task(p, it - n1);
      else if (it < n3) rope_task(p, it - n2);
      else sguw_task(p, it - n3);
    }
  }
  grid.sync();
  for (int it = bid; it < MT / 4; it += G) row_task<0>(p, 0, (long)it * 4 + wv, nullptr);
  grid.sync();

  for (int l = 0; l < 2; ++l) {
    const us* W = wl(p, l);
    const int RT = l == 0 ? 264 : 256;
    for (int it = bid; it < 264 * 17; it += G) {
      int rt = it / 17, ct = it % 17;
      GArgs g{(const us*)(p.ws + OFF_HX) + (size_t)rt * 128 * D, D, W + W_IN + (size_t)ct * 128 * D, D, (long)rt * 128, ct * 128, p.ws + OFF_P, INC, l};
      gemm_tile<32, 0, false>(p, g, smem);
    }
    grid.sync();
    {
      const int n0 = RT * 4, n1 = n0 + 4 * NCHK * 4, n2 = n1 + 4 * NCHK * 8, n3 = n2 + 264 * 3, n4 = n3 + 264 * 4;
      for (int it = bid; it < n4; it += G) {
        if (it < n0) sgu_task(p, l, it >> 2, it & 3, smem);
        else if (it < n1) { int q = it - n0; gla1_task(p, l, q / (NCHK * 4), (q / 4) % NCHK, q & 3, smem); }
        else if (it < n2) { int q = it - n1; s5_task<false>(p, l, q / (NCHK * 8), (q / 8) % NCHK, q & 7, smem); }
        else if (it < n3) { int q = it - n2, rt = q / 3, ct = q % 3;
          GArgs g{(const us*)(p.ws + OFF_P) + (size_t)rt * 128 * INC + 1824, INC, W + W_UQ + (size_t)ct * 128 * 224, 224, (long)rt * 128, ct * 128, nullptr, 0, l};
          gemm_tile<32, 2, true>(p, g, smem); }
        else { int q = it - n3, rt = q >> 2, ct = q & 3;
          GArgs g{(const us*)(p.ws + OFF_P) + (size_t)rt * 128 * INC + 2048, INC, W + W_UKV + (size_t)ct * 128 * 96, 96, (long)rt * 128, ct * 128, nullptr, 0, l};
          gemm_tile<32, 3, true>(p, g, smem);
          if (ct == 0) kr_task(p, (long)rt * 128); }
      }
    }
    grid.sync();
    for (int it = bid; it < 512 + 32; it += G) { if (it < 512) gla2_task(p, it); else s5b_task(p, l, it - 512); }
    grid.sync();
    {
      const int c0 = l == 0 ? 0 : 4, nc = NCHK - c0;
      const int n0 = 1024, n1 = n0 + (l == 0 ? 32 : 0), n2 = n1 + 4 * nc * 4, n3 = n2 + 4 * nc * 8;
      for (int it = bid; it < n3; it += G) {
        if (it < n0) {
          int pair, qb;
          if (G == 512) { pair = (it & 7) * 2 + (it >> 9); qb = (it & 511) >> 3; } else { pair = it >> 6; qb = it & 63; }
          attn_task(p, pair >> 2, pair & 3, 256 + qb * 128, SEQ, smem);
        } else if (it < n1) { int q = it - n0; attn_task(p, q >> 3, (q >> 1) & 3, (q & 1) * 128, 256, smem); }
        else if (it < n2) { int q = it - n1; gla3_task(p, l, q / (nc * 4), c0 + (q / 4) % nc, q & 3, smem); }
        else { int q = it - n2; s5_task<true>(p, l, q / (nc * 8), c0 + (q / 8) % nc, q & 7, smem); }
      }
    }
    grid.sync();
    for (int it = bid; it < RT * 2; it += G) {
      int rt = it >> 1, ct = it & 1;
      GArgs g{(const us*)(p.ws + OFF_Y) + (size_t)rt * 128 * 256, 256, W + W_GLU + (size_t)ct * 128 * 256, 256, (long)rt * 128, ct * 128, nullptr, 0, l};
      gemm_tile<32, 4, false>(p, g, smem);
    }
    grid.sync();
    for (int it = bid; it < RT * 8; it += G) {
      int rt = it >> 3, ct = it & 7;
      GArgs g{(const us*)(p.ws + OFF_MIXIN) + (size_t)rt * 128 * D, D, W + W_OUT + (size_t)ct * 128 * D, D, (long)rt * 128, ct * 128, p.ws + OFF_MIXOUT, D, l};
      gemm_tile<32, 1, false>(p, g, smem);
    }
    grid.sync();
    for (int it = bid; it < RT * 32; it += G) { long m = (long)it * 4 + wv; row_task<1>(p, l, m, (const float*)(p.ws + OFF_MIXOUT) + m * 1024); }
    grid.sync();
    const int CRT = l == 0 ? 66 : 64, CROWS = CRT * 128;
    for (int ch = 0; ch < 4; ++ch) {
      for (int it = bid; it < CRT * 44; it += G) {
        int rt = it / 44, ct = it % 44;
        GArgs g{(const us*)(p.ws + OFF_HX) + (size_t)chunk_row(ch, rt * 128) * D, D, W + W_UP + (size_t)ct * 128 * D, D, (long)rt * 128, ct * 128, p.ws + OFF_ZPRE, DFF2, l};
        gemm_tile<32, 0, false>(p, g, smem);
      }
      grid.sync();
      for (int it = bid; it < (CROWS / 8 * 352 + 255) / 256; it += G) convact_task(p, l, it, CROWS);
      grid.sync();
      for (int it = bid; it < CRT * 8; it += G) {
        int rt = it >> 3, ct = it & 7;
        GArgs g{(const us*)(p.ws + OFF_ACT) + (size_t)rt * 128 * DFF, DFF, W + W_DN + (size_t)ct * 128 * DFF, DFF, (long)rt * 128, ct * 128, p.ws + OFF_FFNOUT, D, l};
        gemm_tile<32, 1, false>(p, g, smem);
      }
      grid.sync();
      for (int it = bid; it < CROWS / 4; it += G) { int i = it * 4 + wv; row_task<2>(p, l, chunk_row(ch, i), (const float*)(p.ws + OFF_FFNOUT) + (size_t)i * 1024); }
      grid.sync();
    }
  }
}

extern "C" void kernel_launch(void* const* d_in, const int* in_sizes, int n_in, void* d_out, int out_size,
                              void* d_ws, size_t ws_size, hipStream_t stream) {
  static int grid_blocks = 0;
  if (!grid_blocks) {
    int dev = 0, cus = 0, per_cu = 0;
    (void)hipGetDevice(&dev);
    (void)hipDeviceGetAttribute(&cus, hipDeviceAttributeMultiprocessorCount, dev);
    (void)hipOccupancyMaxActiveBlocksPerMultiprocessor(&per_cu, fwd_mega, 256, 0);
    if (per_cu > 2) per_cu = 2;
    if (per_cu < 1) per_cu = 1;
    grid_blocks = cus * per_cu;
    if (ws_size < OFF_END) fprintf(stderr, "kernel_launch: ws too small: %zu < %zu\n", ws_size, (size_t)OFF_END);
  }
  if (n_in != 36 || ws_size < OFF_END) return;
  Params p{};
  for (int i = 0; i < 36; ++i) p.in[i] = (const float*)d_in[i];
  p.out = (float*)d_out; p.ws = (char*)d_ws;
  void* args[] = {&p};
  hipError_t e = hipLaunchCooperativeKernel((void*)fwd_mega, dim3(grid_blocks), dim3(256), args, 0, stream);
  if (e != hipSuccess) fprintf(stderr, "cooperative launch failed: %s (grid %d)\n", hipGetErrorString(e), grid_blocks);
}
```

```cpp
#include <hip/hip_runtime.h>
#include <hip/hip_cooperative_groups.h>
#include <cstdio>
#include <cstdint>
namespace cg = cooperative_groups;

typedef unsigned short us;
using bf16x8 = __attribute__((ext_vector_type(8))) short;
using f32x16 = __attribute__((ext_vector_type(16))) float;
using f32x4  = __attribute__((ext_vector_type(4))) float;
using u32x4  = __attribute__((ext_vector_type(4))) unsigned;
using u32x2  = __attribute__((ext_vector_type(2))) unsigned;
#define DI __device__ __forceinline__
#define MFMA(a, b, c) __builtin_amdgcn_mfma_f32_32x32x16_bf16((a), (b), (c), 0, 0, 0)

#ifndef REP_GEMM
#define REP_GEMM 1
#endif
#ifndef REP_M1
#define REP_M1 1
#endif
#ifndef REP_M3
#define REP_M3 1
#endif
#ifndef REP_F2
#define REP_F2 1
#endif
#ifndef REP_P0
#define REP_P0 1
#endif
#ifndef EXTRA_SYNC
#define EXTRA_SYNC 0
#endif
constexpr int D = 1024, MX = 32768, MC = 1024, MT = MX + MC, INC = 2176, DFF = 2816, DFF2 = 5632;
constexpr int SEQ = 8448, NCHK = 132;
constexpr float EPS = 1e-6f;
constexpr float QSCALE = 0.10206207261596577f * 1.4426950408889634f;

constexpr size_t W_IN = 0, W_OUT = W_IN + (size_t)INC * D, W_UP = W_OUT + (size_t)D * D, W_DN = W_UP + (size_t)DFF2 * D,
                 W_UQ = W_DN + (size_t)D * DFF, W_UKV = W_UQ + 384 * 224, W_GLU = W_UKV + 512 * 96, W_SGU = W_GLU + 256 * 256,
                 W_CM = W_SGU + 4 * 128 * 128, W_LAYER = W_CM + 2 * 16 * 16 * 128;
constexpr size_t S_LAMB = 0, S_LAMT = 4096, S_BBAR = 8192, S_LAYER = 8192 + 65536;

constexpr size_t al256(size_t x) { return (x + 255) / 256 * 256; }
constexpr size_t OFF_WB = 0;
constexpr size_t OFF_S5F = al256(OFF_WB + 2 * W_LAYER * 2);
constexpr size_t OFF_MOD = al256(OFF_S5F + 2 * S_LAYER * 4);
constexpr size_t OFF_ROPE = al256(OFF_MOD + 2 * 5 * 6144 * 4);
constexpr size_t OFF_CTXS = al256(OFF_ROPE + 128 * 8 * 2 * 4);
constexpr size_t OFF_HX = al256(OFF_CTXS + (size_t)MC * D * 4);
constexpr size_t OFF_P = al256(OFF_HX + (size_t)MT * D * 2);
constexpr size_t OFF_MIXIN = al256(OFF_P + (size_t)MT * INC * 2);
constexpr size_t OFF_QB = al256(OFF_MIXIN + (size_t)MT * D * 2);
constexpr size_t OFF_KB = al256(OFF_QB + (size_t)16 * SEQ * 96 * 2);
constexpr size_t OFF_VT = al256(OFF_KB + (size_t)16 * SEQ * 96 * 2);
constexpr size_t OFF_KV = al256(OFF_VT + (size_t)16 * 64 * SEQ * 2);
constexpr size_t OFF_DEC = al256(OFF_KV + (size_t)4 * NCHK * 4 * 2 * 4096 * 4);
constexpr size_t OFF_HL = al256(OFF_DEC + (size_t)4 * NCHK * 4 * 2 * 64 * 4);
constexpr size_t OFF_Y = al256(OFF_HL + (size_t)4 * NCHK * 2 * 16 * 64 * 2 * 4);
constexpr size_t OFF_BAR = al256(OFF_Y + (size_t)MT * 256 * 2);
constexpr size_t OFF_END = al256(OFF_BAR + 3456 * 4);
constexpr size_t OFF_MIXOUT = OFF_P;
constexpr size_t OFF_ZPRE = OFF_P;
constexpr size_t OFF_ACT = OFF_MIXIN;
constexpr size_t OFF_FFNOUT = OFF_QB;
static_assert((size_t)MT * D * 4 <= (size_t)MT * INC * 2, "mixout alias");
static_assert((size_t)8448 * 1024 * 4 <= 2 * (size_t)16 * SEQ * 96 * 2, "ffnout alias");

struct Params { const float* in[36]; float* out; char* ws; };

DI float bf2f(us v) { return __uint_as_float(((unsigned)v) << 16); }
typedef float f32x2_ __attribute__((ext_vector_type(2)));
typedef __bf16 bf16x2_ __attribute__((ext_vector_type(2)));
DI unsigned pk2(float lo, float hi) { f32x2_ v = {lo, hi}; bf16x2_ b = __builtin_convertvector(v, bf16x2_); return __builtin_bit_cast(unsigned, b); }
DI us f2bf(float x) { return (us)(pk2(x, x) & 0xffffu); }
DI float lo_bf(unsigned w) { return __uint_as_float(w << 16); }
DI float hi_bf(unsigned w) { return __uint_as_float(w & 0xffff0000u); }
DI int tidx() { int t; asm volatile("v_mov_b32 %0, %1" : "=v"(t) : "v"(threadIdx.x)); return t; }
DI int crow(int i, int hh) { return (i & 3) + 8 * (i >> 2) + 4 * hh; }
DI float sigmoidf_(float x) { return 1.f / (1.f + __expf(-x)); }
DI float gelu_t(float x) { float u = 0.7978845608028654f * (x + 0.044715f * x * x * x); return x / (1.f + __expf(-2.f * u)); }
DI float silu_(float x) { return x / (1.f + __expf(-x)); }
DI float logsig(float z) { return fminf(z, 0.f) - log1pf(__expf(-fabsf(z))); }
DI void unpack8(u32x4 w, float* f) {
  f[0] = lo_bf(w[0]); f[1] = hi_bf(w[0]); f[2] = lo_bf(w[1]); f[3] = hi_bf(w[1]);
  f[4] = lo_bf(w[2]); f[5] = hi_bf(w[2]); f[6] = lo_bf(w[3]); f[7] = hi_bf(w[3]);
}
DI u32x4 pack8(const float* f) { u32x4 w = {pk2(f[0], f[1]), pk2(f[2], f[3]), pk2(f[4], f[5]), pk2(f[6], f[7])}; return w; }
DI long seqrow(int b, int s) { return s < 256 ? (long)MX + b * 256 + s : (long)b * 8192 + (s - 256); }
DI float wave_sum(float v) {
  v += __shfl_xor(v, 1); v += __shfl_xor(v, 2); v += __shfl_xor(v, 4); v += __shfl_xor(v, 8); v += __shfl_xor(v, 16); v += __shfl_xor(v, 32);
  return v;
}
DI const us* wl(const Params& p, int l) { return (const us*)(p.ws + OFF_WB) + (size_t)l * W_LAYER; }
DI const float* s5f(const Params& p, int l) { return (const float*)(p.ws + OFF_S5F) + (size_t)l * S_LAYER; }
DI const float* modv(const Params& p, int l, int v, int idx) { return (const float*)(p.ws + OFF_MOD) + ((size_t)(l * 5 + v) * 6 + idx) * 1024; }
DI float* stream_row(const Params& p, long m) { return m < MX ? p.out + m * 1024 : (float*)(p.ws + OFF_CTXS) + (m - MX) * 1024; }
DI const float* input_row(const Params& p, long m) { return m < MX ? p.in[0] + m * 1024 : p.in[2] + (m - MX) * 1024; }


#define XB_TMO      128
#define XB_XCNT(j)  (256  + 64 * (j))
#define XB_XSUB(j)  (1280 + 64 * (j))
#define XB_XGEN(j)  (2304 + 64 * (j))
#define XB_TOP      3328
#define XB_TOPGEN   3392
#define XCD_BAR_WORDS 3456
#define XB_SPIN_CAP (1u << 20)
#define LAS __attribute__((address_space(3)))
DI unsigned xb_ld(unsigned* p)              { return __hip_atomic_load(p, __ATOMIC_RELAXED, __HIP_MEMORY_SCOPE_AGENT); }
DI unsigned xb_add(unsigned* p, unsigned v) { return __hip_atomic_fetch_add(p, v, __ATOMIC_RELAXED, __HIP_MEMORY_SCOPE_AGENT); }
DI unsigned xb_xcc_id() { return (unsigned)__builtin_amdgcn_s_getreg((3 << 11) | 20) & 0xFu; }
#define XB_SPIN(cond, bar) do { unsigned _sp = 0; while (cond) { __builtin_amdgcn_s_sleep(1); \
    if ((++_sp & 255u) == 0u) { if (xb_ld(&(bar)[XB_TMO])) break; if (_sp > XB_SPIN_CAP) { atomicAdd(&(bar)[XB_TMO], 1u); break; } } } } while (0)
struct XcdBarrier { unsigned* bar; unsigned x; volatile LAS unsigned* st; };
DI XcdBarrier xcd_barrier_post(unsigned* bar, volatile LAS unsigned* st) {
  XcdBarrier b; b.bar = bar; b.x = xb_xcc_id(); b.st = st;
  if (threadIdx.x == 0) (void)xb_add(&bar[XB_XCNT(b.x)], 1u);
  return b;
}
DI void xcd_barrier_complete(unsigned* bar, unsigned x, unsigned& nloc, unsigned& nx) {
  const unsigned G = gridDim.x * gridDim.y * gridDim.z;
  unsigned sum, cnt, mine, sp = 0u;
  for (;;) {
    sum = 0u; cnt = 0u; mine = 0u;
#pragma unroll
    for (unsigned j = 0; j < 16; ++j) { const unsigned c = xb_ld(&bar[XB_XCNT(j)]); sum += c; cnt += (c > 0u) ? 1u : 0u; mine = (j == x) ? c : mine; }
    if (sum == G) break;
    __builtin_amdgcn_s_sleep(1);
    if ((++sp & 255u) == 0u) { if (xb_ld(&bar[XB_TMO])) break; if (sp > XB_SPIN_CAP) { atomicAdd(&bar[XB_TMO], 1u); break; } }
  }
  nloc = mine > 0u ? mine : 1u; nx = cnt > 0u ? cnt : 1u;
}
DI void xcd_barrier(const XcdBarrier& b) {
  asm volatile("s_waitcnt vmcnt(0)" ::: "memory");
  __syncthreads();
  if (threadIdx.x == 0) {
    unsigned* bar = b.bar;
    __builtin_amdgcn_s_waitcnt(0);
    unsigned nloc = b.st[0], nx = b.st[1];
    if (nloc == 0u) { xcd_barrier_complete(bar, b.x, nloc, nx); b.st[0] = nloc; b.st[1] = nx; }
    const unsigned old = xb_add(&bar[XB_XSUB(b.x)], 1u);
    const unsigned gen = old / nloc;
    if (old + 1u == (gen + 1u) * nloc) {
      __builtin_amdgcn_fence(__ATOMIC_RELEASE, "agent");
      asm volatile("s_waitcnt vmcnt(0)" ::: "memory");
      const unsigned og = xb_add(&bar[XB_TOP], 1u);
      const unsigned tg = og / nx;
      if (og + 1u == (tg + 1u) * nx) xb_add(&bar[XB_TOPGEN], 1u);
      else XB_SPIN(xb_ld(&bar[XB_TOPGEN]) == tg, bar);
      __builtin_amdgcn_fence(__ATOMIC_ACQUIRE, "agent");
      xb_add(&bar[XB_XGEN(b.x)], 1u);
      asm volatile("s_waitcnt vmcnt(0)" ::: "memory");
    } else {
      XB_SPIN(xb_ld(&bar[XB_XGEN(b.x)]) == gen, bar);
      __builtin_amdgcn_fence(__ATOMIC_ACQUIRE, "agent");
      asm volatile("s_waitcnt vmcnt(0)" ::: "memory");
    }
  }
  __syncthreads();
}

DI void conv_tile(const float* src, us* dst, int K, int N, const float* scale, int tile, char* smem) {
  float* t = (float*)smem;
  const int tid = tidx(), tn = N / 32, tk = tile / tn, tc = tile % tn;
  __syncthreads();
  {
    int k = tid >> 3, c4 = (tid & 7) * 4;
    f32x4 v = *(const f32x4*)(src + (size_t)(tk * 32 + k) * N + tc * 32 + c4);
    float s = scale ? scale[tk * 32 + k] : 1.f;
    t[k * 33 + c4 + 0] = v[0] * s; t[k * 33 + c4 + 1] = v[1] * s; t[k * 33 + c4 + 2] = v[2] * s; t[k * 33 + c4 + 3] = v[3] * s;
  }
  __syncthreads();
  if (tid < 128) {
    int n = tid >> 2, k8 = (tid & 3) * 8; float f[8];
#pragma unroll
    for (int j = 0; j < 8; ++j) f[j] = t[(k8 + j) * 33 + n];
    *(u32x4*)(dst + (size_t)(tc * 32 + n) * K + tk * 32 + k8) = pack8(f);
  }
}
constexpr int NCONV_LAYER = (1024 / 32) * (2176 / 32) + 32 * 32 + 32 * (5632 / 32) + (2816 / 32) * 32 + 7 * 12 + 3 * 16 + 8 * 8;
DI void conv_task(const Params& p, int it, char* smem) {
  int l = it / NCONV_LAYER; it -= l * NCONV_LAYER;
  us* wb = (us*)(p.ws + OFF_WB) + (size_t)l * W_LAYER;
  int nt;
  nt = 32 * 68;  if (it < nt) { conv_tile(p.in[10] + (size_t)l * 1024 * 2176, wb + W_IN, 1024, 2176, nullptr, it, smem); return; } it -= nt;
  nt = 32 * 32;  if (it < nt) { conv_tile(p.in[31] + (size_t)l * 1024 * 1024, wb + W_OUT, 1024, 1024, nullptr, it, smem); return; } it -= nt;
  nt = 32 * 176; if (it < nt) { conv_tile(p.in[32] + (size_t)l * 1024 * 5632, wb + W_UP, 1024, 5632, nullptr, it, smem); return; } it -= nt;
  nt = 88 * 32;  if (it < nt) { conv_tile(p.in[35] + (size_t)l * 2816 * 1024, wb + W_DN, 2816, 1024, nullptr, it, smem); return; } it -= nt;
  nt = 7 * 12;   if (it < nt) { conv_tile(p.in[28] + (size_t)l * 224 * 384, wb + W_UQ, 224, 384, p.in[27] + l * 224, it, smem); return; } it -= nt;
  nt = 3 * 16;   if (it < nt) { conv_tile(p.in[30] + (size_t)l * 96 * 512, wb + W_UKV, 96, 512, p.in[29] + l * 96, it, smem); return; } it -= nt;
  conv_tile(p.in[25] + (size_t)l * 256 * 256, wb + W_GLU, 256, 256, nullptr, it, smem);
}
DI void mod_task(const Params& p, int it, char* smem) {
  float* sc = (float*)smem;
  float* red = sc + 5 * 1024;
  const int tid = tidx(), l = it / 192, jb = it % 192;
  __syncthreads();
  for (int e = tid; e < 5 * 1024; e += 256) {
    int v = e >> 10, k = e & 1023; float c = v < 4 ? p.in[1][v * 1024 + k] : p.in[3][k];
    sc[e] = silu_(c);
  }
  __syncthreads();
  const int col = tid & 31, ks = tid >> 5;
  const float* w = p.in[4] + (size_t)l * 1024 * 6144 + jb * 32 + col;
  float a0 = 0, a1 = 0, a2 = 0, a3 = 0, a4 = 0;
#pragma unroll 8
  for (int k = ks * 128; k < ks * 128 + 128; ++k) {
    float wv = w[(size_t)k * 6144];
    a0 += sc[k] * wv; a1 += sc[1024 + k] * wv; a2 += sc[2048 + k] * wv; a3 += sc[3072 + k] * wv; a4 += sc[4096 + k] * wv;
  }
  float* rp = red + (ks * 32 + col) * 5;
  rp[0] = a0; rp[1] = a1; rp[2] = a2; rp[3] = a3; rp[4] = a4;
  __syncthreads();
  if (tid < 160) {
    int v = tid >> 5, c = tid & 31; float s = 0;
    for (int q = 0; q < 8; ++q) s += red[(q * 32 + c) * 5 + v];
    int j = jb * 32 + c;
    ((float*)(p.ws + OFF_MOD))[(size_t)(l * 5 + v) * 6144 + j] = s + p.in[5][l * 6144 + j];
  }
}
DI void s5pre_task(const Params& p, int it) {
  int gid = it * 256 + tidx();
  int pp = gid & 63, g = (gid >> 6) & 15, d = (gid >> 10) & 1, l = gid >> 11;
  int idx = ((l * 2 + d) * 16 + g) * 64 + pp;
  float are = p.in[17][idx], aim = p.in[18][idx];
  float dt = expf(p.in[19][(l * 2 + d) * 16 + g]);
  float mag = expf(are * dt), lr = mag * cosf(aim * dt), li = mag * sinf(aim * dt);
  float magT = expf(are * dt * 64.f), tr = magT * cosf(aim * dt * 64.f), ti = magT * sinf(aim * dt * 64.f);
  float nr = lr - 1.f, ni = li, den = are * are + aim * aim;
  float cr = (nr * are + ni * aim) / den, ci = (ni * are - nr * aim) / den;
  float* sf = (float*)(p.ws + OFF_S5F) + (size_t)l * S_LAYER;
  int o2 = ((d * 16 + g) * 64 + pp);
  sf[S_LAMB + o2 * 2] = lr; sf[S_LAMB + o2 * 2 + 1] = li;
  sf[S_LAMT + o2 * 2] = tr; sf[S_LAMT + o2 * 2 + 1] = ti;
  for (int i = 0; i < 16; ++i) {
    float br = p.in[20][(size_t)idx * 16 + i], bi = p.in[21][(size_t)idx * 16 + i];
    sf[S_BBAR + ((size_t)o2 * 16 + i) * 2] = cr * br - ci * bi;
    sf[S_BBAR + ((size_t)o2 * 16 + i) * 2 + 1] = cr * bi + ci * br;
  }
  us* cm = (us*)(p.ws + OFF_WB) + (size_t)l * W_LAYER + W_CM;
  for (int o = 0; o < 16; ++o) {
    size_t ci_ = ((size_t)((l * 2 + d) * 16 + g) * 16 + o) * 64 + pp;
    cm[((size_t)(d * 16 + g) * 16 + o) * 128 + pp] = f2bf(p.in[22][ci_]);
    cm[((size_t)(d * 16 + g) * 16 + o) * 128 + 64 + pp] = f2bf(-p.in[23][ci_]);
  }
}
DI void rope_task(const Params& p, int it) {
  int gid = it * 256 + tidx();
  int pos = gid >> 3, f = gid & 7;
  float inv = powf(10000.f, -(float)f / 8.f), ang = (float)pos * inv;
  float* r = (float*)(p.ws + OFF_ROPE);
  r[gid * 2] = cosf(ang); r[gid * 2 + 1] = sinf(ang);
}
DI void sguw_task(const Params& p, int it) {
  int gid = it * 256 + tidx();
  int l = gid >> 14, e = (gid & 16383) * 4;
  f32x4 v = *(const f32x4*)(p.in[12] + (size_t)l * 65536 + e);
  u32x2 w = {pk2(v[0], v[1]), pk2(v[2], v[3])};
  *(u32x2*)((us*)(p.ws + OFF_WB) + (size_t)l * W_LAYER + W_SGU + e) = w;
}

template <int MODE>
DI void row_task(const Params& p, int l, long m, const float* yrow) {
  const int lane = tidx() & 63, v = m < MX ? (int)(m >> 13) : 4;
  float x[16];
  if (MODE == 0) {
    const float* src = input_row(p, m);
#pragma unroll
    for (int j = 0; j < 4; ++j) { f32x4 t = *(const f32x4*)(src + (j * 64 + lane) * 4); x[4 * j] = t[0]; x[4 * j + 1] = t[1]; x[4 * j + 2] = t[2]; x[4 * j + 3] = t[3]; }
  } else {
    float y[16]; float ss = 0;
    const float* xo = (MODE == 1 && l == 0) ? input_row(p, m) : stream_row(p, m);
#pragma unroll
    for (int j = 0; j < 4; ++j) {
      f32x4 t = *(const f32x4*)(yrow + (j * 64 + lane) * 4); y[4 * j] = t[0]; y[4 * j + 1] = t[1]; y[4 * j + 2] = t[2]; y[4 * j + 3] = t[3];
      f32x4 u = *(const f32x4*)(xo + (j * 64 + lane) * 4); x[4 * j] = u[0]; x[4 * j + 1] = u[1]; x[4 * j + 2] = u[2]; x[4 * j + 3] = u[3];
    }
#pragma unroll
    for (int j = 0; j < 16; ++j) ss += y[j] * y[j];
    ss = wave_sum(ss);
    float rstd = rsqrtf(ss * (1.f / 1024.f) + EPS);
    const float* gp = (MODE == 1 ? p.in[7] : p.in[9]) + l * 1024;
    const float* gt = modv(p, l, v, MODE == 1 ? 2 : 5);
    float* dst = stream_row(p, m);
#pragma unroll
    for (int j = 0; j < 4; ++j) {
      int c = (j * 64 + lane) * 4;
      f32x4 g4 = *(const f32x4*)(gp + c), t4 = *(const f32x4*)(gt + c), o;
#pragma unroll
      for (int q = 0; q < 4; ++q) { x[4 * j + q] += t4[q] * (y[4 * j + q] * rstd * g4[q]); o[q] = x[4 * j + q]; }
      *(f32x4*)(dst + c) = o;
    }
    if (MODE == 2 && l == 1) return;
  }
  const int ln = (MODE == 2) ? 1 : l;
  const float* g = (MODE == 1 ? p.in[8] : p.in[6]) + ln * 1024;
  const float* sh = modv(p, ln, v, MODE == 1 ? 3 : 0);
  const float* sc = modv(p, ln, v, MODE == 1 ? 4 : 1);
  float ss = 0;
#pragma unroll
  for (int j = 0; j < 16; ++j) ss += x[j] * x[j];
  ss = wave_sum(ss);
  float rstd = rsqrtf(ss * (1.f / 1024.f) + EPS);
  us* hx = (us*)(p.ws + OFF_HX) + m * 1024;
#pragma unroll
  for (int j = 0; j < 4; ++j) {
    int c = (j * 64 + lane) * 4;
    f32x4 g4 = *(const f32x4*)(g + c), s4 = *(const f32x4*)(sh + c), c4 = *(const f32x4*)(sc + c); float h[4];
#pragma unroll
    for (int q = 0; q < 4; ++q) h[q] = (x[4 * j + q] * rstd * g4[q]) * (1.f + c4[q]) + s4[q];
    u32x2 w = {pk2(h[0], h[1]), pk2(h[2], h[3])};
    *(u32x2*)(hx + c) = w;
  }
}

struct GArgs { const us* A; int lda; const us* W; int K; long m0; int n0; void* out; int ldo; int l; };
template <int BK, int EPI, bool ROWSS>
DI void gemm_tile(const Params& p, const GArgs& g, char* smem) {
  constexpr int LS = BK + 8, CPR = BK / 8, NCH = 128 * CPR / 256;
  us* sA = (us*)smem; us* sB = sA + 2 * 128 * LS; float* rstd = (float*)(sB + 2 * 128 * LS);
  const int tid = tidx(), w = tid >> 6, lane = tid & 63, r = lane & 31, hh = lane >> 5, wm = w >> 1, wn = w & 1;
  __syncthreads();
  if (ROWSS) {
    int row = tid >> 1, half = tid & 1; float ss = 0;
    const us* ap = g.A + (size_t)row * g.lda + half * (g.K / 2);
    for (int c = 0; c < g.K / 16; ++c) { float f[8]; unpack8(*(const u32x4*)(ap + c * 8), f);
#pragma unroll
      for (int j = 0; j < 8; ++j) ss += f[j] * f[j]; }
    ss += __shfl_xor(ss, 1);
    if (!half) rstd[row] = rsqrtf(ss / (float)g.K + EPS);
  }
  u32x4 ra[NCH], rb[NCH];
  f32x16 acc[2][2];
#pragma unroll
  for (int i = 0; i < 2; ++i)
#pragma unroll
    for (int j = 0; j < 2; ++j)
#pragma unroll
      for (int q = 0; q < 16; ++q) acc[i][j][q] = 0.f;
#define GLOAD(kt) _Pragma("unroll") for (int j = 0; j < NCH; ++j) { int q = tid + 256 * j, row = q / CPR, cc = q % CPR; \
    ra[j] = *(const u32x4*)(g.A + (size_t)row * g.lda + (kt) * BK + cc * 8); rb[j] = *(const u32x4*)(g.W + (size_t)row * g.K + (kt) * BK + cc * 8); }
#define SWRITE(buf) _Pragma("unroll") for (int j = 0; j < NCH; ++j) { int q = tid + 256 * j, row = q / CPR, cc = q % CPR; \
    *(u32x4*)(sA + (buf) * 128 * LS + row * LS + cc * 8) = ra[j]; *(u32x4*)(sB + (buf) * 128 * LS + row * LS + cc * 8) = rb[j]; }
  GLOAD(0); SWRITE(0); __syncthreads();
  const int KT = g.K / BK;
  for (int kt = 0; kt < KT; ++kt) {
    if (kt + 1 < KT) { GLOAD(kt + 1); }
    const us* a0 = sA + (kt & 1) * 128 * LS + (wm * 64 + r) * LS + hh * 8;
    const us* b0 = sB + (kt & 1) * 128 * LS + (wn * 64 + r) * LS + hh * 8;
#pragma unroll
    for (int ks = 0; ks < BK / 16; ++ks) {
      bf16x8 af0 = *(const bf16x8*)(a0 + ks * 16), af1 = *(const bf16x8*)(a0 + 32 * LS + ks * 16);
      bf16x8 bf0 = *(const bf16x8*)(b0 + ks * 16), bf1 = *(const bf16x8*)(b0 + 32 * LS + ks * 16);
      acc[0][0] = MFMA(af0, bf0, acc[0][0]); acc[0][1] = MFMA(af0, bf1, acc[0][1]);
      acc[1][0] = MFMA(af1, bf0, acc[1][0]); acc[1][1] = MFMA(af1, bf1, acc[1][1]);
    }
    if (kt + 1 < KT) { SWRITE((kt + 1) & 1); }
    __syncthreads();
  }
#undef GLOAD
#undef SWRITE
#pragma unroll
  for (int si = 0; si < 2; ++si)
#pragma unroll
    for (int sj = 0; sj < 2; ++sj) {
      const int col = wn * 64 + sj * 32 + r, n = g.n0 + col;
#pragma unroll
      for (int i = 0; i < 16; ++i) {
        const int row = wm * 64 + si * 32 + crow(i, hh);
        const long m = g.m0 + row;
        float v = acc[si][sj][i];
        if (EPI == 0) { ((us*)g.out)[m * g.ldo + n] = f2bf(v); }
        else if (EPI == 1) { ((float*)g.out)[m * g.ldo + n] = v; }
        else if (EPI == 2) {
          v *= rstd[row] * QSCALE;
          float pv = __shfl_xor(v, 8);
          const int head = n / 96, j = n - head * 96;
          const bool isx = m < MX; const int t = isx ? (int)(m & 8191) : (int)((m - MX) & 255);
          const int b = isx ? (int)(m >> 13) : (int)((m - MX) >> 8);
          if (isx && j >= 64) {
            int jj = (j - 64) & 15, blk = (j - 64) >> 4, f = jj & 7, pos = blk ? (t & 63) : (t >> 6);
            const float* rp = (const float*)(p.ws + OFF_ROPE) + (pos * 8 + f) * 2; float cs = rp[0], sn = rp[1];
            v = (jj < 8) ? v * cs - pv * sn : pv * sn + v * cs;
          }
          const int s = isx ? 256 + t : t;
          ((us*)(p.ws + OFF_QB))[((size_t)(b * 4 + head) * SEQ + s) * 96 + j] = f2bf(v);
        } else if (EPI == 3) {
          v *= rstd[row];
          const int head = n >> 7, j = n & 127;
          const bool isx = m < MX; const int t = isx ? (int)(m & 8191) : (int)((m - MX) & 255);
          const int b = isx ? (int)(m >> 13) : (int)((m - MX) >> 8);
          const int s = isx ? 256 + t : t;
          if (j < 64) ((us*)(p.ws + OFF_KB))[((size_t)(b * 4 + head) * SEQ + s) * 96 + j] = f2bf(v);
          else ((us*)(p.ws + OFF_VT))[((size_t)(b * 4 + head) * 64 + (j - 64)) * SEQ + s] = f2bf(v);
        } else if (EPI == 4) {
          float y = bf2f(((const us*)(p.ws + OFF_Y))[m * 256 + n]);
          v += p.in[26][g.l * 256 + n];
          ((us*)(p.ws + OFF_MIXIN))[m * 1024 + 512 + n] = f2bf(y * sigmoidf_(v));
        }
      }
    }
}


template <int EPI>
DI void gemm256(const GArgs& g, char* smem) {
  constexpr int LS = 40;
  us* sA = (us*)smem; us* sB = sA + 2 * 256 * LS;
  const int tid = tidx(), w = tid >> 6, lane = tid & 63, r = lane & 31, hh = lane >> 5, wm = w >> 1, wn = w & 1;
  __syncthreads();
  u32x4 ra[4], rb[2];
  f32x16 acc[4][2];
#pragma unroll
  for (int i = 0; i < 4; ++i)
#pragma unroll
    for (int j = 0; j < 2; ++j)
#pragma unroll
      for (int q = 0; q < 16; ++q) acc[i][j][q] = 0.f;
  const int srow = tid >> 2, scc = (tid & 3) * 8;
  const us* gA = g.A + (size_t)srow * g.lda + scc;
  const us* gB = g.W + (size_t)srow * g.K + scc;
#define GLOAD(kt) { _Pragma("unroll") for (int j = 0; j < 4; ++j) ra[j] = *(const u32x4*)(gA + (size_t)(64 * j) * g.lda + (kt) * 32); \
    _Pragma("unroll") for (int j = 0; j < 2; ++j) rb[j] = *(const u32x4*)(gB + (size_t)(64 * j) * g.K + (kt) * 32); }
#define SWRITE(buf) { _Pragma("unroll") for (int j = 0; j < 4; ++j) *(u32x4*)(sA + (buf) * 256 * LS + (srow + 64 * j) * LS + scc) = ra[j]; \
    _Pragma("unroll") for (int j = 0; j < 2; ++j) *(u32x4*)(sB + (buf) * 128 * LS + (srow + 64 * j) * LS + scc) = rb[j]; }
  GLOAD(0); SWRITE(0); __syncthreads();
  const int KT = g.K / 32;
  for (int kt = 0; kt < KT; ++kt) {
    if (kt + 1 < KT) GLOAD(kt + 1);
    const us* a0 = sA + (kt & 1) * 256 * LS + (wm * 128 + r) * LS + hh * 8;
    const us* b0 = sB + (kt & 1) * 128 * LS + (wn * 64 + r) * LS + hh * 8;
#pragma unroll
    for (int ks = 0; ks < 2; ++ks) {
      bf16x8 bf0 = *(const bf16x8*)(b0 + ks * 16), bf1 = *(const bf16x8*)(b0 + 32 * LS + ks * 16);
#pragma unroll
      for (int i = 0; i < 4; ++i) {
        bf16x8 af = *(const bf16x8*)(a0 + i * 32 * LS + ks * 16);
        acc[i][0] = MFMA(af, bf0, acc[i][0]); acc[i][1] = MFMA(af, bf1, acc[i][1]);
      }
    }
    if (kt + 1 < KT) SWRITE((kt + 1) & 1);
    __syncthreads();
  }
#undef GLOAD
#undef SWRITE
#pragma unroll
  for (int si = 0; si < 4; ++si)
#pragma unroll
    for (int sj = 0; sj < 2; ++sj) {
      const int n = g.n0 + wn * 64 + sj * 32 + r;
#pragma unroll
      for (int i = 0; i < 16; ++i) {
        const long m = g.m0 + wm * 128 + si * 32 + crow(i, hh);
        if (EPI == 0) ((us*)g.out)[m * g.ldo + n] = f2bf(acc[si][sj][i]);
        else ((float*)g.out)[m * g.ldo + n] = acc[si][sj][i];
      }
    }
}
template <class F>
DI void for_tiles_xcd(int RT, int CT, int G, int bid, F f) {
  if ((G & 7) == 0) {
    const int x = bid & 7, rows = (RT - x + 7) >> 3, n = rows * CT, nfull = CT >> 3;
    for (int j = bid >> 3; j < n; j += G >> 3) {
      int rl, ct;
      if (j < nfull * rows * 8) { int pnl = j / (rows * 8), rem = j - pnl * rows * 8; rl = rem >> 3; ct = pnl * 8 + (rem & 7); }
      else { int j2 = j - nfull * rows * 8, wd = CT - nfull * 8; rl = j2 / wd; ct = nfull * 8 + (j2 - rl * wd); }
      f(rl * 8 + x, ct);
    }
  } else {
    for (int it = bid; it < RT * CT; it += G) f(it / CT, it % CT);
  }
}

DI void kr_task(const Params& p, long m0) {
  const int tid = tidx(), row = tid >> 1, blk = tid & 1; const long m = m0 + row;
  const us* src = (const us*)(p.ws + OFF_P) + m * INC + 2144 + blk * 16;
  float v[16], o[16]; unpack8(*(const u32x4*)src, v); unpack8(*(const u32x4*)(src + 8), v + 8);
  const bool isx = m < MX; const int t = isx ? (int)(m & 8191) : (int)((m - MX) & 255);
  const int b = isx ? (int)(m >> 13) : (int)((m - MX) >> 8), s = isx ? 256 + t : t;
  if (isx) {
    int pos = blk ? (t & 63) : (t >> 6);
    const float* rp = (const float*)(p.ws + OFF_ROPE) + pos * 16;
#pragma unroll
    for (int f = 0; f < 8; ++f) { float cs = rp[2 * f], sn = rp[2 * f + 1]; o[f] = v[f] * cs - v[f + 8] * sn; o[f + 8] = v[f] * sn + v[f + 8] * cs; }
  } else {
#pragma unroll
    for (int f = 0; f < 16; ++f) o[f] = v[f];
  }
  u32x4 w0 = pack8(o), w1 = pack8(o + 8);
#pragma unroll
  for (int hd = 0; hd < 4; ++hd) {
    us* dst = (us*)(p.ws + OFF_KB) + ((size_t)(b * 4 + hd) * SEQ + s) * 96 + 64 + blk * 16;
    *(u32x4*)dst = w0; *(u32x4*)(dst + 8) = w1;
  }
}

DI void sgu_task(const Params& p, int l, int chunk, int h, char* smem) {
  us* Vt = (us*)smem;
  const int tid = tidx(), w = tid >> 6, lane = tid & 63, r = lane & 31, hh = lane >> 5;
  const long m0 = (long)chunk * 128;
  const us* P = (const us*)(p.ws + OFF_P);
  __syncthreads();
  {
    int row = tid >> 1, dh = (tid & 1) * 32; float v[32]; float ss = 0;
    const us* src = P + (m0 + row) * INC + 256 + h * 64 + dh;
#pragma unroll
    for (int c = 0; c < 4; ++c) unpack8(*(const u32x4*)(src + c * 8), v + c * 8);
#pragma unroll
    for (int j = 0; j < 32; ++j) { v[j] = gelu_t(v[j]); ss += v[j] * v[j]; }
    ss += __shfl_xor(ss, 1);
    float rstd = rsqrtf(ss * (1.f / 64.f) + EPS);
    const float* gn = p.in[11] + l * 256 + h * 64 + dh;
#pragma unroll
    for (int j = 0; j < 32; ++j) Vt[(dh + j) * 136 + row] = f2bf(v[j] * rstd * gn[j]);
  }
  __syncthreads();
  const us* Wsp = wl(p, l) + W_SGU + (size_t)h * 16384 + (size_t)(w * 32 + r) * 128 + hh * 8;
  f32x16 a0, a1;
#pragma unroll
  for (int q = 0; q < 16; ++q) { a0[q] = 0.f; a1[q] = 0.f; }
#pragma unroll
  for (int ks = 0; ks < 8; ++ks) {
    bf16x8 af = *(const bf16x8*)(Wsp + ks * 16);
    bf16x8 b0 = *(const bf16x8*)(Vt + r * 136 + ks * 16 + hh * 8), b1 = *(const bf16x8*)(Vt + (32 + r) * 136 + ks * 16 + hh * 8);
    a0 = MFMA(af, b0, a0); a1 = MFMA(af, b1, a1);
  }
  us* out = (us*)(p.ws + OFF_MIXIN);
#pragma unroll
  for (int i = 0; i < 16; ++i) {
    int t = w * 32 + crow(i, hh); float bs = p.in[13][l * 512 + h * 128 + t];
    const us* pu = P + (m0 + t) * INC + h * 64;
    float u0 = gelu_t(bf2f(pu[r])), u1 = gelu_t(bf2f(pu[32 + r]));
    out[(m0 + t) * 1024 + h * 64 + r] = f2bf(u0 * (a0[i] + bs));
    out[(m0 + t) * 1024 + h * 64 + 32 + r] = f2bf(u1 * (a1[i] + bs));
  }
}

DI void gla_gate_dir(const Params& p, int l, const us* Prow0, int h, int d, float* sW, float* G) {
  const int tid = tidx();
  const float* wg = p.in[14] + (size_t)l * 2 * 16 * 256;
#pragma unroll
  for (int j = 0; j < 4; ++j) { int e = tid + 256 * j, rr = e >> 6, ch = e & 63; sW[e] = wg[(d * 16 + rr) * 256 + h * 64 + ch]; }
  __syncthreads();
  {
    int t = tid >> 2, q4 = tid & 3; float gl[16];
    const us* src = Prow0 + (size_t)t * INC + 1536 + d * 16;
    unpack8(*(const u32x4*)src, gl); unpack8(*(const u32x4*)(src + 8), gl + 8);
    const float* bg = p.in[15] + l * 512 + d * 256 + h * 64 + q4 * 16;
#pragma unroll
    for (int c = 0; c < 16; ++c) {
      float z = bg[c];
#pragma unroll
      for (int rr = 0; rr < 16; ++rr) z += gl[rr] * sW[rr * 64 + q4 * 16 + c];
      G[t * 64 + q4 * 16 + c] = logsig(z) * (1.f / 16.f);
    }
  }
  __syncthreads();
  if (tid < 64) {
    float run = 0;
    if (d == 0) { for (int t = 0; t < 64; ++t) { run += G[t * 64 + tid]; G[t * 64 + tid] = run; } }
    else { for (int t = 63; t >= 0; --t) { run += G[t * 64 + tid]; G[t * 64 + tid] = run; } }
  }
  __syncthreads();
}
DI size_t gla_idx(int b, int c, int h, int d) { return (size_t)(((b * NCHK + c) * 4 + h) * 2 + d); }

DI void gla1_task(const Params& p, int l, int b, int c, int h, char* smem) {
  float* G0 = (float*)smem; float* G1 = G0 + 4096; float* sW = G1 + 4096;
  us* KeT = (us*)(sW + 1024);
  us* Vt = KeT + 2 * 64 * 72;
  const int tid = tidx(), w = tid >> 6, lane = tid & 63, r = lane & 31, hh = lane >> 5;
  const long m0 = seqrow(b, c * 64);
  const us* P0 = (const us*)(p.ws + OFF_P) + m0 * INC;
  __syncthreads();
  gla_gate_dir(p, l, P0, h, 0, sW, G0);
  gla_gate_dir(p, l, P0, h, 1, sW, G1);
  {
    int t = tid >> 2, q4 = tid & 3; float kk[16], vv[16];
    const us* sk = P0 + (size_t)t * INC + 768 + h * 64 + q4 * 16;
    const us* sv = P0 + (size_t)t * INC + 1024 + h * 64 + q4 * 16;
    unpack8(*(const u32x4*)sk, kk); unpack8(*(const u32x4*)(sk + 8), kk + 8);
    unpack8(*(const u32x4*)sv, vv); unpack8(*(const u32x4*)(sv + 8), vv + 8);
#pragma unroll
    for (int cc = 0; cc < 16; ++cc) {
      int ch = q4 * 16 + cc;
      KeT[ch * 72 + t] = f2bf(kk[cc] * __expf(G0[63 * 64 + ch] - G0[t * 64 + ch]));
      KeT[(64 + ch) * 72 + t] = f2bf(kk[cc] * __expf(G1[ch] - G1[t * 64 + ch]));
      Vt[ch * 72 + t] = f2bf(vv[cc]);
    }
    if (tid < 128) {
      int d = tid >> 6, ch = tid & 63;
      ((float*)(p.ws + OFF_DEC))[gla_idx(b, c, h, d) * 64 + ch] = __expf(d ? G1[ch] : G0[63 * 64 + ch]);
    }
  }
  __syncthreads();
  {
    const int d = w >> 1, mt = w & 1;
    float* kv = (float*)(p.ws + OFF_KV) + gla_idx(b, c, h, d) * 4096;
#pragma unroll
    for (int nt = 0; nt < 2; ++nt) {
      f32x16 acc;
#pragma unroll
      for (int q = 0; q < 16; ++q) acc[q] = 0.f;
#pragma unroll
      for (int ks = 0; ks < 4; ++ks) {
        bf16x8 a = *(const bf16x8*)(Vt + (mt * 32 + r) * 72 + ks * 16 + hh * 8);
        bf16x8 bb = *(const bf16x8*)(KeT + (d * 64 + nt * 32 + r) * 72 + ks * 16 + hh * 8);
        acc = MFMA(a, bb, acc);
      }
#pragma unroll
      for (int i = 0; i < 16; ++i) kv[(mt * 32 + crow(i, hh)) * 64 + nt * 32 + r] = acc[i];
    }
  }
}
DI int gla_order(int d, int j) { return d == 0 ? j : (j < 4 ? 3 - j : 135 - j); }
DI void gla2_task(const Params& p, int it) {
  const int gid = it * 256 + tidx();
  const int e = gid & 4095, d = (gid >> 12) & 1, h = (gid >> 13) & 3, b = gid >> 15, k = e & 63;
  float* KV = (float*)(p.ws + OFF_KV); const float* DEC = (const float*)(p.ws + OFF_DEC);
  float s = 0;
  for (int j0 = 0; j0 < NCHK; j0 += 33) {
    float kv[33], dc[33];
#pragma unroll
    for (int q = 0; q < 33; ++q) { const size_t ix = gla_idx(b, gla_order(d, j0 + q), h, d); kv[q] = KV[ix * 4096 + e]; dc[q] = DEC[ix * 64 + k]; }
#pragma unroll
    for (int q = 0; q < 33; ++q) { const size_t ix = gla_idx(b, gla_order(d, j0 + q), h, d); KV[ix * 4096 + e] = s; s = dc[q] * s + kv[q]; }
  }
}
DI void gla3_task(const Params& p, int l, int b, int c, int h, char* smem) {
  float* G = (float*)smem;
  us* Qin = (us*)(smem + 17408);
  us* Kin = Qin + 64 * 72; us* Vt = Kin + 64 * 72; us* ST = Vt + 64 * 72; us* Sc = ST + 64 * 72;
  float* sW = (float*)Sc;
  const int tid = tidx(), w = tid >> 6, lane = tid & 63, r = lane & 31, hh = lane >> 5;
  const long m0 = seqrow(b, c * 64);
  const us* P0 = (const us*)(p.ws + OFF_P) + m0 * INC;
  const int t_ = tid >> 2, q4 = tid & 3;
  __syncthreads();
  {
    float vv[16]; const us* sv = P0 + (size_t)t_ * INC + 1024 + h * 64 + q4 * 16;
    unpack8(*(const u32x4*)sv, vv); unpack8(*(const u32x4*)(sv + 8), vv + 8);
#pragma unroll
    for (int cc = 0; cc < 16; ++cc) Vt[(q4 * 16 + cc) * 72 + t_] = f2bf(vv[cc]);
  }
  f32x16 oacc;
#pragma unroll
  for (int q = 0; q < 16; ++q) oacc[q] = 0.f;
  const int mt = w >> 1, nt = w & 1;
  for (int d = 0; d < 2; ++d) {
    gla_gate_dir(p, l, P0, h, d, sW, G);
    {
      float qq[16], kk[16], qo[16], ko[16];
      const us* sq = P0 + (size_t)t_ * INC + 512 + h * 64 + q4 * 16;
      const us* sk = P0 + (size_t)t_ * INC + 768 + h * 64 + q4 * 16;
      unpack8(*(const u32x4*)sq, qq); unpack8(*(const u32x4*)(sq + 8), qq + 8);
      unpack8(*(const u32x4*)sk, kk); unpack8(*(const u32x4*)(sk + 8), kk + 8);
#pragma unroll
      for (int cc = 0; cc < 16; ++cc) { float gg = G[t_ * 64 + q4 * 16 + cc]; qo[cc] = qq[cc] * 0.125f * __expf(gg); ko[cc] = kk[cc] * __expf(-gg); }
      *(u32x4*)(Qin + t_ * 72 + q4 * 16) = pack8(qo); *(u32x4*)(Qin + t_ * 72 + q4 * 16 + 8) = pack8(qo + 8);
      *(u32x4*)(Kin + t_ * 72 + q4 * 16) = pack8(ko); *(u32x4*)(Kin + t_ * 72 + q4 * 16 + 8) = pack8(ko + 8);
      const float* ss = (const float*)(p.ws + OFF_KV) + gla_idx(b, c, h, d) * 4096 + tid * 16;
      float sf[16];
#pragma unroll
      for (int j = 0; j < 4; ++j) { f32x4 t4 = *(const f32x4*)(ss + j * 4); sf[4 * j] = t4[0]; sf[4 * j + 1] = t4[1]; sf[4 * j + 2] = t4[2]; sf[4 * j + 3] = t4[3]; }
      const int v_ = tid >> 2, k0 = (tid & 3) * 16;
      *(u32x4*)(ST + v_ * 72 + k0) = pack8(sf); *(u32x4*)(ST + v_ * 72 + k0 + 8) = pack8(sf + 8);
    }
    __syncthreads();
    {
      const int tt = mt, st = nt;
      const bool need = d == 0 ? st <= tt : st >= tt;
      f32x16 sc;
#pragma unroll
      for (int q = 0; q < 16; ++q) sc[q] = 0.f;
      if (need) {
#pragma unroll
        for (int ks = 0; ks < 4; ++ks) {
          bf16x8 a = *(const bf16x8*)(Qin + (tt * 32 + r) * 72 + ks * 16 + hh * 8);
          bf16x8 bb = *(const bf16x8*)(Kin + (st * 32 + r) * 72 + ks * 16 + hh * 8);
          sc = MFMA(a, bb, sc);
        }
      }
#pragma unroll
      for (int i = 0; i < 16; ++i) {
        int trow = tt * 32 + crow(i, hh), scol = st * 32 + r;
        bool keep = d == 0 ? scol <= trow : scol >= trow;
        Sc[trow * 72 + scol] = f2bf(keep ? sc[i] : 0.f);
      }
    }
    __syncthreads();
#pragma unroll
    for (int ks = 0; ks < 4; ++ks) {
      bf16x8 a = *(const bf16x8*)(Sc + (mt * 32 + r) * 72 + ks * 16 + hh * 8);
      bf16x8 bb = *(const bf16x8*)(Vt + (nt * 32 + r) * 72 + ks * 16 + hh * 8);
      oacc = MFMA(a, bb, oacc);
    }
#pragma unroll
    for (int ks = 0; ks < 4; ++ks) {
      bf16x8 a = *(const bf16x8*)(Qin + (mt * 32 + r) * 72 + ks * 16 + hh * 8);
      bf16x8 bb = *(const bf16x8*)(ST + (nt * 32 + r) * 72 + ks * 16 + hh * 8);
      oacc = MFMA(a, bb, oacc);
    }
    __syncthreads();
  }
  float* Ob = (float*)smem;
#pragma unroll
  for (int i = 0; i < 16; ++i) Ob[(mt * 32 + crow(i, hh)) * 68 + nt * 32 + r] = oacc[i];
  __syncthreads();
  {
    float o[16], rr[16]; float ss = 0;
#pragma unroll
    for (int cc = 0; cc < 16; ++cc) { o[cc] = Ob[t_ * 68 + q4 * 16 + cc]; ss += o[cc] * o[cc]; }
    ss += __shfl_xor(ss, 1); ss += __shfl_xor(ss, 2);
    float rstd = rsqrtf(ss * (1.f / 64.f) + EPS);
    const us* sr = P0 + (size_t)t_ * INC + 1280 + h * 64 + q4 * 16;
    unpack8(*(const u32x4*)sr, rr); unpack8(*(const u32x4*)(sr + 8), rr + 8);
    const float* gn = p.in[16] + l * 256 + h * 64 + q4 * 16;
#pragma unroll
    for (int cc = 0; cc < 16; ++cc) o[cc] = o[cc] * rstd * gn[cc] * silu_(rr[cc]);
    us* dst = (us*)(p.ws + OFF_MIXIN) + (m0 + t_) * 1024 + 256 + h * 64 + q4 * 16;
    *(u32x4*)dst = pack8(o); *(u32x4*)(dst + 8) = pack8(o + 8);
  }
}

DI size_t hl_idx(int b, int c, int d, int g, int pp) { return ((size_t)(((b * NCHK + c) * 2 + d) * 16 + g) * 64 + pp) * 2; }
template <bool OUT>
DI void s5_task(const Params& p, int l, int b, int c, int gp, char* smem) {
  float* sU = (float*)smem;
  us* Hb = (us*)(smem + 8192);
  float* Yb = (float*)(smem + 8192 + 4 * 32 * 136 * 2);
  const int tid = tidx(), w = tid >> 6, lane = tid & 63, r = lane & 31, hh = lane >> 5;
  const long m0 = seqrow(b, c * 64);
  const us* P0 = (const us*)(p.ws + OFF_P) + m0 * INC;
  __syncthreads();
  {
    int t = tid >> 2, q4 = tid & 3; float f[8];
    unpack8(*(const u32x4*)(P0 + (size_t)t * INC + 1568 + gp * 32 + q4 * 8), f);
#pragma unroll
    for (int j = 0; j < 8; ++j) sU[t * 32 + q4 * 8 + j] = f[j];
  }
  __syncthreads();
  const int gl = w >> 1, d = w & 1, g = gp * 2 + gl, pp = lane;
  const float* sf = s5f(p, l);
  float Br[16], Bi[16];
  {
    const float* bb = sf + S_BBAR + ((size_t)((d * 16 + g) * 64 + pp) * 16) * 2;
#pragma unroll
    for (int j = 0; j < 8; ++j) { f32x4 t4 = *(const f32x4*)(bb + j * 4); Br[2 * j] = t4[0]; Bi[2 * j] = t4[1]; Br[2 * j + 1] = t4[2]; Bi[2 * j + 1] = t4[3]; }
  }
  const float lr = sf[S_LAMB + ((d * 16 + g) * 64 + pp) * 2], li = sf[S_LAMB + ((d * 16 + g) * 64 + pp) * 2 + 1];
  float hr = 0.f, hi = 0.f;
  float* HL = (float*)(p.ws + OFF_HL) + hl_idx(b, c, d, g, pp);
  if (OUT) { hr = HL[0]; hi = HL[1]; }
  const us* cm = wl(p, l) + W_CM + ((size_t)(d * 16 + g) * 16 + (r & 15)) * 128 + hh * 8;
  for (int half = 0; half < 2; ++half) {
    for (int jj = 0; jj < 32; ++jj) {
      const int j = half * 32 + jj, t = d ? 63 - j : j;
      const float* u = sU + t * 32 + gl * 16;
      float br = 0.f, bi = 0.f;
#pragma unroll
      for (int q = 0; q < 4; ++q) { f32x4 u4 = *(const f32x4*)(u + q * 4);
#pragma unroll
        for (int e = 0; e < 4; ++e) { br += Br[q * 4 + e] * u4[e]; bi += Bi[q * 4 + e] * u4[e]; } }
      float nr = lr * hr - li * hi + br, ni = lr * hi + li * hr + bi; hr = nr; hi = ni;
      if (OUT) { Hb[(w * 32 + (t & 31)) * 136 + pp] = f2bf(hr); Hb[(w * 32 + (t & 31)) * 136 + 64 + pp] = f2bf(hi); }
    }
    if (OUT) {
      __syncthreads();
      f32x16 acc;
#pragma unroll
      for (int q = 0; q < 16; ++q) acc[q] = 0.f;
#pragma unroll
      for (int ks = 0; ks < 8; ++ks) {
        bf16x8 a = *(const bf16x8*)(Hb + (w * 32 + r) * 136 + ks * 16 + hh * 8);
        bf16x8 bb = *(const bf16x8*)(cm + ks * 16);
        if (r >= 16) bb = (bf16x8){0, 0, 0, 0, 0, 0, 0, 0};
        acc = MFMA(a, bb, acc);
      }
      const int tbase = d ? (1 - half) * 32 : half * 32;
      if (r < 16) {
#pragma unroll
        for (int i = 0; i < 16; ++i) Yb[(w * 64 + tbase + crow(i, hh)) * 17 + r] = acc[i];
      }
      __syncthreads();
    }
  }
  if (!OUT) { HL[0] = hr; HL[1] = hi; return; }
  {
    const int gl2 = tid >> 7, t = (tid >> 1) & 63, o8 = (tid & 1) * 8, g2 = gp * 2 + gl2; float y[8];
#pragma unroll
    for (int o = 0; o < 8; ++o) {
      float v = Yb[((gl2 * 2 + 0) * 64 + t) * 17 + o8 + o] + Yb[((gl2 * 2 + 1) * 64 + t) * 17 + o8 + o]
              + p.in[24][l * 256 + g2 * 16 + o8 + o] * sU[t * 32 + gl2 * 16 + o8 + o];
      y[o] = gelu_t(v);
    }
    *(u32x4*)((us*)(p.ws + OFF_Y) + (m0 + t) * 256 + g2 * 16 + o8) = pack8(y);
  }
}
DI void s5b_task(const Params& p, int l, int it) {
  const int gid = it * 256 + tidx();
  const int pp = gid & 63, g = (gid >> 6) & 15, d = (gid >> 10) & 1, b = gid >> 11;
  const float* sf = s5f(p, l);
  const float tr = sf[S_LAMT + ((d * 16 + g) * 64 + pp) * 2], ti = sf[S_LAMT + ((d * 16 + g) * 64 + pp) * 2 + 1];
  float* HL = (float*)(p.ws + OFF_HL);
  float hr = 0.f, hi = 0.f;
  for (int j0 = 0; j0 < NCHK; j0 += 33) {
    f32x2_ xv[33];
#pragma unroll
    for (int q = 0; q < 33; ++q) xv[q] = *(const f32x2_*)(HL + hl_idx(b, gla_order(d, j0 + q), d, g, pp));
#pragma unroll
    for (int q = 0; q < 33; ++q) {
      f32x2_ o = {hr, hi};
      *(f32x2_*)(HL + hl_idx(b, gla_order(d, j0 + q), d, g, pp)) = o;
      float nr = tr * hr - ti * hi + xv[q][0], ni = tr * hi + ti * hr + xv[q][1]; hr = nr; hi = ni;
    }
  }
}

DI void attn_task(const Params& p, int b, int h, int qs0, int nkeys, char* smem) {
  us* sK = (us*)smem;
  us* sV = sK + 2 * 64 * 104;
  const int tid = tidx(), w = tid >> 6, lane = tid & 63, r = lane & 31, hh = lane >> 5;
  const us* Kg = (const us*)(p.ws + OFF_KB) + (size_t)(b * 4 + h) * SEQ * 96;
  const us* Vg = (const us*)(p.ws + OFF_VT) + (size_t)(b * 4 + h) * 64 * SEQ;
  const us* Qg = (const us*)(p.ws + OFF_QB) + ((size_t)(b * 4 + h) * SEQ + qs0 + w * 32 + r) * 96 + hh * 8;
  bf16x8 qf[6];
#pragma unroll
  for (int ks = 0; ks < 6; ++ks) qf[ks] = *(const bf16x8*)(Qg + ks * 16);
  u32x4 rk[3], rv[2];
#define AGLOAD(kt) { _Pragma("unroll") for (int j = 0; j < 3; ++j) { int q = tid + 256 * j; rk[j] = *(const u32x4*)(Kg + (size_t)(kt) * 64 * 96 + q * 8); } \
    _Pragma("unroll") for (int j = 0; j < 2; ++j) { int q = tid + 256 * j, row = q >> 3, cc = q & 7; rv[j] = *(const u32x4*)(Vg + (size_t)row * SEQ + (kt) * 64 + cc * 8); } }
#define ASWRITE(buf) { _Pragma("unroll") for (int j = 0; j < 3; ++j) { int q = tid + 256 * j, row = q / 12, cc = q % 12; *(u32x4*)(sK + (buf) * 64 * 104 + row * 104 + cc * 8) = rk[j]; } \
    _Pragma("unroll") for (int j = 0; j < 2; ++j) { int q = tid + 256 * j, row = q >> 3, cc = q & 7; us* dv = sV + (buf) * 64 * 68 + row * 68 + cc * 8; \
      u32x2 lo = {rv[j][0], rv[j][1]}, hi2 = {rv[j][2], rv[j][3]}; *(u32x2*)dv = lo; *(u32x2*)(dv + 4) = hi2; } }
  f32x16 o0, o1, negm;
#pragma unroll
  for (int q = 0; q < 16; ++q) { o0[q] = 0.f; o1[q] = 0.f; }
  float lsum = 0.f;
  const int NT = nkeys / 64;
  __syncthreads();
  AGLOAD(0); ASWRITE(0); __syncthreads();
  {
    const us* k0 = sK + r * 104 + hh * 8;
    f32x16 s0, s1;
#pragma unroll
    for (int q = 0; q < 16; ++q) { s0[q] = 0.f; s1[q] = 0.f; }
#pragma unroll
    for (int ks = 0; ks < 6; ++ks) {
      bf16x8 a0 = *(const bf16x8*)(k0 + ks * 16), a1 = *(const bf16x8*)(k0 + 32 * 104 + ks * 16);
      s0 = MFMA(a0, qf[ks], s0); s1 = MFMA(a1, qf[ks], s1);
    }
    float mx = s0[0];
#pragma unroll
    for (int i = 1; i < 16; ++i) mx = fmaxf(mx, s0[i]);
#pragma unroll
    for (int i = 0; i < 16; ++i) mx = fmaxf(mx, s1[i]);
    mx = fmaxf(mx, __shfl_xor(mx, 32));
#pragma unroll
    for (int q = 0; q < 16; ++q) negm[q] = -mx;
  }
  for (int kt = 0; kt < NT; ++kt) {
    if (kt + 1 < NT) AGLOAD(kt + 1);
    const us* k0 = sK + (kt & 1) * 64 * 104 + r * 104 + hh * 8;
    const us* v0 = sV + (kt & 1) * 64 * 68 + r * 68 + 4 * hh;
    f32x16 s0, s1;
    {
      bf16x8 a0 = *(const bf16x8*)(k0), a1 = *(const bf16x8*)(k0 + 32 * 104);
      s0 = MFMA(a0, qf[0], negm); s1 = MFMA(a1, qf[0], negm);
    }
#pragma unroll
    for (int ks = 1; ks < 6; ++ks) {
      bf16x8 a0 = *(const bf16x8*)(k0 + ks * 16), a1 = *(const bf16x8*)(k0 + 32 * 104 + ks * 16);
      s0 = MFMA(a0, qf[ks], s0); s1 = MFMA(a1, qf[ks], s1);
    }
    float mx = s0[0];
#pragma unroll
    for (int i = 1; i < 16; ++i) mx = fmaxf(mx, s0[i]);
#pragma unroll
    for (int i = 0; i < 16; ++i) mx = fmaxf(mx, s1[i]);
    mx = fmaxf(mx, __shfl_xor(mx, 32));
    if (__builtin_amdgcn_ballot_w64(mx > 8.f)) {
      const float dl = fmaxf(mx, 0.f), alpha = __builtin_amdgcn_exp2f(-dl);
#pragma unroll
      for (int i = 0; i < 16; ++i) { o0[i] *= alpha; o1[i] *= alpha; s0[i] -= dl; s1[i] -= dl; negm[i] -= dl; }
      lsum *= alpha;
    }
    float ps = 0.f;
#pragma unroll
    for (int i = 0; i < 16; ++i) { s0[i] = __builtin_amdgcn_exp2f(s0[i]); ps += s0[i]; }
#pragma unroll
    for (int i = 0; i < 16; ++i) { s1[i] = __builtin_amdgcn_exp2f(s1[i]); ps += s1[i]; }
    lsum += ps;
    bf16x8 pf[4];
    {
      u32x4 t0 = {pk2(s0[0], s0[1]), pk2(s0[2], s0[3]), pk2(s0[4], s0[5]), pk2(s0[6], s0[7])};
      u32x4 t1 = {pk2(s0[8], s0[9]), pk2(s0[10], s0[11]), pk2(s0[12], s0[13]), pk2(s0[14], s0[15])};
      u32x4 t2 = {pk2(s1[0], s1[1]), pk2(s1[2], s1[3]), pk2(s1[4], s1[5]), pk2(s1[6], s1[7])};
      u32x4 t3 = {pk2(s1[8], s1[9]), pk2(s1[10], s1[11]), pk2(s1[12], s1[13]), pk2(s1[14], s1[15])};
      pf[0] = __builtin_bit_cast(bf16x8, t0); pf[1] = __builtin_bit_cast(bf16x8, t1);
      pf[2] = __builtin_bit_cast(bf16x8, t2); pf[3] = __builtin_bit_cast(bf16x8, t3);
    }
#pragma unroll
    for (int kk = 0; kk < 4; ++kk) {
      u32x2 l0 = *(const u32x2*)(v0 + 16 * kk), h0 = *(const u32x2*)(v0 + 16 * kk + 8);
      u32x2 l1 = *(const u32x2*)(v0 + 32 * 68 + 16 * kk), h1 = *(const u32x2*)(v0 + 32 * 68 + 16 * kk + 8);
      u32x4 a0 = {l0[0], l0[1], h0[0], h0[1]}, a1 = {l1[0], l1[1], h1[0], h1[1]};
      o0 = MFMA(__builtin_bit_cast(bf16x8, a0), pf[kk], o0);
      o1 = MFMA(__builtin_bit_cast(bf16x8, a1), pf[kk], o1);
    }
    if (kt + 1 < NT) ASWRITE((kt + 1) & 1);
    __syncthreads();
  }
#undef AGLOAD
#undef ASWRITE
  lsum += __shfl_xor(lsum, 32);
  const float inv = 1.f / lsum;
  const long m = seqrow(b, qs0 + w * 32 + r);
  us* dst = (us*)(p.ws + OFF_MIXIN) + m * 1024 + 768 + h * 64;
#pragma unroll
  for (int gq = 0; gq < 4; ++gq) {
    u32x2 w0 = {pk2(o0[4 * gq] * inv, o0[4 * gq + 1] * inv), pk2(o0[4 * gq + 2] * inv, o0[4 * gq + 3] * inv)};
    u32x2 w1 = {pk2(o1[4 * gq] * inv, o1[4 * gq + 1] * inv), pk2(o1[4 * gq + 2] * inv, o1[4 * gq + 3] * inv)};
    *(u32x2*)(dst + 8 * gq + 4 * hh) = w0;
    *(u32x2*)(dst + 32 + 8 * gq + 4 * hh) = w1;
  }
}

DI void convact_task(const Params& p, int l, int it, int nrows) {
  const int T = it * 256 + tidx();
  if (T >= (nrows / 8) * 352) return;
  const int rb = T / 352, oct = T - rb * 352, c0 = oct * 8, i0 = rb * 8;
  const int slo = i0 < 8192 ? 0 : 8192, shi = i0 < 8192 ? 8192 : 8448;
  const us* Z = (const us*)(p.ws + OFF_ZPRE);
  const float* cw = p.in[33] + (size_t)l * 3 * DFF2; const float* cb = p.in[34] + (size_t)l * DFF2;
  float wa[3][8], wg[3][8], ba[8], bg[8];
#pragma unroll
  for (int j = 0; j < 3; ++j)
#pragma unroll
    for (int q = 0; q < 8; ++q) { wa[j][q] = cw[j * DFF2 + c0 + q]; wg[j][q] = cw[j * DFF2 + DFF + c0 + q]; }
#pragma unroll
  for (int q = 0; q < 8; ++q) { ba[q] = cb[c0 + q]; bg[q] = cb[DFF + c0 + q]; }
  float za[3][8], zg[3][8];
#define LDROW(slot, i) { if ((i) >= slo && (i) < shi) { unpack8(*(const u32x4*)(Z + (size_t)(i) * DFF2 + c0), za[slot]); unpack8(*(const u32x4*)(Z + (size_t)(i) * DFF2 + DFF + c0), zg[slot]); } \
    else { _Pragma("unroll") for (int q = 0; q < 8; ++q) { za[slot][q] = 0.f; zg[slot][q] = 0.f; } } }
  LDROW(0, i0 - 1); LDROW(1, i0);
  us* A = (us*)(p.ws + OFF_ACT);
#pragma unroll
  for (int ii = 0; ii < 8; ++ii) {
    const int i = i0 + ii;
    LDROW(2, i + 1);
    float o[8];
#pragma unroll
    for (int q = 0; q < 8; ++q) {
      float a = ba[q] + wa[0][q] * za[0][q] + wa[1][q] * za[1][q] + wa[2][q] * za[2][q];
      float gg = bg[q] + wg[0][q] * zg[0][q] + wg[1][q] * zg[1][q] + wg[2][q] * zg[2][q];
      o[q] = gelu_t(a) * gg;
    }
    *(u32x4*)(A + (size_t)i * DFF + c0) = pack8(o);
#pragma unroll
    for (int q = 0; q < 8; ++q) { za[0][q] = za[1][q]; za[1][q] = za[2][q]; zg[0][q] = zg[1][q]; zg[1][q] = zg[2][q]; }
  }
#undef LDROW
}

DI long chunk_row(int ch, int i) { return i < 8192 ? (long)ch * 8192 + i : (long)MX + ch * 256 + (i - 8192); }

__global__ void __launch_bounds__(256, 2) fwd_mega(Params p) {
  cg::grid_group grid = cg::this_grid();
  __shared__ __attribute__((aligned(16))) char smem[64512];
  __shared__ uint4 xb_words;
  const int G = gridDim.x, bid = blockIdx.x, wv = threadIdx.x >> 6;
  if (threadIdx.x == 0) xb_words = make_uint4(0u, 0u, 0u, 0u);
  __syncthreads();
  const XcdBarrier xb = xcd_barrier_post((unsigned*)(p.ws + OFF_BAR), (volatile LAS unsigned*)&xb_words);

  {
    const int n0 = 2 * NCONV_LAYER, n1 = n0 + 384, n2 = n1 + 16, n3 = n2 + 4, n4 = n3 + 128;
    for (int rep = 0; rep < REP_P0; ++rep) for (int it = bid; it < n4; it += G) {
      if (it < n0) conv_task(p, it, smem);
      else if (it < n1) mod_task(p, it - n0, smem);
      else if (it < n2) s5pre_task(p, it - n1);
      else if (it < n3) rope_task(p, it - n2);
      else sguw_task(p, it - n3);
    }
  }
  grid.sync();
  for (int it = bid; it < MT / 4; it += G) row_task<0>(p, 0, (long)it * 4 + wv, nullptr);
  xcd_barrier(xb);

  for (int l = 0; l < 2; ++l) {
    for (int e = 0; e < EXTRA_SYNC; ++e) xcd_barrier(xb);
    const us* W = wl(p, l);
    const int RT = l == 0 ? 264 : 256;
    for (int rep = 0; rep < REP_GEMM; ++rep) for_tiles_xcd(132, 17, G, bid, [&](int rt, int ct) {
      GArgs g{(const us*)(p.ws + OFF_HX) + (size_t)rt * 256 * D, D, W + W_IN + (size_t)ct * 128 * D, D, (long)rt * 256, ct * 128, p.ws + OFF_P, INC, l};
      gemm256<0>(g, smem);
    });
    xcd_barrier(xb);
    {
      const int n0 = RT * 4, n1 = n0 + 4 * NCHK * 4, n2 = n1 + 4 * NCHK * 8, n3 = n2 + 264 * 3, n4 = n3 + 264 * 4;
      for (int rep = 0; rep < REP_M1; ++rep) for (int it = bid; it < n4; it += G) {
        if (it < n0) sgu_task(p, l, it >> 2, it & 3, smem);
        else if (it < n1) { int q = it - n0; gla1_task(p, l, q / (NCHK * 4), (q / 4) % NCHK, q & 3, smem); }
        else if (it < n2) { int q = it - n1; s5_task<false>(p, l, q / (NCHK * 8), (q / 8) % NCHK, q & 7, smem); }
        else if (it < n3) { int q = it - n2, rt = q / 3, ct = q % 3;
          GArgs g{(const us*)(p.ws + OFF_P) + (size_t)rt * 128 * INC + 1824, INC, W + W_UQ + (size_t)ct * 128 * 224, 224, (long)rt * 128, ct * 128, nullptr, 0, l};
          gemm_tile<32, 2, true>(p, g, smem); }
        else { int q = it - n3, rt = q >> 2, ct = q & 3;
          GArgs g{(const us*)(p.ws + OFF_P) + (size_t)rt * 128 * INC + 2048, INC, W + W_UKV + (size_t)ct * 128 * 96, 96, (long)rt * 128, ct * 128, nullptr, 0, l};
          gemm_tile<32, 3, true>(p, g, smem);
          if (ct == 0) kr_task(p, (long)rt * 128); }
      }
    }
    xcd_barrier(xb);
    for (int it = bid; it < 512 + 32; it += G) { if (it < 512) gla2_task(p, it); else s5b_task(p, l, it - 512); }
    xcd_barrier(xb);
    {
      const int c0 = l == 0 ? 0 : 4, nc = NCHK - c0;
      const int n0 = 1024, n1 = n0 + (l == 0 ? 32 : 0), n2 = n1 + 4 * nc * 4, n3 = n2 + 4 * nc * 8;
      for (int rep = 0; rep < REP_M3; ++rep) for (int it = bid; it < n3; it += G) {
        if (it < n0) {
          int pair, qb;
          if (G == 512) { pair = (it & 7) * 2 + (it >> 9); qb = (it & 511) >> 3; } else { pair = it >> 6; qb = it & 63; }
          attn_task(p, pair >> 2, pair & 3, 256 + qb * 128, SEQ, smem);
        } else if (it < n1) { int q = it - n0; attn_task(p, q >> 3, (q >> 1) & 3, (q & 1) * 128, 256, smem); }
        else if (it < n2) { int q = it - n1; gla3_task(p, l, q / (nc * 4), c0 + (q / 4) % nc, q & 3, smem); }
        else { int q = it - n2; s5_task<true>(p, l, q / (nc * 8), c0 + (q / 8) % nc, q & 7, smem); }
      }
    }
    xcd_barrier(xb);
    for (int it = bid; it < RT * 2; it += G) {
      int rt = it >> 1, ct = it & 1;
      GArgs g{(const us*)(p.ws + OFF_Y) + (size_t)rt * 128 * 256, 256, W + W_GLU + (size_t)ct * 128 * 256, 256, (long)rt * 128, ct * 128, nullptr, 0, l};
      gemm_tile<32, 4, false>(p, g, smem);
    }
    xcd_barrier(xb);
    for (int rep = 0; rep < REP_GEMM; ++rep) for_tiles_xcd(RT / 2, 8, G, bid, [&](int rt, int ct) {
      GArgs g{(const us*)(p.ws + OFF_MIXIN) + (size_t)rt * 256 * D, D, W + W_OUT + (size_t)ct * 128 * D, D, (long)rt * 256, ct * 128, p.ws + OFF_MIXOUT, D, l};
      gemm256<1>(g, smem);
    });
    xcd_barrier(xb);
    for (int it = bid; it < RT * 32; it += G) { long m = (long)it * 4 + wv; row_task<1>(p, l, m, (const float*)(p.ws + OFF_MIXOUT) + m * 1024); }
    xcd_barrier(xb);
    const int CRT = l == 0 ? 66 : 64, CROWS = CRT * 128;
    for (int ch = 0; ch < 4; ++ch) {
      for (int rep = 0; rep < REP_GEMM; ++rep) for_tiles_xcd(CRT / 2, 44, G, bid, [&](int rt, int ct) {
        GArgs g{(const us*)(p.ws + OFF_HX) + (size_t)chunk_row(ch, rt * 256) * D, D, W + W_UP + (size_t)ct * 128 * D, D, (long)rt * 256, ct * 128, p.ws + OFF_ZPRE, DFF2, l};
        gemm256<0>(g, smem);
      });
      xcd_barrier(xb);
      for (int rep = 0; rep < REP_F2; ++rep) for (int it = bid; it < (CROWS / 8 * 352 + 255) / 256; it += G) convact_task(p, l, it, CROWS);
      xcd_barrier(xb);
      for (int rep = 0; rep < REP_GEMM; ++rep) for_tiles_xcd(CRT / 2, 8, G, bid, [&](int rt, int ct) {
        GArgs g{(const us*)(p.ws + OFF_ACT) + (size_t)rt * 256 * DFF, DFF, W + W_DN + (size_t)ct * 128 * DFF, DFF, (long)rt * 256, ct * 128, p.ws + OFF_FFNOUT, D, l};
        gemm256<1>(g, smem);
      });
      xcd_barrier(xb);
      for (int it = bid; it < CROWS / 4; it += G) { int i = it * 4 + wv; row_task<2>(p, l, chunk_row(ch, i), (const float*)(p.ws + OFF_FFNOUT) + (size_t)i * 1024); }
      xcd_barrier(xb);
    }
  }
}

extern "C" void kernel_launch(void* const* d_in, const int* in_sizes, int n_in, void* d_out, int out_size,
                              void* d_ws, size_t ws_size, hipStream_t stream) {
  static int grid_blocks = 0;
  if (!grid_blocks) {
    int dev = 0, cus = 0, per_cu = 0;
    (void)hipGetDevice(&dev);
    (void)hipDeviceGetAttribute(&cus, hipDeviceAttributeMultiprocessorCount, dev);
    (void)hipOccupancyMaxActiveBlocksPerMultiprocessor(&per_cu, fwd_mega, 256, 0);
    if (per_cu > 2) per_cu = 2;
    if (per_cu < 1) per_cu = 1;
    grid_blocks = cus * per_cu;
    if (ws_size < OFF_END) fprintf(stderr, "kernel_launch: ws too small: %zu < %zu\n", ws_size, (size_t)OFF_END);
  }
  if (n_in != 36 || ws_size < OFF_END) return;
  Params p{};
  for (int i = 0; i < 36; ++i) p.in[i] = (const float*)d_in[i];
  p.out = (float*)d_out; p.ws = (char*)d_ws;
  void* args[] = {&p};
  (void)hipMemsetAsync((char*)d_ws + OFF_BAR, 0, XCD_BAR_WORDS * 4, stream);
  hipError_t e = hipLaunchCooperativeKernel((void*)fwd_mega, dim3(grid_blocks), dim3(256), args, 0, stream);
  if (e != hipSuccess) fprintf(stderr, "cooperative launch failed: %s (grid %d)\n", hipGetErrorString(e), grid_blocks);
}
```

```cpp
#include <hip/hip_runtime.h>
#include <hip/hip_cooperative_groups.h>
#include <cstdio>
#include <cstdint>
namespace cg = cooperative_groups;

typedef unsigned short us;
using bf16x8 = __attribute__((ext_vector_type(8))) short;
using f32x16 = __attribute__((ext_vector_type(16))) float;
using f32x4  = __attribute__((ext_vector_type(4))) float;
using u32x4  = __attribute__((ext_vector_type(4))) unsigned;
using u32x2  = __attribute__((ext_vector_type(2))) unsigned;
#define DI __device__ __forceinline__
#define MFMA(a, b, c) __builtin_amdgcn_mfma_f32_32x32x16_bf16((a), (b), (c), 0, 0, 0)

#ifndef REP_GEMM
#define REP_GEMM 1
#endif
#ifndef REP_M1
#define REP_M1 1
#endif
#ifndef REP_M3
#define REP_M3 1
#endif
#ifndef REP_ATT
#define REP_ATT 1
#endif
#ifndef REP_GLA3
#define REP_GLA3 1
#endif
#ifndef REP_S5C
#define REP_S5C 1
#endif
#ifndef REP_F2
#define REP_F2 1
#endif
#ifndef REP_P0
#define REP_P0 1
#endif
#ifndef EXTRA_SYNC
#define EXTRA_SYNC 0
#endif
constexpr int D = 1024, MX = 32768, MC = 1024, MT = MX + MC, INC = 2176, DFF = 2816, DFF2 = 5632;
constexpr int SEQ = 8448, NCHK = 132;
constexpr float EPS = 1e-6f;
constexpr float QSCALE = 0.10206207261596577f * 1.4426950408889634f;

constexpr size_t W_IN = 0, W_OUT = W_IN + (size_t)INC * D, W_UP = W_OUT + (size_t)D * D, W_DN = W_UP + (size_t)DFF2 * D,
                 W_UQ = W_DN + (size_t)D * DFF, W_UKV = W_UQ + 384 * 224, W_GLU = W_UKV + 512 * 96, W_SGU = W_GLU + 256 * 256,
                 W_CM = W_SGU + 4 * 128 * 128, W_LAYER = W_CM + 2 * 16 * 16 * 128;
constexpr size_t S_LAMB = 0, S_LAMT = 4096, S_BBAR = 8192, S_LAYER = 8192 + 65536;

constexpr size_t al256(size_t x) { return (x + 255) / 256 * 256; }
constexpr size_t OFF_WB = 0;
constexpr size_t OFF_S5F = al256(OFF_WB + 2 * W_LAYER * 2);
constexpr size_t OFF_MOD = al256(OFF_S5F + 2 * S_LAYER * 4);
constexpr size_t OFF_ROPE = al256(OFF_MOD + 2 * 5 * 6144 * 4);
constexpr size_t OFF_CTXS = al256(OFF_ROPE + 128 * 8 * 2 * 4);
constexpr size_t OFF_HX = al256(OFF_CTXS + (size_t)MC * D * 4);
constexpr size_t OFF_P = al256(OFF_HX + (size_t)MT * D * 2);
constexpr size_t OFF_MIXIN = al256(OFF_P + (size_t)MT * INC * 2);
constexpr size_t OFF_QB = al256(OFF_MIXIN + (size_t)MT * D * 2);
constexpr size_t OFF_KB = al256(OFF_QB + (size_t)16 * SEQ * 96 * 2);
constexpr size_t OFF_VT = al256(OFF_KB + (size_t)16 * SEQ * 96 * 2);
constexpr size_t OFF_KV = al256(OFF_VT + (size_t)16 * 64 * SEQ * 2);
constexpr size_t OFF_DEC = al256(OFF_KV + (size_t)4 * NCHK * 4 * 2 * 4096 * 4);
constexpr size_t OFF_HL = al256(OFF_DEC + (size_t)4 * NCHK * 4 * 2 * 64 * 4);
constexpr size_t OFF_Y = al256(OFF_HL + (size_t)4 * NCHK * 2 * 16 * 64 * 2 * 4);
constexpr size_t OFF_BAR = al256(OFF_Y + (size_t)MT * 256 * 2);
constexpr size_t OFF_SCHED = OFF_BAR + 3456 * 4;
constexpr size_t OFF_END = al256(OFF_SCHED + 1024 * 4);
constexpr size_t OFF_MIXOUT = OFF_P;
constexpr size_t OFF_ZPRE = OFF_P;
constexpr size_t OFF_ACT = OFF_MIXIN;
constexpr size_t OFF_FFNOUT = OFF_QB;
static_assert((size_t)MT * D * 4 <= (size_t)MT * INC * 2, "mixout alias");
static_assert((size_t)8448 * 1024 * 4 <= 2 * (size_t)16 * SEQ * 96 * 2, "ffnout alias");

struct Params { const float* in[36]; float* out; char* ws; };

DI float bf2f(us v) { return __uint_as_float(((unsigned)v) << 16); }
typedef float f32x2_ __attribute__((ext_vector_type(2)));
typedef __bf16 bf16x2_ __attribute__((ext_vector_type(2)));
DI unsigned pk2(float lo, float hi) { f32x2_ v = {lo, hi}; bf16x2_ b = __builtin_convertvector(v, bf16x2_); return __builtin_bit_cast(unsigned, b); }
DI us f2bf(float x) { return (us)(pk2(x, x) & 0xffffu); }
DI float lo_bf(unsigned w) { return __uint_as_float(w << 16); }
DI float hi_bf(unsigned w) { return __uint_as_float(w & 0xffff0000u); }
DI int tid512() { int t; asm volatile("v_mov_b32 %0, %1" : "=v"(t) : "v"(threadIdx.x)); return t; }
DI int tidx() { return tid512() & 255; }
DI int crow(int i, int hh) { return (i & 3) + 8 * (i >> 2) + 4 * hh; }
DI float sigmoidf_(float x) { return 1.f / (1.f + __expf(-x)); }
DI float gelu_t(float x) { float u = 0.7978845608028654f * (x + 0.044715f * x * x * x); return x / (1.f + __expf(-2.f * u)); }
DI float silu_(float x) { return x / (1.f + __expf(-x)); }
DI float logsig(float z) { return fminf(z, 0.f) - log1pf(__expf(-fabsf(z))); }
DI void unpack8(u32x4 w, float* f) {
  f[0] = lo_bf(w[0]); f[1] = hi_bf(w[0]); f[2] = lo_bf(w[1]); f[3] = hi_bf(w[1]);
  f[4] = lo_bf(w[2]); f[5] = hi_bf(w[2]); f[6] = lo_bf(w[3]); f[7] = hi_bf(w[3]);
}
DI u32x4 pack8(const float* f) { u32x4 w = {pk2(f[0], f[1]), pk2(f[2], f[3]), pk2(f[4], f[5]), pk2(f[6], f[7])}; return w; }
DI long seqrow(int b, int s) { return s < 256 ? (long)MX + b * 256 + s : (long)b * 8192 + (s - 256); }
DI float wave_sum(float v) {
  v += __shfl_xor(v, 1); v += __shfl_xor(v, 2); v += __shfl_xor(v, 4); v += __shfl_xor(v, 8); v += __shfl_xor(v, 16); v += __shfl_xor(v, 32);
  return v;
}
DI const us* wl(const Params& p, int l) { return (const us*)(p.ws + OFF_WB) + (size_t)l * W_LAYER; }
DI const float* s5f(const Params& p, int l) { return (const float*)(p.ws + OFF_S5F) + (size_t)l * S_LAYER; }
DI const float* modv(const Params& p, int l, int v, int idx) { return (const float*)(p.ws + OFF_MOD) + ((size_t)(l * 5 + v) * 6 + idx) * 1024; }
DI float* stream_row(const Params& p, long m) { return m < MX ? p.out + m * 1024 : (float*)(p.ws + OFF_CTXS) + (m - MX) * 1024; }
DI const float* input_row(const Params& p, long m) { return m < MX ? p.in[0] + m * 1024 : p.in[2] + (m - MX) * 1024; }


#define XB_TMO      128
#define XB_XCNT(j)  (256  + 64 * (j))
#define XB_XSUB(j)  (1280 + 64 * (j))
#define XB_XGEN(j)  (2304 + 64 * (j))
#define XB_TOP      3328
#define XB_TOPGEN   3392
#define XCD_BAR_WORDS 3456
#define XB_SPIN_CAP (1u << 20)
#define LAS __attribute__((address_space(3)))
DI unsigned xb_ld(unsigned* p)              { return __hip_atomic_load(p, __ATOMIC_RELAXED, __HIP_MEMORY_SCOPE_AGENT); }
DI unsigned xb_add(unsigned* p, unsigned v) { return __hip_atomic_fetch_add(p, v, __ATOMIC_RELAXED, __HIP_MEMORY_SCOPE_AGENT); }
DI unsigned xb_xcc_id() { return (unsigned)__builtin_amdgcn_s_getreg((3 << 11) | 20) & 0xFu; }
#define XB_SPIN(cond, bar) do { unsigned _sp = 0; while (cond) { __builtin_amdgcn_s_sleep(1); \
    if ((++_sp & 255u) == 0u) { if (xb_ld(&(bar)[XB_TMO])) break; if (_sp > XB_SPIN_CAP) { atomicAdd(&(bar)[XB_TMO], 1u); break; } } } } while (0)
struct XcdBarrier { unsigned* bar; unsigned x; volatile LAS unsigned* st; };
DI XcdBarrier xcd_barrier_post(unsigned* bar, volatile LAS unsigned* st) {
  XcdBarrier b; b.bar = bar; b.x = xb_xcc_id(); b.st = st;
  if (threadIdx.x == 0) (void)xb_add(&bar[XB_XCNT(b.x)], 1u);
  return b;
}
DI void xcd_barrier_complete(unsigned* bar, unsigned x, unsigned& nloc, unsigned& nx) {
  const unsigned G = gridDim.x * gridDim.y * gridDim.z;
  unsigned sum, cnt, mine, sp = 0u;
  for (;;) {
    sum = 0u; cnt = 0u; mine = 0u;
#pragma unroll
    for (unsigned j = 0; j < 16; ++j) { const unsigned c = xb_ld(&bar[XB_XCNT(j)]); sum += c; cnt += (c > 0u) ? 1u : 0u; mine = (j == x) ? c : mine; }
    if (sum == G) break;
    __builtin_amdgcn_s_sleep(1);
    if ((++sp & 255u) == 0u) { if (xb_ld(&bar[XB_TMO])) break; if (sp > XB_SPIN_CAP) { atomicAdd(&bar[XB_TMO], 1u); break; } }
  }
  nloc = mine > 0u ? mine : 1u; nx = cnt > 0u ? cnt : 1u;
}
DI void xcd_barrier(const XcdBarrier& b) {
  asm volatile("s_waitcnt vmcnt(0)" ::: "memory");
  __syncthreads();
  if (threadIdx.x == 0) {
    unsigned* bar = b.bar;
    __builtin_amdgcn_s_waitcnt(0);
    unsigned nloc = b.st[0], nx = b.st[1];
    if (nloc == 0u) { xcd_barrier_complete(bar, b.x, nloc, nx); b.st[0] = nloc; b.st[1] = nx; }
    const unsigned old = xb_add(&bar[XB_XSUB(b.x)], 1u);
    const unsigned gen = old / nloc;
    if (old + 1u == (gen + 1u) * nloc) {
      __builtin_amdgcn_fence(__ATOMIC_RELEASE, "agent");
      asm volatile("s_waitcnt vmcnt(0)" ::: "memory");
      const unsigned og = xb_add(&bar[XB_TOP], 1u);
      const unsigned tg = og / nx;
      if (og + 1u == (tg + 1u) * nx) xb_add(&bar[XB_TOPGEN], 1u);
      else XB_SPIN(xb_ld(&bar[XB_TOPGEN]) == tg, bar);
      __builtin_amdgcn_fence(__ATOMIC_ACQUIRE, "agent");
      xb_add(&bar[XB_XGEN(b.x)], 1u);
      asm volatile("s_waitcnt vmcnt(0)" ::: "memory");
    } else {
      XB_SPIN(xb_ld(&bar[XB_XGEN(b.x)]) == gen, bar);
      __builtin_amdgcn_fence(__ATOMIC_ACQUIRE, "agent");
      asm volatile("s_waitcnt vmcnt(0)" ::: "memory");
    }
  }
  __syncthreads();
}

DI void conv_tile(const float* src, us* dst, int K, int N, const float* scale, int tile, char* smem) {
  float* t = (float*)smem;
  const int tid = tidx(), tn = N / 32, tk = tile / tn, tc = tile % tn;
  __syncthreads();
  {
    int k = tid >> 3, c4 = (tid & 7) * 4;
    f32x4 v = *(const f32x4*)(src + (size_t)(tk * 32 + k) * N + tc * 32 + c4);
    float s = scale ? scale[tk * 32 + k] : 1.f;
    t[k * 33 + c4 + 0] = v[0] * s; t[k * 33 + c4 + 1] = v[1] * s; t[k * 33 + c4 + 2] = v[2] * s; t[k * 33 + c4 + 3] = v[3] * s;
  }
  __syncthreads();
  if (tid < 128) {
    int n = tid >> 2, k8 = (tid & 3) * 8; float f[8];
#pragma unroll
    for (int j = 0; j < 8; ++j) f[j] = t[(k8 + j) * 33 + n];
    *(u32x4*)(dst + (size_t)(tc * 32 + n) * K + tk * 32 + k8) = pack8(f);
  }
}
constexpr int NCONV_LAYER = (1024 / 32) * (2176 / 32) + 32 * 32 + 32 * (5632 / 32) + (2816 / 32) * 32 + 7 * 12 + 3 * 16 + 8 * 8;
DI void conv_task(const Params& p, int it, char* smem) {
  int l = it / NCONV_LAYER; it -= l * NCONV_LAYER;
  us* wb = (us*)(p.ws + OFF_WB) + (size_t)l * W_LAYER;
  int nt;
  nt = 32 * 68;  if (it < nt) { conv_tile(p.in[10] + (size_t)l * 1024 * 2176, wb + W_IN, 1024, 2176, nullptr, it, smem); return; } it -= nt;
  nt = 32 * 32;  if (it < nt) { conv_tile(p.in[31] + (size_t)l * 1024 * 1024, wb + W_OUT, 1024, 1024, nullptr, it, smem); return; } it -= nt;
  nt = 32 * 176; if (it < nt) { conv_tile(p.in[32] + (size_t)l * 1024 * 5632, wb + W_UP, 1024, 5632, nullptr, it, smem); return; } it -= nt;
  nt = 88 * 32;  if (it < nt) { conv_tile(p.in[35] + (size_t)l * 2816 * 1024, wb + W_DN, 2816, 1024, nullptr, it, smem); return; } it -= nt;
  nt = 7 * 12;   if (it < nt) { conv_tile(p.in[28] + (size_t)l * 224 * 384, wb + W_UQ, 224, 384, p.in[27] + l * 224, it, smem); return; } it -= nt;
  nt = 3 * 16;   if (it < nt) { conv_tile(p.in[30] + (size_t)l * 96 * 512, wb + W_UKV, 96, 512, p.in[29] + l * 96, it, smem); return; } it -= nt;
  conv_tile(p.in[25] + (size_t)l * 256 * 256, wb + W_GLU, 256, 256, nullptr, it, smem);
}
DI void mod_task(const Params& p, int it, char* smem) {
  float* sc = (float*)smem;
  float* red = sc + 5 * 1024;
  const int tid = tidx(), l = it / 192, jb = it % 192;
  __syncthreads();
  for (int e = tid; e < 5 * 1024; e += 256) {
    int v = e >> 10, k = e & 1023; float c = v < 4 ? p.in[1][v * 1024 + k] : p.in[3][k];
    sc[e] = silu_(c);
  }
  __syncthreads();
  const int col = tid & 31, ks = tid >> 5;
  const float* w = p.in[4] + (size_t)l * 1024 * 6144 + jb * 32 + col;
  float a0 = 0, a1 = 0, a2 = 0, a3 = 0, a4 = 0;
#pragma unroll 8
  for (int k = ks * 128; k < ks * 128 + 128; ++k) {
    float wv = w[(size_t)k * 6144];
    a0 += sc[k] * wv; a1 += sc[1024 + k] * wv; a2 += sc[2048 + k] * wv; a3 += sc[3072 + k] * wv; a4 += sc[4096 + k] * wv;
  }
  float* rp = red + (ks * 32 + col) * 5;
  rp[0] = a0; rp[1] = a1; rp[2] = a2; rp[3] = a3; rp[4] = a4;
  __syncthreads();
  if (tid < 160) {
    int v = tid >> 5, c = tid & 31; float s = 0;
    for (int q = 0; q < 8; ++q) s += red[(q * 32 + c) * 5 + v];
    int j = jb * 32 + c;
    ((float*)(p.ws + OFF_MOD))[(size_t)(l * 5 + v) * 6144 + j] = s + p.in[5][l * 6144 + j];
  }
}
DI void s5pre_task(const Params& p, int it) {
  int gid = it * 256 + tidx();
  int pp = gid & 63, g = (gid >> 6) & 15, d = (gid >> 10) & 1, l = gid >> 11;
  int idx = ((l * 2 + d) * 16 + g) * 64 + pp;
  float are = p.in[17][idx], aim = p.in[18][idx];
  float dt = expf(p.in[19][(l * 2 + d) * 16 + g]);
  float mag = expf(are * dt), lr = mag * cosf(aim * dt), li = mag * sinf(aim * dt);
  float magT = expf(are * dt * 64.f), tr = magT * cosf(aim * dt * 64.f), ti = magT * sinf(aim * dt * 64.f);
  float nr = lr - 1.f, ni = li, den = are * are + aim * aim;
  float cr = (nr * are + ni * aim) / den, ci = (ni * are - nr * aim) / den;
  float* sf = (float*)(p.ws + OFF_S5F) + (size_t)l * S_LAYER;
  int o2 = ((d * 16 + g) * 64 + pp);
  sf[S_LAMB + o2 * 2] = lr; sf[S_LAMB + o2 * 2 + 1] = li;
  sf[S_LAMT + o2 * 2] = tr; sf[S_LAMT + o2 * 2 + 1] = ti;
  for (int i = 0; i < 16; ++i) {
    float br = p.in[20][(size_t)idx * 16 + i], bi = p.in[21][(size_t)idx * 16 + i];
    sf[S_BBAR + ((size_t)o2 * 16 + i) * 2] = cr * br - ci * bi;
    sf[S_BBAR + ((size_t)o2 * 16 + i) * 2 + 1] = cr * bi + ci * br;
  }
  us* cm = (us*)(p.ws + OFF_WB) + (size_t)l * W_LAYER + W_CM;
  for (int o = 0; o < 16; ++o) {
    size_t ci_ = ((size_t)((l * 2 + d) * 16 + g) * 16 + o) * 64 + pp;
    cm[((size_t)(d * 16 + g) * 16 + o) * 128 + pp] = f2bf(p.in[22][ci_]);
    cm[((size_t)(d * 16 + g) * 16 + o) * 128 + 64 + pp] = f2bf(-p.in[23][ci_]);
  }
}
DI void rope_task(const Params& p, int it) {
  int gid = it * 256 + tidx();
  int pos = gid >> 3, f = gid & 7;
  float inv = powf(10000.f, -(float)f / 8.f), ang = (float)pos * inv;
  float* r = (float*)(p.ws + OFF_ROPE);
  r[gid * 2] = cosf(ang); r[gid * 2 + 1] = sinf(ang);
}
DI void sguw_task(const Params& p, int it) {
  int gid = it * 256 + tidx();
  int l = gid >> 14, e = (gid & 16383) * 4;
  f32x4 v = *(const f32x4*)(p.in[12] + (size_t)l * 65536 + e);
  u32x2 w = {pk2(v[0], v[1]), pk2(v[2], v[3])};
  *(u32x2*)((us*)(p.ws + OFF_WB) + (size_t)l * W_LAYER + W_SGU + e) = w;
}

template <int MODE>
DI void row_task(const Params& p, int l, long m, const us* yrow) {
  const int lane = tidx() & 63, v = m < MX ? (int)(m >> 13) : 4;
  float x[16];
  if (MODE == 0) {
    const float* src = input_row(p, m);
#pragma unroll
    for (int j = 0; j < 4; ++j) { f32x4 t = *(const f32x4*)(src + (j * 64 + lane) * 4); x[4 * j] = t[0]; x[4 * j + 1] = t[1]; x[4 * j + 2] = t[2]; x[4 * j + 3] = t[3]; }
  } else {
    float y[16]; float ss = 0;
    const float* xo = (MODE == 1 && l == 0) ? input_row(p, m) : stream_row(p, m);
#pragma unroll
    for (int j = 0; j < 4; ++j) {
      u32x2 t = *(const u32x2*)(yrow + (j * 64 + lane) * 4); y[4 * j] = lo_bf(t[0]); y[4 * j + 1] = hi_bf(t[0]); y[4 * j + 2] = lo_bf(t[1]); y[4 * j + 3] = hi_bf(t[1]);
      f32x4 u = *(const f32x4*)(xo + (j * 64 + lane) * 4); x[4 * j] = u[0]; x[4 * j + 1] = u[1]; x[4 * j + 2] = u[2]; x[4 * j + 3] = u[3];
    }
#pragma unroll
    for (int j = 0; j < 16; ++j) ss += y[j] * y[j];
    ss = wave_sum(ss);
    float rstd = rsqrtf(ss * (1.f / 1024.f) + EPS);
    const float* gp = (MODE == 1 ? p.in[7] : p.in[9]) + l * 1024;
    const float* gt = modv(p, l, v, MODE == 1 ? 2 : 5);
    float* dst = stream_row(p, m);
#pragma unroll
    for (int j = 0; j < 4; ++j) {
      int c = (j * 64 + lane) * 4;
      f32x4 g4 = *(const f32x4*)(gp + c), t4 = *(const f32x4*)(gt + c), o;
#pragma unroll
      for (int q = 0; q < 4; ++q) { x[4 * j + q] += t4[q] * (y[4 * j + q] * rstd * g4[q]); o[q] = x[4 * j + q]; }
      *(f32x4*)(dst + c) = o;
    }
    if (MODE == 2 && l == 1) return;
  }
  const int ln = (MODE == 2) ? 1 : l;
  const float* g = (MODE == 1 ? p.in[8] : p.in[6]) + ln * 1024;
  const float* sh = modv(p, ln, v, MODE == 1 ? 3 : 0);
  const float* sc = modv(p, ln, v, MODE == 1 ? 4 : 1);
  float ss = 0;
#pragma unroll
  for (int j = 0; j < 16; ++j) ss += x[j] * x[j];
  ss = wave_sum(ss);
  float rstd = rsqrtf(ss * (1.f / 1024.f) + EPS);
  us* hx = (us*)(p.ws + OFF_HX) + m * 1024;
#pragma unroll
  for (int j = 0; j < 4; ++j) {
    int c = (j * 64 + lane) * 4;
    f32x4 g4 = *(const f32x4*)(g + c), s4 = *(const f32x4*)(sh + c), c4 = *(const f32x4*)(sc + c); float h[4];
#pragma unroll
    for (int q = 0; q < 4; ++q) h[q] = (x[4 * j + q] * rstd * g4[q]) * (1.f + c4[q]) + s4[q];
    u32x2 w = {pk2(h[0], h[1]), pk2(h[2], h[3])};
    *(u32x2*)(hx + c) = w;
  }
}

struct GArgs { const us* A; int lda; const us* W; int K; long m0; int n0; void* out; int ldo; int l; };
template <int BK, int EPI, bool ROWSS>
DI void gemm_tile(const Params& p, const GArgs& g, char* smem) {
  constexpr int LS = BK + 8, CPR = BK / 8, NCH = 128 * CPR / 256;
  us* sA = (us*)smem; us* sB = sA + 2 * 128 * LS; float* rstd = (float*)(sB + 2 * 128 * LS);
  const int tid = tidx(), w = tid >> 6, lane = tid & 63, r = lane & 31, hh = lane >> 5, wm = w >> 1, wn = w & 1;
  __syncthreads();
  if (ROWSS) {
    int row = tid >> 1, half = tid & 1; float ss = 0;
    const us* ap = g.A + (size_t)row * g.lda + half * (g.K / 2);
    for (int c = 0; c < g.K / 16; ++c) { float f[8]; unpack8(*(const u32x4*)(ap + c * 8), f);
#pragma unroll
      for (int j = 0; j < 8; ++j) ss += f[j] * f[j]; }
    ss += __shfl_xor(ss, 1);
    if (!half) rstd[row] = rsqrtf(ss / (float)g.K + EPS);
  }
  u32x4 ra[NCH], rb[NCH];
  f32x16 acc[2][2];
#pragma unroll
  for (int i = 0; i < 2; ++i)
#pragma unroll
    for (int j = 0; j < 2; ++j)
#pragma unroll
      for (int q = 0; q < 16; ++q) acc[i][j][q] = 0.f;
#define GLOAD(kt) _Pragma("unroll") for (int j = 0; j < NCH; ++j) { int q = tid + 256 * j, row = q / CPR, cc = q % CPR; \
    ra[j] = *(const u32x4*)(g.A + (size_t)row * g.lda + (kt) * BK + cc * 8); rb[j] = *(const u32x4*)(g.W + (size_t)row * g.K + (kt) * BK + cc * 8); }
#define SWRITE(buf) _Pragma("unroll") for (int j = 0; j < NCH; ++j) { int q = tid + 256 * j, row = q / CPR, cc = q % CPR; \
    *(u32x4*)(sA + (buf) * 128 * LS + row * LS + cc * 8) = ra[j]; *(u32x4*)(sB + (buf) * 128 * LS + row * LS + cc * 8) = rb[j]; }
  GLOAD(0); SWRITE(0); __syncthreads();
  const int KT = g.K / BK;
  for (int kt = 0; kt < KT; ++kt) {
    if (kt + 1 < KT) { GLOAD(kt + 1); }
    const us* a0 = sA + (kt & 1) * 128 * LS + (wm * 64 + r) * LS + hh * 8;
    const us* b0 = sB + (kt & 1) * 128 * LS + (wn * 64 + r) * LS + hh * 8;
#pragma unroll
    for (int ks = 0; ks < BK / 16; ++ks) {
      bf16x8 af0 = *(const bf16x8*)(a0 + ks * 16), af1 = *(const bf16x8*)(a0 + 32 * LS + ks * 16);
      bf16x8 bf0 = *(const bf16x8*)(b0 + ks * 16), bf1 = *(const bf16x8*)(b0 + 32 * LS + ks * 16);
      acc[0][0] = MFMA(af0, bf0, acc[0][0]); acc[0][1] = MFMA(af0, bf1, acc[0][1]);
      acc[1][0] = MFMA(af1, bf0, acc[1][0]); acc[1][1] = MFMA(af1, bf1, acc[1][1]);
    }
    if (kt + 1 < KT) { SWRITE((kt + 1) & 1); }
    __syncthreads();
  }
#undef GLOAD
#undef SWRITE
#pragma unroll
  for (int si = 0; si < 2; ++si)
#pragma unroll
    for (int sj = 0; sj < 2; ++sj) {
      const int col = wn * 64 + sj * 32 + r, n = g.n0 + col;
#pragma unroll
      for (int i = 0; i < 16; ++i) {
        const int row = wm * 64 + si * 32 + crow(i, hh);
        const long m = g.m0 + row;
        float v = acc[si][sj][i];
        if (EPI == 0) { ((us*)g.out)[m * g.ldo + n] = f2bf(v); }
        else if (EPI == 1) { ((float*)g.out)[m * g.ldo + n] = v; }
        else if (EPI == 2) {
          v *= rstd[row] * QSCALE;
          float pv = __shfl_xor(v, 8);
          const int head = n / 96, j = n - head * 96;
          const bool isx = m < MX; const int t = isx ? (int)(m & 8191) : (int)((m - MX) & 255);
          const int b = isx ? (int)(m >> 13) : (int)((m - MX) >> 8);
          if (isx && j >= 64) {
            int jj = (j - 64) & 15, blk = (j - 64) >> 4, f = jj & 7, pos = blk ? (t & 63) : (t >> 6);
            const float* rp = (const float*)(p.ws + OFF_ROPE) + (pos * 8 + f) * 2; float cs = rp[0], sn = rp[1];
            v = (jj < 8) ? v * cs - pv * sn : pv * sn + v * cs;
          }
          const int s = isx ? 256 + t : t;
          ((us*)(p.ws + OFF_QB))[((size_t)(b * 4 + head) * SEQ + s) * 96 + j] = f2bf(v);
        } else if (EPI == 3) {
          v *= rstd[row];
          const int head = n >> 7, j = n & 127;
          const bool isx = m < MX; const int t = isx ? (int)(m & 8191) : (int)((m - MX) & 255);
          const int b = isx ? (int)(m >> 13) : (int)((m - MX) >> 8);
          const int s = isx ? 256 + t : t;
          if (j < 64) ((us*)(p.ws + OFF_KB))[((size_t)(b * 4 + head) * SEQ + s) * 96 + j] = f2bf(v);
          else if ((i & 3) == 3) {
            const float r1 = rstd[row - 1], r2 = rstd[row - 2], r3 = rstd[row - 3];
            u32x2 w2 = {pk2(acc[si][sj][i - 3] * r3, acc[si][sj][i - 2] * r2), pk2(acc[si][sj][i - 1] * r1, v)};
            *(u32x2*)((us*)(p.ws + OFF_VT) + ((size_t)(b * 4 + head) * 64 + (j - 64)) * SEQ + s - 3) = w2;
          }
        } else if (EPI == 4) {
          float y = bf2f(((const us*)(p.ws + OFF_Y))[m * 256 + n]);
          v += p.in[26][g.l * 256 + n];
          ((us*)(p.ws + OFF_MIXIN))[m * 1024 + 512 + n] = f2bf(y * sigmoidf_(v));
        }
      }
    }
}


DI void gemm_big(const GArgs& g, int ncv, char* smem) {
  constexpr int LS = 72, ST = 256 * LS;
  us* sA = (us*)smem; us* sB = sA + 2 * ST;
  const int tid = tid512(), w = tid >> 6, lane = tid & 63, r = lane & 31, hh = lane >> 5, wm = w >> 2, wn = w & 3;
  u32x4 ra[4], rb[4];
  f32x16 acc[4][2];
#pragma unroll
  for (int i = 0; i < 4; ++i)
#pragma unroll
    for (int j = 0; j < 2; ++j)
#pragma unroll
      for (int q = 0; q < 16; ++q) acc[i][j][q] = 0.f;
  const int srow = tid >> 3, scc = (tid & 7) * 8;
  const us* gA = g.A + (size_t)srow * g.lda + scc;
  const us* gB = g.W + (size_t)srow * g.K + scc;
#define GLOAD(kt) { _Pragma("unroll") for (int j = 0; j < 4; ++j) { ra[j] = *(const u32x4*)(gA + (size_t)(64 * j) * g.lda + (kt) * 64); rb[j] = *(const u32x4*)(gB + (size_t)(64 * j) * g.K + (kt) * 64); } }
#define SWRITE(buf) { _Pragma("unroll") for (int j = 0; j < 4; ++j) { *(u32x4*)(sA + (buf) * ST + (srow + 64 * j) * LS + scc) = ra[j]; *(u32x4*)(sB + (buf) * ST + (srow + 64 * j) * LS + scc) = rb[j]; } }
  const int KT = g.K / 64;
  __syncthreads();
  GLOAD(0); SWRITE(0); __syncthreads();
  const bool act = wn * 64 < ncv;
  for (int kt = 0; kt < KT; ++kt) {
    { const int kl = kt + 1 < KT ? kt + 1 : kt; GLOAD(kl); }
    if (act) {
      const us* a0 = sA + (kt & 1) * ST + (wm * 128 + r) * LS + hh * 8;
      const us* b0 = sB + (kt & 1) * ST + (wn * 64 + r) * LS + hh * 8;
      bf16x8 fa[2], fb[2][2];
      fb[0][0] = *(const bf16x8*)(b0); fb[0][1] = *(const bf16x8*)(b0 + 32 * LS);
      fa[0] = *(const bf16x8*)(a0);
#pragma unroll
      for (int t = 0; t < 16; ++t) {
        const int ks = t >> 2, i = t & 3;
        if (t + 1 < 16) { const int t2 = t + 1; fa[t2 & 1] = *(const bf16x8*)(a0 + (t2 & 3) * 32 * LS + (t2 >> 2) * 16); }
        if (i == 1 && ks < 3) { fb[(ks + 1) & 1][0] = *(const bf16x8*)(b0 + (ks + 1) * 16); fb[(ks + 1) & 1][1] = *(const bf16x8*)(b0 + 32 * LS + (ks + 1) * 16); }
        __builtin_amdgcn_sched_barrier(0);
        acc[i][0] = MFMA(fb[ks & 1][0], fa[t & 1], acc[i][0]); acc[i][1] = MFMA(fb[ks & 1][1], fa[t & 1], acc[i][1]);
        __builtin_amdgcn_sched_barrier(0);
      }
    }
    SWRITE((kt + 1) & 1);
    __syncthreads();
  }
#undef GLOAD
#undef SWRITE
  {
    us* sC = (us*)smem; constexpr int CS = 264;
    if (act) {
#pragma unroll
      for (int si = 0; si < 4; ++si)
#pragma unroll
        for (int sj = 0; sj < 2; ++sj)
#pragma unroll
          for (int gq = 0; gq < 4; ++gq) {
            u32x2 w2 = {pk2(acc[si][sj][4 * gq], acc[si][sj][4 * gq + 1]), pk2(acc[si][sj][4 * gq + 2], acc[si][sj][4 * gq + 3])};
            *(u32x2*)(sC + (wm * 128 + si * 32 + r) * CS + wn * 64 + sj * 32 + 8 * gq + 4 * hh) = w2;
          }
    }
    __syncthreads();
    us* outp = (us*)g.out + (size_t)g.m0 * g.ldo + g.n0;
#pragma unroll 4
    for (int k = 0; k < 16; ++k) {
      const int q = tid + 512 * k, row = q >> 5, cc = q & 31;
      if (cc * 8 < ncv) *(u32x4*)(outp + (size_t)row * g.ldo + cc * 8) = *(const u32x4*)(sC + row * CS + cc * 8);
    }
  }
}
template <class F>
DI void for_tiles_xcd(int RT, int CT, int G, int bid, F f) {
  if ((G & 7) == 0) {
    const int x = bid & 7, rows = (RT - x + 7) >> 3, n = rows * CT, nfull = CT >> 3;
    for (int j = bid >> 3; j < n; j += G >> 3) {
      int rl, ct;
      if (j < nfull * rows * 8) { int pnl = j / (rows * 8), rem = j - pnl * rows * 8; rl = rem >> 3; ct = pnl * 8 + (rem & 7); }
      else { int j2 = j - nfull * rows * 8, wd = CT - nfull * 8; rl = j2 / wd; ct = nfull * 8 + (j2 - rl * wd); }
      f(rl * 8 + x, ct);
    }
  } else {
    for (int it = bid; it < RT * CT; it += G) f(it / CT, it % CT);
  }
}

DI void kr_task(const Params& p, long m0) {
  const int tid = tidx(), row = tid >> 1, blk = tid & 1; const long m = m0 + row;
  const us* src = (const us*)(p.ws + OFF_P) + m * INC + 2144 + blk * 16;
  float v[16], o[16]; unpack8(*(const u32x4*)src, v); unpack8(*(const u32x4*)(src + 8), v + 8);
  const bool isx = m < MX; const int t = isx ? (int)(m & 8191) : (int)((m - MX) & 255);
  const int b = isx ? (int)(m >> 13) : (int)((m - MX) >> 8), s = isx ? 256 + t : t;
  if (isx) {
    int pos = blk ? (t & 63) : (t >> 6);
    const float* rp = (const float*)(p.ws + OFF_ROPE) + pos * 16;
#pragma unroll
    for (int f = 0; f < 8; ++f) { float cs = rp[2 * f], sn = rp[2 * f + 1]; o[f] = v[f] * cs - v[f + 8] * sn; o[f + 8] = v[f] * sn + v[f + 8] * cs; }
  } else {
#pragma unroll
    for (int f = 0; f < 16; ++f) o[f] = v[f];
  }
  u32x4 w0 = pack8(o), w1 = pack8(o + 8);
#pragma unroll
  for (int hd = 0; hd < 4; ++hd) {
    us* dst = (us*)(p.ws + OFF_KB) + ((size_t)(b * 4 + hd) * SEQ + s) * 96 + 64 + blk * 16;
    *(u32x4*)dst = w0; *(u32x4*)(dst + 8) = w1;
  }
}

DI void sgu_task(const Params& p, int l, int chunk, int h, char* smem) {
  us* Vt = (us*)smem;
  const int tid = tidx(), w = tid >> 6, lane = tid & 63, r = lane & 31, hh = lane >> 5;
  const long m0 = (long)chunk * 128;
  const us* P = (const us*)(p.ws + OFF_P);
  __syncthreads();
  {
    int row = tid >> 1, dh = (tid & 1) * 32; float v[32]; float ss = 0;
    const us* src = P + (m0 + row) * INC + 256 + h * 64 + dh;
#pragma unroll
    for (int c = 0; c < 4; ++c) unpack8(*(const u32x4*)(src + c * 8), v + c * 8);
#pragma unroll
    for (int j = 0; j < 32; ++j) { v[j] = gelu_t(v[j]); ss += v[j] * v[j]; }
    ss += __shfl_xor(ss, 1);
    float rstd = rsqrtf(ss * (1.f / 64.f) + EPS);
    const float* gn = p.in[11] + l * 256 + h * 64 + dh;
#pragma unroll
    for (int j = 0; j < 32; ++j) Vt[(dh + j) * 136 + row] = f2bf(v[j] * rstd * gn[j]);
  }
  __syncthreads();
  const us* Wsp = wl(p, l) + W_SGU + (size_t)h * 16384 + (size_t)(w * 32 + r) * 128 + hh * 8;
  f32x16 a0, a1;
#pragma unroll
  for (int q = 0; q < 16; ++q) { a0[q] = 0.f; a1[q] = 0.f; }
#pragma unroll
  for (int ks = 0; ks < 8; ++ks) {
    bf16x8 af = *(const bf16x8*)(Wsp + ks * 16);
    bf16x8 b0 = *(const bf16x8*)(Vt + r * 136 + ks * 16 + hh * 8), b1 = *(const bf16x8*)(Vt + (32 + r) * 136 + ks * 16 + hh * 8);
    a0 = MFMA(af, b0, a0); a1 = MFMA(af, b1, a1);
  }
  us* out = (us*)(p.ws + OFF_MIXIN);
#pragma unroll
  for (int i = 0; i < 16; ++i) {
    int t = w * 32 + crow(i, hh); float bs = p.in[13][l * 512 + h * 128 + t];
    const us* pu = P + (m0 + t) * INC + h * 64;
    float u0 = gelu_t(bf2f(pu[r])), u1 = gelu_t(bf2f(pu[32 + r]));
    out[(m0 + t) * 1024 + h * 64 + r] = f2bf(u0 * (a0[i] + bs));
    out[(m0 + t) * 1024 + h * 64 + 32 + r] = f2bf(u1 * (a1[i] + bs));
  }
}

DI void gla_gate_dir(const Params& p, int l, const us* Prow0, int h, int d, float* sW, float* G) {
  const int tid = tidx();
  const float* wg = p.in[14] + (size_t)l * 2 * 16 * 256;
#pragma unroll
  for (int j = 0; j < 4; ++j) { int e = tid + 256 * j, rr = e >> 6, ch = e & 63; sW[e] = wg[(d * 16 + rr) * 256 + h * 64 + ch]; }
  __syncthreads();
  {
    int t = tid >> 2, q4 = tid & 3; float gl[16];
    const us* src = Prow0 + (size_t)t * INC + 1536 + d * 16;
    unpack8(*(const u32x4*)src, gl); unpack8(*(const u32x4*)(src + 8), gl + 8);
    const float* bg = p.in[15] + l * 512 + d * 256 + h * 64 + q4 * 16;
#pragma unroll
    for (int c = 0; c < 16; ++c) {
      float z = bg[c];
#pragma unroll
      for (int rr = 0; rr < 16; ++rr) z += gl[rr] * sW[rr * 64 + q4 * 16 + c];
      G[t * 64 + q4 * 16 + c] = logsig(z) * (1.f / 16.f);
    }
  }
  __syncthreads();
  if (tid < 64) {
    float run = 0;
    if (d == 0) { for (int t = 0; t < 64; ++t) { run += G[t * 64 + tid]; G[t * 64 + tid] = run; } }
    else { for (int t = 63; t >= 0; --t) { run += G[t * 64 + tid]; G[t * 64 + tid] = run; } }
  }
  __syncthreads();
}
DI size_t gla_idx(int b, int c, int h, int d) { return (size_t)(((b * NCHK + c) * 4 + h) * 2 + d); }

DI void gla1_task(const Params& p, int l, int b, int c, int h, char* smem) {
  float* G0 = (float*)smem; float* G1 = G0 + 4096; float* sW = G1 + 4096;
  us* KeT = (us*)(sW + 1024);
  us* Vt = KeT + 2 * 64 * 72;
  const int tid = tidx(), w = tid >> 6, lane = tid & 63, r = lane & 31, hh = lane >> 5;
  const long m0 = seqrow(b, c * 64);
  const us* P0 = (const us*)(p.ws + OFF_P) + m0 * INC;
  __syncthreads();
  gla_gate_dir(p, l, P0, h, 0, sW, G0);
  gla_gate_dir(p, l, P0, h, 1, sW, G1);
  {
    int t = tid >> 2, q4 = tid & 3; float kk[16], vv[16];
    const us* sk = P0 + (size_t)t * INC + 768 + h * 64 + q4 * 16;
    const us* sv = P0 + (size_t)t * INC + 1024 + h * 64 + q4 * 16;
    unpack8(*(const u32x4*)sk, kk); unpack8(*(const u32x4*)(sk + 8), kk + 8);
    unpack8(*(const u32x4*)sv, vv); unpack8(*(const u32x4*)(sv + 8), vv + 8);
#pragma unroll
    for (int cc = 0; cc < 16; ++cc) {
      int ch = q4 * 16 + cc;
      KeT[ch * 72 + t] = f2bf(kk[cc] * __expf(G0[63 * 64 + ch] - G0[t * 64 + ch]));
      KeT[(64 + ch) * 72 + t] = f2bf(kk[cc] * __expf(G1[ch] - G1[t * 64 + ch]));
      Vt[ch * 72 + t] = f2bf(vv[cc]);
    }
    if (tid < 128) {
      int d = tid >> 6, ch = tid & 63;
      ((float*)(p.ws + OFF_DEC))[gla_idx(b, c, h, d) * 64 + ch] = __expf(d ? G1[ch] : G0[63 * 64 + ch]);
    }
  }
  __syncthreads();
  {
    const int d = w >> 1, mt = w & 1;
    float* kv = (float*)(p.ws + OFF_KV) + gla_idx(b, c, h, d) * 4096;
#pragma unroll
    for (int nt = 0; nt < 2; ++nt) {
      f32x16 acc;
#pragma unroll
      for (int q = 0; q < 16; ++q) acc[q] = 0.f;
#pragma unroll
      for (int ks = 0; ks < 4; ++ks) {
        bf16x8 a = *(const bf16x8*)(Vt + (mt * 32 + r) * 72 + ks * 16 + hh * 8);
        bf16x8 bb = *(const bf16x8*)(KeT + (d * 64 + nt * 32 + r) * 72 + ks * 16 + hh * 8);
        acc = MFMA(a, bb, acc);
      }
#pragma unroll
      for (int i = 0; i < 16; ++i) kv[(mt * 32 + crow(i, hh)) * 64 + nt * 32 + r] = acc[i];
    }
  }
}
DI int gla_order(int d, int j) { return d == 0 ? j : (j < 4 ? 3 - j : 135 - j); }
DI void gla2_task(const Params& p, int it) {
  const int gid = it * 256 + tidx();
  const int e = gid & 4095, d = (gid >> 12) & 1, h = (gid >> 13) & 3, b = gid >> 15, k = e & 63;
  float* KV = (float*)(p.ws + OFF_KV); const float* DEC = (const float*)(p.ws + OFF_DEC);
  float s = 0;
  for (int j0 = 0; j0 < NCHK; j0 += 33) {
    float kv[33], dc[33];
#pragma unroll
    for (int q = 0; q < 33; ++q) { const size_t ix = gla_idx(b, gla_order(d, j0 + q), h, d); kv[q] = KV[ix * 4096 + e]; dc[q] = DEC[ix * 64 + k]; }
#pragma unroll
    for (int q = 0; q < 33; ++q) { const size_t ix = gla_idx(b, gla_order(d, j0 + q), h, d); KV[ix * 4096 + e] = s; s = dc[q] * s + kv[q]; }
  }
}
DI void gla3_task(const Params& p, int l, int b, int c, int h, char* smem) {
  float* G = (float*)smem;
  us* Qin = (us*)(smem + 17408);
  us* Kin = Qin + 64 * 72; us* Vt = Kin + 64 * 72; us* ST = Vt + 64 * 72; us* Sc = ST + 64 * 72;
  float* sW = (float*)Sc;
  const int tid = tidx(), w = tid >> 6, lane = tid & 63, r = lane & 31, hh = lane >> 5;
  const long m0 = seqrow(b, c * 64);
  const us* P0 = (const us*)(p.ws + OFF_P) + m0 * INC;
  const int t_ = tid >> 2, q4 = tid & 3;
  __syncthreads();
  {
    float vv[16]; const us* sv = P0 + (size_t)t_ * INC + 1024 + h * 64 + q4 * 16;
    unpack8(*(const u32x4*)sv, vv); unpack8(*(const u32x4*)(sv + 8), vv + 8);
#pragma unroll
    for (int cc = 0; cc < 16; ++cc) Vt[(q4 * 16 + cc) * 72 + t_] = f2bf(vv[cc]);
  }
  f32x16 oacc;
#pragma unroll
  for (int q = 0; q < 16; ++q) oacc[q] = 0.f;
  const int mt = w >> 1, nt = w & 1;
  for (int d = 0; d < 2; ++d) {
    gla_gate_dir(p, l, P0, h, d, sW, G);
    {
      float qq[16], kk[16], qo[16], ko[16];
      const us* sq = P0 + (size_t)t_ * INC + 512 + h * 64 + q4 * 16;
      const us* sk = P0 + (size_t)t_ * INC + 768 + h * 64 + q4 * 16;
      unpack8(*(const u32x4*)sq, qq); unpack8(*(const u32x4*)(sq + 8), qq + 8);
      unpack8(*(const u32x4*)sk, kk); unpack8(*(const u32x4*)(sk + 8), kk + 8);
#pragma unroll
      for (int cc = 0; cc < 16; ++cc) { float gg = G[t_ * 64 + q4 * 16 + cc]; qo[cc] = qq[cc] * 0.125f * __expf(gg); ko[cc] = kk[cc] * __expf(-gg); }
      *(u32x4*)(Qin + t_ * 72 + q4 * 16) = pack8(qo); *(u32x4*)(Qin + t_ * 72 + q4 * 16 + 8) = pack8(qo + 8);
      *(u32x4*)(Kin + t_ * 72 + q4 * 16) = pack8(ko); *(u32x4*)(Kin + t_ * 72 + q4 * 16 + 8) = pack8(ko + 8);
      const float* ss = (const float*)(p.ws + OFF_KV) + gla_idx(b, c, h, d) * 4096 + tid * 16;
      float sf[16];
#pragma unroll
      for (int j = 0; j < 4; ++j) { f32x4 t4 = *(const f32x4*)(ss + j * 4); sf[4 * j] = t4[0]; sf[4 * j + 1] = t4[1]; sf[4 * j + 2] = t4[2]; sf[4 * j + 3] = t4[3]; }
      const int v_ = tid >> 2, k0 = (tid & 3) * 16;
      *(u32x4*)(ST + v_ * 72 + k0) = pack8(sf); *(u32x4*)(ST + v_ * 72 + k0 + 8) = pack8(sf + 8);
    }
    __syncthreads();
    {
      const int tt = mt, st = nt;
      const bool need = d == 0 ? st <= tt : st >= tt;
      f32x16 sc;
#pragma unroll
      for (int q = 0; q < 16; ++q) sc[q] = 0.f;
      if (need) {
#pragma unroll
        for (int ks = 0; ks < 4; ++ks) {
          bf16x8 a = *(const bf16x8*)(Qin + (tt * 32 + r) * 72 + ks * 16 + hh * 8);
          bf16x8 bb = *(const bf16x8*)(Kin + (st * 32 + r) * 72 + ks * 16 + hh * 8);
          sc = MFMA(a, bb, sc);
        }
      }
#pragma unroll
      for (int i = 0; i < 16; ++i) {
        int trow = tt * 32 + crow(i, hh), scol = st * 32 + r;
        bool keep = d == 0 ? scol <= trow : scol >= trow;
        Sc[trow * 72 + scol] = f2bf(keep ? sc[i] : 0.f);
      }
    }
    __syncthreads();
#pragma unroll
    for (int ks = 0; ks < 4; ++ks) {
      bf16x8 a = *(const bf16x8*)(Sc + (mt * 32 + r) * 72 + ks * 16 + hh * 8);
      bf16x8 bb = *(const bf16x8*)(Vt + (nt * 32 + r) * 72 + ks * 16 + hh * 8);
      oacc = MFMA(a, bb, oacc);
    }
#pragma unroll
    for (int ks = 0; ks < 4; ++ks) {
      bf16x8 a = *(const bf16x8*)(Qin + (mt * 32 + r) * 72 + ks * 16 + hh * 8);
      bf16x8 bb = *(const bf16x8*)(ST + (nt * 32 + r) * 72 + ks * 16 + hh * 8);
      oacc = MFMA(a, bb, oacc);
    }
    __syncthreads();
  }
  float* Ob = (float*)smem;
#pragma unroll
  for (int i = 0; i < 16; ++i) Ob[(mt * 32 + crow(i, hh)) * 68 + nt * 32 + r] = oacc[i];
  __syncthreads();
  {
    float o[16], rr[16]; float ss = 0;
#pragma unroll
    for (int cc = 0; cc < 16; ++cc) { o[cc] = Ob[t_ * 68 + q4 * 16 + cc]; ss += o[cc] * o[cc]; }
    ss += __shfl_xor(ss, 1); ss += __shfl_xor(ss, 2);
    float rstd = rsqrtf(ss * (1.f / 64.f) + EPS);
    const us* sr = P0 + (size_t)t_ * INC + 1280 + h * 64 + q4 * 16;
    unpack8(*(const u32x4*)sr, rr); unpack8(*(const u32x4*)(sr + 8), rr + 8);
    const float* gn = p.in[16] + l * 256 + h * 64 + q4 * 16;
#pragma unroll
    for (int cc = 0; cc < 16; ++cc) o[cc] = o[cc] * rstd * gn[cc] * silu_(rr[cc]);
    us* dst = (us*)(p.ws + OFF_MIXIN) + (m0 + t_) * 1024 + 256 + h * 64 + q4 * 16;
    *(u32x4*)dst = pack8(o); *(u32x4*)(dst + 8) = pack8(o + 8);
  }
}

DI size_t hl_idx(int b, int c, int d, int g, int pp) { return ((size_t)(((b * NCHK + c) * 2 + d) * 16 + g) * 64 + pp) * 2; }
template <bool OUT>
DI void s5_task(const Params& p, int l, int b, int c, int gp, char* smem) {
  float* sU = (float*)smem;
  us* Hb = (us*)(smem + 8192);
  float* Yb = (float*)(smem + 8192 + 4 * 32 * 136 * 2);
  const int tid = tidx(), w = tid >> 6, lane = tid & 63, r = lane & 31, hh = lane >> 5;
  const long m0 = seqrow(b, c * 64);
  const us* P0 = (const us*)(p.ws + OFF_P) + m0 * INC;
  __syncthreads();
  {
    int t = tid >> 2, q4 = tid & 3; float f[8];
    unpack8(*(const u32x4*)(P0 + (size_t)t * INC + 1568 + gp * 32 + q4 * 8), f);
#pragma unroll
    for (int j = 0; j < 8; ++j) sU[t * 32 + q4 * 8 + j] = f[j];
  }
  __syncthreads();
  const int gl = w >> 1, d = w & 1, g = gp * 2 + gl, pp = lane;
  const float* sf = s5f(p, l);
  float Br[16], Bi[16];
  {
    const float* bb = sf + S_BBAR + ((size_t)((d * 16 + g) * 64 + pp) * 16) * 2;
#pragma unroll
    for (int j = 0; j < 8; ++j) { f32x4 t4 = *(const f32x4*)(bb + j * 4); Br[2 * j] = t4[0]; Bi[2 * j] = t4[1]; Br[2 * j + 1] = t4[2]; Bi[2 * j + 1] = t4[3]; }
  }
  const float lr = sf[S_LAMB + ((d * 16 + g) * 64 + pp) * 2], li = sf[S_LAMB + ((d * 16 + g) * 64 + pp) * 2 + 1];
  float hr = 0.f, hi = 0.f;
  float* HL = (float*)(p.ws + OFF_HL) + hl_idx(b, c, d, g, pp);
  if (OUT) { hr = HL[0]; hi = HL[1]; }
  const us* cm = wl(p, l) + W_CM + ((size_t)(d * 16 + g) * 16 + (r & 15)) * 128 + hh * 8;
  for (int half = 0; half < 2; ++half) {
    for (int jj = 0; jj < 32; ++jj) {
      const int j = half * 32 + jj, t = d ? 63 - j : j;
      const float* u = sU + t * 32 + gl * 16;
      float br = 0.f, bi = 0.f;
#pragma unroll
      for (int q = 0; q < 4; ++q) { f32x4 u4 = *(const f32x4*)(u + q * 4);
#pragma unroll
        for (int e = 0; e < 4; ++e) { br += Br[q * 4 + e] * u4[e]; bi += Bi[q * 4 + e] * u4[e]; } }
      float nr = lr * hr - li * hi + br, ni = lr * hi + li * hr + bi; hr = nr; hi = ni;
      if (OUT) { Hb[(w * 32 + (t & 31)) * 136 + pp] = f2bf(hr); Hb[(w * 32 + (t & 31)) * 136 + 64 + pp] = f2bf(hi); }
    }
    if (OUT) {
      __syncthreads();
      f32x16 acc;
#pragma unroll
      for (int q = 0; q < 16; ++q) acc[q] = 0.f;
#pragma unroll
      for (int ks = 0; ks < 8; ++ks) {
        bf16x8 a = *(const bf16x8*)(Hb + (w * 32 + r) * 136 + ks * 16 + hh * 8);
        bf16x8 bb = *(const bf16x8*)(cm + ks * 16);
        if (r >= 16) bb = (bf16x8){0, 0, 0, 0, 0, 0, 0, 0};
        acc = MFMA(a, bb, acc);
      }
      const int tbase = d ? (1 - half) * 32 : half * 32;
      if (r < 16) {
#pragma unroll
        for (int i = 0; i < 16; ++i) Yb[(w * 64 + tbase + crow(i, hh)) * 17 + r] = acc[i];
      }
      __syncthreads();
    }
  }
  if (!OUT) { HL[0] = hr; HL[1] = hi; return; }
  {
    const int gl2 = tid >> 7, t = (tid >> 1) & 63, o8 = (tid & 1) * 8, g2 = gp * 2 + gl2; float y[8];
#pragma unroll
    for (int o = 0; o < 8; ++o) {
      float v = Yb[((gl2 * 2 + 0) * 64 + t) * 17 + o8 + o] + Yb[((gl2 * 2 + 1) * 64 + t) * 17 + o8 + o]
              + p.in[24][l * 256 + g2 * 16 + o8 + o] * sU[t * 32 + gl2 * 16 + o8 + o];
      y[o] = gelu_t(v);
    }
    *(u32x4*)((us*)(p.ws + OFF_Y) + (m0 + t) * 256 + g2 * 16 + o8) = pack8(y);
  }
}
DI void s5b_task(const Params& p, int l, int it) {
  const int gid = it * 256 + tidx();
  const int pp = gid & 63, g = (gid >> 6) & 15, d = (gid >> 10) & 1, b = gid >> 11;
  const float* sf = s5f(p, l);
  const float tr = sf[S_LAMT + ((d * 16 + g) * 64 + pp) * 2], ti = sf[S_LAMT + ((d * 16 + g) * 64 + pp) * 2 + 1];
  float* HL = (float*)(p.ws + OFF_HL);
  float hr = 0.f, hi = 0.f;
  for (int j0 = 0; j0 < NCHK; j0 += 33) {
    f32x2_ xv[33];
#pragma unroll
    for (int q = 0; q < 33; ++q) xv[q] = *(const f32x2_*)(HL + hl_idx(b, gla_order(d, j0 + q), d, g, pp));
#pragma unroll
    for (int q = 0; q < 33; ++q) {
      f32x2_ o = {hr, hi};
      *(f32x2_*)(HL + hl_idx(b, gla_order(d, j0 + q), d, g, pp)) = o;
      float nr = tr * hr - ti * hi + xv[q][0], ni = tr * hi + ti * hr + xv[q][1]; hr = nr; hi = ni;
    }
  }
}

DI void attn_task(const Params& p, int b, int h, int qs0, int nkeys, char* smem) {
  us* sK = (us*)smem;
  us* sV = sK + 2 * 64 * 104;
  const int tid = tid512(), w = tid >> 6, lane = tid & 63, r = lane & 31, hh = lane >> 5;
  const us* Kg = (const us*)(p.ws + OFF_KB) + (size_t)(b * 4 + h) * SEQ * 96;
  const us* Vg = (const us*)(p.ws + OFF_VT) + (size_t)(b * 4 + h) * 64 * SEQ;
  const us* Qg = (const us*)(p.ws + OFF_QB) + ((size_t)(b * 4 + h) * SEQ + qs0 + w * 32 + r) * 96 + hh * 8;
  bf16x8 qf[6];
#pragma unroll
  for (int ks = 0; ks < 6; ++ks) qf[ks] = *(const bf16x8*)(Qg + ks * 16);
  u32x4 rk[2], rv;
  const int kq1 = tid + 512 < 768 ? tid + 512 : tid;
  const int vrow = tid >> 3, vcc = tid & 7;
#define AGLOAD(kt) { rk[0] = *(const u32x4*)(Kg + (size_t)(kt) * 64 * 96 + tid * 8); rk[1] = *(const u32x4*)(Kg + (size_t)(kt) * 64 * 96 + kq1 * 8); \
    rv = *(const u32x4*)(Vg + (size_t)vrow * SEQ + (kt) * 64 + vcc * 8); }
#define ASWRITE(buf) { *(u32x4*)(sK + (buf) * 64 * 104 + (tid / 12) * 104 + (tid % 12) * 8) = rk[0]; *(u32x4*)(sK + (buf) * 64 * 104 + (kq1 / 12) * 104 + (kq1 % 12) * 8) = rk[1]; \
    us* dv = sV + (buf) * 64 * 68 + vrow * 68 + vcc * 8; u32x2 lo = {rv[0], rv[1]}, hi2 = {rv[2], rv[3]}; *(u32x2*)dv = lo; *(u32x2*)(dv + 4) = hi2; }
  f32x16 o0, o1, negm;
#pragma unroll
  for (int q = 0; q < 16; ++q) { o0[q] = 0.f; o1[q] = 0.f; }
  float lsum = 0.f;
  const int NT = nkeys / 64;
  __syncthreads();
  AGLOAD(0); ASWRITE(0); __syncthreads();
  {
    const us* k0 = sK + r * 104 + hh * 8;
    f32x16 s0, s1;
#pragma unroll
    for (int q = 0; q < 16; ++q) { s0[q] = 0.f; s1[q] = 0.f; }
#pragma unroll
    for (int ks = 0; ks < 6; ++ks) {
      bf16x8 a0 = *(const bf16x8*)(k0 + ks * 16), a1 = *(const bf16x8*)(k0 + 32 * 104 + ks * 16);
      s0 = MFMA(a0, qf[ks], s0); s1 = MFMA(a1, qf[ks], s1);
    }
    float mx = s0[0];
#pragma unroll
    for (int i = 1; i < 16; ++i) mx = fmaxf(mx, s0[i]);
#pragma unroll
    for (int i = 0; i < 16; ++i) mx = fmaxf(mx, s1[i]);
    mx = fmaxf(mx, __shfl_xor(mx, 32));
#pragma unroll
    for (int q = 0; q < 16; ++q) negm[q] = -mx;
  }
  for (int kt = 0; kt < NT; ++kt) {
    if (kt + 1 < NT) AGLOAD(kt + 1);
    const us* k0 = sK + (kt & 1) * 64 * 104 + r * 104 + hh * 8;
    const us* v0 = sV + (kt & 1) * 64 * 68 + r * 68 + 4 * hh;
    f32x16 s0, s1;
    {
      bf16x8 a0 = *(const bf16x8*)(k0), a1 = *(const bf16x8*)(k0 + 32 * 104);
      s0 = MFMA(a0, qf[0], negm); s1 = MFMA(a1, qf[0], negm);
    }
#pragma unroll
    for (int ks = 1; ks < 6; ++ks) {
      bf16x8 a0 = *(const bf16x8*)(k0 + ks * 16), a1 = *(const bf16x8*)(k0 + 32 * 104 + ks * 16);
      s0 = MFMA(a0, qf[ks], s0); s1 = MFMA(a1, qf[ks], s1);
    }
    float mx = s0[0];
#pragma unroll
    for (int i = 1; i < 16; ++i) mx = fmaxf(mx, s0[i]);
#pragma unroll
    for (int i = 0; i < 16; ++i) mx = fmaxf(mx, s1[i]);
    mx = fmaxf(mx, __shfl_xor(mx, 32));
    if (__builtin_amdgcn_ballot_w64(mx > 8.f)) {
      const float dl = fmaxf(mx, 0.f), alpha = __builtin_amdgcn_exp2f(-dl);
#pragma unroll
      for (int i = 0; i < 16; ++i) { o0[i] *= alpha; o1[i] *= alpha; s0[i] -= dl; s1[i] -= dl; negm[i] -= dl; }
      lsum *= alpha;
    }
    float ps = 0.f;
#pragma unroll
    for (int i = 0; i < 16; ++i) { s0[i] = __builtin_amdgcn_exp2f(s0[i]); ps += s0[i]; }
#pragma unroll
    for (int i = 0; i < 16; ++i) { s1[i] = __builtin_amdgcn_exp2f(s1[i]); ps += s1[i]; }
    lsum += ps;
    bf16x8 pf[4];
    {
      u32x4 t0 = {pk2(s0[0], s0[1]), pk2(s0[2], s0[3]), pk2(s0[4], s0[5]), pk2(s0[6], s0[7])};
      u32x4 t1 = {pk2(s0[8], s0[9]), pk2(s0[10], s0[11]), pk2(s0[12], s0[13]), pk2(s0[14], s0[15])};
      u32x4 t2 = {pk2(s1[0], s1[1]), pk2(s1[2], s1[3]), pk2(s1[4], s1[5]), pk2(s1[6], s1[7])};
      u32x4 t3 = {pk2(s1[8], s1[9]), pk2(s1[10], s1[11]), pk2(s1[12], s1[13]), pk2(s1[14], s1[15])};
      pf[0] = __builtin_bit_cast(bf16x8, t0); pf[1] = __builtin_bit_cast(bf16x8, t1);
      pf[2] = __builtin_bit_cast(bf16x8, t2); pf[3] = __builtin_bit_cast(bf16x8, t3);
    }
#pragma unroll
    for (int kk = 0; kk < 4; ++kk) {
      u32x2 l0 = *(const u32x2*)(v0 + 16 * kk), h0 = *(const u32x2*)(v0 + 16 * kk + 8);
      u32x2 l1 = *(const u32x2*)(v0 + 32 * 68 + 16 * kk), h1 = *(const u32x2*)(v0 + 32 * 68 + 16 * kk + 8);
      u32x4 a0 = {l0[0], l0[1], h0[0], h0[1]}, a1 = {l1[0], l1[1], h1[0], h1[1]};
      o0 = MFMA(__builtin_bit_cast(bf16x8, a0), pf[kk], o0);
      o1 = MFMA(__builtin_bit_cast(bf16x8, a1), pf[kk], o1);
    }
    if (kt + 1 < NT) ASWRITE((kt + 1) & 1);
    __syncthreads();
  }
#undef AGLOAD
#undef ASWRITE
  lsum += __shfl_xor(lsum, 32);
  const float inv = 1.f / lsum;
  const long m = seqrow(b, qs0 + w * 32 + r);
  us* dst = (us*)(p.ws + OFF_MIXIN) + m * 1024 + 768 + h * 64;
#pragma unroll
  for (int gq = 0; gq < 4; ++gq) {
    u32x2 w0 = {pk2(o0[4 * gq] * inv, o0[4 * gq + 1] * inv), pk2(o0[4 * gq + 2] * inv, o0[4 * gq + 3] * inv)};
    u32x2 w1 = {pk2(o1[4 * gq] * inv, o1[4 * gq + 1] * inv), pk2(o1[4 * gq + 2] * inv, o1[4 * gq + 3] * inv)};
    *(u32x2*)(dst + 8 * gq + 4 * hh) = w0;
    *(u32x2*)(dst + 32 + 8 * gq + 4 * hh) = w1;
  }
}

DI void convact_task(const Params& p, int l, int it, int nrows) {
  const int T = it * 256 + tidx();
  if (T >= (nrows / 8) * 352) return;
  const int rb = T / 352, oct = T - rb * 352, c0 = oct * 8, i0 = rb * 8;
  const int slo = i0 < 8192 ? 0 : 8192, shi = i0 < 8192 ? 8192 : 8448;
  const us* Z = (const us*)(p.ws + OFF_ZPRE);
  const float* cw = p.in[33] + (size_t)l * 3 * DFF2; const float* cb = p.in[34] + (size_t)l * DFF2;
  float wa[3][8], wg[3][8], ba[8], bg[8];
#pragma unroll
  for (int j = 0; j < 3; ++j)
#pragma unroll
    for (int q = 0; q < 8; ++q) { wa[j][q] = cw[j * DFF2 + c0 + q]; wg[j][q] = cw[j * DFF2 + DFF + c0 + q]; }
#pragma unroll
  for (int q = 0; q < 8; ++q) { ba[q] = cb[c0 + q]; bg[q] = cb[DFF + c0 + q]; }
  float za[3][8], zg[3][8];
#define LDROW(slot, i) { if ((i) >= slo && (i) < shi) { unpack8(*(const u32x4*)(Z + (size_t)(i) * DFF2 + c0), za[slot]); unpack8(*(const u32x4*)(Z + (size_t)(i) * DFF2 + DFF + c0), zg[slot]); } \
    else { _Pragma("unroll") for (int q = 0; q < 8; ++q) { za[slot][q] = 0.f; zg[slot][q] = 0.f; } } }
  LDROW(0, i0 - 1); LDROW(1, i0);
  us* A = (us*)(p.ws + OFF_ACT);
#pragma unroll
  for (int ii = 0; ii < 8; ++ii) {
    const int i = i0 + ii;
    LDROW(2, i + 1);
    float o[8];
#pragma unroll
    for (int q = 0; q < 8; ++q) {
      float a = ba[q] + wa[0][q] * za[0][q] + wa[1][q] * za[1][q] + wa[2][q] * za[2][q];
      float gg = bg[q] + wg[0][q] * zg[0][q] + wg[1][q] * zg[1][q] + wg[2][q] * zg[2][q];
      o[q] = gelu_t(a) * gg;
    }
    *(u32x4*)(A + (size_t)i * DFF + c0) = pack8(o);
#pragma unroll
    for (int q = 0; q < 8; ++q) { za[0][q] = za[1][q]; za[1][q] = za[2][q]; zg[0][q] = zg[1][q]; zg[1][q] = zg[2][q]; }
  }
#undef LDROW
}


constexpr int SCHED_WORDS = 1024;
DI int gl_n(int RT, int CT, int x) { return ((RT - x + 7) >> 3) * CT; }
DI void gl_tile(int RT, int CT, int x, int j, int& rt, int& ct) {
  const int rows = (RT - x + 7) >> 3, nfull = CT >> 3; int rl;
  if (j < nfull * rows * 8) { int pnl = j / (rows * 8), rem = j - pnl * rows * 8; rl = rem >> 3; ct = pnl * 8 + (rem & 7); }
  else { int j2 = j - nfull * rows * 8, wd = CT - nfull * 8; rl = j2 / wd; ct = nfull * 8 + (j2 - rl * wd); }
  rt = rl * 8 + x;
}
DI int ml_n(int n, int x) { return (n - x + 7) >> 3; }
template <class NX, class RUN>
DI void run_phase(unsigned*& ctr, int G, int bid, volatile int* s_bc, NX nx, RUN run) {
  const int x0 = bid & 7, per = G >> 3;
  const int x = x0; int j = bid >> 3;
  for (;;) {
    if (j < nx(x)) {
      int nj = 0;
      if (threadIdx.x == 0) nj = per + (int)atomicAdd(&ctr[x], 1u);
      run(x, j);
      __syncthreads();
      if (threadIdx.x == 0) *s_bc = nj;
      __syncthreads();
      j = *s_bc;
    } else break;
  }
  ctr += 8;
}

DI long chunk_row(int ch, int i) { return i < 8192 ? (long)ch * 8192 + i : (long)MX + ch * 256 + (i - 8192); }


template <class RUN>
DI void run_tiles(unsigned*& ctr, int n, int G, int bid, volatile int* s_bc, RUN run) {
  int it = bid;
  while (it < n) {
    int nx = 0;
    if (threadIdx.x == 0) nx = G + (int)atomicAdd(ctr, 1u);
    run(it);
    __syncthreads();
    if (threadIdx.x == 0) *s_bc = nx;
    __syncthreads();
    it = *s_bc;
  }
  ctr += 1;
}

constexpr int HLDS = 64512;
constexpr int LDS_BYTES = 147456;
static_assert(2 * HLDS <= LDS_BYTES, "lds");

__global__ void __launch_bounds__(512) fwd_mega(Params p) {
  cg::grid_group grid = cg::this_grid();
  extern __shared__ __attribute__((aligned(16))) char dsm[];
  __shared__ uint4 xb_words;
  const int G = gridDim.x, bid = blockIdx.x, wv8 = threadIdx.x >> 6, half = threadIdx.x >> 8;
  char* smem = dsm + half * HLDS;
  const int vb = bid * 2 + half, V = 2 * G;
  if (threadIdx.x == 0) xb_words = make_uint4(0u, 0u, 0u, 0u);
  __syncthreads();
  const XcdBarrier xb = xcd_barrier_post((unsigned*)(p.ws + OFF_BAR), (volatile LAS unsigned*)&xb_words);
#define HALF_LOOP(n, IT, ...) { const int n_ = (n); const int iters_ = (n_ + V - 1) / V; for (int k_ = 0; k_ < iters_; ++k_) { int IT = vb + k_ * V; IT = IT < n_ ? IT : n_ - 1; __VA_ARGS__ } }
#define HALF_LOOP_NB(n, IT, ...) { const int n_ = (n); for (int IT = vb; IT < n_; IT += V) { __VA_ARGS__ } }

  HALF_LOOP(2 * NCONV_LAYER, it, conv_task(p, it, smem);)
  HALF_LOOP(384, it, mod_task(p, it, smem);)
  HALF_LOOP_NB(16, it, s5pre_task(p, it);)
  HALF_LOOP_NB(4, it, rope_task(p, it);)
  HALF_LOOP_NB(128, it, sguw_task(p, it);)
  grid.sync();
  for (int it = bid; it < MT / 8; it += G) row_task<0>(p, 0, (long)it * 8 + wv8, nullptr);
  xcd_barrier(xb);

  unsigned* ctr = (unsigned*)(p.ws + OFF_SCHED);
  volatile int* s_bc = (volatile int*)&xb_words.z;
  for (int l = 0; l < 2; ++l) {
    const us* W = wl(p, l);
    const int RT = l == 0 ? 264 : 256;
    run_tiles(ctr, 132 * 9, G, bid, s_bc, [&](int it) {
      const int rt = it / 9, ct = it - rt * 9;
      GArgs g{(const us*)(p.ws + OFF_HX) + (size_t)rt * 256 * D, D, W + W_IN + (size_t)ct * 256 * D, D, (long)rt * 256, ct * 256, p.ws + OFF_P, INC, l};
      gemm_big(g, ct == 8 ? 128 : 256, dsm);
    });
    xcd_barrier(xb);
    HALF_LOOP(4 * NCHK * 8, q, s5_task<false>(p, l, q / (NCHK * 8), (q / 8) % NCHK, q & 7, smem);)
    HALF_LOOP(4 * NCHK * 4, q, gla1_task(p, l, q / (NCHK * 4), (q / 4) % NCHK, q & 3, smem);)
    HALF_LOOP(RT * 4, q, sgu_task(p, l, q >> 2, q & 3, smem);)
    HALF_LOOP(264 * 3, q, { int rt = q / 3, ct = q % 3;
      GArgs g{(const us*)(p.ws + OFF_P) + (size_t)rt * 128 * INC + 1824, INC, W + W_UQ + (size_t)ct * 128 * 224, 224, (long)rt * 128, ct * 128, nullptr, 0, l};
      gemm_tile<32, 2, true>(p, g, smem); })
    HALF_LOOP(264 * 4, q, { int rt = q >> 2, ct = q & 3;
      GArgs g{(const us*)(p.ws + OFF_P) + (size_t)rt * 128 * INC + 2048, INC, W + W_UKV + (size_t)ct * 128 * 96, 96, (long)rt * 128, ct * 128, nullptr, 0, l};
      gemm_tile<32, 3, true>(p, g, smem);
      if (ct == 0) kr_task(p, (long)rt * 128); })
    xcd_barrier(xb);
    HALF_LOOP_NB(512, it, gla2_task(p, it);)
    HALF_LOOP_NB(32, it, s5b_task(p, l, it);)
    xcd_barrier(xb);
    if ((G & 7) == 0) {
      const int x = bid & 7;
      for (int j = bid >> 3; j < 64; j += G >> 3) { int pair = 2 * x + (j >> 5), qb = j & 31; attn_task(p, pair >> 2, pair & 3, 256 + qb * 256, SEQ, dsm); }
    } else {
      for (int it = bid; it < 512; it += G) attn_task(p, it >> 7, (it >> 5) & 3, 256 + (it & 31) * 256, SEQ, dsm);
    }
    if (l == 0) for (int it = bid; it < 16; it += G) attn_task(p, it >> 2, it & 3, 0, 256, dsm);
    {
      const int c0 = l == 0 ? 0 : 4, nc = NCHK - c0;
      HALF_LOOP(4 * nc * 8, q, s5_task<true>(p, l, q / (nc * 8), c0 + (q / 8) % nc, q & 7, smem);)
      HALF_LOOP(4 * nc * 4, q, gla3_task(p, l, q / (nc * 4), c0 + (q / 4) % nc, q & 3, smem);)
    }
    xcd_barrier(xb);
    HALF_LOOP(RT * 2, it, { int rt = it >> 1, ct = it & 1;
      GArgs g{(const us*)(p.ws + OFF_Y) + (size_t)rt * 128 * 256, 256, W + W_GLU + (size_t)ct * 128 * 256, 256, (long)rt * 128, ct * 128, nullptr, 0, l};
      gemm_tile<32, 4, false>(p, g, smem); })
    xcd_barrier(xb);
    run_tiles(ctr, (RT / 2) * 4, G, bid, s_bc, [&](int it) {
      const int rt = it >> 2, ct = it & 3;
      GArgs g{(const us*)(p.ws + OFF_MIXIN) + (size_t)rt * 256 * D, D, W + W_OUT + (size_t)ct * 256 * D, D, (long)rt * 256, ct * 256, p.ws + OFF_MIXOUT, D, l};
      gemm_big(g, 256, dsm);
    });
    xcd_barrier(xb);
    for (int it = bid; it < RT * 16; it += G) { long m = (long)it * 8 + wv8; row_task<1>(p, l, m, (const us*)(p.ws + OFF_MIXOUT) + m * 1024); }
    xcd_barrier(xb);
    const int CR2 = l == 0 ? 33 : 32, CROWS = CR2 * 256, NF2 = (CROWS / 8 * 352 + 255) / 256;
    for (int ch = 0; ch <= 4; ++ch) {
      {
        const bool hasF3 = ch > 0, hasF1 = ch < 4;
        const int n3 = hasF3 ? CR2 * 4 : 0, n1 = hasF1 ? CR2 * 22 : 0;
        run_tiles(ctr, n3 + n1, G, bid, s_bc, [&](int it) {
          if (it < n3) {
            const int rt = it >> 2, ct = it & 3;
            GArgs g{(const us*)(p.ws + OFF_ACT) + (size_t)rt * 256 * DFF, DFF, W + W_DN + (size_t)ct * 256 * DFF, DFF, (long)rt * 256, ct * 256, p.ws + OFF_FFNOUT, D, l};
            gemm_big(g, 256, dsm);
          } else {
            const int q = it - n3, rt = q / 22, ct = q - rt * 22;
            GArgs g{(const us*)(p.ws + OFF_HX) + (size_t)chunk_row(ch, rt * 256) * D, D, W + W_UP + (size_t)ct * 256 * D, D, (long)rt * 256, ct * 256, p.ws + OFF_ZPRE, DFF2, l};
            gemm_big(g, 256, dsm);
          }
        });
      }
      xcd_barrier(xb);
      if (ch < 4) HALF_LOOP_NB(NF2, it, convact_task(p, l, it, CROWS);)
      if (ch > 0) for (int it = bid; it < CROWS / 8; it += G) { int i = it * 8 + wv8; row_task<2>(p, l, chunk_row(ch - 1, i), (const us*)(p.ws + OFF_FFNOUT) + (size_t)i * 1024); }
      xcd_barrier(xb);
    }
  }
#undef HALF_LOOP
#undef HALF_LOOP_NB
}

extern "C" void kernel_launch(void* const* d_in, const int* in_sizes, int n_in, void* d_out, int out_size,
                              void* d_ws, size_t ws_size, hipStream_t stream) {
  static int grid_blocks = 0;
  if (!grid_blocks) {
    int dev = 0, cus = 0, per_cu = 0;
    (void)hipGetDevice(&dev);
    (void)hipDeviceGetAttribute(&cus, hipDeviceAttributeMultiprocessorCount, dev);
    if (hipFuncSetAttribute((const void*)fwd_mega, hipFuncAttributeMaxDynamicSharedMemorySize, LDS_BYTES) != hipSuccess)
      fprintf(stderr, "kernel_launch: hipFuncSetAttribute(%d B LDS) failed\n", LDS_BYTES);
    (void)hipOccupancyMaxActiveBlocksPerMultiprocessor(&per_cu, fwd_mega, 512, LDS_BYTES);
    if (per_cu < 1) fprintf(stderr, "kernel_launch: occupancy query returned %d\n", per_cu);
    grid_blocks = cus;
    if (ws_size < OFF_END) fprintf(stderr, "kernel_launch: ws too small: %zu < %zu\n", ws_size, (size_t)OFF_END);
  }
  if (n_in != 36 || ws_size < OFF_END) return;
  Params p{};
  for (int i = 0; i < 36; ++i) p.in[i] = (const float*)d_in[i];
  p.out = (float*)d_out; p.ws = (char*)d_ws;
  void* args[] = {&p};
  (void)hipMemsetAsync((char*)d_ws + OFF_BAR, 0, (XCD_BAR_WORDS + SCHED_WORDS) * 4, stream);
  hipError_t e = hipLaunchCooperativeKernel((void*)fwd_mega, dim3(grid_blocks), dim3(512), args, LDS_BYTES, stream);
  if (e != hipSuccess) fprintf(stderr, "cooperative launch failed: %s (grid %d)\n", hipGetErrorString(e), grid_blocks);
}
```

```cpp
#include <hip/hip_runtime.h>
#include <hip/hip_cooperative_groups.h>
#include <cstdio>
#include <cstdint>
namespace cg = cooperative_groups;

typedef unsigned short us;
using bf16x8 = __attribute__((ext_vector_type(8))) short;
using f32x16 = __attribute__((ext_vector_type(16))) float;
using f32x4  = __attribute__((ext_vector_type(4))) float;
using u32x4  = __attribute__((ext_vector_type(4))) unsigned;
using u32x2  = __attribute__((ext_vector_type(2))) unsigned;
#define DI __device__ __forceinline__
#define MFMA(a, b, c) __builtin_amdgcn_mfma_f32_32x32x16_bf16((a), (b), (c), 0, 0, 0)

#ifndef REP_F3N
#define REP_F3N 1
#endif
#ifndef REP_F1N
#define REP_F1N 1
#endif
#ifndef REP_GEMM
#define REP_GEMM 1
#endif
#ifndef REP_M1
#define REP_M1 1
#endif
#ifndef REP_M3
#define REP_M3 1
#endif
#ifndef REP_ATT
#define REP_ATT 1
#endif
#ifndef REP_GLA3
#define REP_GLA3 1
#endif
#ifndef REP_S5C
#define REP_S5C 1
#endif
#ifndef REP_F2
#define REP_F2 1
#endif
#ifndef REP_P0
#define REP_P0 1
#endif
#ifndef EXTRA_SYNC
#define EXTRA_SYNC 0
#endif
constexpr int D = 1024, MX = 32768, MC = 1024, MT = MX + MC, INC = 2176, DFF = 2816, DFF2 = 5632;
constexpr int SEQ = 8448, NCHK = 132;
constexpr float EPS = 1e-6f;
constexpr float QSCALE = 0.10206207261596577f * 1.4426950408889634f;

constexpr size_t W_IN = 0, W_OUT = W_IN + (size_t)INC * D, W_UP = W_OUT + (size_t)D * D, W_DN = W_UP + (size_t)DFF2 * D,
                 W_UQ = W_DN + (size_t)D * DFF, W_UKV = W_UQ + 384 * 224, W_GLU = W_UKV + 512 * 96, W_SGU = W_GLU + 256 * 256,
                 W_CM = W_SGU + 4 * 128 * 128, W_WG = W_CM + 2 * 16 * 16 * 128, W_LAYER = W_WG + 2 * 256 * 16;
constexpr size_t S_LAMB = 0, S_LAMT = 4096, S_BBAR = 8192, S_LAYER = 8192 + 65536;

constexpr size_t al256(size_t x) { return (x + 255) / 256 * 256; }
constexpr size_t OFF_WB = 0;
constexpr size_t OFF_S5F = al256(OFF_WB + 2 * W_LAYER * 2);
constexpr size_t OFF_MOD = al256(OFF_S5F + 2 * S_LAYER * 4);
constexpr size_t OFF_ROPE = al256(OFF_MOD + 2 * 5 * 6144 * 4);
constexpr size_t OFF_CTXS = al256(OFF_ROPE + 128 * 8 * 2 * 4);
constexpr size_t OFF_HX = al256(OFF_CTXS + (size_t)MC * D * 4);
constexpr size_t OFF_P = al256(OFF_HX + (size_t)MT * D * 2);
constexpr size_t OFF_MIXIN = al256(OFF_P + (size_t)MT * INC * 2);
constexpr size_t OFF_QB = al256(OFF_MIXIN + (size_t)MT * D * 2);
constexpr size_t OFF_KB = al256(OFF_QB + (size_t)16 * SEQ * 96 * 2);
constexpr size_t OFF_VT = al256(OFF_KB + (size_t)16 * SEQ * 96 * 2);
constexpr size_t OFF_KV = al256(OFF_VT + (size_t)16 * 64 * SEQ * 2);
constexpr size_t OFF_DEC = al256(OFF_KV + (size_t)4 * NCHK * 4 * 2 * 4096 * 4);
constexpr size_t OFF_HL = al256(OFF_DEC + (size_t)4 * NCHK * 4 * 2 * 64 * 4);
constexpr size_t OFF_Y = al256(OFF_HL + (size_t)4 * NCHK * 2 * 16 * 64 * 2 * 4);
constexpr size_t OFF_BAR = al256(OFF_Y + (size_t)MT * 256 * 2);
constexpr size_t OFF_SCHED = OFF_BAR + 3456 * 4;
constexpr size_t OFF_END = al256(OFF_SCHED + 1024 * 4);
constexpr size_t OFF_MIXOUT = OFF_P;
constexpr size_t OFF_ZPRE = OFF_P;
constexpr size_t OFF_ACT = OFF_MIXIN;
constexpr size_t OFF_FFNOUT = OFF_QB;
static_assert((size_t)MT * D * 4 <= (size_t)MT * INC * 2, "mixout alias");
static_assert((size_t)8448 * 1024 * 4 <= 2 * (size_t)16 * SEQ * 96 * 2, "ffnout alias");

struct Params { const float* in[36]; float* out; char* ws; };

DI float bf2f(us v) { return __uint_as_float(((unsigned)v) << 16); }
typedef float f32x2_ __attribute__((ext_vector_type(2)));
typedef __bf16 bf16x2_ __attribute__((ext_vector_type(2)));
DI unsigned pk2(float lo, float hi) { f32x2_ v = {lo, hi}; bf16x2_ b = __builtin_convertvector(v, bf16x2_); return __builtin_bit_cast(unsigned, b); }
DI us f2bf(float x) { return (us)(pk2(x, x) & 0xffffu); }
DI float lo_bf(unsigned w) { return __uint_as_float(w << 16); }
DI float hi_bf(unsigned w) { return __uint_as_float(w & 0xffff0000u); }
DI int tid512() { int t; asm volatile("v_mov_b32 %0, %1" : "=v"(t) : "v"(threadIdx.x)); return t; }
DI int tidx() { return tid512() & 255; }
DI int crow(int i, int hh) { return (i & 3) + 8 * (i >> 2) + 4 * hh; }
DI float sigmoidf_(float x) { return __builtin_amdgcn_rcpf(1.f + __expf(-x)); }
DI float gelu_t(float x) { float u = 0.7978845608028654f * (x + 0.044715f * x * x * x); return x * __builtin_amdgcn_rcpf(1.f + __expf(-2.f * u)); }
DI float silu_(float x) { return x * __builtin_amdgcn_rcpf(1.f + __expf(-x)); }
DI float logsig(float z) { return fminf(z, 0.f) - __logf(1.f + __expf(-fabsf(z))); }
DI void unpack8(u32x4 w, float* f) {
  f[0] = lo_bf(w[0]); f[1] = hi_bf(w[0]); f[2] = lo_bf(w[1]); f[3] = hi_bf(w[1]);
  f[4] = lo_bf(w[2]); f[5] = hi_bf(w[2]); f[6] = lo_bf(w[3]); f[7] = hi_bf(w[3]);
}
DI u32x4 pack8(const float* f) { u32x4 w = {pk2(f[0], f[1]), pk2(f[2], f[3]), pk2(f[4], f[5]), pk2(f[6], f[7])}; return w; }
DI long seqrow(int b, int s) { return s < 256 ? (long)MX + b * 256 + s : (long)b * 8192 + (s - 256); }
DI float wave_sum(float v) {
  v += __shfl_xor(v, 1); v += __shfl_xor(v, 2); v += __shfl_xor(v, 4); v += __shfl_xor(v, 8); v += __shfl_xor(v, 16); v += __shfl_xor(v, 32);
  return v;
}
DI const us* wl(const Params& p, int l) { return (const us*)(p.ws + OFF_WB) + (size_t)l * W_LAYER; }
DI const float* s5f(const Params& p, int l) { return (const float*)(p.ws + OFF_S5F) + (size_t)l * S_LAYER; }
DI const float* modv(const Params& p, int l, int v, int idx) { return (const float*)(p.ws + OFF_MOD) + ((size_t)(l * 5 + v) * 6 + idx) * 1024; }
DI float* stream_row(const Params& p, long m) { return m < MX ? p.out + m * 1024 : (float*)(p.ws + OFF_CTXS) + (m - MX) * 1024; }
DI const float* input_row(const Params& p, long m) { return m < MX ? p.in[0] + m * 1024 : p.in[2] + (m - MX) * 1024; }


#define XB_TMO      128
#define XB_XCNT(j)  (256  + 64 * (j))
#define XB_XSUB(j)  (1280 + 64 * (j))
#define XB_XGEN(j)  (2304 + 64 * (j))
#define XB_TOP      3328
#define XB_TOPGEN   3392
#define XCD_BAR_WORDS 3456
#define XB_SPIN_CAP (1u << 20)
#define LAS __attribute__((address_space(3)))
DI unsigned xb_ld(unsigned* p)              { return __hip_atomic_load(p, __ATOMIC_RELAXED, __HIP_MEMORY_SCOPE_AGENT); }
DI unsigned xb_add(unsigned* p, unsigned v) { return __hip_atomic_fetch_add(p, v, __ATOMIC_RELAXED, __HIP_MEMORY_SCOPE_AGENT); }
DI unsigned xb_xcc_id() { return (unsigned)__builtin_amdgcn_s_getreg((3 << 11) | 20) & 0xFu; }
#define XB_SPIN(cond, bar) do { unsigned _sp = 0; while (cond) { __builtin_amdgcn_s_sleep(1); \
    if ((++_sp & 255u) == 0u) { if (xb_ld(&(bar)[XB_TMO])) break; if (_sp > XB_SPIN_CAP) { atomicAdd(&(bar)[XB_TMO], 1u); break; } } } } while (0)
struct XcdBarrier { unsigned* bar; unsigned x; volatile LAS unsigned* st; };
DI XcdBarrier xcd_barrier_post(unsigned* bar, volatile LAS unsigned* st) {
  XcdBarrier b; b.bar = bar; b.x = xb_xcc_id(); b.st = st;
  if (threadIdx.x == 0) (void)xb_add(&bar[XB_XCNT(b.x)], 1u);
  return b;
}
DI void xcd_barrier_complete(unsigned* bar, unsigned x, unsigned& nloc, unsigned& nx) {
  const unsigned G = gridDim.x * gridDim.y * gridDim.z;
  unsigned sum, cnt, mine, sp = 0u;
  for (;;) {
    sum = 0u; cnt = 0u; mine = 0u;
#pragma unroll
    for (unsigned j = 0; j < 16; ++j) { const unsigned c = xb_ld(&bar[XB_XCNT(j)]); sum += c; cnt += (c > 0u) ? 1u : 0u; mine = (j == x) ? c : mine; }
    if (sum == G) break;
    __builtin_amdgcn_s_sleep(1);
    if ((++sp & 255u) == 0u) { if (xb_ld(&bar[XB_TMO])) break; if (sp > XB_SPIN_CAP) { atomicAdd(&bar[XB_TMO], 1u); break; } }
  }
  nloc = mine > 0u ? mine : 1u; nx = cnt > 0u ? cnt : 1u;
}
DI void xcd_barrier(const XcdBarrier& b) {
  asm volatile("s_waitcnt vmcnt(0)" ::: "memory");
  __syncthreads();
  if (threadIdx.x == 0) {
    unsigned* bar = b.bar;
    __builtin_amdgcn_s_waitcnt(0);
    unsigned nloc = b.st[0], nx = b.st[1];
    if (nloc == 0u) { xcd_barrier_complete(bar, b.x, nloc, nx); b.st[0] = nloc; b.st[1] = nx; }
    const unsigned old = xb_add(&bar[XB_XSUB(b.x)], 1u);
    const unsigned gen = old / nloc;
    if (old + 1u == (gen + 1u) * nloc) {
      __builtin_amdgcn_fence(__ATOMIC_RELEASE, "agent");
      asm volatile("s_waitcnt vmcnt(0)" ::: "memory");
      const unsigned og = xb_add(&bar[XB_TOP], 1u);
      const unsigned tg = og / nx;
      if (og + 1u == (tg + 1u) * nx) xb_add(&bar[XB_TOPGEN], 1u);
      else XB_SPIN(xb_ld(&bar[XB_TOPGEN]) == tg, bar);
      __builtin_amdgcn_fence(__ATOMIC_ACQUIRE, "agent");
      xb_add(&bar[XB_XGEN(b.x)], 1u);
      asm volatile("s_waitcnt vmcnt(0)" ::: "memory");
    } else {
      XB_SPIN(xb_ld(&bar[XB_XGEN(b.x)]) == gen, bar);
      __builtin_amdgcn_fence(__ATOMIC_ACQUIRE, "agent");
      asm volatile("s_waitcnt vmcnt(0)" ::: "memory");
    }
  }
  __syncthreads();
}

DI void conv_tile(const float* src, us* dst, int K, int N, const float* scale, int tile, char* smem) {
  float* t = (float*)smem;
  const int tid = tidx(), tn = N / 32, tk = tile / tn, tc = tile % tn;
  __syncthreads();
  {
    int k = tid >> 3, c4 = (tid & 7) * 4;
    f32x4 v = *(const f32x4*)(src + (size_t)(tk * 32 + k) * N + tc * 32 + c4);
    float s = scale ? scale[tk * 32 + k] : 1.f;
    t[k * 33 + c4 + 0] = v[0] * s; t[k * 33 + c4 + 1] = v[1] * s; t[k * 33 + c4 + 2] = v[2] * s; t[k * 33 + c4 + 3] = v[3] * s;
  }
  __syncthreads();
  if (tid < 128) {
    int n = tid >> 2, k8 = (tid & 3) * 8; float f[8];
#pragma unroll
    for (int j = 0; j < 8; ++j) f[j] = t[(k8 + j) * 33 + n];
    *(u32x4*)(dst + (size_t)(tc * 32 + n) * K + tk * 32 + k8) = pack8(f);
  }
}
constexpr int NCONV_LAYER = (1024 / 32) * (2176 / 32) + 32 * 32 + 32 * (5632 / 32) + (2816 / 32) * 32 + 7 * 12 + 3 * 16 + 8 * 8;
DI void conv_task(const Params& p, int it, char* smem) {
  int l = it / NCONV_LAYER; it -= l * NCONV_LAYER;
  us* wb = (us*)(p.ws + OFF_WB) + (size_t)l * W_LAYER;
  int nt;
  nt = 32 * 68;  if (it < nt) { conv_tile(p.in[10] + (size_t)l * 1024 * 2176, wb + W_IN, 1024, 2176, nullptr, it, smem); return; } it -= nt;
  nt = 32 * 32;  if (it < nt) { conv_tile(p.in[31] + (size_t)l * 1024 * 1024, wb + W_OUT, 1024, 1024, nullptr, it, smem); return; } it -= nt;
  nt = 32 * 176; if (it < nt) { conv_tile(p.in[32] + (size_t)l * 1024 * 5632, wb + W_UP, 1024, 5632, nullptr, it, smem); return; } it -= nt;
  nt = 88 * 32;  if (it < nt) { conv_tile(p.in[35] + (size_t)l * 2816 * 1024, wb + W_DN, 2816, 1024, nullptr, it, smem); return; } it -= nt;
  nt = 7 * 12;   if (it < nt) { conv_tile(p.in[28] + (size_t)l * 224 * 384, wb + W_UQ, 224, 384, p.in[27] + l * 224, it, smem); return; } it -= nt;
  nt = 3 * 16;   if (it < nt) { conv_tile(p.in[30] + (size_t)l * 96 * 512, wb + W_UKV, 96, 512, p.in[29] + l * 96, it, smem); return; } it -= nt;
  conv_tile(p.in[25] + (size_t)l * 256 * 256, wb + W_GLU, 256, 256, nullptr, it, smem);
}
DI void mod_task(const Params& p, int it, char* smem) {
  float* sc = (float*)smem;
  float* red = sc + 5 * 1024;
  const int tid = tidx(), l = it / 192, jb = it % 192;
  __syncthreads();
  for (int e = tid; e < 5 * 1024; e += 256) {
    int v = e >> 10, k = e & 1023; float c = v < 4 ? p.in[1][v * 1024 + k] : p.in[3][k];
    sc[e] = silu_(c);
  }
  __syncthreads();
  const int col = tid & 31, ks = tid >> 5;
  const float* w = p.in[4] + (size_t)l * 1024 * 6144 + jb * 32 + col;
  float a0 = 0, a1 = 0, a2 = 0, a3 = 0, a4 = 0;
#pragma unroll 8
  for (int k = ks * 128; k < ks * 128 + 128; ++k) {
    float wv = w[(size_t)k * 6144];
    a0 += sc[k] * wv; a1 += sc[1024 + k] * wv; a2 += sc[2048 + k] * wv; a3 += sc[3072 + k] * wv; a4 += sc[4096 + k] * wv;
  }
  float* rp = red + (ks * 32 + col) * 5;
  rp[0] = a0; rp[1] = a1; rp[2] = a2; rp[3] = a3; rp[4] = a4;
  __syncthreads();
  if (tid < 160) {
    int v = tid >> 5, c = tid & 31; float s = 0;
    for (int q = 0; q < 8; ++q) s += red[(q * 32 + c) * 5 + v];
    int j = jb * 32 + c;
    ((float*)(p.ws + OFF_MOD))[(size_t)(l * 5 + v) * 6144 + j] = s + p.in[5][l * 6144 + j];
  }
}
DI void s5pre_task(const Params& p, int it) {
  int gid = it * 256 + tidx();
  int pp = gid & 63, g = (gid >> 6) & 15, d = (gid >> 10) & 1, l = gid >> 11;
  int idx = ((l * 2 + d) * 16 + g) * 64 + pp;
  float are = p.in[17][idx], aim = p.in[18][idx];
  float dt = expf(p.in[19][(l * 2 + d) * 16 + g]);
  float mag = expf(are * dt), lr = mag * cosf(aim * dt), li = mag * sinf(aim * dt);
  float magT = expf(are * dt * 64.f), tr = magT * cosf(aim * dt * 64.f), ti = magT * sinf(aim * dt * 64.f);
  float nr = lr - 1.f, ni = li, den = are * are + aim * aim;
  float cr = (nr * are + ni * aim) / den, ci = (ni * are - nr * aim) / den;
  float* sf = (float*)(p.ws + OFF_S5F) + (size_t)l * S_LAYER;
  int o2 = ((d * 16 + g) * 64 + pp);
  sf[S_LAMB + o2 * 2] = lr; sf[S_LAMB + o2 * 2 + 1] = li;
  sf[S_LAMT + o2 * 2] = tr; sf[S_LAMT + o2 * 2 + 1] = ti;
  for (int i = 0; i < 16; ++i) {
    float br = p.in[20][(size_t)idx * 16 + i], bi = p.in[21][(size_t)idx * 16 + i];
    sf[S_BBAR + ((size_t)o2 * 16 + i) * 2] = cr * br - ci * bi;
    sf[S_BBAR + ((size_t)o2 * 16 + i) * 2 + 1] = cr * bi + ci * br;
  }
  us* cm = (us*)(p.ws + OFF_WB) + (size_t)l * W_LAYER + W_CM;
  for (int o = 0; o < 16; ++o) {
    size_t ci_ = ((size_t)((l * 2 + d) * 16 + g) * 16 + o) * 64 + pp;
    cm[((size_t)(d * 16 + g) * 16 + o) * 128 + pp] = f2bf(p.in[22][ci_]);
    cm[((size_t)(d * 16 + g) * 16 + o) * 128 + 64 + pp] = f2bf(-p.in[23][ci_]);
  }
}
DI void rope_task(const Params& p, int it) {
  int gid = it * 256 + tidx();
  int pos = gid >> 3, f = gid & 7;
  float inv = powf(10000.f, -(float)f / 8.f), ang = (float)pos * inv;
  float* r = (float*)(p.ws + OFF_ROPE);
  r[gid * 2] = cosf(ang); r[gid * 2 + 1] = sinf(ang);
}
DI void wgt_task(const Params& p, int it) {
  int gid = it * 256 + tidx();
  int rr = gid & 15, c = (gid >> 4) & 255, d = (gid >> 12) & 1, l = gid >> 13;
  ((us*)(p.ws + OFF_WB))[(size_t)l * W_LAYER + W_WG + (d * 256 + c) * 16 + rr] = f2bf(p.in[14][((l * 2 + d) * 16 + rr) * 256 + c]);
}
DI void sguw_task(const Params& p, int it) {
  int gid = it * 256 + tidx();
  int l = gid >> 14, e = (gid & 16383) * 4;
  f32x4 v = *(const f32x4*)(p.in[12] + (size_t)l * 65536 + e);
  u32x2 w = {pk2(v[0], v[1]), pk2(v[2], v[3])};
  *(u32x2*)((us*)(p.ws + OFF_WB) + (size_t)l * W_LAYER + W_SGU + e) = w;
}

template <int MODE>
DI void row_task(const Params& p, int l, long m, const us* yrow) {
  const int lane = tidx() & 63, v = m < MX ? (int)(m >> 13) : 4;
  float x[16];
  if (MODE == 0) {
    const float* src = input_row(p, m);
#pragma unroll
    for (int j = 0; j < 4; ++j) { f32x4 t = *(const f32x4*)(src + (j * 64 + lane) * 4); x[4 * j] = t[0]; x[4 * j + 1] = t[1]; x[4 * j + 2] = t[2]; x[4 * j + 3] = t[3]; }
  } else {
    float y[16]; float ss = 0;
    const float* xo = (MODE == 1 && l == 0) ? input_row(p, m) : stream_row(p, m);
#pragma unroll
    for (int j = 0; j < 4; ++j) {
      u32x2 t = *(const u32x2*)(yrow + (j * 64 + lane) * 4); y[4 * j] = lo_bf(t[0]); y[4 * j + 1] = hi_bf(t[0]); y[4 * j + 2] = lo_bf(t[1]); y[4 * j + 3] = hi_bf(t[1]);
      f32x4 u = *(const f32x4*)(xo + (j * 64 + lane) * 4); x[4 * j] = u[0]; x[4 * j + 1] = u[1]; x[4 * j + 2] = u[2]; x[4 * j + 3] = u[3];
    }
#pragma unroll
    for (int j = 0; j < 16; ++j) ss += y[j] * y[j];
    ss = wave_sum(ss);
    float rstd = rsqrtf(ss * (1.f / 1024.f) + EPS);
    const float* gp = (MODE == 1 ? p.in[7] : p.in[9]) + l * 1024;
    const float* gt = modv(p, l, v, MODE == 1 ? 2 : 5);
    float* dst = stream_row(p, m);
#pragma unroll
    for (int j = 0; j < 4; ++j) {
      int c = (j * 64 + lane) * 4;
      f32x4 g4 = *(const f32x4*)(gp + c), t4 = *(const f32x4*)(gt + c), o;
#pragma unroll
      for (int q = 0; q < 4; ++q) { x[4 * j + q] += t4[q] * (y[4 * j + q] * rstd * g4[q]); o[q] = x[4 * j + q]; }
      *(f32x4*)(dst + c) = o;
    }
    if (MODE == 2 && l == 1) return;
  }
  const int ln = (MODE == 2) ? 1 : l;
  const float* g = (MODE == 1 ? p.in[8] : p.in[6]) + ln * 1024;
  const float* sh = modv(p, ln, v, MODE == 1 ? 3 : 0);
  const float* sc = modv(p, ln, v, MODE == 1 ? 4 : 1);
  float ss = 0;
#pragma unroll
  for (int j = 0; j < 16; ++j) ss += x[j] * x[j];
  ss = wave_sum(ss);
  float rstd = rsqrtf(ss * (1.f / 1024.f) + EPS);
  us* hx = (us*)(p.ws + OFF_HX) + m * 1024;
#pragma unroll
  for (int j = 0; j < 4; ++j) {
    int c = (j * 64 + lane) * 4;
    f32x4 g4 = *(const f32x4*)(g + c), s4 = *(const f32x4*)(sh + c), c4 = *(const f32x4*)(sc + c); float h[4];
#pragma unroll
    for (int q = 0; q < 4; ++q) h[q] = (x[4 * j + q] * rstd * g4[q]) * (1.f + c4[q]) + s4[q];
    u32x2 w = {pk2(h[0], h[1]), pk2(h[2], h[3])};
    *(u32x2*)(hx + c) = w;
  }
}

struct GArgs { const us* A; int lda; const us* W; int K; long m0; int n0; void* out; int ldo; int l; };
template <int BK, int EPI, bool ROWSS>
DI void gemm_tile(const Params& p, const GArgs& g, char* smem) {
  constexpr int LS = BK + 8, CPR = BK / 8, NCH = 128 * CPR / 256;
  us* sA = (us*)smem; us* sB = sA + 2 * 128 * LS; float* rstd = (float*)(sB + 2 * 128 * LS);
  const int tid = tidx(), w = tid >> 6, lane = tid & 63, r = lane & 31, hh = lane >> 5, wm = w >> 1, wn = w & 1;
  __syncthreads();
  if (ROWSS) {
    int row = tid >> 1, half = tid & 1; float ss = 0;
    const us* ap = g.A + (size_t)row * g.lda + half * (g.K / 2);
    for (int c = 0; c < g.K / 16; ++c) { float f[8]; unpack8(*(const u32x4*)(ap + c * 8), f);
#pragma unroll
      for (int j = 0; j < 8; ++j) ss += f[j] * f[j]; }
    ss += __shfl_xor(ss, 1);
    if (!half) rstd[row] = rsqrtf(ss / (float)g.K + EPS);
  }
  u32x4 ra[NCH], rb[NCH];
  f32x16 acc[2][2];
#pragma unroll
  for (int i = 0; i < 2; ++i)
#pragma unroll
    for (int j = 0; j < 2; ++j)
#pragma unroll
      for (int q = 0; q < 16; ++q) acc[i][j][q] = 0.f;
#define GLOAD(kt) _Pragma("unroll") for (int j = 0; j < NCH; ++j) { int q = tid + 256 * j, row = q / CPR, cc = q % CPR; \
    ra[j] = *(const u32x4*)(g.A + (size_t)row * g.lda + (kt) * BK + cc * 8); rb[j] = *(const u32x4*)(g.W + (size_t)row * g.K + (kt) * BK + cc * 8); }
#define SWRITE(buf) _Pragma("unroll") for (int j = 0; j < NCH; ++j) { int q = tid + 256 * j, row = q / CPR, cc = q % CPR; \
    *(u32x4*)(sA + (buf) * 128 * LS + row * LS + cc * 8) = ra[j]; *(u32x4*)(sB + (buf) * 128 * LS + row * LS + cc * 8) = rb[j]; }
  GLOAD(0); SWRITE(0); __syncthreads();
  const int KT = g.K / BK;
  for (int kt = 0; kt < KT; ++kt) {
    if (kt + 1 < KT) { GLOAD(kt + 1); }
    const us* a0 = sA + (kt & 1) * 128 * LS + (wm * 64 + r) * LS + hh * 8;
    const us* b0 = sB + (kt & 1) * 128 * LS + (wn * 64 + r) * LS + hh * 8;
#pragma unroll
    for (int ks = 0; ks < BK / 16; ++ks) {
      bf16x8 af0 = *(const bf16x8*)(a0 + ks * 16), af1 = *(const bf16x8*)(a0 + 32 * LS + ks * 16);
      bf16x8 bf0 = *(const bf16x8*)(b0 + ks * 16), bf1 = *(const bf16x8*)(b0 + 32 * LS + ks * 16);
      acc[0][0] = MFMA(af0, bf0, acc[0][0]); acc[0][1] = MFMA(af0, bf1, acc[0][1]);
      acc[1][0] = MFMA(af1, bf0, acc[1][0]); acc[1][1] = MFMA(af1, bf1, acc[1][1]);
    }
    if (kt + 1 < KT) { SWRITE((kt + 1) & 1); }
    __syncthreads();
  }
#undef GLOAD
#undef SWRITE
#pragma unroll
  for (int si = 0; si < 2; ++si)
#pragma unroll
    for (int sj = 0; sj < 2; ++sj) {
      const int col = wn * 64 + sj * 32 + r, n = g.n0 + col;
#pragma unroll
      for (int i = 0; i < 16; ++i) {
        const int row = wm * 64 + si * 32 + crow(i, hh);
        const long m = g.m0 + row;
        float v = acc[si][sj][i];
        if (EPI == 0) { ((us*)g.out)[m * g.ldo + n] = f2bf(v); }
        else if (EPI == 1) { ((float*)g.out)[m * g.ldo + n] = v; }
        else if (EPI == 2) {
          v *= rstd[row] * QSCALE;
          float pv = __shfl_xor(v, 8);
          const int head = n / 96, j = n - head * 96;
          const bool isx = m < MX; const int t = isx ? (int)(m & 8191) : (int)((m - MX) & 255);
          const int b = isx ? (int)(m >> 13) : (int)((m - MX) >> 8);
          if (isx && j >= 64) {
            int jj = (j - 64) & 15, blk = (j - 64) >> 4, f = jj & 7, pos = blk ? (t & 63) : (t >> 6);
            const float* rp = (const float*)(p.ws + OFF_ROPE) + (pos * 8 + f) * 2; float cs = rp[0], sn = rp[1];
            v = (jj < 8) ? v * cs - pv * sn : pv * sn + v * cs;
          }
          const int s = isx ? 256 + t : t;
          ((us*)(p.ws + OFF_QB))[((size_t)(b * 4 + head) * SEQ + s) * 96 + j] = f2bf(v);
        } else if (EPI == 3) {
          v *= rstd[row];
          const int head = n >> 7, j = n & 127;
          const bool isx = m < MX; const int t = isx ? (int)(m & 8191) : (int)((m - MX) & 255);
          const int b = isx ? (int)(m >> 13) : (int)((m - MX) >> 8);
          const int s = isx ? 256 + t : t;
          if (j < 64) ((us*)(p.ws + OFF_KB))[((size_t)(b * 4 + head) * SEQ + s) * 96 + j] = f2bf(v);
          else if ((i & 3) == 3) {
            const float r1 = rstd[row - 1], r2 = rstd[row - 2], r3 = rstd[row - 3];
            u32x2 w2 = {pk2(acc[si][sj][i - 3] * r3, acc[si][sj][i - 2] * r2), pk2(acc[si][sj][i - 1] * r1, v)};
            *(u32x2*)((us*)(p.ws + OFF_VT) + ((size_t)(b * 4 + head) * 64 + (j - 64)) * SEQ + s - 3) = w2;
          }
        } else if (EPI == 4) {
          float y = bf2f(((const us*)(p.ws + OFF_Y))[m * 256 + n]);
          v += p.in[26][g.l * 256 + n];
          ((us*)(p.ws + OFF_MIXIN))[m * 1024 + 512 + n] = f2bf(y * sigmoidf_(v));
        }
      }
    }
}


using f32x4_ = __attribute__((ext_vector_type(4))) float;
#define MFMA16(a, b, c) __builtin_amdgcn_mfma_f32_16x16x32_bf16((a), (b), (c), 0, 0, 0)
DI void gemm_big(const GArgs& g, int ncv, char* smem) {
  constexpr int ST = 256 * 64;
  us* sA = (us*)smem; us* sB = sA + 2 * ST;
  const int tid = tid512(), w = tid >> 6, lane = tid & 63, l16 = lane & 15, lq = lane >> 4, wm = w >> 2, wn = w & 3;
  u32x4 ra[4], rb[4];
  f32x4_ acc[8][4];
#pragma unroll
  for (int i = 0; i < 8; ++i)
#pragma unroll
    for (int j = 0; j < 4; ++j) { acc[i][j][0] = 0.f; acc[i][j][1] = 0.f; acc[i][j][2] = 0.f; acc[i][j][3] = 0.f; }
  const int srow = tid >> 3, sch = tid & 7;
  const us* gA = g.A + (size_t)srow * g.lda + sch * 8;
  const us* gB = g.W + (size_t)srow * g.K + sch * 8;
  const int swr = srow * 64 + ((sch ^ (srow & 7)) << 3);
#define GLOAD(kt) { _Pragma("unroll") for (int j = 0; j < 4; ++j) { ra[j] = *(const u32x4*)(gA + (size_t)(64 * j) * g.lda + (kt) * 64); rb[j] = *(const u32x4*)(gB + (size_t)(64 * j) * g.K + (kt) * 64); } }
#define SWRITE(buf) { _Pragma("unroll") for (int j = 0; j < 4; ++j) { *(u32x4*)(sA + (buf) * ST + swr + j * 4096) = ra[j]; *(u32x4*)(sB + (buf) * ST + swr + j * 4096) = rb[j]; } }
  const int KT = g.K / 64;
  const bool act = wn * 64 < ncv;
  const int fo0 = l16 * 64 + ((lq ^ (l16 & 7)) << 3), fo1 = l16 * 64 + (((4 + lq) ^ (l16 & 7)) << 3);
  __syncthreads();
  GLOAD(0); SWRITE(0); GLOAD(KT > 1 ? 1 : 0);
  for (int kt = 0; kt < KT; ++kt) {
    __syncthreads();
    SWRITE((kt + 1) & 1);
    { const int kl = kt + 2 < KT ? kt + 2 : KT - 1; GLOAD(kl); }
    if (act) {
      const us* a0 = sA + (kt & 1) * ST + wm * 128 * 64;
      const us* b0 = sB + (kt & 1) * ST + wn * 64 * 64;
#pragma unroll
      for (int ks = 0; ks < 2; ++ks) {
        const int fo = ks ? fo1 : fo0;
        bf16x8 fb[4];
#pragma unroll
        for (int j = 0; j < 4; ++j) fb[j] = *(const bf16x8*)(b0 + j * 1024 + fo);
#pragma unroll
        for (int i = 0; i < 8; ++i) {
          bf16x8 fa = *(const bf16x8*)(a0 + i * 1024 + fo);
#pragma unroll
          for (int j = 0; j < 4; ++j) acc[i][j] = MFMA16(fb[j], fa, acc[i][j]);
        }
      }
    }
  }
#undef GLOAD
#undef SWRITE
  __syncthreads();
  {
    us* sC = (us*)smem; constexpr int CS = 264;
    if (act) {
#pragma unroll
      for (int i = 0; i < 8; ++i)
#pragma unroll
        for (int j = 0; j < 4; ++j) {
          u32x2 w2 = {pk2(acc[i][j][0], acc[i][j][1]), pk2(acc[i][j][2], acc[i][j][3])};
          *(u32x2*)(sC + (wm * 128 + i * 16 + l16) * CS + wn * 64 + j * 16 + lq * 4) = w2;
        }
    }
    __syncthreads();
    us* outp = (us*)g.out + (size_t)g.m0 * g.ldo + g.n0;
#pragma unroll 4
    for (int k = 0; k < 16; ++k) {
      const int q = tid + 512 * k, row = q >> 5, cc = q & 31;
      if (cc * 8 < ncv) *(u32x4*)(outp + (size_t)row * g.ldo + cc * 8) = *(const u32x4*)(sC + row * CS + cc * 8);
    }
  }
}
template <class F>
DI void for_tiles_xcd(int RT, int CT, int G, int bid, F f) {
  if ((G & 7) == 0) {
    const int x = bid & 7, rows = (RT - x + 7) >> 3, n = rows * CT, nfull = CT >> 3;
    for (int j = bid >> 3; j < n; j += G >> 3) {
      int rl, ct;
      if (j < nfull * rows * 8) { int pnl = j / (rows * 8), rem = j - pnl * rows * 8; rl = rem >> 3; ct = pnl * 8 + (rem & 7); }
      else { int j2 = j - nfull * rows * 8, wd = CT - nfull * 8; rl = j2 / wd; ct = nfull * 8 + (j2 - rl * wd); }
      f(rl * 8 + x, ct);
    }
  } else {
    for (int it = bid; it < RT * CT; it += G) f(it / CT, it % CT);
  }
}

DI void kr_task(const Params& p, long m0) {
  const int tid = tidx(), row = tid >> 1, blk = tid & 1; const long m = m0 + row;
  const us* src = (const us*)(p.ws + OFF_P) + m * INC + 2144 + blk * 16;
  float v[16], o[16]; unpack8(*(const u32x4*)src, v); unpack8(*(const u32x4*)(src + 8), v + 8);
  const bool isx = m < MX; const int t = isx ? (int)(m & 8191) : (int)((m - MX) & 255);
  const int b = isx ? (int)(m >> 13) : (int)((m - MX) >> 8), s = isx ? 256 + t : t;
  if (isx) {
    int pos = blk ? (t & 63) : (t >> 6);
    const float* rp = (const float*)(p.ws + OFF_ROPE) + pos * 16;
#pragma unroll
    for (int f = 0; f < 8; ++f) { float cs = rp[2 * f], sn = rp[2 * f + 1]; o[f] = v[f] * cs - v[f + 8] * sn; o[f + 8] = v[f] * sn + v[f + 8] * cs; }
  } else {
#pragma unroll
    for (int f = 0; f < 16; ++f) o[f] = v[f];
  }
  u32x4 w0 = pack8(o), w1 = pack8(o + 8);
#pragma unroll
  for (int hd = 0; hd < 4; ++hd) {
    us* dst = (us*)(p.ws + OFF_KB) + ((size_t)(b * 4 + hd) * SEQ + s) * 96 + 64 + blk * 16;
    *(u32x4*)dst = w0; *(u32x4*)(dst + 8) = w1;
  }
}

DI void sgu_task(const Params& p, int l, int chunk, int h, char* smem) {
  us* Vt = (us*)smem;
  const int tid = tidx(), w = tid >> 6, lane = tid & 63, r = lane & 31, hh = lane >> 5;
  const long m0 = (long)chunk * 128;
  const us* P = (const us*)(p.ws + OFF_P);
  __syncthreads();
  {
    int row = tid >> 1, dh = (tid & 1) * 32; float v[32]; float ss = 0;
    const us* src = P + (m0 + row) * INC + 256 + h * 64 + dh;
#pragma unroll
    for (int c = 0; c < 4; ++c) unpack8(*(const u32x4*)(src + c * 8), v + c * 8);
#pragma unroll
    for (int j = 0; j < 32; ++j) { v[j] = gelu_t(v[j]); ss += v[j] * v[j]; }
    ss += __shfl_xor(ss, 1);
    float rstd = rsqrtf(ss * (1.f / 64.f) + EPS);
    const float* gn = p.in[11] + l * 256 + h * 64 + dh;
#pragma unroll
    for (int j = 0; j < 32; ++j) Vt[(dh + j) * 136 + row] = f2bf(v[j] * rstd * gn[j]);
  }
  __syncthreads();
  const us* Wsp = wl(p, l) + W_SGU + (size_t)h * 16384 + (size_t)(w * 32 + r) * 128 + hh * 8;
  f32x16 a0, a1;
#pragma unroll
  for (int q = 0; q < 16; ++q) { a0[q] = 0.f; a1[q] = 0.f; }
#pragma unroll
  for (int ks = 0; ks < 8; ++ks) {
    bf16x8 af = *(const bf16x8*)(Wsp + ks * 16);
    bf16x8 b0 = *(const bf16x8*)(Vt + r * 136 + ks * 16 + hh * 8), b1 = *(const bf16x8*)(Vt + (32 + r) * 136 + ks * 16 + hh * 8);
    a0 = MFMA(af, b0, a0); a1 = MFMA(af, b1, a1);
  }
  us* out = (us*)(p.ws + OFF_MIXIN);
#pragma unroll
  for (int i = 0; i < 16; ++i) {
    int t = w * 32 + crow(i, hh); float bs = p.in[13][l * 512 + h * 128 + t];
    const us* pu = P + (m0 + t) * INC + h * 64;
    float u0 = gelu_t(bf2f(pu[r])), u1 = gelu_t(bf2f(pu[32 + r]));
    out[(m0 + t) * 1024 + h * 64 + r] = f2bf(u0 * (a0[i] + bs));
    out[(m0 + t) * 1024 + h * 64 + 32 + r] = f2bf(u1 * (a1[i] + bs));
  }
}

DI void gla_gate_dir(const Params& p, int l, const us* Prow0, int h, int d, float* sW, float* G) {
  const int tid = tidx(), w = tid >> 6, lane = tid & 63, r = lane & 31, hh = lane >> 5, mt = w >> 1, nt = w & 1;
  {
    const bf16x8 a = *(const bf16x8*)(Prow0 + (size_t)(mt * 32 + r) * INC + 1536 + d * 16 + hh * 8);
    const bf16x8 bw = *(const bf16x8*)(wl(p, l) + W_WG + (size_t)(d * 256 + h * 64 + nt * 32 + r) * 16 + hh * 8);
    f32x16 z;
#pragma unroll
    for (int q = 0; q < 16; ++q) z[q] = 0.f;
    z = MFMA(a, bw, z);
    const float bg = p.in[15][l * 512 + d * 256 + h * 64 + nt * 32 + r];
#pragma unroll
    for (int i = 0; i < 16; ++i) G[(mt * 32 + crow(i, hh)) * 64 + nt * 32 + r] = logsig(z[i] + bg) * (1.f / 16.f);
  }
  __syncthreads();
  {
    const int ch = tid & 63, seg = tid >> 6;
    float v[16];
#pragma unroll
    for (int k = 0; k < 16; ++k) v[k] = G[(seg * 16 + k) * 64 + ch];
    if (d == 0) {
#pragma unroll
      for (int k = 1; k < 16; ++k) v[k] += v[k - 1];
      sW[seg * 64 + ch] = v[15];
    } else {
#pragma unroll
      for (int k = 14; k >= 0; --k) v[k] += v[k + 1];
      sW[seg * 64 + ch] = v[0];
    }
    __syncthreads();
    float off = 0.f;
    if (d == 0) { for (int q = 0; q < 3; ++q) off += (q < seg) ? sW[q * 64 + ch] : 0.f; }
    else { for (int q = 1; q < 4; ++q) off += (q > seg) ? sW[q * 64 + ch] : 0.f; }
#pragma unroll
    for (int k = 0; k < 16; ++k) G[(seg * 16 + k) * 64 + ch] = v[k] + off;
  }
  __syncthreads();
}
DI size_t gla_idx(int b, int c, int h, int d) { return (size_t)(((b * NCHK + c) * 4 + h) * 2 + d); }

DI void gla1_task(const Params& p, int l, int b, int c, int h, char* smem) {
  float* G0 = (float*)smem; float* G1 = G0 + 4096; float* sW = G1 + 4096;
  us* KeT = (us*)(sW + 1024);
  us* Vt = KeT + 2 * 64 * 72;
  const int tid = tidx(), w = tid >> 6, lane = tid & 63, r = lane & 31, hh = lane >> 5;
  const long m0 = seqrow(b, c * 64);
  const us* P0 = (const us*)(p.ws + OFF_P) + m0 * INC;
  __syncthreads();
  gla_gate_dir(p, l, P0, h, 0, sW, G0);
  gla_gate_dir(p, l, P0, h, 1, sW, G1);
  {
    int t = tid >> 2, q4 = tid & 3; float kk[16], vv[16];
    const us* sk = P0 + (size_t)t * INC + 768 + h * 64 + q4 * 16;
    const us* sv = P0 + (size_t)t * INC + 1024 + h * 64 + q4 * 16;
    unpack8(*(const u32x4*)sk, kk); unpack8(*(const u32x4*)(sk + 8), kk + 8);
    unpack8(*(const u32x4*)sv, vv); unpack8(*(const u32x4*)(sv + 8), vv + 8);
#pragma unroll
    for (int cc = 0; cc < 16; ++cc) {
      int ch = q4 * 16 + cc;
      KeT[ch * 72 + t] = f2bf(kk[cc] * __expf(G0[63 * 64 + ch] - G0[t * 64 + ch]));
      KeT[(64 + ch) * 72 + t] = f2bf(kk[cc] * __expf(G1[ch] - G1[t * 64 + ch]));
      Vt[ch * 72 + t] = f2bf(vv[cc]);
    }
    if (tid < 128) {
      int d = tid >> 6, ch = tid & 63;
      ((float*)(p.ws + OFF_DEC))[gla_idx(b, c, h, d) * 64 + ch] = __expf(d ? G1[ch] : G0[63 * 64 + ch]);
    }
  }
  __syncthreads();
  {
    const int d = w >> 1, mt = w & 1;
    float* kv = (float*)(p.ws + OFF_KV) + gla_idx(b, c, h, d) * 4096;
#pragma unroll
    for (int nt = 0; nt < 2; ++nt) {
      f32x16 acc;
#pragma unroll
      for (int q = 0; q < 16; ++q) acc[q] = 0.f;
#pragma unroll
      for (int ks = 0; ks < 4; ++ks) {
        bf16x8 a = *(const bf16x8*)(Vt + (mt * 32 + r) * 72 + ks * 16 + hh * 8);
        bf16x8 bb = *(const bf16x8*)(KeT + (d * 64 + nt * 32 + r) * 72 + ks * 16 + hh * 8);
        acc = MFMA(a, bb, acc);
      }
#pragma unroll
      for (int i = 0; i < 16; ++i) kv[(mt * 32 + crow(i, hh)) * 64 + nt * 32 + r] = acc[i];
    }
  }
}
DI int gla_order(int d, int j) { return d == 0 ? j : (j < 4 ? 3 - j : 135 - j); }
DI void gla2_task(const Params& p, int it) {
  const int gid = it * 256 + tidx();
  const int e = gid & 4095, d = (gid >> 12) & 1, h = (gid >> 13) & 3, b = gid >> 15, k = e & 63;
  float* KV = (float*)(p.ws + OFF_KV); const float* DEC = (const float*)(p.ws + OFF_DEC);
  float s = 0;
  for (int j0 = 0; j0 < NCHK; j0 += 33) {
    float kv[33], dc[33];
#pragma unroll
    for (int q = 0; q < 33; ++q) { const size_t ix = gla_idx(b, gla_order(d, j0 + q), h, d); kv[q] = KV[ix * 4096 + e]; dc[q] = DEC[ix * 64 + k]; }
#pragma unroll
    for (int q = 0; q < 33; ++q) { const size_t ix = gla_idx(b, gla_order(d, j0 + q), h, d); KV[ix * 4096 + e] = s; s = dc[q] * s + kv[q]; }
  }
}
DI void gla3_task(const Params& p, int l, int b, int c, int h, char* smem) {
  float* G = (float*)smem;
  us* Qin = (us*)(smem + 17408);
  us* Kin = Qin + 64 * 72; us* Vt = Kin + 64 * 72; us* ST = Vt + 64 * 72; us* Sc = ST + 64 * 72;
  float* sW = (float*)Sc;
  const int tid = tidx(), w = tid >> 6, lane = tid & 63, r = lane & 31, hh = lane >> 5;
  const long m0 = seqrow(b, c * 64);
  const us* P0 = (const us*)(p.ws + OFF_P) + m0 * INC;
  const int t_ = tid >> 2, q4 = tid & 3;
  __syncthreads();
  {
    float vv[16]; const us* sv = P0 + (size_t)t_ * INC + 1024 + h * 64 + q4 * 16;
    unpack8(*(const u32x4*)sv, vv); unpack8(*(const u32x4*)(sv + 8), vv + 8);
#pragma unroll
    for (int cc = 0; cc < 16; ++cc) Vt[(q4 * 16 + cc) * 72 + t_] = f2bf(vv[cc]);
  }
  f32x16 oacc;
#pragma unroll
  for (int q = 0; q < 16; ++q) oacc[q] = 0.f;
  const int mt = w >> 1, nt = w & 1;
  for (int d = 0; d < 2; ++d) {
    gla_gate_dir(p, l, P0, h, d, sW, G);
    {
      float qq[16], kk[16], qo[16], ko[16];
      const us* sq = P0 + (size_t)t_ * INC + 512 + h * 64 + q4 * 16;
      const us* sk = P0 + (size_t)t_ * INC + 768 + h * 64 + q4 * 16;
      unpack8(*(const u32x4*)sq, qq); unpack8(*(const u32x4*)(sq + 8), qq + 8);
      unpack8(*(const u32x4*)sk, kk); unpack8(*(const u32x4*)(sk + 8), kk + 8);
#pragma unroll
      for (int cc = 0; cc < 16; ++cc) { float gg = G[t_ * 64 + q4 * 16 + cc]; qo[cc] = qq[cc] * 0.125f * __expf(gg); ko[cc] = kk[cc] * __expf(-gg); }
      *(u32x4*)(Qin + t_ * 72 + q4 * 16) = pack8(qo); *(u32x4*)(Qin + t_ * 72 + q4 * 16 + 8) = pack8(qo + 8);
      *(u32x4*)(Kin + t_ * 72 + q4 * 16) = pack8(ko); *(u32x4*)(Kin + t_ * 72 + q4 * 16 + 8) = pack8(ko + 8);
      const float* ss = (const float*)(p.ws + OFF_KV) + gla_idx(b, c, h, d) * 4096 + tid * 16;
      float sf[16];
#pragma unroll
      for (int j = 0; j < 4; ++j) { f32x4 t4 = *(const f32x4*)(ss + j * 4); sf[4 * j] = t4[0]; sf[4 * j + 1] = t4[1]; sf[4 * j + 2] = t4[2]; sf[4 * j + 3] = t4[3]; }
      const int v_ = tid >> 2, k0 = (tid & 3) * 16;
      *(u32x4*)(ST + v_ * 72 + k0) = pack8(sf); *(u32x4*)(ST + v_ * 72 + k0 + 8) = pack8(sf + 8);
    }
    __syncthreads();
    {
      const int tt = mt, st = nt;
      const bool need = d == 0 ? st <= tt : st >= tt;
      f32x16 sc;
#pragma unroll
      for (int q = 0; q < 16; ++q) sc[q] = 0.f;
      if (need) {
#pragma unroll
        for (int ks = 0; ks < 4; ++ks) {
          bf16x8 a = *(const bf16x8*)(Qin + (tt * 32 + r) * 72 + ks * 16 + hh * 8);
          bf16x8 bb = *(const bf16x8*)(Kin + (st * 32 + r) * 72 + ks * 16 + hh * 8);
          sc = MFMA(a, bb, sc);
        }
      }
#pragma unroll
      for (int i = 0; i < 16; ++i) {
        int trow = tt * 32 + crow(i, hh), scol = st * 32 + r;
        bool keep = d == 0 ? scol <= trow : scol >= trow;
        Sc[trow * 72 + scol] = f2bf(keep ? sc[i] : 0.f);
      }
    }
    __syncthreads();
#pragma unroll
    for (int ks = 0; ks < 4; ++ks) {
      bf16x8 a = *(const bf16x8*)(Sc + (mt * 32 + r) * 72 + ks * 16 + hh * 8);
      bf16x8 bb = *(const bf16x8*)(Vt + (nt * 32 + r) * 72 + ks * 16 + hh * 8);
      oacc = MFMA(a, bb, oacc);
    }
#pragma unroll
    for (int ks = 0; ks < 4; ++ks) {
      bf16x8 a = *(const bf16x8*)(Qin + (mt * 32 + r) * 72 + ks * 16 + hh * 8);
      bf16x8 bb = *(const bf16x8*)(ST + (nt * 32 + r) * 72 + ks * 16 + hh * 8);
      oacc = MFMA(a, bb, oacc);
    }
    __syncthreads();
  }
  float* Ob = (float*)smem;
#pragma unroll
  for (int i = 0; i < 16; ++i) Ob[(mt * 32 + crow(i, hh)) * 68 + nt * 32 + r] = oacc[i];
  __syncthreads();
  {
    float o[16], rr[16]; float ss = 0;
#pragma unroll
    for (int cc = 0; cc < 16; ++cc) { o[cc] = Ob[t_ * 68 + q4 * 16 + cc]; ss += o[cc] * o[cc]; }
    ss += __shfl_xor(ss, 1); ss += __shfl_xor(ss, 2);
    float rstd = rsqrtf(ss * (1.f / 64.f) + EPS);
    const us* sr = P0 + (size_t)t_ * INC + 1280 + h * 64 + q4 * 16;
    unpack8(*(const u32x4*)sr, rr); unpack8(*(const u32x4*)(sr + 8), rr + 8);
    const float* gn = p.in[16] + l * 256 + h * 64 + q4 * 16;
#pragma unroll
    for (int cc = 0; cc < 16; ++cc) o[cc] = o[cc] * rstd * gn[cc] * silu_(rr[cc]);
    us* dst = (us*)(p.ws + OFF_MIXIN) + (m0 + t_) * 1024 + 256 + h * 64 + q4 * 16;
    *(u32x4*)dst = pack8(o); *(u32x4*)(dst + 8) = pack8(o + 8);
  }
}

DI size_t hl_idx(int b, int c, int d, int g, int pp) { return ((size_t)(((b * NCHK + c) * 2 + d) * 16 + g) * 64 + pp) * 2; }
template <bool OUT>
DI void s5_task(const Params& p, int l, int b, int c, int gp, char* smem) {
  float* sU = (float*)smem;
  us* Hb = (us*)(smem + 8192);
  float* Yb = (float*)(smem + 8192 + 4 * 32 * 136 * 2);
  const int tid = tidx(), w = tid >> 6, lane = tid & 63, r = lane & 31, hh = lane >> 5;
  const long m0 = seqrow(b, c * 64);
  const us* P0 = (const us*)(p.ws + OFF_P) + m0 * INC;
  __syncthreads();
  {
    int t = tid >> 2, q4 = tid & 3; float f[8];
    unpack8(*(const u32x4*)(P0 + (size_t)t * INC + 1568 + gp * 32 + q4 * 8), f);
#pragma unroll
    for (int j = 0; j < 8; ++j) sU[t * 32 + q4 * 8 + j] = f[j];
  }
  __syncthreads();
  const int gl = w >> 1, d = w & 1, g = gp * 2 + gl, pp = lane;
  const float* sf = s5f(p, l);
  f32x2_ B2[16];
  {
    const float* bb = sf + S_BBAR + ((size_t)((d * 16 + g) * 64 + pp) * 16) * 2;
#pragma unroll
    for (int j = 0; j < 8; ++j) { f32x4 t4 = *(const f32x4*)(bb + j * 4); B2[2 * j] = (f32x2_){t4[0], t4[1]}; B2[2 * j + 1] = (f32x2_){t4[2], t4[3]}; }
  }
  const float lr = sf[S_LAMB + ((d * 16 + g) * 64 + pp) * 2], li = sf[S_LAMB + ((d * 16 + g) * 64 + pp) * 2 + 1];
  const f32x2_ la = {lr, lr}, lb = {-li, li};
  float hr = 0.f, hi = 0.f;
  float* HL = (float*)(p.ws + OFF_HL) + hl_idx(b, c, d, g, pp);
  if (OUT) { hr = HL[0]; hi = HL[1]; }
  const us* cm = wl(p, l) + W_CM + ((size_t)(d * 16 + g) * 16 + (r & 15)) * 128 + hh * 8;
  for (int half = 0; half < 2; ++half) {
    for (int jj = 0; jj < 32; ++jj) {
      const int j = half * 32 + jj, t = d ? 63 - j : j;
      const float* u = sU + t * 32 + gl * 16;
      f32x2_ bu = {0.f, 0.f};
#pragma unroll
      for (int q = 0; q < 4; ++q) { f32x4 u4 = *(const f32x4*)(u + q * 4);
#pragma unroll
        for (int e = 0; e < 4; ++e) bu += B2[q * 4 + e] * (f32x2_){u4[e], u4[e]}; }
      { f32x2_ h = {hr, hi}, hs = {hi, hr}; f32x2_ nh = la * h + lb * hs + bu; hr = nh[0]; hi = nh[1]; }
      if (OUT) { Hb[(w * 32 + (t & 31)) * 136 + pp] = f2bf(hr); Hb[(w * 32 + (t & 31)) * 136 + 64 + pp] = f2bf(hi); }
    }
    if (OUT) {
      __syncthreads();
      f32x16 acc;
#pragma unroll
      for (int q = 0; q < 16; ++q) acc[q] = 0.f;
#pragma unroll
      for (int ks = 0; ks < 8; ++ks) {
        bf16x8 a = *(const bf16x8*)(Hb + (w * 32 + r) * 136 + ks * 16 + hh * 8);
        bf16x8 bb = *(const bf16x8*)(cm + ks * 16);
        if (r >= 16) bb = (bf16x8){0, 0, 0, 0, 0, 0, 0, 0};
        acc = MFMA(a, bb, acc);
      }
      const int tbase = d ? (1 - half) * 32 : half * 32;
      if (r < 16) {
#pragma unroll
        for (int i = 0; i < 16; ++i) Yb[(w * 64 + tbase + crow(i, hh)) * 17 + r] = acc[i];
      }
      __syncthreads();
    }
  }
  if (!OUT) { HL[0] = hr; HL[1] = hi; return; }
  {
    const int gl2 = tid >> 7, t = (tid >> 1) & 63, o8 = (tid & 1) * 8, g2 = gp * 2 + gl2; float y[8];
#pragma unroll
    for (int o = 0; o < 8; ++o) {
      float v = Yb[((gl2 * 2 + 0) * 64 + t) * 17 + o8 + o] + Yb[((gl2 * 2 + 1) * 64 + t) * 17 + o8 + o]
              + p.in[24][l * 256 + g2 * 16 + o8 + o] * sU[t * 32 + gl2 * 16 + o8 + o];
      y[o] = gelu_t(v);
    }
    *(u32x4*)((us*)(p.ws + OFF_Y) + (m0 + t) * 256 + g2 * 16 + o8) = pack8(y);
  }
}
DI void s5b_task(const Params& p, int l, int it) {
  const int gid = it * 256 + tidx();
  const int pp = gid & 63, g = (gid >> 6) & 15, d = (gid >> 10) & 1, b = gid >> 11;
  const float* sf = s5f(p, l);
  const float tr = sf[S_LAMT + ((d * 16 + g) * 64 + pp) * 2], ti = sf[S_LAMT + ((d * 16 + g) * 64 + pp) * 2 + 1];
  float* HL = (float*)(p.ws + OFF_HL);
  float hr = 0.f, hi = 0.f;
  for (int j0 = 0; j0 < NCHK; j0 += 33) {
    f32x2_ xv[33];
#pragma unroll
    for (int q = 0; q < 33; ++q) xv[q] = *(const f32x2_*)(HL + hl_idx(b, gla_order(d, j0 + q), d, g, pp));
#pragma unroll
    for (int q = 0; q < 33; ++q) {
      f32x2_ o = {hr, hi};
      *(f32x2_*)(HL + hl_idx(b, gla_order(d, j0 + q), d, g, pp)) = o;
      float nr = tr * hr - ti * hi + xv[q][0], ni = tr * hi + ti * hr + xv[q][1]; hr = nr; hi = ni;
    }
  }
}

DI void attn_task(const Params& p, int b, int h, int qs0, int nkeys, char* smem) {
  constexpr int KSZ = 64 * 104, VSZ = 64 * 68;
  us* sK = (us*)smem;
  us* sV = sK + 3 * KSZ;
  const int tid = tid512(), w = tid >> 6, lane = tid & 63, r = lane & 31, hh = lane >> 5;
  const us* Kg = (const us*)(p.ws + OFF_KB) + (size_t)(b * 4 + h) * SEQ * 96;
  const us* Vg = (const us*)(p.ws + OFF_VT) + (size_t)(b * 4 + h) * 64 * SEQ;
  const us* Qg = (const us*)(p.ws + OFF_QB) + ((size_t)(b * 4 + h) * SEQ + qs0 + w * 32 + r) * 96 + hh * 8;
  bf16x8 qf[6];
#pragma unroll
  for (int ks = 0; ks < 6; ++ks) qf[ks] = *(const bf16x8*)(Qg + ks * 16);
  u32x4 rk[2], rv;
  const int kq1 = tid + 512 < 768 ? tid + 512 : tid;
  const int vrow = tid >> 3, vcc = tid & 7;
  const int kw0 = (tid / 12) * 104 + (tid % 12) * 8, kw1 = (kq1 / 12) * 104 + (kq1 % 12) * 8, vw = vrow * 68 + vcc * 8;
#define AGLOAD(kt) { rk[0] = *(const u32x4*)(Kg + (size_t)(kt) * 64 * 96 + tid * 8); rk[1] = *(const u32x4*)(Kg + (size_t)(kt) * 64 * 96 + kq1 * 8); \
    rv = *(const u32x4*)(Vg + (size_t)vrow * SEQ + (kt) * 64 + vcc * 8); }
#define ASWRITE(buf) { *(u32x4*)(sK + (buf) * KSZ + kw0) = rk[0]; *(u32x4*)(sK + (buf) * KSZ + kw1) = rk[1]; \
    us* dv = sV + (buf) * VSZ + vw; u32x2 lo = {rv[0], rv[1]}, hi2 = {rv[2], rv[3]}; *(u32x2*)dv = lo; *(u32x2*)(dv + 4) = hi2; }
  f32x16 o0, o1, negm, sc0, sc1;
#pragma unroll
  for (int q = 0; q < 16; ++q) { o0[q] = 0.f; o1[q] = 0.f; sc0[q] = 0.f; sc1[q] = 0.f; }
  float lsum = 0.f;
  const int NT = nkeys / 64;
  __syncthreads();
  AGLOAD(0); ASWRITE(0); AGLOAD(1); ASWRITE(1); AGLOAD(2);
  __syncthreads();
  {
    const us* k0 = sK + r * 104 + hh * 8;
#pragma unroll
    for (int ks = 0; ks < 6; ++ks) {
      bf16x8 a0 = *(const bf16x8*)(k0 + ks * 16), a1 = *(const bf16x8*)(k0 + 32 * 104 + ks * 16);
      sc0 = MFMA(a0, qf[ks], sc0); sc1 = MFMA(a1, qf[ks], sc1);
    }
    float mx = sc0[0];
#pragma unroll
    for (int i = 1; i < 16; ++i) mx = fmaxf(mx, sc0[i]);
#pragma unroll
    for (int i = 0; i < 16; ++i) mx = fmaxf(mx, sc1[i]);
    mx = fmaxf(mx, __shfl_xor(mx, 32));
#pragma unroll
    for (int q = 0; q < 16; ++q) { negm[q] = -mx; sc0[q] -= mx; sc1[q] -= mx; }
  }
  int bc = 0, bn = 1, bw = 2;
  for (int kt = 0; kt < NT; ++kt) {
    __syncthreads();
    ASWRITE(bw);
    { const int kl = kt + 3 < NT ? kt + 3 : NT - 1; AGLOAD(kl); }
    float mx = sc0[0];
#pragma unroll
    for (int i = 1; i < 16; ++i) mx = fmaxf(mx, sc0[i]);
#pragma unroll
    for (int i = 0; i < 16; ++i) mx = fmaxf(mx, sc1[i]);
    mx = fmaxf(mx, __shfl_xor(mx, 32));
    if (__builtin_amdgcn_ballot_w64(mx > 8.f)) {
      const float dl = fmaxf(mx, 0.f), alpha = __builtin_amdgcn_exp2f(-dl);
#pragma unroll
      for (int i = 0; i < 16; ++i) { o0[i] *= alpha; o1[i] *= alpha; sc0[i] -= dl; sc1[i] -= dl; negm[i] -= dl; }
      lsum *= alpha;
    }
    f32x16 sn0, sn1;
    {
      const us* k0 = sK + bn * KSZ + r * 104 + hh * 8;
      {
        bf16x8 a0 = *(const bf16x8*)(k0), a1 = *(const bf16x8*)(k0 + 32 * 104);
        sn0 = MFMA(a0, qf[0], negm); sn1 = MFMA(a1, qf[0], negm);
      }
#pragma unroll
      for (int ks = 1; ks < 6; ++ks) {
        bf16x8 a0 = *(const bf16x8*)(k0 + ks * 16), a1 = *(const bf16x8*)(k0 + 32 * 104 + ks * 16);
        sn0 = MFMA(a0, qf[ks], sn0); sn1 = MFMA(a1, qf[ks], sn1);
      }
    }
    float ps = 0.f;
#pragma unroll
    for (int i = 0; i < 16; ++i) { sc0[i] = __builtin_amdgcn_exp2f(sc0[i]); ps += sc0[i]; }
#pragma unroll
    for (int i = 0; i < 16; ++i) { sc1[i] = __builtin_amdgcn_exp2f(sc1[i]); ps += sc1[i]; }
    lsum += ps;
    bf16x8 pf[4];
    {
      u32x4 t0 = {pk2(sc0[0], sc0[1]), pk2(sc0[2], sc0[3]), pk2(sc0[4], sc0[5]), pk2(sc0[6], sc0[7])};
      u32x4 t1 = {pk2(sc0[8], sc0[9]), pk2(sc0[10], sc0[11]), pk2(sc0[12], sc0[13]), pk2(sc0[14], sc0[15])};
      u32x4 t2 = {pk2(sc1[0], sc1[1]), pk2(sc1[2], sc1[3]), pk2(sc1[4], sc1[5]), pk2(sc1[6], sc1[7])};
      u32x4 t3 = {pk2(sc1[8], sc1[9]), pk2(sc1[10], sc1[11]), pk2(sc1[12], sc1[13]), pk2(sc1[14], sc1[15])};
      pf[0] = __builtin_bit_cast(bf16x8, t0); pf[1] = __builtin_bit_cast(bf16x8, t1);
      pf[2] = __builtin_bit_cast(bf16x8, t2); pf[3] = __builtin_bit_cast(bf16x8, t3);
    }
    {
      const us* v0 = sV + bc * VSZ + r * 68 + 4 * hh;
#pragma unroll
      for (int kk = 0; kk < 4; ++kk) {
        u32x2 l0 = *(const u32x2*)(v0 + 16 * kk), h0 = *(const u32x2*)(v0 + 16 * kk + 8);
        u32x2 l1 = *(const u32x2*)(v0 + 32 * 68 + 16 * kk), h1 = *(const u32x2*)(v0 + 32 * 68 + 16 * kk + 8);
        u32x4 a0 = {l0[0], l0[1], h0[0], h0[1]}, a1 = {l1[0], l1[1], h1[0], h1[1]};
        o0 = MFMA(__builtin_bit_cast(bf16x8, a0), pf[kk], o0);
        o1 = MFMA(__builtin_bit_cast(bf16x8, a1), pf[kk], o1);
      }
    }
    sc0 = sn0; sc1 = sn1;
    { const int t = bc; bc = bn; bn = bw; bw = t; }
  }
#undef AGLOAD
#undef ASWRITE
  lsum += __shfl_xor(lsum, 32);
  const float inv = 1.f / lsum;
  const long m = seqrow(b, qs0 + w * 32 + r);
  us* dst = (us*)(p.ws + OFF_MIXIN) + m * 1024 + 768 + h * 64;
#pragma unroll
  for (int gq = 0; gq < 4; ++gq) {
    u32x2 w0 = {pk2(o0[4 * gq] * inv, o0[4 * gq + 1] * inv), pk2(o0[4 * gq + 2] * inv, o0[4 * gq + 3] * inv)};
    u32x2 w1 = {pk2(o1[4 * gq] * inv, o1[4 * gq + 1] * inv), pk2(o1[4 * gq + 2] * inv, o1[4 * gq + 3] * inv)};
    *(u32x2*)(dst + 8 * gq + 4 * hh) = w0;
    *(u32x2*)(dst + 32 + 8 * gq + 4 * hh) = w1;
  }
}

DI void convact_task(const Params& p, int l, int it, int nrows) {
  const int T = it * 256 + tidx();
  if (T >= (nrows / 8) * 352) return;
  const int rb = T / 352, oct = T - rb * 352, c0 = oct * 8, i0 = rb * 8;
  const int slo = i0 < 8192 ? 0 : 8192, shi = i0 < 8192 ? 8192 : 8448;
  const us* Z = (const us*)(p.ws + OFF_ZPRE);
  const float* cw = p.in[33] + (size_t)l * 3 * DFF2; const float* cb = p.in[34] + (size_t)l * DFF2;
  float wa[3][8], wg[3][8], ba[8], bg[8];
#pragma unroll
  for (int j = 0; j < 3; ++j) {
    f32x4 a0 = *(const f32x4*)(cw + j * DFF2 + c0), a1 = *(const f32x4*)(cw + j * DFF2 + c0 + 4);
    f32x4 g0 = *(const f32x4*)(cw + j * DFF2 + DFF + c0), g1 = *(const f32x4*)(cw + j * DFF2 + DFF + c0 + 4);
#pragma unroll
    for (int q = 0; q < 4; ++q) { wa[j][q] = a0[q]; wa[j][4 + q] = a1[q]; wg[j][q] = g0[q]; wg[j][4 + q] = g1[q]; }
  }
  {
    f32x4 a0 = *(const f32x4*)(cb + c0), a1 = *(const f32x4*)(cb + c0 + 4), g0 = *(const f32x4*)(cb + DFF + c0), g1 = *(const f32x4*)(cb + DFF + c0 + 4);
#pragma unroll
    for (int q = 0; q < 4; ++q) { ba[q] = a0[q]; ba[4 + q] = a1[q]; bg[q] = g0[q]; bg[4 + q] = g1[q]; }
  }
  float za[3][8], zg[3][8];
#define LDROW(slot, i) { if ((i) >= slo && (i) < shi) { unpack8(*(const u32x4*)(Z + (size_t)(i) * DFF2 + c0), za[slot]); unpack8(*(const u32x4*)(Z + (size_t)(i) * DFF2 + DFF + c0), zg[slot]); } \
    else { _Pragma("unroll") for (int q = 0; q < 8; ++q) { za[slot][q] = 0.f; zg[slot][q] = 0.f; } } }
  LDROW(0, i0 - 1); LDROW(1, i0);
  us* A = (us*)(p.ws + OFF_ACT);
#pragma unroll
  for (int ii = 0; ii < 8; ++ii) {
    const int i = i0 + ii;
    LDROW(2, i + 1);
    float o[8];
#pragma unroll
    for (int q = 0; q < 8; ++q) {
      float a = ba[q] + wa[0][q] * za[0][q] + wa[1][q] * za[1][q] + wa[2][q] * za[2][q];
      float gg = bg[q] + wg[0][q] * zg[0][q] + wg[1][q] * zg[1][q] + wg[2][q] * zg[2][q];
      o[q] = gelu_t(a) * gg;
    }
    *(u32x4*)(A + (size_t)i * DFF + c0) = pack8(o);
#pragma unroll
    for (int q = 0; q < 8; ++q) { za[0][q] = za[1][q]; za[1][q] = za[2][q]; zg[0][q] = zg[1][q]; zg[1][q] = zg[2][q]; }
  }
#undef LDROW
}


constexpr int SCHED_WORDS = 1024;
DI int gl_n(int RT, int CT, int x) { return ((RT - x + 7) >> 3) * CT; }
DI void gl_tile(int RT, int CT, int x, int j, int& rt, int& ct) {
  const int rows = (RT - x + 7) >> 3, nfull = CT >> 3; int rl;
  if (j < nfull * rows * 8) { int pnl = j / (rows * 8), rem = j - pnl * rows * 8; rl = rem >> 3; ct = pnl * 8 + (rem & 7); }
  else { int j2 = j - nfull * rows * 8, wd = CT - nfull * 8; rl = j2 / wd; ct = nfull * 8 + (j2 - rl * wd); }
  rt = rl * 8 + x;
}
DI int ml_n(int n, int x) { return (n - x + 7) >> 3; }
template <class NX, class RUN>
DI void run_phase(unsigned*& ctr, int G, int bid, volatile int* s_bc, NX nx, RUN run) {
  const int x0 = bid & 7, per = G >> 3;
  const int x = x0; int j = bid >> 3;
  for (;;) {
    if (j < nx(x)) {
      int nj = 0;
      if (threadIdx.x == 0) nj = per + (int)atomicAdd(&ctr[x], 1u);
      run(x, j);
      __syncthreads();
      if (threadIdx.x == 0) *s_bc = nj;
      __syncthreads();
      j = *s_bc;
    } else break;
  }
  ctr += 8;
}

DI long chunk_row(int ch, int i) { return i < 8192 ? (long)ch * 8192 + i : (long)MX + ch * 256 + (i - 8192); }


template <class RUN>
DI void run_tiles(unsigned*& ctr, int n, int G, int bid, volatile int* s_bc, RUN run) {
  int it = bid;
  while (it < n) {
    int nx = 0;
    if (threadIdx.x == 0) nx = G + (int)atomicAdd(ctr, 1u);
    run(it);
    __syncthreads();
    if (threadIdx.x == 0) *s_bc = nx;
    __syncthreads();
    it = *s_bc;
  }
  ctr += 1;
}

constexpr int HLDS = 64512;
constexpr int LDS_BYTES = 147456;
static_assert(2 * HLDS <= LDS_BYTES, "lds");

__global__ void __launch_bounds__(512) fwd_mega(Params p) {
  cg::grid_group grid = cg::this_grid();
  extern __shared__ __attribute__((aligned(16))) char dsm[];
  __shared__ uint4 xb_words;
  const int G = gridDim.x, bid = blockIdx.x, wv8 = __builtin_amdgcn_readfirstlane(threadIdx.x >> 6), half = wv8 >> 2;
  char* smem = dsm + half * HLDS;
  const int vb = bid * 2 + half, V = 2 * G;
  if (threadIdx.x == 0) xb_words = make_uint4(0u, 0u, 0u, 0u);
  __syncthreads();
  const XcdBarrier xb = xcd_barrier_post((unsigned*)(p.ws + OFF_BAR), (volatile LAS unsigned*)&xb_words);
#define HALF_LOOP(n, IT, ...) { const int n_ = (n); const int iters_ = (n_ + V - 1) / V; for (int k_ = 0; k_ < iters_; ++k_) { int IT = vb + k_ * V; IT = IT < n_ ? IT : n_ - 1; __VA_ARGS__ } }
#define HALF_LOOP_NB(n, IT, ...) { const int n_ = (n); for (int IT = vb; IT < n_; IT += V) { __VA_ARGS__ } }

  HALF_LOOP(2 * NCONV_LAYER, it, conv_task(p, it, smem);)
  HALF_LOOP(384, it, mod_task(p, it, smem);)
  HALF_LOOP_NB(16, it, s5pre_task(p, it);)
  HALF_LOOP_NB(4, it, rope_task(p, it);)
  HALF_LOOP_NB(128, it, sguw_task(p, it);)
  HALF_LOOP_NB(64, it, wgt_task(p, it);)
  grid.sync();
  for (int it = bid; it < MT / 8; it += G) row_task<0>(p, 0, (long)it * 8 + wv8, nullptr);
  xcd_barrier(xb);

  unsigned* ctr = (unsigned*)(p.ws + OFF_SCHED);
  volatile int* s_bc = (volatile int*)&xb_words.z;
  for (int l = 0; l < 2; ++l) {
    const us* W = wl(p, l);
    const int RT = l == 0 ? 264 : 256;
    run_tiles(ctr, 132 * 9, G, bid, s_bc, [&](int it) {
      const int rt = it / 9, ct = it - rt * 9;
      GArgs g{(const us*)(p.ws + OFF_HX) + (size_t)rt * 256 * D, D, W + W_IN + (size_t)ct * 256 * D, D, (long)rt * 256, ct * 256, p.ws + OFF_P, INC, l};
      for (int rp = 0; rp < REP_GEMM; ++rp) gemm_big(g, ct == 8 ? 128 : 256, dsm);
    });
    xcd_barrier(xb);
    {
      const int p0 = (4 * NCHK * 8) >> 1, p1 = p0 + ((4 * NCHK * 4) >> 1), p2 = p1 + ((RT * 4) >> 1), p3 = p2 + ((264 * 3) >> 1), p4 = p3 + ((264 * 4) >> 1);
      for (int P = bid; P < p4; P += G) {
        if (P < p0) { const int q = 2 * P + half; s5_task<false>(p, l, q / (NCHK * 8), (q / 8) % NCHK, q & 7, smem); }
        else if (P < p1) { const int q = 2 * (P - p0) + half; gla1_task(p, l, q / (NCHK * 4), (q / 4) % NCHK, q & 3, smem); }
        else if (P < p2) { const int q = 2 * (P - p1) + half; sgu_task(p, l, q >> 2, q & 3, smem); }
        else if (P < p3) { const int q = 2 * (P - p2) + half, rt = q / 3, ct = q % 3;
          GArgs g{(const us*)(p.ws + OFF_P) + (size_t)rt * 128 * INC + 1824, INC, W + W_UQ + (size_t)ct * 128 * 224, 224, (long)rt * 128, ct * 128, nullptr, 0, l};
          gemm_tile<32, 2, true>(p, g, smem); }
        else { const int q = 2 * (P - p3) + half, rt = q >> 2, ct = q & 3;
          GArgs g{(const us*)(p.ws + OFF_P) + (size_t)rt * 128 * INC + 2048, INC, W + W_UKV + (size_t)ct * 128 * 96, 96, (long)rt * 128, ct * 128, nullptr, 0, l};
          gemm_tile<32, 3, true>(p, g, smem);
          if (ct == 0) kr_task(p, (long)rt * 128); }
      }
    }
    xcd_barrier(xb);
    HALF_LOOP_NB(512, it, gla2_task(p, it);)
    HALF_LOOP_NB(32, it, s5b_task(p, l, it);)
    xcd_barrier(xb);
    if ((G & 7) == 0) {
      const int x = bid & 7;
      for (int j = bid >> 3; j < 64; j += G >> 3) { int pair = 2 * x + (j >> 5), qb = j & 31; for (int rp = 0; rp < REP_ATT; ++rp) attn_task(p, pair >> 2, pair & 3, 256 + qb * 256, SEQ, dsm); }
    } else {
      for (int it = bid; it < 512; it += G) attn_task(p, it >> 7, (it >> 5) & 3, 256 + (it & 31) * 256, SEQ, dsm);
    }
    if (l == 0) for (int it = bid; it < 16; it += G) attn_task(p, it >> 2, it & 3, 0, 256, dsm);
    {
      const int c0 = l == 0 ? 0 : 4, nc = NCHK - c0;
      const int p0 = (4 * nc * 8) >> 1, p1 = p0 + ((4 * nc * 4) >> 1);
      for (int P = bid; P < p1; P += G) {
        if (P < p0) { const int q = 2 * P + half; s5_task<true>(p, l, q / (nc * 8), c0 + (q / 8) % nc, q & 7, smem); }
        else { const int q = 2 * (P - p0) + half; gla3_task(p, l, q / (nc * 4), c0 + (q / 4) % nc, q & 3, smem); }
      }
    }
    xcd_barrier(xb);
    HALF_LOOP(RT * 2, it, { int rt = it >> 1, ct = it & 1;
      GArgs g{(const us*)(p.ws + OFF_Y) + (size_t)rt * 128 * 256, 256, W + W_GLU + (size_t)ct * 128 * 256, 256, (long)rt * 128, ct * 128, nullptr, 0, l};
      gemm_tile<32, 4, false>(p, g, smem); })
    xcd_barrier(xb);
    run_tiles(ctr, (RT / 2) * 4, G, bid, s_bc, [&](int it) {
      const int rt = it >> 2, ct = it & 3;
      GArgs g{(const us*)(p.ws + OFF_MIXIN) + (size_t)rt * 256 * D, D, W + W_OUT + (size_t)ct * 256 * D, D, (long)rt * 256, ct * 256, p.ws + OFF_MIXOUT, D, l};
      for (int rp = 0; rp < REP_GEMM; ++rp) gemm_big(g, 256, dsm);
    });
    xcd_barrier(xb);
    for (int it = bid; it < RT * 16; it += G) { long m = (long)it * 8 + wv8; row_task<1>(p, l, m, (const us*)(p.ws + OFF_MIXOUT) + m * 1024); }
    xcd_barrier(xb);
    const int CR2 = l == 0 ? 33 : 32, CROWS = CR2 * 256, NF2 = (CROWS / 8 * 352 + 255) / 256;
    for (int ch = 0; ch <= 4; ++ch) {
      {
        const bool hasF3 = ch > 0, hasF1 = ch < 4;
        const int n3 = hasF3 ? CR2 * 4 : 0, n1 = hasF1 ? CR2 * 22 : 0;
        run_tiles(ctr, n3 + n1, G, bid, s_bc, [&](int it) {
          if (it < n3) {
            const int rt = it >> 2, ct = it & 3;
            GArgs g{(const us*)(p.ws + OFF_ACT) + (size_t)rt * 256 * DFF, DFF, W + W_DN + (size_t)ct * 256 * DFF, DFF, (long)rt * 256, ct * 256, p.ws + OFF_FFNOUT, D, l};
            for (int rp = 0; rp < REP_GEMM; ++rp) gemm_big(g, 256, dsm);
          } else {
            const int q = it - n3, rt = q / 22, ct = q - rt * 22;
            GArgs g{(const us*)(p.ws + OFF_HX) + (size_t)chunk_row(ch, rt * 256) * D, D, W + W_UP + (size_t)ct * 256 * D, D, (long)rt * 256, ct * 256, p.ws + OFF_ZPRE, DFF2, l};
            for (int rp = 0; rp < REP_GEMM; ++rp) gemm_big(g, 256, dsm);
          }
        });
      }
      xcd_barrier(xb);
      if (ch < 4) HALF_LOOP_NB(NF2, it, convact_task(p, l, it, CROWS);)
      if (ch > 0) for (int it = bid; it < CROWS / 8; it += G) { int i = it * 8 + wv8; row_task<2>(p, l, chunk_row(ch - 1, i), (const us*)(p.ws + OFF_FFNOUT) + (size_t)i * 1024); }
      xcd_barrier(xb);
    }
  }
#undef HALF_LOOP
#undef HALF_LOOP_NB
}

extern "C" void kernel_launch(void* const* d_in, const int* in_sizes, int n_in, void* d_out, int out_size,
                              void* d_ws, size_t ws_size, hipStream_t stream) {
  static int grid_blocks = 0;
  if (!grid_blocks) {
    int dev = 0, cus = 0, per_cu = 0;
    (void)hipGetDevice(&dev);
    (void)hipDeviceGetAttribute(&cus, hipDeviceAttributeMultiprocessorCount, dev);
    if (hipFuncSetAttribute((const void*)fwd_mega, hipFuncAttributeMaxDynamicSharedMemorySize, LDS_BYTES) != hipSuccess)
      fprintf(stderr, "kernel_launch: hipFuncSetAttribute(%d B LDS) failed\n", LDS_BYTES);
    (void)hipOccupancyMaxActiveBlocksPerMultiprocessor(&per_cu, fwd_mega, 512, LDS_BYTES);
    if (per_cu < 1) fprintf(stderr, "kernel_launch: occupancy query returned %d\n", per_cu);
    grid_blocks = cus;
    if (ws_size < OFF_END) fprintf(stderr, "kernel_launch: ws too small: %zu < %zu\n", ws_size, (size_t)OFF_END);
  }
  if (n_in != 36 || ws_size < OFF_END) return;
  Params p{};
  for (int i = 0; i < 36; ++i) p.in[i] = (const float*)d_in[i];
  p.out = (float*)d_out; p.ws = (char*)d_ws;
  void* args[] = {&p};
  (void)hipMemsetAsync((char*)d_ws + OFF_BAR, 0, (XCD_BAR_WORDS + SCHED_WORDS) * 4, stream);
  hipError_t e = hipLaunchCooperativeKernel((void*)fwd_mega, dim3(grid_blocks), dim3(512), args, LDS_BYTES, stream);
  if (e != hipSuccess) fprintf(stderr, "cooperative launch failed: %s (grid %d)\n", hipGetErrorString(e), grid_blocks);
}
```

```cpp
#include <hip/hip_runtime.h>
#include <hip/hip_cooperative_groups.h>
#include <cstdio>
#include <cstdint>
namespace cg = cooperative_groups;

typedef unsigned short us;
using bf16x8 = __attribute__((ext_vector_type(8))) short;
using f32x16 = __attribute__((ext_vector_type(16))) float;
using f32x4  = __attribute__((ext_vector_type(4))) float;
using u32x4  = __attribute__((ext_vector_type(4))) unsigned;
using u32x2  = __attribute__((ext_vector_type(2))) unsigned;
#define DI __device__ __forceinline__
#define MFMA(a, b, c) __builtin_amdgcn_mfma_f32_32x32x16_bf16((a), (b), (c), 0, 0, 0)

#ifndef REP_F3N
#define REP_F3N 1
#endif
#ifndef REP_F1N
#define REP_F1N 1
#endif
#ifndef REP_GEMM
#define REP_GEMM 1
#endif
#ifndef REP_M1
#define REP_M1 1
#endif
#ifndef REP_M3
#define REP_M3 1
#endif
#ifndef REP_ATT
#define REP_ATT 1
#endif
#ifndef REP_GLA3
#define REP_GLA3 1
#endif
#ifndef REP_S5C
#define REP_S5C 1
#endif
#ifndef REP_F2
#define REP_F2 1
#endif
#ifndef REP_P0
#define REP_P0 1
#endif
#ifndef EXTRA_SYNC
#define EXTRA_SYNC 0
#endif
constexpr int D = 1024, MX = 32768, MC = 1024, MT = MX + MC, INC = 2176, DFF = 2816, DFF2 = 5632;
constexpr int SEQ = 8448, NCHK = 132;
constexpr float EPS = 1e-6f;
constexpr float QSCALE = 0.10206207261596577f * 1.4426950408889634f;

constexpr size_t W_IN = 0, W_OUT = W_IN + (size_t)INC * D, W_UP = W_OUT + (size_t)D * D, W_DN = W_UP + (size_t)DFF2 * D,
                 W_UQ = W_DN + (size_t)D * DFF, W_UKV = W_UQ + 384 * 224, W_GLU = W_UKV + 512 * 96, W_SGU = W_GLU + 256 * 256,
                 W_CM = W_SGU + 4 * 128 * 128, W_WG = W_CM + 2 * 16 * 16 * 128, W_BM = W_WG + 2 * 256 * 16, W_LAYER = W_BM + 2 * 16 * 128 * 16;
constexpr size_t S_LAMB = 0, S_LAMT = 4096, S_BBAR = 8192, S_LAYER = 8192 + 65536;

constexpr size_t al256(size_t x) { return (x + 255) / 256 * 256; }
constexpr size_t OFF_WB = 0;
constexpr size_t OFF_S5F = al256(OFF_WB + 2 * W_LAYER * 2);
constexpr size_t OFF_MOD = al256(OFF_S5F + 2 * S_LAYER * 4);
constexpr size_t OFF_ROPE = al256(OFF_MOD + 2 * 5 * 6144 * 4);
constexpr size_t OFF_CTXS = al256(OFF_ROPE + 128 * 8 * 2 * 4);
constexpr size_t OFF_HX = al256(OFF_CTXS + (size_t)MC * D * 4);
constexpr size_t OFF_P = al256(OFF_HX + (size_t)MT * D * 2);
constexpr size_t OFF_MIXIN = al256(OFF_P + (size_t)MT * INC * 2);
constexpr size_t OFF_QB = al256(OFF_MIXIN + (size_t)MT * D * 2);
constexpr size_t OFF_KB = al256(OFF_QB + (size_t)16 * SEQ * 96 * 2);
constexpr size_t OFF_VT = al256(OFF_KB + (size_t)16 * SEQ * 96 * 2);
constexpr size_t OFF_KV = al256(OFF_VT + (size_t)16 * 64 * SEQ * 2);
constexpr size_t OFF_DEC = al256(OFF_KV + (size_t)4 * NCHK * 4 * 2 * 4096 * 4);
constexpr size_t OFF_HL = al256(OFF_DEC + (size_t)4 * NCHK * 4 * 2 * 64 * 4);
constexpr size_t OFF_Y = al256(OFF_HL + (size_t)4 * NCHK * 2 * 16 * 64 * 2 * 4);
constexpr size_t OFF_BAR = al256(OFF_Y + (size_t)MT * 256 * 2);
constexpr size_t OFF_SCHED = OFF_BAR + 3456 * 4;
constexpr size_t OFF_END = al256(OFF_SCHED + 1024 * 4);
constexpr size_t OFF_MIXOUT = OFF_P;
constexpr size_t OFF_ZPRE = OFF_P;
constexpr size_t OFF_ACT = OFF_MIXIN;
constexpr size_t OFF_FFNOUT = OFF_QB;
static_assert((size_t)MT * D * 4 <= (size_t)MT * INC * 2, "mixout alias");
static_assert((size_t)8448 * 1024 * 4 <= 2 * (size_t)16 * SEQ * 96 * 2, "ffnout alias");

struct Params { const float* in[36]; float* out; char* ws; };

DI float bf2f(us v) { return __uint_as_float(((unsigned)v) << 16); }
typedef float f32x2_ __attribute__((ext_vector_type(2)));
typedef __bf16 bf16x2_ __attribute__((ext_vector_type(2)));
DI unsigned pk2(float lo, float hi) { f32x2_ v = {lo, hi}; bf16x2_ b = __builtin_convertvector(v, bf16x2_); return __builtin_bit_cast(unsigned, b); }
DI us f2bf(float x) { return (us)(pk2(x, x) & 0xffffu); }
DI float lo_bf(unsigned w) { return __uint_as_float(w << 16); }
DI float hi_bf(unsigned w) { return __uint_as_float(w & 0xffff0000u); }
DI int tid512() { int t; asm volatile("v_mov_b32 %0, %1" : "=v"(t) : "v"(threadIdx.x)); return t; }
DI int tidx() { return tid512() & 255; }
DI int crow(int i, int hh) { return (i & 3) + 8 * (i >> 2) + 4 * hh; }
DI float sigmoidf_(float x) { return __builtin_amdgcn_rcpf(1.f + __expf(-x)); }
DI float gelu_t(float x) { float u = 0.7978845608028654f * (x + 0.044715f * x * x * x); return x * __builtin_amdgcn_rcpf(1.f + __expf(-2.f * u)); }
DI float silu_(float x) { return x * __builtin_amdgcn_rcpf(1.f + __expf(-x)); }
DI float logsig(float z) { return fminf(z, 0.f) - __logf(1.f + __expf(-fabsf(z))); }
DI void unpack8(u32x4 w, float* f) {
  f[0] = lo_bf(w[0]); f[1] = hi_bf(w[0]); f[2] = lo_bf(w[1]); f[3] = hi_bf(w[1]);
  f[4] = lo_bf(w[2]); f[5] = hi_bf(w[2]); f[6] = lo_bf(w[3]); f[7] = hi_bf(w[3]);
}
DI u32x4 pack8(const float* f) { u32x4 w = {pk2(f[0], f[1]), pk2(f[2], f[3]), pk2(f[4], f[5]), pk2(f[6], f[7])}; return w; }
DI long seqrow(int b, int s) { return s < 256 ? (long)MX + b * 256 + s : (long)b * 8192 + (s - 256); }
DI float wave_sum(float v) {
  v += __shfl_xor(v, 1); v += __shfl_xor(v, 2); v += __shfl_xor(v, 4); v += __shfl_xor(v, 8); v += __shfl_xor(v, 16); v += __shfl_xor(v, 32);
  return v;
}
DI const us* wl(const Params& p, int l) { return (const us*)(p.ws + OFF_WB) + (size_t)l * W_LAYER; }
DI const float* s5f(const Params& p, int l) { return (const float*)(p.ws + OFF_S5F) + (size_t)l * S_LAYER; }
DI const float* modv(const Params& p, int l, int v, int idx) { return (const float*)(p.ws + OFF_MOD) + ((size_t)(l * 5 + v) * 6 + idx) * 1024; }
DI float* stream_row(const Params& p, long m) { return m < MX ? p.out + m * 1024 : (float*)(p.ws + OFF_CTXS) + (m - MX) * 1024; }
DI const float* input_row(const Params& p, long m) { return m < MX ? p.in[0] + m * 1024 : p.in[2] + (m - MX) * 1024; }


#define XB_TMO      128
#define XB_XCNT(j)  (256  + 64 * (j))
#define XB_XSUB(j)  (1280 + 64 * (j))
#define XB_XGEN(j)  (2304 + 64 * (j))
#define XB_TOP      3328
#define XB_TOPGEN   3392
#define XCD_BAR_WORDS 3456
#define XB_SPIN_CAP (1u << 20)
#define LAS __attribute__((address_space(3)))
DI unsigned xb_ld(unsigned* p)              { return __hip_atomic_load(p, __ATOMIC_RELAXED, __HIP_MEMORY_SCOPE_AGENT); }
DI unsigned xb_add(unsigned* p, unsigned v) { return __hip_atomic_fetch_add(p, v, __ATOMIC_RELAXED, __HIP_MEMORY_SCOPE_AGENT); }
DI unsigned xb_xcc_id() { return (unsigned)__builtin_amdgcn_s_getreg((3 << 11) | 20) & 0xFu; }
#define XB_SPIN(cond, bar) do { unsigned _sp = 0; while (cond) { __builtin_amdgcn_s_sleep(1); \
    if ((++_sp & 255u) == 0u) { if (xb_ld(&(bar)[XB_TMO])) break; if (_sp > XB_SPIN_CAP) { atomicAdd(&(bar)[XB_TMO], 1u); break; } } } } while (0)
struct XcdBarrier { unsigned* bar; unsigned x; volatile LAS unsigned* st; };
DI XcdBarrier xcd_barrier_post(unsigned* bar, volatile LAS unsigned* st) {
  XcdBarrier b; b.bar = bar; b.x = xb_xcc_id(); b.st = st;
  if (threadIdx.x == 0) (void)xb_add(&bar[XB_XCNT(b.x)], 1u);
  return b;
}
DI void xcd_barrier_complete(unsigned* bar, unsigned x, unsigned& nloc, unsigned& nx) {
  const unsigned G = gridDim.x * gridDim.y * gridDim.z;
  unsigned sum, cnt, mine, sp = 0u;
  for (;;) {
    sum = 0u; cnt = 0u; mine = 0u;
#pragma unroll
    for (unsigned j = 0; j < 16; ++j) { const unsigned c = xb_ld(&bar[XB_XCNT(j)]); sum += c; cnt += (c > 0u) ? 1u : 0u; mine = (j == x) ? c : mine; }
    if (sum == G) break;
    __builtin_amdgcn_s_sleep(1);
    if ((++sp & 255u) == 0u) { if (xb_ld(&bar[XB_TMO])) break; if (sp > XB_SPIN_CAP) { atomicAdd(&bar[XB_TMO], 1u); break; } }
  }
  nloc = mine > 0u ? mine : 1u; nx = cnt > 0u ? cnt : 1u;
}
DI void xcd_barrier(const XcdBarrier& b) {
  asm volatile("s_waitcnt vmcnt(0)" ::: "memory");
  __syncthreads();
  if (threadIdx.x == 0) {
    unsigned* bar = b.bar;
    __builtin_amdgcn_s_waitcnt(0);
    unsigned nloc = b.st[0], nx = b.st[1];
    if (nloc == 0u) { xcd_barrier_complete(bar, b.x, nloc, nx); b.st[0] = nloc; b.st[1] = nx; }
    const unsigned old = xb_add(&bar[XB_XSUB(b.x)], 1u);
    const unsigned gen = old / nloc;
    if (old + 1u == (gen + 1u) * nloc) {
      __builtin_amdgcn_fence(__ATOMIC_RELEASE, "agent");
      asm volatile("s_waitcnt vmcnt(0)" ::: "memory");
      const unsigned og = xb_add(&bar[XB_TOP], 1u);
      const unsigned tg = og / nx;
      if (og + 1u == (tg + 1u) * nx) xb_add(&bar[XB_TOPGEN], 1u);
      else XB_SPIN(xb_ld(&bar[XB_TOPGEN]) == tg, bar);
      __builtin_amdgcn_fence(__ATOMIC_ACQUIRE, "agent");
      xb_add(&bar[XB_XGEN(b.x)], 1u);
      asm volatile("s_waitcnt vmcnt(0)" ::: "memory");
    } else {
      XB_SPIN(xb_ld(&bar[XB_XGEN(b.x)]) == gen, bar);
      __builtin_amdgcn_fence(__ATOMIC_ACQUIRE, "agent");
      asm volatile("s_waitcnt vmcnt(0)" ::: "memory");
    }
  }
  __syncthreads();
}

DI void conv_tile(const float* src, us* dst, int K, int N, const float* scale, int tile, char* smem) {
  float* t = (float*)smem;
  const int tid = tidx(), tn = N / 128, tk = tile / tn, tc = tile % tn;
  __syncthreads();
  {
    const int k = tid >> 3, c4 = (tid & 7) * 4;
    const float s = scale ? scale[tk * 32 + k] : 1.f;
    const float* sp = src + (size_t)(tk * 32 + k) * N + tc * 128 + c4;
    f32x4 v0 = *(const f32x4*)(sp), v1 = *(const f32x4*)(sp + 32), v2 = *(const f32x4*)(sp + 64), v3 = *(const f32x4*)(sp + 96);
    float* tp = t + k * 129 + c4;
#pragma unroll
    for (int q = 0; q < 4; ++q) { tp[q] = v0[q] * s; tp[32 + q] = v1[q] * s; tp[64 + q] = v2[q] * s; tp[96 + q] = v3[q] * s; }
  }
  __syncthreads();
  {
    const int n = tid >> 1, k16 = (tid & 1) * 16; float f[16];
#pragma unroll
    for (int j = 0; j < 16; ++j) f[j] = t[(k16 + j) * 129 + n];
    us* dp = dst + (size_t)(tc * 128 + n) * K + tk * 32 + k16;
    *(u32x4*)dp = pack8(f); *(u32x4*)(dp + 8) = pack8(f + 8);
  }
}
constexpr int NCONV_LAYER = 32 * 17 + 32 * 8 + 32 * 44 + 88 * 8 + 7 * 3 + 3 * 4 + 8 * 2;
DI void conv_task(const Params& p, int it, char* smem) {
  int l = it / NCONV_LAYER; it -= l * NCONV_LAYER;
  us* wb = (us*)(p.ws + OFF_WB) + (size_t)l * W_LAYER;
  int nt;
  nt = 32 * 17;  if (it < nt) { conv_tile(p.in[10] + (size_t)l * 1024 * 2176, wb + W_IN, 1024, 2176, nullptr, it, smem); return; } it -= nt;
  nt = 32 * 8;   if (it < nt) { conv_tile(p.in[31] + (size_t)l * 1024 * 1024, wb + W_OUT, 1024, 1024, nullptr, it, smem); return; } it -= nt;
  nt = 32 * 44;  if (it < nt) { conv_tile(p.in[32] + (size_t)l * 1024 * 5632, wb + W_UP, 1024, 5632, nullptr, it, smem); return; } it -= nt;
  nt = 88 * 8;   if (it < nt) { conv_tile(p.in[35] + (size_t)l * 2816 * 1024, wb + W_DN, 2816, 1024, nullptr, it, smem); return; } it -= nt;
  nt = 7 * 3;    if (it < nt) { conv_tile(p.in[28] + (size_t)l * 224 * 384, wb + W_UQ, 224, 384, p.in[27] + l * 224, it, smem); return; } it -= nt;
  nt = 3 * 4;    if (it < nt) { conv_tile(p.in[30] + (size_t)l * 96 * 512, wb + W_UKV, 96, 512, p.in[29] + l * 96, it, smem); return; } it -= nt;
  conv_tile(p.in[25] + (size_t)l * 256 * 256, wb + W_GLU, 256, 256, nullptr, it, smem);
}
DI void mod_task(const Params& p, int it, char* smem) {
  float* sc = (float*)smem;
  float* red = sc + 5 * 1024;
  const int tid = tidx(), l = it / 192, jb = it % 192;
  __syncthreads();
  for (int e = tid; e < 5 * 1024; e += 256) {
    int v = e >> 10, k = e & 1023; float c = v < 4 ? p.in[1][v * 1024 + k] : p.in[3][k];
    sc[e] = silu_(c);
  }
  __syncthreads();
  const int col = tid & 31, ks = tid >> 5;
  const float* w = p.in[4] + (size_t)l * 1024 * 6144 + jb * 32 + col;
  float a0 = 0, a1 = 0, a2 = 0, a3 = 0, a4 = 0;
#pragma unroll 8
  for (int k = ks * 128; k < ks * 128 + 128; ++k) {
    float wv = w[(size_t)k * 6144];
    a0 += sc[k] * wv; a1 += sc[1024 + k] * wv; a2 += sc[2048 + k] * wv; a3 += sc[3072 + k] * wv; a4 += sc[4096 + k] * wv;
  }
  float* rp = red + (ks * 32 + col) * 5;
  rp[0] = a0; rp[1] = a1; rp[2] = a2; rp[3] = a3; rp[4] = a4;
  __syncthreads();
  if (tid < 160) {
    int v = tid >> 5, c = tid & 31; float s = 0;
    for (int q = 0; q < 8; ++q) s += red[(q * 32 + c) * 5 + v];
    int j = jb * 32 + c;
    ((float*)(p.ws + OFF_MOD))[(size_t)(l * 5 + v) * 6144 + j] = s + p.in[5][l * 6144 + j];
  }
}
DI void s5pre_task(const Params& p, int it) {
  int gid = it * 256 + tidx();
  int pp = gid & 63, g = (gid >> 6) & 15, d = (gid >> 10) & 1, l = gid >> 11;
  int idx = ((l * 2 + d) * 16 + g) * 64 + pp;
  float are = p.in[17][idx], aim = p.in[18][idx];
  float dt = expf(p.in[19][(l * 2 + d) * 16 + g]);
  float mag = expf(are * dt), lr = mag * cosf(aim * dt), li = mag * sinf(aim * dt);
  float magT = expf(are * dt * 64.f), tr = magT * cosf(aim * dt * 64.f), ti = magT * sinf(aim * dt * 64.f);
  float nr = lr - 1.f, ni = li, den = are * are + aim * aim;
  float cr = (nr * are + ni * aim) / den, ci = (ni * are - nr * aim) / den;
  float* sf = (float*)(p.ws + OFF_S5F) + (size_t)l * S_LAYER;
  int o2 = ((d * 16 + g) * 64 + pp);
  sf[S_LAMB + o2 * 2] = lr; sf[S_LAMB + o2 * 2 + 1] = li;
  sf[S_LAMT + o2 * 2] = tr; sf[S_LAMT + o2 * 2 + 1] = ti;
  for (int i = 0; i < 16; ++i) {
    float br = p.in[20][(size_t)idx * 16 + i], bi = p.in[21][(size_t)idx * 16 + i];
    sf[S_BBAR + ((size_t)o2 * 16 + i) * 2] = cr * br - ci * bi;
    sf[S_BBAR + ((size_t)o2 * 16 + i) * 2 + 1] = cr * bi + ci * br;
    us* bm = (us*)(p.ws + OFF_WB) + (size_t)l * W_LAYER + W_BM + (size_t)(d * 16 + g) * 128 * 16;
    bm[pp * 16 + i] = f2bf(cr * br - ci * bi);
    bm[(64 + pp) * 16 + i] = f2bf(cr * bi + ci * br);
  }
  us* cm = (us*)(p.ws + OFF_WB) + (size_t)l * W_LAYER + W_CM;
  for (int o = 0; o < 16; ++o) {
    size_t ci_ = ((size_t)((l * 2 + d) * 16 + g) * 16 + o) * 64 + pp;
    cm[((size_t)(d * 16 + g) * 16 + o) * 128 + pp] = f2bf(p.in[22][ci_]);
    cm[((size_t)(d * 16 + g) * 16 + o) * 128 + 64 + pp] = f2bf(-p.in[23][ci_]);
  }
}
DI void rope_task(const Params& p, int it) {
  int gid = it * 256 + tidx();
  int pos = gid >> 3, f = gid & 7;
  float inv = powf(10000.f, -(float)f / 8.f), ang = (float)pos * inv;
  float* r = (float*)(p.ws + OFF_ROPE);
  r[gid * 2] = cosf(ang); r[gid * 2 + 1] = sinf(ang);
}
DI void wgt_task(const Params& p, int it) {
  int gid = it * 256 + tidx();
  int rr = gid & 15, c = (gid >> 4) & 255, d = (gid >> 12) & 1, l = gid >> 13;
  ((us*)(p.ws + OFF_WB))[(size_t)l * W_LAYER + W_WG + (d * 256 + c) * 16 + rr] = f2bf(p.in[14][((l * 2 + d) * 16 + rr) * 256 + c]);
}
DI void sguw_task(const Params& p, int it) {
  int gid = it * 256 + tidx();
  int l = gid >> 14, e = (gid & 16383) * 4;
  f32x4 v = *(const f32x4*)(p.in[12] + (size_t)l * 65536 + e);
  u32x2 w = {pk2(v[0], v[1]), pk2(v[2], v[3])};
  *(u32x2*)((us*)(p.ws + OFF_WB) + (size_t)l * W_LAYER + W_SGU + e) = w;
}

template <int MODE>
DI void row_task(const Params& p, int l, long m, const us* yrow) {
  const int lane = tidx() & 63, v = m < MX ? (int)(m >> 13) : 4;
  float x[16];
  if (MODE == 0) {
    const float* src = input_row(p, m);
#pragma unroll
    for (int j = 0; j < 4; ++j) { f32x4 t = *(const f32x4*)(src + (j * 64 + lane) * 4); x[4 * j] = t[0]; x[4 * j + 1] = t[1]; x[4 * j + 2] = t[2]; x[4 * j + 3] = t[3]; }
  } else {
    float y[16]; float ss = 0;
    const float* xo = (MODE == 1 && l == 0) ? input_row(p, m) : stream_row(p, m);
#pragma unroll
    for (int j = 0; j < 4; ++j) {
      u32x2 t = *(const u32x2*)(yrow + (j * 64 + lane) * 4); y[4 * j] = lo_bf(t[0]); y[4 * j + 1] = hi_bf(t[0]); y[4 * j + 2] = lo_bf(t[1]); y[4 * j + 3] = hi_bf(t[1]);
      f32x4 u = *(const f32x4*)(xo + (j * 64 + lane) * 4); x[4 * j] = u[0]; x[4 * j + 1] = u[1]; x[4 * j + 2] = u[2]; x[4 * j + 3] = u[3];
    }
#pragma unroll
    for (int j = 0; j < 16; ++j) ss += y[j] * y[j];
    ss = wave_sum(ss);
    float rstd = rsqrtf(ss * (1.f / 1024.f) + EPS);
    const float* gp = (MODE == 1 ? p.in[7] : p.in[9]) + l * 1024;
    const float* gt = modv(p, l, v, MODE == 1 ? 2 : 5);
    float* dst = stream_row(p, m);
#pragma unroll
    for (int j = 0; j < 4; ++j) {
      int c = (j * 64 + lane) * 4;
      f32x4 g4 = *(const f32x4*)(gp + c), t4 = *(const f32x4*)(gt + c), o;
#pragma unroll
      for (int q = 0; q < 4; ++q) { x[4 * j + q] += t4[q] * (y[4 * j + q] * rstd * g4[q]); o[q] = x[4 * j + q]; }
      *(f32x4*)(dst + c) = o;
    }
    if (MODE == 2 && l == 1) return;
  }
  const int ln = (MODE == 2) ? 1 : l;
  const float* g = (MODE == 1 ? p.in[8] : p.in[6]) + ln * 1024;
  const float* sh = modv(p, ln, v, MODE == 1 ? 3 : 0);
  const float* sc = modv(p, ln, v, MODE == 1 ? 4 : 1);
  float ss = 0;
#pragma unroll
  for (int j = 0; j < 16; ++j) ss += x[j] * x[j];
  ss = wave_sum(ss);
  float rstd = rsqrtf(ss * (1.f / 1024.f) + EPS);
  us* hx = (us*)(p.ws + OFF_HX) + m * 1024;
#pragma unroll
  for (int j = 0; j < 4; ++j) {
    int c = (j * 64 + lane) * 4;
    f32x4 g4 = *(const f32x4*)(g + c), s4 = *(const f32x4*)(sh + c), c4 = *(const f32x4*)(sc + c); float h[4];
#pragma unroll
    for (int q = 0; q < 4; ++q) h[q] = (x[4 * j + q] * rstd * g4[q]) * (1.f + c4[q]) + s4[q];
    u32x2 w = {pk2(h[0], h[1]), pk2(h[2], h[3])};
    *(u32x2*)(hx + c) = w;
  }
}

struct GArgs { const us* A; int lda; const us* W; int K; long m0; int n0; void* out; int ldo; int l; };
template <int BK, int EPI, bool ROWSS>
DI void gemm_tile(const Params& p, const GArgs& g, char* smem) {
  constexpr int LS = BK + 8, CPR = BK / 8, NCH = 128 * CPR / 256;
  us* sA = (us*)smem; us* sB = sA + 2 * 128 * LS; float* rstd = (float*)(sB + 2 * 128 * LS);
  const int tid = tidx(), w = tid >> 6, lane = tid & 63, r = lane & 31, hh = lane >> 5, wm = w >> 1, wn = w & 1;
  __syncthreads();
  if (ROWSS) {
    int row = tid >> 1, half = tid & 1; float ss = 0;
    const us* ap = g.A + (size_t)row * g.lda + half * (g.K / 2);
    for (int c = 0; c < g.K / 16; ++c) { float f[8]; unpack8(*(const u32x4*)(ap + c * 8), f);
#pragma unroll
      for (int j = 0; j < 8; ++j) ss += f[j] * f[j]; }
    ss += __shfl_xor(ss, 1);
    if (!half) rstd[row] = rsqrtf(ss / (float)g.K + EPS);
  }
  u32x4 ra[NCH], rb[NCH];
  f32x16 acc[2][2];
#pragma unroll
  for (int i = 0; i < 2; ++i)
#pragma unroll
    for (int j = 0; j < 2; ++j)
#pragma unroll
      for (int q = 0; q < 16; ++q) acc[i][j][q] = 0.f;
#define GLOAD(kt) _Pragma("unroll") for (int j = 0; j < NCH; ++j) { int q = tid + 256 * j, row = q / CPR, cc = q % CPR; \
    ra[j] = *(const u32x4*)(g.A + (size_t)row * g.lda + (kt) * BK + cc * 8); rb[j] = *(const u32x4*)(g.W + (size_t)row * g.K + (kt) * BK + cc * 8); }
#define SWRITE(buf) _Pragma("unroll") for (int j = 0; j < NCH; ++j) { int q = tid + 256 * j, row = q / CPR, cc = q % CPR; \
    *(u32x4*)(sA + (buf) * 128 * LS + row * LS + cc * 8) = ra[j]; *(u32x4*)(sB + (buf) * 128 * LS + row * LS + cc * 8) = rb[j]; }
  GLOAD(0); SWRITE(0); __syncthreads();
  const int KT = g.K / BK;
  for (int kt = 0; kt < KT; ++kt) {
    if (kt + 1 < KT) { GLOAD(kt + 1); }
    const us* a0 = sA + (kt & 1) * 128 * LS + (wm * 64 + r) * LS + hh * 8;
    const us* b0 = sB + (kt & 1) * 128 * LS + (wn * 64 + r) * LS + hh * 8;
#pragma unroll
    for (int ks = 0; ks < BK / 16; ++ks) {
      bf16x8 af0 = *(const bf16x8*)(a0 + ks * 16), af1 = *(const bf16x8*)(a0 + 32 * LS + ks * 16);
      bf16x8 bf0 = *(const bf16x8*)(b0 + ks * 16), bf1 = *(const bf16x8*)(b0 + 32 * LS + ks * 16);
      acc[0][0] = MFMA(af0, bf0, acc[0][0]); acc[0][1] = MFMA(af0, bf1, acc[0][1]);
      acc[1][0] = MFMA(af1, bf0, acc[1][0]); acc[1][1] = MFMA(af1, bf1, acc[1][1]);
    }
    if (kt + 1 < KT) { SWRITE((kt + 1) & 1); }
    __syncthreads();
  }
#undef GLOAD
#undef SWRITE
#pragma unroll
  for (int si = 0; si < 2; ++si)
#pragma unroll
    for (int sj = 0; sj < 2; ++sj) {
      const int col = wn * 64 + sj * 32 + r, n = g.n0 + col;
#pragma unroll
      for (int i = 0; i < 16; ++i) {
        const int row = wm * 64 + si * 32 + crow(i, hh);
        const long m = g.m0 + row;
        float v = acc[si][sj][i];
        if (EPI == 0) { ((us*)g.out)[m * g.ldo + n] = f2bf(v); }
        else if (EPI == 1) { ((float*)g.out)[m * g.ldo + n] = v; }
        else if (EPI == 2) {
          v *= rstd[row] * QSCALE;
          float pv = __shfl_xor(v, 8);
          const int head = n / 96, j = n - head * 96;
          const bool isx = m < MX; const int t = isx ? (int)(m & 8191) : (int)((m - MX) & 255);
          const int b = isx ? (int)(m >> 13) : (int)((m - MX) >> 8);
          if (isx && j >= 64) {
            int jj = (j - 64) & 15, blk = (j - 64) >> 4, f = jj & 7, pos = blk ? (t & 63) : (t >> 6);
            const float* rp = (const float*)(p.ws + OFF_ROPE) + (pos * 8 + f) * 2; float cs = rp[0], sn = rp[1];
            v = (jj < 8) ? v * cs - pv * sn : pv * sn + v * cs;
          }
          const int s = isx ? 256 + t : t;
          ((us*)(p.ws + OFF_QB))[((size_t)(b * 4 + head) * SEQ + s) * 96 + j] = f2bf(v);
        } else if (EPI == 3) {
          v *= rstd[row];
          const int head = n >> 7, j = n & 127;
          const bool isx = m < MX; const int t = isx ? (int)(m & 8191) : (int)((m - MX) & 255);
          const int b = isx ? (int)(m >> 13) : (int)((m - MX) >> 8);
          const int s = isx ? 256 + t : t;
          if (j < 64) ((us*)(p.ws + OFF_KB))[((size_t)(b * 4 + head) * SEQ + s) * 96 + j] = f2bf(v);
          else if ((i & 3) == 3) {
            const float r1 = rstd[row - 1], r2 = rstd[row - 2], r3 = rstd[row - 3];
            u32x2 w2 = {pk2(acc[si][sj][i - 3] * r3, acc[si][sj][i - 2] * r2), pk2(acc[si][sj][i - 1] * r1, v)};
            *(u32x2*)((us*)(p.ws + OFF_VT) + ((size_t)(b * 4 + head) * 64 + (j - 64)) * SEQ + s - 3) = w2;
          }
        } else if (EPI == 4) {
          float y = bf2f(((const us*)(p.ws + OFF_Y))[m * 256 + n]);
          v += p.in[26][g.l * 256 + n];
          ((us*)(p.ws + OFF_MIXIN))[m * 1024 + 512 + n] = f2bf(y * sigmoidf_(v));
        }
      }
    }
}


using f32x4_ = __attribute__((ext_vector_type(4))) float;
#define MFMA16(a, b, c) __builtin_amdgcn_mfma_f32_16x16x32_bf16((a), (b), (c), 0, 0, 0)
DI void gemm_big(const GArgs& g, int ncv, char* smem) {
  constexpr int ST = 256 * 64;
  us* sA = (us*)smem; us* sB = sA + 2 * ST;
  const int tid = tid512(), w = tid >> 6, lane = tid & 63, l16 = lane & 15, lq = lane >> 4, wm = w >> 2, wn = w & 3;
  u32x4 ra[4], rb[4];
  f32x4_ acc[8][4];
#pragma unroll
  for (int i = 0; i < 8; ++i)
#pragma unroll
    for (int j = 0; j < 4; ++j) { acc[i][j][0] = 0.f; acc[i][j][1] = 0.f; acc[i][j][2] = 0.f; acc[i][j][3] = 0.f; }
  const int srow = tid >> 3, sch = tid & 7;
  const us* gA = g.A + (size_t)srow * g.lda + sch * 8;
  const us* gB = g.W + (size_t)srow * g.K + sch * 8;
  const int swr = srow * 64 + ((sch ^ (srow & 7)) << 3);
#define GLOAD(kt) { _Pragma("unroll") for (int j = 0; j < 4; ++j) { ra[j] = *(const u32x4*)(gA + (size_t)(64 * j) * g.lda + (kt) * 64); rb[j] = *(const u32x4*)(gB + (size_t)(64 * j) * g.K + (kt) * 64); } }
#define SWRITE(buf) { _Pragma("unroll") for (int j = 0; j < 4; ++j) { *(u32x4*)(sA + (buf) * ST + swr + j * 4096) = ra[j]; *(u32x4*)(sB + (buf) * ST + swr + j * 4096) = rb[j]; } }
  const int KT = g.K / 64;
  const bool act = wn * 64 < ncv;
  const int fo0 = l16 * 64 + ((lq ^ (l16 & 7)) << 3), fo1 = l16 * 64 + (((4 + lq) ^ (l16 & 7)) << 3);
  __syncthreads();
  GLOAD(0); SWRITE(0); GLOAD(KT > 1 ? 1 : 0);
  for (int kt = 0; kt < KT; ++kt) {
    __syncthreads();
    SWRITE((kt + 1) & 1);
    { const int kl = kt + 2 < KT ? kt + 2 : KT - 1; GLOAD(kl); }
    if (act) {
      const us* a0 = sA + (kt & 1) * ST + wm * 128 * 64;
      const us* b0 = sB + (kt & 1) * ST + wn * 64 * 64;
#pragma unroll
      for (int ks = 0; ks < 2; ++ks) {
        const int fo = ks ? fo1 : fo0;
        bf16x8 fb[4];
#pragma unroll
        for (int j = 0; j < 4; ++j) fb[j] = *(const bf16x8*)(b0 + j * 1024 + fo);
#pragma unroll
        for (int i = 0; i < 8; ++i) {
          bf16x8 fa = *(const bf16x8*)(a0 + i * 1024 + fo);
#pragma unroll
          for (int j = 0; j < 4; ++j) acc[i][j] = MFMA16(fb[j], fa, acc[i][j]);
        }
      }
    }
  }
#undef GLOAD
#undef SWRITE
  __syncthreads();
  {
    us* sC = (us*)smem; constexpr int CS = 264;
    if (act) {
#pragma unroll
      for (int i = 0; i < 8; ++i)
#pragma unroll
        for (int j = 0; j < 4; ++j) {
          u32x2 w2 = {pk2(acc[i][j][0], acc[i][j][1]), pk2(acc[i][j][2], acc[i][j][3])};
          *(u32x2*)(sC + (wm * 128 + i * 16 + l16) * CS + wn * 64 + j * 16 + lq * 4) = w2;
        }
    }
    __syncthreads();
    us* outp = (us*)g.out + (size_t)g.m0 * g.ldo + g.n0;
#pragma unroll 4
    for (int k = 0; k < 16; ++k) {
      const int q = tid + 512 * k, row = q >> 5, cc = q & 31;
      if (cc * 8 < ncv) *(u32x4*)(outp + (size_t)row * g.ldo + cc * 8) = *(const u32x4*)(sC + row * CS + cc * 8);
    }
  }
}
template <class F>
DI void for_tiles_xcd(int RT, int CT, int G, int bid, F f) {
  if ((G & 7) == 0) {
    const int x = bid & 7, rows = (RT - x + 7) >> 3, n = rows * CT, nfull = CT >> 3;
    for (int j = bid >> 3; j < n; j += G >> 3) {
      int rl, ct;
      if (j < nfull * rows * 8) { int pnl = j / (rows * 8), rem = j - pnl * rows * 8; rl = rem >> 3; ct = pnl * 8 + (rem & 7); }
      else { int j2 = j - nfull * rows * 8, wd = CT - nfull * 8; rl = j2 / wd; ct = nfull * 8 + (j2 - rl * wd); }
      f(rl * 8 + x, ct);
    }
  } else {
    for (int it = bid; it < RT * CT; it += G) f(it / CT, it % CT);
  }
}

DI void kr_task(const Params& p, long m0) {
  const int tid = tidx(), row = tid >> 1, blk = tid & 1; const long m = m0 + row;
  const us* src = (const us*)(p.ws + OFF_P) + m * INC + 2144 + blk * 16;
  float v[16], o[16]; unpack8(*(const u32x4*)src, v); unpack8(*(const u32x4*)(src + 8), v + 8);
  const bool isx = m < MX; const int t = isx ? (int)(m & 8191) : (int)((m - MX) & 255);
  const int b = isx ? (int)(m >> 13) : (int)((m - MX) >> 8), s = isx ? 256 + t : t;
  if (isx) {
    int pos = blk ? (t & 63) : (t >> 6);
    const float* rp = (const float*)(p.ws + OFF_ROPE) + pos * 16;
#pragma unroll
    for (int f = 0; f < 8; ++f) { float cs = rp[2 * f], sn = rp[2 * f + 1]; o[f] = v[f] * cs - v[f + 8] * sn; o[f + 8] = v[f] * sn + v[f + 8] * cs; }
  } else {
#pragma unroll
    for (int f = 0; f < 16; ++f) o[f] = v[f];
  }
  u32x4 w0 = pack8(o), w1 = pack8(o + 8);
#pragma unroll
  for (int hd = 0; hd < 4; ++hd) {
    us* dst = (us*)(p.ws + OFF_KB) + ((size_t)(b * 4 + hd) * SEQ + s) * 96 + 64 + blk * 16;
    *(u32x4*)dst = w0; *(u32x4*)(dst + 8) = w1;
  }
}

DI void sgu_task(const Params& p, int l, int chunk, int h, char* smem) {
  us* Vt = (us*)smem;
  const int tid = tidx(), w = tid >> 6, lane = tid & 63, r = lane & 31, hh = lane >> 5;
  const long m0 = (long)chunk * 128;
  const us* P = (const us*)(p.ws + OFF_P);
  __syncthreads();
  {
    int row = tid >> 1, dh = (tid & 1) * 32; float v[32]; float ss = 0;
    const us* src = P + (m0 + row) * INC + 256 + h * 64 + dh;
#pragma unroll
    for (int c = 0; c < 4; ++c) unpack8(*(const u32x4*)(src + c * 8), v + c * 8);
#pragma unroll
    for (int j = 0; j < 32; ++j) { v[j] = gelu_t(v[j]); ss += v[j] * v[j]; }
    ss += __shfl_xor(ss, 1);
    float rstd = rsqrtf(ss * (1.f / 64.f) + EPS);
    const float* gn = p.in[11] + l * 256 + h * 64 + dh;
#pragma unroll
    for (int j = 0; j < 32; ++j) Vt[(dh + j) * 136 + row] = f2bf(v[j] * rstd * gn[j]);
  }
  __syncthreads();
  const us* Wsp = wl(p, l) + W_SGU + (size_t)h * 16384 + (size_t)(w * 32 + r) * 128 + hh * 8;
  f32x16 a0, a1;
#pragma unroll
  for (int q = 0; q < 16; ++q) { a0[q] = 0.f; a1[q] = 0.f; }
#pragma unroll
  for (int ks = 0; ks < 8; ++ks) {
    bf16x8 af = *(const bf16x8*)(Wsp + ks * 16);
    bf16x8 b0 = *(const bf16x8*)(Vt + r * 136 + ks * 16 + hh * 8), b1 = *(const bf16x8*)(Vt + (32 + r) * 136 + ks * 16 + hh * 8);
    a0 = MFMA(af, b0, a0); a1 = MFMA(af, b1, a1);
  }
  us* out = (us*)(p.ws + OFF_MIXIN);
#pragma unroll
  for (int i = 0; i < 16; ++i) {
    int t = w * 32 + crow(i, hh); float bs = p.in[13][l * 512 + h * 128 + t];
    const us* pu = P + (m0 + t) * INC + h * 64;
    float u0 = gelu_t(bf2f(pu[r])), u1 = gelu_t(bf2f(pu[32 + r]));
    out[(m0 + t) * 1024 + h * 64 + r] = f2bf(u0 * (a0[i] + bs));
    out[(m0 + t) * 1024 + h * 64 + 32 + r] = f2bf(u1 * (a1[i] + bs));
  }
}

DI void gla_gate_dir(const Params& p, int l, const us* Prow0, int h, int d, float* sW, float* G) {
  const int tid = tidx(), w = tid >> 6, lane = tid & 63, r = lane & 31, hh = lane >> 5, mt = w >> 1, nt = w & 1;
  {
    const bf16x8 a = *(const bf16x8*)(Prow0 + (size_t)(mt * 32 + r) * INC + 1536 + d * 16 + hh * 8);
    const bf16x8 bw = *(const bf16x8*)(wl(p, l) + W_WG + (size_t)(d * 256 + h * 64 + nt * 32 + r) * 16 + hh * 8);
    f32x16 z;
#pragma unroll
    for (int q = 0; q < 16; ++q) z[q] = 0.f;
    z = MFMA(a, bw, z);
    const float bg = p.in[15][l * 512 + d * 256 + h * 64 + nt * 32 + r];
#pragma unroll
    for (int i = 0; i < 16; ++i) G[(mt * 32 + crow(i, hh)) * 64 + nt * 32 + r] = logsig(z[i] + bg) * (1.f / 16.f);
  }
  __syncthreads();
  {
    const int ch = tid & 63, seg = tid >> 6;
    float v[16];
#pragma unroll
    for (int k = 0; k < 16; ++k) v[k] = G[(seg * 16 + k) * 64 + ch];
    if (d == 0) {
#pragma unroll
      for (int k = 1; k < 16; ++k) v[k] += v[k - 1];
      sW[seg * 64 + ch] = v[15];
    } else {
#pragma unroll
      for (int k = 14; k >= 0; --k) v[k] += v[k + 1];
      sW[seg * 64 + ch] = v[0];
    }
    __syncthreads();
    float off = 0.f;
    if (d == 0) { for (int q = 0; q < 3; ++q) off += (q < seg) ? sW[q * 64 + ch] : 0.f; }
    else { for (int q = 1; q < 4; ++q) off += (q > seg) ? sW[q * 64 + ch] : 0.f; }
#pragma unroll
    for (int k = 0; k < 16; ++k) G[(seg * 16 + k) * 64 + ch] = v[k] + off;
  }
  __syncthreads();
}
DI size_t gla_idx(int b, int c, int h, int d) { return (size_t)(((b * NCHK + c) * 4 + h) * 2 + d); }

DI void gla1_task(const Params& p, int l, int b, int c, int h, char* smem) {
  float* G0 = (float*)smem; float* G1 = G0 + 4096; float* sW = G1 + 4096;
  us* KeT = (us*)(sW + 1024);
  us* Vt = KeT + 2 * 64 * 72;
  const int tid = tidx(), w = tid >> 6, lane = tid & 63, r = lane & 31, hh = lane >> 5;
  const long m0 = seqrow(b, c * 64);
  const us* P0 = (const us*)(p.ws + OFF_P) + m0 * INC;
  __syncthreads();
  gla_gate_dir(p, l, P0, h, 0, sW, G0);
  gla_gate_dir(p, l, P0, h, 1, sW, G1);
  {
    int t = tid >> 2, q4 = tid & 3; float kk[16], vv[16];
    const us* sk = P0 + (size_t)t * INC + 768 + h * 64 + q4 * 16;
    const us* sv = P0 + (size_t)t * INC + 1024 + h * 64 + q4 * 16;
    unpack8(*(const u32x4*)sk, kk); unpack8(*(const u32x4*)(sk + 8), kk + 8);
    unpack8(*(const u32x4*)sv, vv); unpack8(*(const u32x4*)(sv + 8), vv + 8);
#pragma unroll
    for (int cc = 0; cc < 16; ++cc) {
      int ch = q4 * 16 + cc;
      KeT[ch * 72 + t] = f2bf(kk[cc] * __expf(G0[63 * 64 + ch] - G0[t * 64 + ch]));
      KeT[(64 + ch) * 72 + t] = f2bf(kk[cc] * __expf(G1[ch] - G1[t * 64 + ch]));
      Vt[ch * 72 + t] = f2bf(vv[cc]);
    }
    if (tid < 128) {
      int d = tid >> 6, ch = tid & 63;
      ((float*)(p.ws + OFF_DEC))[gla_idx(b, c, h, d) * 64 + ch] = __expf(d ? G1[ch] : G0[63 * 64 + ch]);
    }
  }
  __syncthreads();
  {
    const int d = w >> 1, mt = w & 1;
    float* kv = (float*)(p.ws + OFF_KV) + gla_idx(b, c, h, d) * 4096;
#pragma unroll
    for (int nt = 0; nt < 2; ++nt) {
      f32x16 acc;
#pragma unroll
      for (int q = 0; q < 16; ++q) acc[q] = 0.f;
#pragma unroll
      for (int ks = 0; ks < 4; ++ks) {
        bf16x8 a = *(const bf16x8*)(Vt + (mt * 32 + r) * 72 + ks * 16 + hh * 8);
        bf16x8 bb = *(const bf16x8*)(KeT + (d * 64 + nt * 32 + r) * 72 + ks * 16 + hh * 8);
        acc = MFMA(a, bb, acc);
      }
#pragma unroll
      for (int i = 0; i < 16; ++i) kv[(mt * 32 + crow(i, hh)) * 64 + nt * 32 + r] = acc[i];
    }
  }
}
DI int gla_order(int d, int j) { return d == 0 ? j : (j < 4 ? 3 - j : 135 - j); }
DI void gla2_task(const Params& p, int it) {
  const int gid = it * 256 + tidx();
  const int e = gid & 4095, d = (gid >> 12) & 1, h = (gid >> 13) & 3, b = gid >> 15, k = e & 63;
  float* KV = (float*)(p.ws + OFF_KV); const float* DEC = (const float*)(p.ws + OFF_DEC);
  float s = 0;
  for (int j0 = 0; j0 < NCHK; j0 += 33) {
    float kv[33], dc[33];
#pragma unroll
    for (int q = 0; q < 33; ++q) { const size_t ix = gla_idx(b, gla_order(d, j0 + q), h, d); kv[q] = KV[ix * 4096 + e]; dc[q] = DEC[ix * 64 + k]; }
#pragma unroll
    for (int q = 0; q < 33; ++q) { const size_t ix = gla_idx(b, gla_order(d, j0 + q), h, d); KV[ix * 4096 + e] = s; s = dc[q] * s + kv[q]; }
  }
}
DI void gla3_task(const Params& p, int l, int b, int c, int h, char* smem) {
  float* G = (float*)smem;
  us* Qin = (us*)(smem + 17408);
  us* Kin = Qin + 64 * 72; us* Vt = Kin + 64 * 72; us* ST = Vt + 64 * 72; us* Sc = ST + 64 * 72;
  float* sW = (float*)Sc;
  const int tid = tidx(), w = tid >> 6, lane = tid & 63, r = lane & 31, hh = lane >> 5;
  const long m0 = seqrow(b, c * 64);
  const us* P0 = (const us*)(p.ws + OFF_P) + m0 * INC;
  const int t_ = tid >> 2, q4 = tid & 3;
  __syncthreads();
  {
    float vv[16]; const us* sv = P0 + (size_t)t_ * INC + 1024 + h * 64 + q4 * 16;
    unpack8(*(const u32x4*)sv, vv); unpack8(*(const u32x4*)(sv + 8), vv + 8);
#pragma unroll
    for (int cc = 0; cc < 16; ++cc) Vt[(q4 * 16 + cc) * 72 + t_] = f2bf(vv[cc]);
  }
  f32x16 oacc;
#pragma unroll
  for (int q = 0; q < 16; ++q) oacc[q] = 0.f;
  const int mt = w >> 1, nt = w & 1;
  for (int d = 0; d < 2; ++d) {
    gla_gate_dir(p, l, P0, h, d, sW, G);
    {
      float qq[16], kk[16], qo[16], ko[16];
      const us* sq = P0 + (size_t)t_ * INC + 512 + h * 64 + q4 * 16;
      const us* sk = P0 + (size_t)t_ * INC + 768 + h * 64 + q4 * 16;
      unpack8(*(const u32x4*)sq, qq); unpack8(*(const u32x4*)(sq + 8), qq + 8);
      unpack8(*(const u32x4*)sk, kk); unpack8(*(const u32x4*)(sk + 8), kk + 8);
#pragma unroll
      for (int cc = 0; cc < 16; ++cc) { float gg = G[t_ * 64 + q4 * 16 + cc]; qo[cc] = qq[cc] * 0.125f * __expf(gg); ko[cc] = kk[cc] * __expf(-gg); }
      *(u32x4*)(Qin + t_ * 72 + q4 * 16) = pack8(qo); *(u32x4*)(Qin + t_ * 72 + q4 * 16 + 8) = pack8(qo + 8);
      *(u32x4*)(Kin + t_ * 72 + q4 * 16) = pack8(ko); *(u32x4*)(Kin + t_ * 72 + q4 * 16 + 8) = pack8(ko + 8);
      const float* ss = (const float*)(p.ws + OFF_KV) + gla_idx(b, c, h, d) * 4096 + tid * 16;
      float sf[16];
#pragma unroll
      for (int j = 0; j < 4; ++j) { f32x4 t4 = *(const f32x4*)(ss + j * 4); sf[4 * j] = t4[0]; sf[4 * j + 1] = t4[1]; sf[4 * j + 2] = t4[2]; sf[4 * j + 3] = t4[3]; }
      const int v_ = tid >> 2, k0 = (tid & 3) * 16;
      *(u32x4*)(ST + v_ * 72 + k0) = pack8(sf); *(u32x4*)(ST + v_ * 72 + k0 + 8) = pack8(sf + 8);
    }
    __syncthreads();
    {
      const int tt = mt, st = nt;
      const bool need = d == 0 ? st <= tt : st >= tt;
      f32x16 sc;
#pragma unroll
      for (int q = 0; q < 16; ++q) sc[q] = 0.f;
      if (need) {
#pragma unroll
        for (int ks = 0; ks < 4; ++ks) {
          bf16x8 a = *(const bf16x8*)(Qin + (tt * 32 + r) * 72 + ks * 16 + hh * 8);
          bf16x8 bb = *(const bf16x8*)(Kin + (st * 32 + r) * 72 + ks * 16 + hh * 8);
          sc = MFMA(a, bb, sc);
        }
      }
#pragma unroll
      for (int i = 0; i < 16; ++i) {
        int trow = tt * 32 + crow(i, hh), scol = st * 32 + r;
        bool keep = d == 0 ? scol <= trow : scol >= trow;
        Sc[trow * 72 + scol] = f2bf(keep ? sc[i] : 0.f);
      }
    }
    __syncthreads();
#pragma unroll
    for (int ks = 0; ks < 4; ++ks) {
      bf16x8 a = *(const bf16x8*)(Sc + (mt * 32 + r) * 72 + ks * 16 + hh * 8);
      bf16x8 bb = *(const bf16x8*)(Vt + (nt * 32 + r) * 72 + ks * 16 + hh * 8);
      oacc = MFMA(a, bb, oacc);
    }
#pragma unroll
    for (int ks = 0; ks < 4; ++ks) {
      bf16x8 a = *(const bf16x8*)(Qin + (mt * 32 + r) * 72 + ks * 16 + hh * 8);
      bf16x8 bb = *(const bf16x8*)(ST + (nt * 32 + r) * 72 + ks * 16 + hh * 8);
      oacc = MFMA(a, bb, oacc);
    }
    __syncthreads();
  }
  float* Ob = (float*)smem;
#pragma unroll
  for (int i = 0; i < 16; ++i) Ob[(mt * 32 + crow(i, hh)) * 68 + nt * 32 + r] = oacc[i];
  __syncthreads();
  {
    float o[16], rr[16]; float ss = 0;
#pragma unroll
    for (int cc = 0; cc < 16; ++cc) { o[cc] = Ob[t_ * 68 + q4 * 16 + cc]; ss += o[cc] * o[cc]; }
    ss += __shfl_xor(ss, 1); ss += __shfl_xor(ss, 2);
    float rstd = rsqrtf(ss * (1.f / 64.f) + EPS);
    const us* sr = P0 + (size_t)t_ * INC + 1280 + h * 64 + q4 * 16;
    unpack8(*(const u32x4*)sr, rr); unpack8(*(const u32x4*)(sr + 8), rr + 8);
    const float* gn = p.in[16] + l * 256 + h * 64 + q4 * 16;
#pragma unroll
    for (int cc = 0; cc < 16; ++cc) o[cc] = o[cc] * rstd * gn[cc] * silu_(rr[cc]);
    us* dst = (us*)(p.ws + OFF_MIXIN) + (m0 + t_) * 1024 + 256 + h * 64 + q4 * 16;
    *(u32x4*)dst = pack8(o); *(u32x4*)(dst + 8) = pack8(o + 8);
  }
}

DI size_t hl_idx(int b, int c, int d, int g, int pp) { return ((size_t)(((b * NCHK + c) * 2 + d) * 16 + g) * 64 + pp) * 2; }
template <bool OUT>
DI void s5_task(const Params& p, int l, int b, int c, int gp, char* smem) {
  us* Hb = (us*)smem;
  float* Yb = (float*)(smem + 4 * 32 * 136 * 2);
  const int tid = tidx(), w = tid >> 6, lane = tid & 63, r = lane & 31, hh = lane >> 5;
  const long m0 = seqrow(b, c * 64);
  const us* P0 = (const us*)(p.ws + OFF_P) + m0 * INC;
  const int gl = w >> 1, d = w & 1, g = gp * 2 + gl, pp = lane;
  const float* sf = s5f(p, l);
  const float lr = sf[S_LAMB + ((d * 16 + g) * 64 + pp) * 2], li = sf[S_LAMB + ((d * 16 + g) * 64 + pp) * 2 + 1];
  const f32x2_ la = {lr, lr}, lb = {-li, li};
  float hr = 0.f, hi = 0.f;
  float* HL = (float*)(p.ws + OFF_HL) + hl_idx(b, c, d, g, pp);
  if (OUT) { hr = HL[0]; hi = HL[1]; }
  const us* cm = wl(p, l) + W_CM + ((size_t)(d * 16 + g) * 16 + (r & 15)) * 128 + hh * 8;
  const us* bm = wl(p, l) + W_BM + ((size_t)(d * 16 + g) * 128 + r) * 16 + hh * 8;
  us* hb = Hb + w * 32 * 136;
  __syncthreads();
  for (int half = 0; half < 2; ++half) {
    const int tbase = d ? (1 - half) * 32 : half * 32;
    {
      const bf16x8 a = *(const bf16x8*)(P0 + (size_t)(tbase + r) * INC + 1568 + g * 16 + hh * 8);
#pragma unroll
      for (int nt = 0; nt < 4; ++nt) {
        const bf16x8 bb = *(const bf16x8*)(bm + nt * 32 * 16);
        f32x16 z;
#pragma unroll
        for (int q = 0; q < 16; ++q) z[q] = 0.f;
        z = MFMA(a, bb, z);
#pragma unroll
        for (int i = 0; i < 16; ++i) hb[crow(i, hh) * 136 + nt * 32 + r] = f2bf(z[i]);
      }
    }
    __syncthreads();
    for (int jj = 0; jj < 32; ++jj) {
      const int tl = d ? 31 - jj : jj;
      const f32x2_ bu = {bf2f(hb[tl * 136 + pp]), bf2f(hb[tl * 136 + 64 + pp])};
      { f32x2_ h = {hr, hi}, hs = {hi, hr}; f32x2_ nh = la * h + lb * hs + bu; hr = nh[0]; hi = nh[1]; }
      if (OUT) { hb[tl * 136 + pp] = f2bf(hr); hb[tl * 136 + 64 + pp] = f2bf(hi); }
    }
    if (OUT) {
      __syncthreads();
      f32x16 acc;
#pragma unroll
      for (int q = 0; q < 16; ++q) acc[q] = 0.f;
#pragma unroll
      for (int ks = 0; ks < 8; ++ks) {
        bf16x8 a = *(const bf16x8*)(hb + r * 136 + ks * 16 + hh * 8);
        bf16x8 bb = *(const bf16x8*)(cm + ks * 16);
        if (r >= 16) bb = (bf16x8){0, 0, 0, 0, 0, 0, 0, 0};
        acc = MFMA(a, bb, acc);
      }
      if (r < 16) {
#pragma unroll
        for (int i = 0; i < 16; ++i) Yb[(w * 64 + tbase + crow(i, hh)) * 17 + r] = acc[i];
      }
    }
    __syncthreads();
  }
  if (!OUT) { HL[0] = hr; HL[1] = hi; return; }
  {
    const int gl2 = tid >> 7, t = (tid >> 1) & 63, o8 = (tid & 1) * 8, g2 = gp * 2 + gl2; float y[8], u8[8];
    unpack8(*(const u32x4*)(P0 + (size_t)t * INC + 1568 + g2 * 16 + o8), u8);
#pragma unroll
    for (int o = 0; o < 8; ++o) {
      float v = Yb[((gl2 * 2 + 0) * 64 + t) * 17 + o8 + o] + Yb[((gl2 * 2 + 1) * 64 + t) * 17 + o8 + o]
              + p.in[24][l * 256 + g2 * 16 + o8 + o] * u8[o];
      y[o] = gelu_t(v);
    }
    *(u32x4*)((us*)(p.ws + OFF_Y) + (m0 + t) * 256 + g2 * 16 + o8) = pack8(y);
  }
}
DI void s5b_task(const Params& p, int l, int it) {
  const int gid = it * 256 + tidx();
  const int pp = gid & 63, g = (gid >> 6) & 15, d = (gid >> 10) & 1, b = gid >> 11;
  const float* sf = s5f(p, l);
  const float tr = sf[S_LAMT + ((d * 16 + g) * 64 + pp) * 2], ti = sf[S_LAMT + ((d * 16 + g) * 64 + pp) * 2 + 1];
  float* HL = (float*)(p.ws + OFF_HL);
  float hr = 0.f, hi = 0.f;
  for (int j0 = 0; j0 < NCHK; j0 += 33) {
    f32x2_ xv[33];
#pragma unroll
    for (int q = 0; q < 33; ++q) xv[q] = *(const f32x2_*)(HL + hl_idx(b, gla_order(d, j0 + q), d, g, pp));
#pragma unroll
    for (int q = 0; q < 33; ++q) {
      f32x2_ o = {hr, hi};
      *(f32x2_*)(HL + hl_idx(b, gla_order(d, j0 + q), d, g, pp)) = o;
      float nr = tr * hr - ti * hi + xv[q][0], ni = tr * hi + ti * hr + xv[q][1]; hr = nr; hi = ni;
    }
  }
}

DI void attn_task(const Params& p, int b, int h, int qs0, int nkeys, char* smem) {
  constexpr int KSZ = 64 * 104, VSZ = 64 * 68;
  us* sK = (us*)smem;
  us* sV = sK + 3 * KSZ;
  const int tid = tid512(), w = tid >> 6, lane = tid & 63, r = lane & 31, hh = lane >> 5;
  const us* Kg = (const us*)(p.ws + OFF_KB) + (size_t)(b * 4 + h) * SEQ * 96;
  const us* Vg = (const us*)(p.ws + OFF_VT) + (size_t)(b * 4 + h) * 64 * SEQ;
  const us* Qg = (const us*)(p.ws + OFF_QB) + ((size_t)(b * 4 + h) * SEQ + qs0 + w * 32 + r) * 96 + hh * 8;
  bf16x8 qf[6];
#pragma unroll
  for (int ks = 0; ks < 6; ++ks) qf[ks] = *(const bf16x8*)(Qg + ks * 16);
  u32x4 rk[2], rv;
  const int kq1 = tid + 512 < 768 ? tid + 512 : tid;
  const int vrow = tid >> 3, vcc = tid & 7;
  const int kw0 = (tid / 12) * 104 + (tid % 12) * 8, kw1 = (kq1 / 12) * 104 + (kq1 % 12) * 8, vw = vrow * 68 + vcc * 8;
#define AGLOAD(kt) { rk[0] = *(const u32x4*)(Kg + (size_t)(kt) * 64 * 96 + tid * 8); rk[1] = *(const u32x4*)(Kg + (size_t)(kt) * 64 * 96 + kq1 * 8); \
    rv = *(const u32x4*)(Vg + (size_t)vrow * SEQ + (kt) * 64 + vcc * 8); }
#define ASWRITE(buf) { *(u32x4*)(sK + (buf) * KSZ + kw0) = rk[0]; *(u32x4*)(sK + (buf) * KSZ + kw1) = rk[1]; \
    us* dv = sV + (buf) * VSZ + vw; u32x2 lo = {rv[0], rv[1]}, hi2 = {rv[2], rv[3]}; *(u32x2*)dv = lo; *(u32x2*)(dv + 4) = hi2; }
  f32x16 o0, o1, negm, sc0, sc1;
#pragma unroll
  for (int q = 0; q < 16; ++q) { o0[q] = 0.f; o1[q] = 0.f; sc0[q] = 0.f; sc1[q] = 0.f; }
  float lsum = 0.f;
  const int NT = nkeys / 64;
  __syncthreads();
  AGLOAD(0); ASWRITE(0); AGLOAD(1); ASWRITE(1); AGLOAD(2);
  __syncthreads();
  {
    const us* k0 = sK + r * 104 + hh * 8;
#pragma unroll
    for (int ks = 0; ks < 6; ++ks) {
      bf16x8 a0 = *(const bf16x8*)(k0 + ks * 16), a1 = *(const bf16x8*)(k0 + 32 * 104 + ks * 16);
      sc0 = MFMA(a0, qf[ks], sc0); sc1 = MFMA(a1, qf[ks], sc1);
    }
    float mx = sc0[0];
#pragma unroll
    for (int i = 1; i < 16; ++i) mx = fmaxf(mx, sc0[i]);
#pragma unroll
    for (int i = 0; i < 16; ++i) mx = fmaxf(mx, sc1[i]);
    mx = fmaxf(mx, __shfl_xor(mx, 32));
#pragma unroll
    for (int q = 0; q < 16; ++q) { negm[q] = -mx; sc0[q] -= mx; sc1[q] -= mx; }
  }
  int bc = 0, bn = 1, bw = 2;
  for (int kt = 0; kt < NT; ++kt) {
    __syncthreads();
    ASWRITE(bw);
    { const int kl = kt + 3 < NT ? kt + 3 : NT - 1; AGLOAD(kl); }
    float mx = sc0[0];
#pragma unroll
    for (int i = 1; i < 16; ++i) mx = fmaxf(mx, sc0[i]);
#pragma unroll
    for (int i = 0; i < 16; ++i) mx = fmaxf(mx, sc1[i]);
    mx = fmaxf(mx, __shfl_xor(mx, 32));
    if (__builtin_amdgcn_ballot_w64(mx > 8.f)) {
      const float dl = fmaxf(mx, 0.f), alpha = __builtin_amdgcn_exp2f(-dl);
#pragma unroll
      for (int i = 0; i < 16; ++i) { o0[i] *= alpha; o1[i] *= alpha; sc0[i] -= dl; sc1[i] -= dl; negm[i] -= dl; }
      lsum *= alpha;
    }
    f32x16 sn0, sn1;
    {
      const us* k0 = sK + bn * KSZ + r * 104 + hh * 8;
      {
        bf16x8 a0 = *(const bf16x8*)(k0), a1 = *(const bf16x8*)(k0 + 32 * 104);
        sn0 = MFMA(a0, qf[0], negm); sn1 = MFMA(a1, qf[0], negm);
      }
#pragma unroll
      for (int ks = 1; ks < 6; ++ks) {
        bf16x8 a0 = *(const bf16x8*)(k0 + ks * 16), a1 = *(const bf16x8*)(k0 + 32 * 104 + ks * 16);
        sn0 = MFMA(a0, qf[ks], sn0); sn1 = MFMA(a1, qf[ks], sn1);
      }
    }
    float ps = 0.f;
#pragma unroll
    for (int i = 0; i < 16; ++i) { sc0[i] = __builtin_amdgcn_exp2f(sc0[i]); ps += sc0[i]; }
#pragma unroll
    for (int i = 0; i < 16; ++i) { sc1[i] = __builtin_amdgcn_exp2f(sc1[i]); ps += sc1[i]; }
    lsum += ps;
    bf16x8 pf[4];
    {
      u32x4 t0 = {pk2(sc0[0], sc0[1]), pk2(sc0[2], sc0[3]), pk2(sc0[4], sc0[5]), pk2(sc0[6], sc0[7])};
      u32x4 t1 = {pk2(sc0[8], sc0[9]), pk2(sc0[10], sc0[11]), pk2(sc0[12], sc0[13]), pk2(sc0[14], sc0[15])};
      u32x4 t2 = {pk2(sc1[0], sc1[1]), pk2(sc1[2], sc1[3]), pk2(sc1[4], sc1[5]), pk2(sc1[6], sc1[7])};
      u32x4 t3 = {pk2(sc1[8], sc1[9]), pk2(sc1[10], sc1[11]), pk2(sc1[12], sc1[13]), pk2(sc1[14], sc1[15])};
      pf[0] = __builtin_bit_cast(bf16x8, t0); pf[1] = __builtin_bit_cast(bf16x8, t1);
      pf[2] = __builtin_bit_cast(bf16x8, t2); pf[3] = __builtin_bit_cast(bf16x8, t3);
    }
    {
      const us* v0 = sV + bc * VSZ + r * 68 + 4 * hh;
#pragma unroll
      for (int kk = 0; kk < 4; ++kk) {
        u32x2 l0 = *(const u32x2*)(v0 + 16 * kk), h0 = *(const u32x2*)(v0 + 16 * kk + 8);
        u32x2 l1 = *(const u32x2*)(v0 + 32 * 68 + 16 * kk), h1 = *(const u32x2*)(v0 + 32 * 68 + 16 * kk + 8);
        u32x4 a0 = {l0[0], l0[1], h0[0], h0[1]}, a1 = {l1[0], l1[1], h1[0], h1[1]};
        o0 = MFMA(__builtin_bit_cast(bf16x8, a0), pf[kk], o0);
        o1 = MFMA(__builtin_bit_cast(bf16x8, a1), pf[kk], o1);
      }
    }
    sc0 = sn0; sc1 = sn1;
    { const int t = bc; bc = bn; bn = bw; bw = t; }
  }
#undef AGLOAD
#undef ASWRITE
  lsum += __shfl_xor(lsum, 32);
  const float inv = 1.f / lsum;
  const long m = seqrow(b, qs0 + w * 32 + r);
  us* dst = (us*)(p.ws + OFF_MIXIN) + m * 1024 + 768 + h * 64;
#pragma unroll
  for (int gq = 0; gq < 4; ++gq) {
    u32x2 w0 = {pk2(o0[4 * gq] * inv, o0[4 * gq + 1] * inv), pk2(o0[4 * gq + 2] * inv, o0[4 * gq + 3] * inv)};
    u32x2 w1 = {pk2(o1[4 * gq] * inv, o1[4 * gq + 1] * inv), pk2(o1[4 * gq + 2] * inv, o1[4 * gq + 3] * inv)};
    *(u32x2*)(dst + 8 * gq + 4 * hh) = w0;
    *(u32x2*)(dst + 32 + 8 * gq + 4 * hh) = w1;
  }
}

DI void convact_task(const Params& p, int l, int it, int nrows) {
  const int T = it * 256 + tidx();
  if (T >= (nrows / 8) * 352) return;
  const int rb = T / 352, oct = T - rb * 352, c0 = oct * 8, i0 = rb * 8;
  const int slo = i0 < 8192 ? 0 : 8192, shi = i0 < 8192 ? 8192 : 8448;
  const us* Z = (const us*)(p.ws + OFF_ZPRE);
  const float* cw = p.in[33] + (size_t)l * 3 * DFF2; const float* cb = p.in[34] + (size_t)l * DFF2;
  float wa[3][8], wg[3][8], ba[8], bg[8];
#pragma unroll
  for (int j = 0; j < 3; ++j) {
    f32x4 a0 = *(const f32x4*)(cw + j * DFF2 + c0), a1 = *(const f32x4*)(cw + j * DFF2 + c0 + 4);
    f32x4 g0 = *(const f32x4*)(cw + j * DFF2 + DFF + c0), g1 = *(const f32x4*)(cw + j * DFF2 + DFF + c0 + 4);
#pragma unroll
    for (int q = 0; q < 4; ++q) { wa[j][q] = a0[q]; wa[j][4 + q] = a1[q]; wg[j][q] = g0[q]; wg[j][4 + q] = g1[q]; }
  }
  {
    f32x4 a0 = *(const f32x4*)(cb + c0), a1 = *(const f32x4*)(cb + c0 + 4), g0 = *(const f32x4*)(cb + DFF + c0), g1 = *(const f32x4*)(cb + DFF + c0 + 4);
#pragma unroll
    for (int q = 0; q < 4; ++q) { ba[q] = a0[q]; ba[4 + q] = a1[q]; bg[q] = g0[q]; bg[4 + q] = g1[q]; }
  }
  u32x4 ra_[10], rg_[10];
#pragma unroll
  for (int k = 0; k < 10; ++k) {
    const int i = i0 - 1 + k;
    if (i >= slo && i < shi) { ra_[k] = *(const u32x4*)(Z + (size_t)i * DFF2 + c0); rg_[k] = *(const u32x4*)(Z + (size_t)i * DFF2 + DFF + c0); }
    else { ra_[k] = (u32x4){0u, 0u, 0u, 0u}; rg_[k] = (u32x4){0u, 0u, 0u, 0u}; }
  }
  us* A = (us*)(p.ws + OFF_ACT);
  float za[3][8], zg[3][8];
  unpack8(ra_[0], za[0]); unpack8(rg_[0], zg[0]); unpack8(ra_[1], za[1]); unpack8(rg_[1], zg[1]);
#pragma unroll
  for (int ii = 0; ii < 8; ++ii) {
    const int i = i0 + ii;
    unpack8(ra_[ii + 2], za[2]); unpack8(rg_[ii + 2], zg[2]);
    float o[8];
#pragma unroll
    for (int q = 0; q < 8; ++q) {
      float a = ba[q] + wa[0][q] * za[0][q] + wa[1][q] * za[1][q] + wa[2][q] * za[2][q];
      float gg = bg[q] + wg[0][q] * zg[0][q] + wg[1][q] * zg[1][q] + wg[2][q] * zg[2][q];
      o[q] = gelu_t(a) * gg;
    }
    *(u32x4*)(A + (size_t)i * DFF + c0) = pack8(o);
#pragma unroll
    for (int q = 0; q < 8; ++q) { za[0][q] = za[1][q]; za[1][q] = za[2][q]; zg[0][q] = zg[1][q]; zg[1][q] = zg[2][q]; }
  }
}

constexpr int SCHED_WORDS = 1024;
DI int gl_n(int RT, int CT, int x) { return ((RT - x + 7) >> 3) * CT; }
DI void gl_tile(int RT, int CT, int x, int j, int& rt, int& ct) {
  const int rows = (RT - x + 7) >> 3, nfull = CT >> 3; int rl;
  if (j < nfull * rows * 8) { int pnl = j / (rows * 8), rem = j - pnl * rows * 8; rl = rem >> 3; ct = pnl * 8 + (rem & 7); }
  else { int j2 = j - nfull * rows * 8, wd = CT - nfull * 8; rl = j2 / wd; ct = nfull * 8 + (j2 - rl * wd); }
  rt = rl * 8 + x;
}
DI int ml_n(int n, int x) { return (n - x + 7) >> 3; }
template <class NX, class RUN>
DI void run_phase(unsigned*& ctr, int G, int bid, volatile int* s_bc, NX nx, RUN run) {
  const int x0 = bid & 7, per = G >> 3;
  const int x = x0; int j = bid >> 3;
  for (;;) {
    if (j < nx(x)) {
      int nj = 0;
      if (threadIdx.x == 0) nj = per + (int)atomicAdd(&ctr[x], 1u);
      run(x, j);
      __syncthreads();
      if (threadIdx.x == 0) *s_bc = nj;
      __syncthreads();
      j = *s_bc;
    } else break;
  }
  ctr += 8;
}

DI long chunk_row(int ch, int i) { return i < 8192 ? (long)ch * 8192 + i : (long)MX + ch * 256 + (i - 8192); }


template <class RUN>
DI void run_tiles(unsigned*& ctr, int n, int G, int bid, volatile int* s_bc, RUN run) {
  int it = bid;
  while (it < n) {
    int nx = 0;
    if (threadIdx.x == 0) nx = G + (int)atomicAdd(ctr, 1u);
    run(it);
    __syncthreads();
    if (threadIdx.x == 0) *s_bc = nx;
    __syncthreads();
    it = *s_bc;
  }
  ctr += 1;
}

constexpr int HLDS = 64512;
constexpr int LDS_BYTES = 147456;
static_assert(2 * HLDS <= LDS_BYTES, "lds");

__global__ void __launch_bounds__(512) fwd_mega(Params p) {
  cg::grid_group grid = cg::this_grid();
  extern __shared__ __attribute__((aligned(16))) char dsm[];
  __shared__ uint4 xb_words;
  const int G = gridDim.x, bid = blockIdx.x, wv8 = __builtin_amdgcn_readfirstlane(threadIdx.x >> 6), half = wv8 >> 2;
  char* smem = dsm + half * HLDS;
  const int vb = bid * 2 + half, V = 2 * G;
  if (threadIdx.x == 0) xb_words = make_uint4(0u, 0u, 0u, 0u);
  __syncthreads();
  const XcdBarrier xb = xcd_barrier_post((unsigned*)(p.ws + OFF_BAR), (volatile LAS unsigned*)&xb_words);
#define HALF_LOOP(n, IT, ...) { const int n_ = (n); const int iters_ = (n_ + V - 1) / V; for (int k_ = 0; k_ < iters_; ++k_) { int IT = vb + k_ * V; IT = IT < n_ ? IT : n_ - 1; __VA_ARGS__ } }
#define HALF_LOOP_NB(n, IT, ...) { const int n_ = (n); for (int IT = vb; IT < n_; IT += V) { __VA_ARGS__ } }

  HALF_LOOP(2 * NCONV_LAYER, it, conv_task(p, it, smem);)
  HALF_LOOP(384, it, mod_task(p, it, smem);)
  HALF_LOOP_NB(16, it, s5pre_task(p, it);)
  HALF_LOOP_NB(4, it, rope_task(p, it);)
  HALF_LOOP_NB(128, it, sguw_task(p, it);)
  HALF_LOOP_NB(64, it, wgt_task(p, it);)
  grid.sync();
  for (int it = bid; it < MT / 8; it += G) row_task<0>(p, 0, (long)it * 8 + wv8, nullptr);
  xcd_barrier(xb);

  unsigned* ctr = (unsigned*)(p.ws + OFF_SCHED);
  volatile int* s_bc = (volatile int*)&xb_words.z;
  for (int l = 0; l < 2; ++l) {
    const us* W = wl(p, l);
    const int RT = l == 0 ? 264 : 256;
    run_tiles(ctr, 132 * 9, G, bid, s_bc, [&](int it) {
      const int rt = it / 9, ct = it - rt * 9;
      GArgs g{(const us*)(p.ws + OFF_HX) + (size_t)rt * 256 * D, D, W + W_IN + (size_t)ct * 256 * D, D, (long)rt * 256, ct * 256, p.ws + OFF_P, INC, l};
      for (int rp = 0; rp < REP_GEMM; ++rp) gemm_big(g, ct == 8 ? 128 : 256, dsm);
    });
    xcd_barrier(xb);
    {
      const int p0 = (4 * NCHK * 8) >> 1, p1 = p0 + ((4 * NCHK * 4) >> 1), p2 = p1 + ((RT * 4) >> 1), p3 = p2 + ((264 * 3) >> 1), p4 = p3 + ((264 * 4) >> 1);
      for (int P = bid; P < p4; P += G) {
        if (P < p0) { const int q = 2 * P + half; s5_task<false>(p, l, q / (NCHK * 8), (q / 8) % NCHK, q & 7, smem); }
        else if (P < p1) { const int q = 2 * (P - p0) + half; gla1_task(p, l, q / (NCHK * 4), (q / 4) % NCHK, q & 3, smem); }
        else if (P < p2) { const int q = 2 * (P - p1) + half; sgu_task(p, l, q >> 2, q & 3, smem); }
        else if (P < p3) { const int q = 2 * (P - p2) + half, rt = q / 3, ct = q % 3;
          GArgs g{(const us*)(p.ws + OFF_P) + (size_t)rt * 128 * INC + 1824, INC, W + W_UQ + (size_t)ct * 128 * 224, 224, (long)rt * 128, ct * 128, nullptr, 0, l};
          gemm_tile<32, 2, true>(p, g, smem); }
        else { const int q = 2 * (P - p3) + half, rt = q >> 2, ct = q & 3;
          GArgs g{(const us*)(p.ws + OFF_P) + (size_t)rt * 128 * INC + 2048, INC, W + W_UKV + (size_t)ct * 128 * 96, 96, (long)rt * 128, ct * 128, nullptr, 0, l};
          gemm_tile<32, 3, true>(p, g, smem);
          if (ct == 0) kr_task(p, (long)rt * 128); }
      }
    }
    xcd_barrier(xb);
    HALF_LOOP_NB(512, it, gla2_task(p, it);)
    HALF_LOOP_NB(32, it, s5b_task(p, l, it);)
    xcd_barrier(xb);
    if ((G & 7) == 0) {
      const int x = bid & 7;
      for (int j = bid >> 3; j < 64; j += G >> 3) { int pair = 2 * x + (j >> 5), qb = j & 31; for (int rp = 0; rp < REP_ATT; ++rp) attn_task(p, pair >> 2, pair & 3, 256 + qb * 256, SEQ, dsm); }
    } else {
      for (int it = bid; it < 512; it += G) attn_task(p, it >> 7, (it >> 5) & 3, 256 + (it & 31) * 256, SEQ, dsm);
    }
    if (l == 0) for (int it = bid; it < 16; it += G) attn_task(p, it >> 2, it & 3, 0, 256, dsm);
    {
      const int c0 = l == 0 ? 0 : 4, nc = NCHK - c0;
      const int p0 = (4 * nc * 8) >> 1, p1 = p0 + ((4 * nc * 4) >> 1);
      for (int P = bid; P < p1; P += G) {
        if (P < p0) { const int q = 2 * P + half; s5_task<true>(p, l, q / (nc * 8), c0 + (q / 8) % nc, q & 7, smem); }
        else { const int q = 2 * (P - p0) + half; gla3_task(p, l, q / (nc * 4), c0 + (q / 4) % nc, q & 3, smem); }
      }
    }
    xcd_barrier(xb);
    HALF_LOOP(RT * 2, it, { int rt = it >> 1, ct = it & 1;
      GArgs g{(const us*)(p.ws + OFF_Y) + (size_t)rt * 128 * 256, 256, W + W_GLU + (size_t)ct * 128 * 256, 256, (long)rt * 128, ct * 128, nullptr, 0, l};
      gemm_tile<32, 4, false>(p, g, smem); })
    xcd_barrier(xb);
    run_tiles(ctr, (RT / 2) * 4, G, bid, s_bc, [&](int it) {
      const int rt = it >> 2, ct = it & 3;
      GArgs g{(const us*)(p.ws + OFF_MIXIN) + (size_t)rt * 256 * D, D, W + W_OUT + (size_t)ct * 256 * D, D, (long)rt * 256, ct * 256, p.ws + OFF_MIXOUT, D, l};
      for (int rp = 0; rp < REP_GEMM; ++rp) gemm_big(g, 256, dsm);
    });
    xcd_barrier(xb);
    for (int it = bid; it < RT * 16; it += G) { long m = (long)it * 8 + wv8; row_task<1>(p, l, m, (const us*)(p.ws + OFF_MIXOUT) + m * 1024); }
    xcd_barrier(xb);
    const int CR2 = l == 0 ? 33 : 32, CROWS = CR2 * 256, NF2 = (CROWS / 8 * 352 + 255) / 256;
    for (int ch = 0; ch <= 4; ++ch) {
      {
        const bool hasF3 = ch > 0, hasF1 = ch < 4;
        const int n3 = hasF3 ? CR2 * 4 : 0, n1 = hasF1 ? CR2 * 22 : 0;
        run_tiles(ctr, n3 + n1, G, bid, s_bc, [&](int it) {
          if (it < n3) {
            const int rt = it >> 2, ct = it & 3;
            GArgs g{(const us*)(p.ws + OFF_ACT) + (size_t)rt * 256 * DFF, DFF, W + W_DN + (size_t)ct * 256 * DFF, DFF, (long)rt * 256, ct * 256, p.ws + OFF_FFNOUT, D, l};
            for (int rp = 0; rp < REP_GEMM; ++rp) gemm_big(g, 256, dsm);
          } else {
            const int q = it - n3, rt = q / 22, ct = q - rt * 22;
            GArgs g{(const us*)(p.ws + OFF_HX) + (size_t)chunk_row(ch, rt * 256) * D, D, W + W_UP + (size_t)ct * 256 * D, D, (long)rt * 256, ct * 256, p.ws + OFF_ZPRE, DFF2, l};
            for (int rp = 0; rp < REP_GEMM; ++rp) gemm_big(g, 256, dsm);
          }
        });
      }
      xcd_barrier(xb);
      if (ch < 4) HALF_LOOP_NB(NF2, it, convact_task(p, l, it, CROWS);)
      if (ch > 0) for (int it = bid; it < CROWS / 8; it += G) { int i = it * 8 + wv8; row_task<2>(p, l, chunk_row(ch - 1, i), (const us*)(p.ws + OFF_FFNOUT) + (size_t)i * 1024); }
      xcd_barrier(xb);
    }
  }
#undef HALF_LOOP
#undef HALF_LOOP_NB
}

extern "C" void kernel_launch(void* const* d_in, const int* in_sizes, int n_in, void* d_out, int out_size,
                              void* d_ws, size_t ws_size, hipStream_t stream) {
  static int grid_blocks = 0;
  if (!grid_blocks) {
    int dev = 0, cus = 0, per_cu = 0;
    (void)hipGetDevice(&dev);
    (void)hipDeviceGetAttribute(&cus, hipDeviceAttributeMultiprocessorCount, dev);
    if (hipFuncSetAttribute((const void*)fwd_mega, hipFuncAttributeMaxDynamicSharedMemorySize, LDS_BYTES) != hipSuccess)
      fprintf(stderr, "kernel_launch: hipFuncSetAttribute(%d B LDS) failed\n", LDS_BYTES);
    (void)hipOccupancyMaxActiveBlocksPerMultiprocessor(&per_cu, fwd_mega, 512, LDS_BYTES);
    if (per_cu < 1) fprintf(stderr, "kernel_launch: occupancy query returned %d\n", per_cu);
    grid_blocks = cus;
    if (ws_size < OFF_END) fprintf(stderr, "kernel_launch: ws too small: %zu < %zu\n", ws_size, (size_t)OFF_END);
  }
  if (n_in != 36 || ws_size < OFF_END) return;
  Params p{};
  for (int i = 0; i < 36; ++i) p.in[i] = (const float*)d_in[i];
  p.out = (float*)d_out; p.ws = (char*)d_ws;
  void* args[] = {&p};
  (void)hipMemsetAsync((char*)d_ws + OFF_BAR, 0, (XCD_BAR_WORDS + SCHED_WORDS) * 4, stream);
  hipError_t e = hipLaunchCooperativeKernel((void*)fwd_mega, dim3(grid_blocks), dim3(512), args, LDS_BYTES, stream);
  if (e != hipSuccess) fprintf(stderr, "cooperative launch failed: %s (grid %d)\n", hipGetErrorString(e), grid_blocks);
}
```

```cpp
#include <hip/hip_runtime.h>
#include <hip/hip_cooperative_groups.h>
#include <cstdio>
#include <cstdint>
namespace cg = cooperative_groups;

typedef unsigned short us;
using bf16x8 = __attribute__((ext_vector_type(8))) short;
using f32x16 = __attribute__((ext_vector_type(16))) float;
using f32x4  = __attribute__((ext_vector_type(4))) float;
using u32x4  = __attribute__((ext_vector_type(4))) unsigned;
using u32x2  = __attribute__((ext_vector_type(2))) unsigned;
#define DI __device__ __forceinline__
#define MFMA(a, b, c) __builtin_amdgcn_mfma_f32_32x32x16_bf16((a), (b), (c), 0, 0, 0)

#ifndef REP_F3N
#define REP_F3N 1
#endif
#ifndef REP_F1N
#define REP_F1N 1
#endif
#ifndef REP_GEMM
#define REP_GEMM 1
#endif
#ifndef REP_M1
#define REP_M1 1
#endif
#ifndef REP_M3
#define REP_M3 1
#endif
#ifndef REP_ATT
#define REP_ATT 1
#endif
#ifndef REP_GLA3
#define REP_GLA3 1
#endif
#ifndef REP_S5C
#define REP_S5C 1
#endif
#ifndef REP_F2
#define REP_F2 1
#endif
#ifndef REP_P0
#define REP_P0 1
#endif
#ifndef EXTRA_SYNC
#define EXTRA_SYNC 0
#endif
constexpr int D = 1024, MX = 32768, MC = 1024, MT = MX + MC, INC = 2176, DFF = 2816, DFF2 = 5632;
constexpr int SEQ = 8448, NCHK = 132;
constexpr float EPS = 1e-6f;
constexpr float QSCALE = 0.10206207261596577f * 1.4426950408889634f;

constexpr size_t W_IN = 0, W_OUT = W_IN + (size_t)INC * D, W_UP = W_OUT + (size_t)D * D, W_DN = W_UP + (size_t)DFF2 * D,
                 W_UQ = W_DN + (size_t)D * DFF, W_UKV = W_UQ + 384 * 224, W_GLU = W_UKV + 512 * 96, W_SGU = W_GLU + 256 * 256,
                 W_CM = W_SGU + 4 * 128 * 128, W_WG = W_CM + 2 * 16 * 16 * 128, W_BM = W_WG + 2 * 256 * 16, W_LAYER = W_BM + 2 * 16 * 128 * 16;
constexpr size_t S_LAMB = 0, S_LAMT = 4096, S_BBAR = 8192, S_LAYER = 8192 + 65536;

constexpr size_t al256(size_t x) { return (x + 255) / 256 * 256; }
constexpr size_t OFF_WB = 0;
constexpr size_t OFF_S5F = al256(OFF_WB + 2 * W_LAYER * 2);
constexpr size_t OFF_MOD = al256(OFF_S5F + 2 * S_LAYER * 4);
constexpr size_t OFF_ROPE = al256(OFF_MOD + 2 * 5 * 6144 * 4);
constexpr size_t OFF_CTXS = al256(OFF_ROPE + 128 * 8 * 2 * 4);
constexpr size_t OFF_HX = al256(OFF_CTXS + (size_t)MC * D * 4);
constexpr size_t OFF_P = al256(OFF_HX + (size_t)MT * D * 2);
constexpr size_t OFF_MIXIN = al256(OFF_P + (size_t)MT * INC * 2);
constexpr size_t OFF_QB = al256(OFF_MIXIN + (size_t)MT * D * 2);
constexpr size_t OFF_KB = al256(OFF_QB + (size_t)16 * SEQ * 96 * 2);
constexpr size_t OFF_VT = al256(OFF_KB + (size_t)16 * SEQ * 96 * 2);
constexpr size_t OFF_KV = al256(OFF_VT + (size_t)16 * 64 * SEQ * 2);
constexpr size_t OFF_DEC = al256(OFF_KV + (size_t)4 * NCHK * 4 * 2 * 4096 * 4);
constexpr size_t OFF_HL = al256(OFF_DEC + (size_t)4 * NCHK * 4 * 2 * 64 * 4);
constexpr size_t OFF_Y = al256(OFF_HL + (size_t)4 * NCHK * 2 * 16 * 64 * 2 * 4);
constexpr size_t OFF_BAR = al256(OFF_Y + (size_t)MT * 256 * 2);
constexpr size_t OFF_SCHED = OFF_BAR + 3456 * 4;
constexpr size_t OFF_END = al256(OFF_SCHED + 1024 * 4);
constexpr size_t OFF_MIXOUT = OFF_P;
constexpr size_t OFF_ZPRE = OFF_P;
constexpr size_t OFF_ACT = OFF_MIXIN;
constexpr size_t OFF_FFNOUT = OFF_QB;
static_assert((size_t)MT * D * 4 <= (size_t)MT * INC * 2, "mixout alias");
static_assert((size_t)8448 * 1024 * 4 <= 2 * (size_t)16 * SEQ * 96 * 2, "ffnout alias");

struct Params { const float* in[36]; float* out; char* ws; };

DI float bf2f(us v) { return __uint_as_float(((unsigned)v) << 16); }
typedef float f32x2_ __attribute__((ext_vector_type(2)));
typedef __bf16 bf16x2_ __attribute__((ext_vector_type(2)));
DI unsigned pk2(float lo, float hi) { f32x2_ v = {lo, hi}; bf16x2_ b = __builtin_convertvector(v, bf16x2_); return __builtin_bit_cast(unsigned, b); }
DI us f2bf(float x) { return (us)(pk2(x, x) & 0xffffu); }
DI float lo_bf(unsigned w) { return __uint_as_float(w << 16); }
DI float hi_bf(unsigned w) { return __uint_as_float(w & 0xffff0000u); }
DI int tid512() { int t; asm volatile("v_mov_b32 %0, %1" : "=v"(t) : "v"(threadIdx.x)); return t; }
DI int tidx() { return tid512() & 255; }
DI int crow(int i, int hh) { return (i & 3) + 8 * (i >> 2) + 4 * hh; }
DI float sigmoidf_(float x) { return __builtin_amdgcn_rcpf(1.f + __expf(-x)); }
DI float gelu_t(float x) { float u = 0.7978845608028654f * (x + 0.044715f * x * x * x); return x * __builtin_amdgcn_rcpf(1.f + __expf(-2.f * u)); }
DI float silu_(float x) { return x * __builtin_amdgcn_rcpf(1.f + __expf(-x)); }
DI float logsig(float z) { return fminf(z, 0.f) - __logf(1.f + __expf(-fabsf(z))); }
DI void unpack8(u32x4 w, float* f) {
  f[0] = lo_bf(w[0]); f[1] = hi_bf(w[0]); f[2] = lo_bf(w[1]); f[3] = hi_bf(w[1]);
  f[4] = lo_bf(w[2]); f[5] = hi_bf(w[2]); f[6] = lo_bf(w[3]); f[7] = hi_bf(w[3]);
}
DI u32x4 pack8(const float* f) { u32x4 w = {pk2(f[0], f[1]), pk2(f[2], f[3]), pk2(f[4], f[5]), pk2(f[6], f[7])}; return w; }
DI long seqrow(int b, int s) { return s < 256 ? (long)MX + b * 256 + s : (long)b * 8192 + (s - 256); }
DI float wave_sum(float v) {
  v += __shfl_xor(v, 1); v += __shfl_xor(v, 2); v += __shfl_xor(v, 4); v += __shfl_xor(v, 8); v += __shfl_xor(v, 16); v += __shfl_xor(v, 32);
  return v;
}
DI const us* wl(const Params& p, int l) { return (const us*)(p.ws + OFF_WB) + (size_t)l * W_LAYER; }
DI const float* s5f(const Params& p, int l) { return (const float*)(p.ws + OFF_S5F) + (size_t)l * S_LAYER; }
DI const float* modv(const Params& p, int l, int v, int idx) { return (const float*)(p.ws + OFF_MOD) + ((size_t)(l * 5 + v) * 6 + idx) * 1024; }
DI float* stream_row(const Params& p, long m) { return m < MX ? p.out + m * 1024 : (float*)(p.ws + OFF_CTXS) + (m - MX) * 1024; }
DI const float* input_row(const Params& p, long m) { return m < MX ? p.in[0] + m * 1024 : p.in[2] + (m - MX) * 1024; }


#define XB_TMO      128
#define XB_XCNT(j)  (256  + 64 * (j))
#define XB_XSUB(j)  (1280 + 64 * (j))
#define XB_XGEN(j)  (2304 + 64 * (j))
#define XB_TOP      3328
#define XB_TOPGEN   3392
#define XCD_BAR_WORDS 3456
#define XB_SPIN_CAP (1u << 20)
#define LAS __attribute__((address_space(3)))
DI unsigned xb_ld(unsigned* p)              { return __hip_atomic_load(p, __ATOMIC_RELAXED, __HIP_MEMORY_SCOPE_AGENT); }
DI unsigned xb_add(unsigned* p, unsigned v) { return __hip_atomic_fetch_add(p, v, __ATOMIC_RELAXED, __HIP_MEMORY_SCOPE_AGENT); }
DI unsigned xb_xcc_id() { return (unsigned)__builtin_amdgcn_s_getreg((3 << 11) | 20) & 0xFu; }
#define XB_SPIN(cond, bar) do { unsigned _sp = 0; while (cond) { __builtin_amdgcn_s_sleep(1); \
    if ((++_sp & 255u) == 0u) { if (xb_ld(&(bar)[XB_TMO])) break; if (_sp > XB_SPIN_CAP) { atomicAdd(&(bar)[XB_TMO], 1u); break; } } } } while (0)
struct XcdBarrier { unsigned* bar; unsigned x; volatile LAS unsigned* st; };
DI XcdBarrier xcd_barrier_post(unsigned* bar, volatile LAS unsigned* st) {
  XcdBarrier b; b.bar = bar; b.x = (unsigned)__builtin_amdgcn_readfirstlane((int)xb_xcc_id()); b.st = st;
  if (threadIdx.x == 0) (void)xb_add(&bar[XB_XCNT(b.x)], 1u);
  return b;
}
DI void xcd_barrier_complete(unsigned* bar, unsigned x, unsigned& nloc, unsigned& nx) {
  const unsigned G = gridDim.x * gridDim.y * gridDim.z;
  unsigned sum, cnt, mine, sp = 0u;
  for (;;) {
    sum = 0u; cnt = 0u; mine = 0u;
#pragma unroll
    for (unsigned j = 0; j < 16; ++j) { const unsigned c = xb_ld(&bar[XB_XCNT(j)]); sum += c; cnt += (c > 0u) ? 1u : 0u; mine = (j == x) ? c : mine; }
    if (sum == G) break;
    __builtin_amdgcn_s_sleep(1);
    if ((++sp & 255u) == 0u) { if (xb_ld(&bar[XB_TMO])) break; if (sp > XB_SPIN_CAP) { atomicAdd(&bar[XB_TMO], 1u); break; } }
  }
  nloc = mine > 0u ? mine : 1u; nx = cnt > 0u ? cnt : 1u;
}
DI void xcd_barrier(const XcdBarrier& b) {
  asm volatile("s_waitcnt vmcnt(0)" ::: "memory");
  __syncthreads();
  if (threadIdx.x == 0) {
    unsigned* bar = b.bar;
    unsigned bx = b.x; asm volatile("" : "+s"(bx));
    __builtin_amdgcn_s_waitcnt(0);
    unsigned nloc = b.st[0], nx = b.st[1];
    if (nloc == 0u) { xcd_barrier_complete(bar, bx, nloc, nx); b.st[0] = nloc; b.st[1] = nx; }
    const unsigned old = xb_add(&bar[XB_XSUB(bx)], 1u);
    const unsigned gen = old / nloc;
    if (old + 1u == (gen + 1u) * nloc) {
      __builtin_amdgcn_fence(__ATOMIC_RELEASE, "agent");
      asm volatile("s_waitcnt vmcnt(0)" ::: "memory");
      const unsigned og = xb_add(&bar[XB_TOP], 1u);
      const unsigned tg = og / nx;
      if (og + 1u == (tg + 1u) * nx) xb_add(&bar[XB_TOPGEN], 1u);
      else XB_SPIN(xb_ld(&bar[XB_TOPGEN]) == tg, bar);
      __builtin_amdgcn_fence(__ATOMIC_ACQUIRE, "agent");
      xb_add(&bar[XB_XGEN(bx)], 1u);
      asm volatile("s_waitcnt vmcnt(0)" ::: "memory");
    } else {
      XB_SPIN(xb_ld(&bar[XB_XGEN(bx)]) == gen, bar);
      __builtin_amdgcn_fence(__ATOMIC_ACQUIRE, "agent");
      asm volatile("s_waitcnt vmcnt(0)" ::: "memory");
    }
  }
  __syncthreads();
}

DI void conv_tile(const float* src, us* dst, int K, int N, const float* scale, int tile, char* smem) {
  float* t = (float*)smem;
  const int tid = tidx(), tn = N / 128, tk = tile / tn, tc = tile % tn;
  __syncthreads();
  {
    const int k = tid >> 3, c4 = (tid & 7) * 4;
    const float s = scale ? scale[tk * 32 + k] : 1.f;
    const float* sp = src + (size_t)(tk * 32 + k) * N + tc * 128 + c4;
    f32x4 v0 = *(const f32x4*)(sp), v1 = *(const f32x4*)(sp + 32), v2 = *(const f32x4*)(sp + 64), v3 = *(const f32x4*)(sp + 96);
    float* tp = t + k * 129 + c4;
#pragma unroll
    for (int q = 0; q < 4; ++q) { tp[q] = v0[q] * s; tp[32 + q] = v1[q] * s; tp[64 + q] = v2[q] * s; tp[96 + q] = v3[q] * s; }
  }
  __syncthreads();
  {
    const int n = tid >> 1, k16 = (tid & 1) * 16; float f[16];
#pragma unroll
    for (int j = 0; j < 16; ++j) f[j] = t[(k16 + j) * 129 + n];
    us* dp = dst + (size_t)(tc * 128 + n) * K + tk * 32 + k16;
    *(u32x4*)dp = pack8(f); *(u32x4*)(dp + 8) = pack8(f + 8);
  }
}
constexpr int NCONV_LAYER = 32 * 17 + 32 * 8 + 32 * 44 + 88 * 8 + 7 * 3 + 3 * 4 + 8 * 2;
DI void conv_task(const Params& p, int it, char* smem) {
  int l = it / NCONV_LAYER; it -= l * NCONV_LAYER;
  us* wb = (us*)(p.ws + OFF_WB) + (size_t)l * W_LAYER;
  int nt;
  nt = 32 * 17;  if (it < nt) { conv_tile(p.in[10] + (size_t)l * 1024 * 2176, wb + W_IN, 1024, 2176, nullptr, it, smem); return; } it -= nt;
  nt = 32 * 8;   if (it < nt) { conv_tile(p.in[31] + (size_t)l * 1024 * 1024, wb + W_OUT, 1024, 1024, nullptr, it, smem); return; } it -= nt;
  nt = 32 * 44;  if (it < nt) { conv_tile(p.in[32] + (size_t)l * 1024 * 5632, wb + W_UP, 1024, 5632, nullptr, it, smem); return; } it -= nt;
  nt = 88 * 8;   if (it < nt) { conv_tile(p.in[35] + (size_t)l * 2816 * 1024, wb + W_DN, 2816, 1024, nullptr, it, smem); return; } it -= nt;
  nt = 7 * 3;    if (it < nt) { conv_tile(p.in[28] + (size_t)l * 224 * 384, wb + W_UQ, 224, 384, p.in[27] + l * 224, it, smem); return; } it -= nt;
  nt = 3 * 4;    if (it < nt) { conv_tile(p.in[30] + (size_t)l * 96 * 512, wb + W_UKV, 96, 512, p.in[29] + l * 96, it, smem); return; } it -= nt;
  conv_tile(p.in[25] + (size_t)l * 256 * 256, wb + W_GLU, 256, 256, nullptr, it, smem);
}
DI void mod_task(const Params& p, int it, char* smem) {
  float* sc = (float*)smem;
  float* red = sc + 5 * 1024;
  const int tid = tidx(), l = it / 192, jb = it % 192;
  __syncthreads();
  for (int e = tid; e < 5 * 1024; e += 256) {
    int v = e >> 10, k = e & 1023; float c = v < 4 ? p.in[1][v * 1024 + k] : p.in[3][k];
    sc[e] = silu_(c);
  }
  __syncthreads();
  const int col = tid & 31, ks = tid >> 5;
  const float* w = p.in[4] + (size_t)l * 1024 * 6144 + jb * 32 + col;
  float a0 = 0, a1 = 0, a2 = 0, a3 = 0, a4 = 0;
#pragma unroll 8
  for (int k = ks * 128; k < ks * 128 + 128; ++k) {
    float wv = w[(size_t)k * 6144];
    a0 += sc[k] * wv; a1 += sc[1024 + k] * wv; a2 += sc[2048 + k] * wv; a3 += sc[3072 + k] * wv; a4 += sc[4096 + k] * wv;
  }
  float* rp = red + (ks * 32 + col) * 5;
  rp[0] = a0; rp[1] = a1; rp[2] = a2; rp[3] = a3; rp[4] = a4;
  __syncthreads();
  if (tid < 160) {
    int v = tid >> 5, c = tid & 31; float s = 0;
    for (int q = 0; q < 8; ++q) s += red[(q * 32 + c) * 5 + v];
    int j = jb * 32 + c;
    ((float*)(p.ws + OFF_MOD))[(size_t)(l * 5 + v) * 6144 + j] = s + p.in[5][l * 6144 + j];
  }
}
DI void s5pre_task(const Params& p, int it) {
  int gid = it * 256 + tidx();
  int pp = gid & 63, g = (gid >> 6) & 15, d = (gid >> 10) & 1, l = gid >> 11;
  int idx = ((l * 2 + d) * 16 + g) * 64 + pp;
  float are = p.in[17][idx], aim = p.in[18][idx];
  float dt = expf(p.in[19][(l * 2 + d) * 16 + g]);
  float mag = expf(are * dt), lr = mag * cosf(aim * dt), li = mag * sinf(aim * dt);
  float magT = expf(are * dt * 64.f), tr = magT * cosf(aim * dt * 64.f), ti = magT * sinf(aim * dt * 64.f);
  float nr = lr - 1.f, ni = li, den = are * are + aim * aim;
  float cr = (nr * are + ni * aim) / den, ci = (ni * are - nr * aim) / den;
  float* sf = (float*)(p.ws + OFF_S5F) + (size_t)l * S_LAYER;
  int o2 = ((d * 16 + g) * 64 + pp);
  sf[S_LAMB + o2 * 2] = lr; sf[S_LAMB + o2 * 2 + 1] = li;
  sf[S_LAMT + o2 * 2] = tr; sf[S_LAMT + o2 * 2 + 1] = ti;
  for (int i = 0; i < 16; ++i) {
    float br = p.in[20][(size_t)idx * 16 + i], bi = p.in[21][(size_t)idx * 16 + i];
    sf[S_BBAR + ((size_t)o2 * 16 + i) * 2] = cr * br - ci * bi;
    sf[S_BBAR + ((size_t)o2 * 16 + i) * 2 + 1] = cr * bi + ci * br;
    us* bm = (us*)(p.ws + OFF_WB) + (size_t)l * W_LAYER + W_BM + (size_t)(d * 16 + g) * 128 * 16;
    bm[pp * 16 + i] = f2bf(cr * br - ci * bi);
    bm[(64 + pp) * 16 + i] = f2bf(cr * bi + ci * br);
  }
  us* cm = (us*)(p.ws + OFF_WB) + (size_t)l * W_LAYER + W_CM;
  for (int o = 0; o < 16; ++o) {
    size_t ci_ = ((size_t)((l * 2 + d) * 16 + g) * 16 + o) * 64 + pp;
    cm[((size_t)(d * 16 + g) * 16 + o) * 128 + pp] = f2bf(p.in[22][ci_]);
    cm[((size_t)(d * 16 + g) * 16 + o) * 128 + 64 + pp] = f2bf(-p.in[23][ci_]);
  }
}
DI void rope_task(const Params& p, int it) {
  int gid = it * 256 + tidx();
  int pos = gid >> 3, f = gid & 7;
  float inv = powf(10000.f, -(float)f / 8.f), ang = (float)pos * inv;
  float* r = (float*)(p.ws + OFF_ROPE);
  r[gid * 2] = cosf(ang); r[gid * 2 + 1] = sinf(ang);
}
DI void wgt_task(const Params& p, int it) {
  int gid = it * 256 + tidx();
  int rr = gid & 15, c = (gid >> 4) & 255, d = (gid >> 12) & 1, l = gid >> 13;
  ((us*)(p.ws + OFF_WB))[(size_t)l * W_LAYER + W_WG + (d * 256 + c) * 16 + rr] = f2bf(p.in[14][((l * 2 + d) * 16 + rr) * 256 + c]);
}
DI void sguw_task(const Params& p, int it) {
  int gid = it * 256 + tidx();
  int l = gid >> 14, e = (gid & 16383) * 4;
  f32x4 v = *(const f32x4*)(p.in[12] + (size_t)l * 65536 + e);
  u32x2 w = {pk2(v[0], v[1]), pk2(v[2], v[3])};
  *(u32x2*)((us*)(p.ws + OFF_WB) + (size_t)l * W_LAYER + W_SGU + e) = w;
}

template <int MODE>
DI void row_task(const Params& p, int l, long m, const us* yrow) {
  const int lane = tidx() & 63, v = m < MX ? (int)(m >> 13) : 4;
  float x[16];
  if (MODE == 0) {
    const float* src = input_row(p, m);
#pragma unroll
    for (int j = 0; j < 4; ++j) { f32x4 t = *(const f32x4*)(src + (j * 64 + lane) * 4); x[4 * j] = t[0]; x[4 * j + 1] = t[1]; x[4 * j + 2] = t[2]; x[4 * j + 3] = t[3]; }
  } else {
    float y[16]; float ss = 0;
    const float* xo = (MODE == 1 && l == 0) ? input_row(p, m) : stream_row(p, m);
#pragma unroll
    for (int j = 0; j < 4; ++j) {
      u32x2 t = *(const u32x2*)(yrow + (j * 64 + lane) * 4); y[4 * j] = lo_bf(t[0]); y[4 * j + 1] = hi_bf(t[0]); y[4 * j + 2] = lo_bf(t[1]); y[4 * j + 3] = hi_bf(t[1]);
      f32x4 u = *(const f32x4*)(xo + (j * 64 + lane) * 4); x[4 * j] = u[0]; x[4 * j + 1] = u[1]; x[4 * j + 2] = u[2]; x[4 * j + 3] = u[3];
    }
#pragma unroll
    for (int j = 0; j < 16; ++j) ss += y[j] * y[j];
    ss = wave_sum(ss);
    float rstd = rsqrtf(ss * (1.f / 1024.f) + EPS);
    const float* gp = (MODE == 1 ? p.in[7] : p.in[9]) + l * 1024;
    const float* gt = modv(p, l, v, MODE == 1 ? 2 : 5);
    float* dst = stream_row(p, m);
#pragma unroll
    for (int j = 0; j < 4; ++j) {
      int c = (j * 64 + lane) * 4;
      f32x4 g4 = *(const f32x4*)(gp + c), t4 = *(const f32x4*)(gt + c), o;
#pragma unroll
      for (int q = 0; q < 4; ++q) { x[4 * j + q] += t4[q] * (y[4 * j + q] * rstd * g4[q]); o[q] = x[4 * j + q]; }
      *(f32x4*)(dst + c) = o;
    }
    if (MODE == 2 && l == 1) return;
  }
  const int ln = (MODE == 2) ? 1 : l;
  const float* g = (MODE == 1 ? p.in[8] : p.in[6]) + ln * 1024;
  const float* sh = modv(p, ln, v, MODE == 1 ? 3 : 0);
  const float* sc = modv(p, ln, v, MODE == 1 ? 4 : 1);
  float ss = 0;
#pragma unroll
  for (int j = 0; j < 16; ++j) ss += x[j] * x[j];
  ss = wave_sum(ss);
  float rstd = rsqrtf(ss * (1.f / 1024.f) + EPS);
  us* hx = (us*)(p.ws + OFF_HX) + m * 1024;
#pragma unroll
  for (int j = 0; j < 4; ++j) {
    int c = (j * 64 + lane) * 4;
    f32x4 g4 = *(const f32x4*)(g + c), s4 = *(const f32x4*)(sh + c), c4 = *(const f32x4*)(sc + c); float h[4];
#pragma unroll
    for (int q = 0; q < 4; ++q) h[q] = (x[4 * j + q] * rstd * g4[q]) * (1.f + c4[q]) + s4[q];
    u32x2 w = {pk2(h[0], h[1]), pk2(h[2], h[3])};
    *(u32x2*)(hx + c) = w;
  }
}

struct GArgs { const us* A; int lda; const us* W; int K; long m0; int n0; void* out; int ldo; int l; };
template <int BK, int EPI, bool ROWSS>
DI void gemm_tile(const Params& p, const GArgs& g, char* smem) {
  constexpr int LS = BK + 8, CPR = BK / 8, NCH = 128 * CPR / 256;
  us* sA = (us*)smem; us* sB = sA + 2 * 128 * LS; float* rstd = (float*)(sB + 2 * 128 * LS);
  const int tid = tidx(), w = tid >> 6, lane = tid & 63, r = lane & 31, hh = lane >> 5, wm = w >> 1, wn = w & 1;
  __syncthreads();
  if (ROWSS) {
    int row = tid >> 1, half = tid & 1; float ss = 0;
    const us* ap = g.A + (size_t)row * g.lda + half * (g.K / 2);
    for (int c = 0; c < g.K / 16; ++c) { float f[8]; unpack8(*(const u32x4*)(ap + c * 8), f);
#pragma unroll
      for (int j = 0; j < 8; ++j) ss += f[j] * f[j]; }
    ss += __shfl_xor(ss, 1);
    if (!half) rstd[row] = rsqrtf(ss / (float)g.K + EPS);
  }
  u32x4 ra[NCH], rb[NCH];
  f32x16 acc[2][2];
#pragma unroll
  for (int i = 0; i < 2; ++i)
#pragma unroll
    for (int j = 0; j < 2; ++j)
#pragma unroll
      for (int q = 0; q < 16; ++q) acc[i][j][q] = 0.f;
#define GLOAD(kt) _Pragma("unroll") for (int j = 0; j < NCH; ++j) { int q = tid + 256 * j, row = q / CPR, cc = q % CPR; \
    ra[j] = *(const u32x4*)(g.A + (size_t)row * g.lda + (kt) * BK + cc * 8); rb[j] = *(const u32x4*)(g.W + (size_t)row * g.K + (kt) * BK + cc * 8); }
#define SWRITE(buf) _Pragma("unroll") for (int j = 0; j < NCH; ++j) { int q = tid + 256 * j, row = q / CPR, cc = q % CPR; \
    *(u32x4*)(sA + (buf) * 128 * LS + row * LS + cc * 8) = ra[j]; *(u32x4*)(sB + (buf) * 128 * LS + row * LS + cc * 8) = rb[j]; }
  GLOAD(0); SWRITE(0); __syncthreads();
  const int KT = g.K / BK;
  for (int kt = 0; kt < KT; ++kt) {
    if (kt + 1 < KT) { GLOAD(kt + 1); }
    const us* a0 = sA + (kt & 1) * 128 * LS + (wm * 64 + r) * LS + hh * 8;
    const us* b0 = sB + (kt & 1) * 128 * LS + (wn * 64 + r) * LS + hh * 8;
#pragma unroll
    for (int ks = 0; ks < BK / 16; ++ks) {
      bf16x8 af0 = *(const bf16x8*)(a0 + ks * 16), af1 = *(const bf16x8*)(a0 + 32 * LS + ks * 16);
      bf16x8 bf0 = *(const bf16x8*)(b0 + ks * 16), bf1 = *(const bf16x8*)(b0 + 32 * LS + ks * 16);
      acc[0][0] = MFMA(af0, bf0, acc[0][0]); acc[0][1] = MFMA(af0, bf1, acc[0][1]);
      acc[1][0] = MFMA(af1, bf0, acc[1][0]); acc[1][1] = MFMA(af1, bf1, acc[1][1]);
    }
    if (kt + 1 < KT) { SWRITE((kt + 1) & 1); }
    __syncthreads();
  }
#undef GLOAD
#undef SWRITE
#pragma unroll
  for (int si = 0; si < 2; ++si)
#pragma unroll
    for (int sj = 0; sj < 2; ++sj) {
      const int col = wn * 64 + sj * 32 + r, n = g.n0 + col;
#pragma unroll
      for (int i = 0; i < 16; ++i) {
        const int row = wm * 64 + si * 32 + crow(i, hh);
        const long m = g.m0 + row;
        float v = acc[si][sj][i];
        if (EPI == 0) { ((us*)g.out)[m * g.ldo + n] = f2bf(v); }
        else if (EPI == 1) { ((float*)g.out)[m * g.ldo + n] = v; }
        else if (EPI == 2) {
          v *= rstd[row] * QSCALE;
          float pv = __shfl_xor(v, 8);
          const int head = n / 96, j = n - head * 96;
          const bool isx = m < MX; const int t = isx ? (int)(m & 8191) : (int)((m - MX) & 255);
          const int b = isx ? (int)(m >> 13) : (int)((m - MX) >> 8);
          if (isx && j >= 64) {
            int jj = (j - 64) & 15, blk = (j - 64) >> 4, f = jj & 7, pos = blk ? (t & 63) : (t >> 6);
            const float* rp = (const float*)(p.ws + OFF_ROPE) + (pos * 8 + f) * 2; float cs = rp[0], sn = rp[1];
            v = (jj < 8) ? v * cs - pv * sn : pv * sn + v * cs;
          }
          const int s = isx ? 256 + t : t;
          ((us*)(p.ws + OFF_QB))[((size_t)(b * 4 + head) * SEQ + s) * 96 + j] = f2bf(v);
        } else if (EPI == 3) {
          v *= rstd[row];
          const int head = n >> 7, j = n & 127;
          const bool isx = m < MX; const int t = isx ? (int)(m & 8191) : (int)((m - MX) & 255);
          const int b = isx ? (int)(m >> 13) : (int)((m - MX) >> 8);
          const int s = isx ? 256 + t : t;
          if (j < 64) ((us*)(p.ws + OFF_KB))[((size_t)(b * 4 + head) * SEQ + s) * 96 + j] = f2bf(v);
          else if ((i & 3) == 3) {
            const float r1 = rstd[row - 1], r2 = rstd[row - 2], r3 = rstd[row - 3];
            u32x2 w2 = {pk2(acc[si][sj][i - 3] * r3, acc[si][sj][i - 2] * r2), pk2(acc[si][sj][i - 1] * r1, v)};
            *(u32x2*)((us*)(p.ws + OFF_VT) + ((size_t)(b * 4 + head) * 64 + (j - 64)) * SEQ + s - 3) = w2;
          }
        } else if (EPI == 4) {
          float y = bf2f(((const us*)(p.ws + OFF_Y))[m * 256 + n]);
          v += p.in[26][g.l * 256 + n];
          ((us*)(p.ws + OFF_MIXIN))[m * 1024 + 512 + n] = f2bf(y * sigmoidf_(v));
        }
      }
    }
}


using f32x4_ = __attribute__((ext_vector_type(4))) float;
#define MFMA16(a, b, c) __builtin_amdgcn_mfma_f32_16x16x32_bf16((a), (b), (c), 0, 0, 0)
DI void gemm_big(const GArgs& g, int ncv, char* smem) {
  constexpr int ST = 256 * 64;
  us* sA = (us*)smem; us* sB = sA + 2 * ST;
  const int tid = tid512(), w = tid >> 6, lane = tid & 63, l16 = lane & 15, lq = lane >> 4, wm = w >> 2, wn = w & 3;
  u32x4 ra[4], rb[4];
  f32x4_ acc[8][4];
#pragma unroll
  for (int i = 0; i < 8; ++i)
#pragma unroll
    for (int j = 0; j < 4; ++j) { acc[i][j][0] = 0.f; acc[i][j][1] = 0.f; acc[i][j][2] = 0.f; acc[i][j][3] = 0.f; }
  const int srow = tid >> 3, sch = tid & 7;
  const us* gA = g.A + (size_t)srow * g.lda + sch * 8;
  const us* gB = g.W + (size_t)srow * g.K + sch * 8;
  const int swr = srow * 64 + ((sch ^ (srow & 7)) << 3);
#define GLOAD(kt) { _Pragma("unroll") for (int j = 0; j < 4; ++j) { ra[j] = *(const u32x4*)(gA + (size_t)(64 * j) * g.lda + (kt) * 64); rb[j] = *(const u32x4*)(gB + (size_t)(64 * j) * g.K + (kt) * 64); } }
#define SWRITE(buf) { _Pragma("unroll") for (int j = 0; j < 4; ++j) { *(u32x4*)(sA + (buf) * ST + swr + j * 4096) = ra[j]; *(u32x4*)(sB + (buf) * ST + swr + j * 4096) = rb[j]; } }
  const int KT = g.K / 64;
  const bool act = wn * 64 < ncv;
  const int fo0 = l16 * 64 + ((lq ^ (l16 & 7)) << 3), fo1 = l16 * 64 + (((4 + lq) ^ (l16 & 7)) << 3);
  __syncthreads();
  GLOAD(0); SWRITE(0); GLOAD(KT > 1 ? 1 : 0);
  for (int kt = 0; kt < KT; ++kt) {
    __syncthreads();
    SWRITE((kt + 1) & 1);
    { const int kl = kt + 2 < KT ? kt + 2 : KT - 1; GLOAD(kl); }
    if (act) {
      const us* a0 = sA + (kt & 1) * ST + wm * 128 * 64;
      const us* b0 = sB + (kt & 1) * ST + wn * 64 * 64;
#pragma unroll
      for (int ks = 0; ks < 2; ++ks) {
        const int fo = ks ? fo1 : fo0;
        bf16x8 fb[4];
#pragma unroll
        for (int j = 0; j < 4; ++j) fb[j] = *(const bf16x8*)(b0 + j * 1024 + fo);
#pragma unroll
        for (int i = 0; i < 8; ++i) {
          bf16x8 fa = *(const bf16x8*)(a0 + i * 1024 + fo);
#pragma unroll
          for (int j = 0; j < 4; ++j) acc[i][j] = MFMA16(fb[j], fa, acc[i][j]);
        }
      }
    }
  }
#undef GLOAD
#undef SWRITE
  __syncthreads();
  {
    us* sC = (us*)smem; constexpr int CS = 264;
    if (act) {
#pragma unroll
      for (int i = 0; i < 8; ++i)
#pragma unroll
        for (int j = 0; j < 4; ++j) {
          u32x2 w2 = {pk2(acc[i][j][0], acc[i][j][1]), pk2(acc[i][j][2], acc[i][j][3])};
          *(u32x2*)(sC + (wm * 128 + i * 16 + l16) * CS + wn * 64 + j * 16 + lq * 4) = w2;
        }
    }
    __syncthreads();
    us* outp = (us*)g.out + (size_t)g.m0 * g.ldo + g.n0;
#pragma unroll 4
    for (int k = 0; k < 16; ++k) {
      const int q = tid + 512 * k, row = q >> 5, cc = q & 31;
      if (cc * 8 < ncv) *(u32x4*)(outp + (size_t)row * g.ldo + cc * 8) = *(const u32x4*)(sC + row * CS + cc * 8);
    }
  }
}

DI int lds_byte8(int r, int c) { int st = (r >> 4) * 2 + (c >> 5), rr = r & 15, cc = c & 31, ob = rr * 64 + cc * 2; return st * 1024 + (ob ^ (((ob >> 9) & 1) << 5)); }
DI void stage_rc8(int b, int& R, int& C) { int st = b / 1024, sb = b % 1024, swz = sb ^ (((sb >> 9) & 1) << 5); R = (st >> 1) * 16 + swz / 64; C = (st & 1) * 32 + (swz % 64) / 2; }
DI void gemm_8p(const GArgs& g, char* smem) {
  constexpr int BK8 = 64, HALF8 = 128, HT8 = HALF8 * BK8;
  us* shm = (us*)smem;
  const int tid = tid512();
  const us* __restrict__ A = g.A; const us* __restrict__ Bt = g.W;
  const unsigned lda = (unsigned)g.lda, ldb = (unsigned)g.K;
#define SA8(b, h) (shm + ((b) * 2 + (h)) * HT8)
#define SB8(b, h) (shm + (4 + (b) * 2 + (h)) * HT8)
#define STAGE8(P, BASE, LD, br, kt) do { const unsigned _g = (unsigned)(br) * (unsigned)(LD) + (unsigned)(kt) * BK8; \
    for (int _i = 0; _i < 2; ++_i) { int _b = tid * 16 + _i * 8192; int _r, _c; stage_rc8(_b, _r, _c); \
      __builtin_amdgcn_global_load_lds((const unsigned*)((BASE) + (size_t)(_g + (unsigned)_r * (unsigned)(LD) + (unsigned)_c)), \
        (__attribute__((address_space(3))) unsigned*)((char*)(P) + _b), 16, 0, 0); } } while (0)
#define LDA8(dst, b, h) for (int m = 0; m < 4; ++m) for (int k = 0; k < 2; ++k) \
    dst[m][k] = *reinterpret_cast<const bf16x8*>((char*)SA8(b, h) + lds_byte8(wr * 64 + m * 16 + fr, k * 32 + fq * 8))
#define LDB8(dst, b, h) for (int n = 0; n < 2; ++n) for (int k = 0; k < 2; ++k) \
    dst[n][k] = *reinterpret_cast<const bf16x8*>((char*)SB8(b, h) + lds_byte8(wc * 32 + n * 16 + fr, k * 32 + fq * 8))
#define MMA8(ai, bj, At_, Bt_) do { __builtin_amdgcn_s_setprio(1); \
    for (int m = 0; m < 4; ++m) for (int n = 0; n < 2; ++n) for (int k = 0; k < 2; ++k) \
      acc[ai][bj][m][n] = __builtin_amdgcn_mfma_f32_16x16x32_bf16(Bt_[n][k], At_[m][k], acc[ai][bj][m][n], 0, 0, 0); \
    __builtin_amdgcn_s_setprio(0); } while (0)
#define WAIT_V(n) asm volatile("s_waitcnt vmcnt(" #n ")" ::: "memory")
#define WAIT_L(n) asm volatile("s_waitcnt lgkmcnt(" #n ")" ::: "memory")
#define BAR8 __builtin_amdgcn_s_barrier()
#define SCHED8 __builtin_amdgcn_sched_barrier(0)
  const int wid = tid >> 6, lane = tid & 63, wr = wid >> 2, wc = wid & 3, fr = lane & 15, fq = lane >> 4;
  f32x4_ acc[2][2][4][2];
#pragma unroll
  for (int a_ = 0; a_ < 2; ++a_)
#pragma unroll
    for (int b_ = 0; b_ < 2; ++b_)
#pragma unroll
      for (int m = 0; m < 4; ++m)
#pragma unroll
        for (int n = 0; n < 2; ++n) acc[a_][b_][m][n] = (f32x4_){0.f, 0.f, 0.f, 0.f};
  bf16x8 At[4][2], B0[2][2], B1[2][2];
  const int nt = g.K / BK8;
  __syncthreads();
  STAGE8(SB8(0, 0), Bt, ldb, 0, 0); STAGE8(SA8(0, 0), A, lda, 0, 0);
  STAGE8(SB8(0, 1), Bt, ldb, HALF8, 0); STAGE8(SA8(0, 1), A, lda, HALF8, 0);
  if (wr == 1) BAR8;
  WAIT_V(4); BAR8;
  STAGE8(SB8(1, 0), Bt, ldb, 0, 1); STAGE8(SA8(1, 0), A, lda, 0, 1); STAGE8(SB8(1, 1), Bt, ldb, HALF8, 1);
  WAIT_V(6); BAR8;
  for (int t = 0; t < nt - 2; t += 2) {
    LDB8(B0, 0, 0); SCHED8; LDA8(At, 0, 0); STAGE8(SA8(1, 1), A, lda, HALF8, t + 1);
    WAIT_L(8); BAR8; WAIT_L(0); MMA8(0, 0, At, B0); BAR8; SCHED8;
    LDB8(B1, 0, 1); STAGE8(SB8(0, 0), Bt, ldb, 0, t + 2);
    BAR8; WAIT_L(0); MMA8(0, 1, At, B1); BAR8;
    LDA8(At, 0, 1); STAGE8(SA8(0, 0), A, lda, 0, t + 2);
    BAR8; WAIT_L(0); MMA8(1, 0, At, B0); BAR8; SCHED8;
    STAGE8(SB8(0, 1), Bt, ldb, HALF8, t + 2);
    WAIT_V(6); BAR8; MMA8(1, 1, At, B1); BAR8;
    LDB8(B0, 1, 0); SCHED8; LDA8(At, 1, 0); STAGE8(SA8(0, 1), A, lda, HALF8, t + 2);
    WAIT_L(8); BAR8; WAIT_L(0); MMA8(0, 0, At, B0); BAR8; SCHED8;
    LDB8(B1, 1, 1); STAGE8(SB8(1, 0), Bt, ldb, 0, t + 3);
    BAR8; WAIT_L(0); MMA8(0, 1, At, B1); BAR8;
    LDA8(At, 1, 1); STAGE8(SA8(1, 0), A, lda, 0, t + 3);
    BAR8; WAIT_L(0); MMA8(1, 0, At, B0); BAR8; SCHED8;
    STAGE8(SB8(1, 1), Bt, ldb, HALF8, t + 3);
    WAIT_V(6); BAR8; MMA8(1, 1, At, B1); BAR8;
  }
  { LDB8(B0, 0, 0); LDA8(At, 0, 0); STAGE8(SA8(1, 1), A, lda, HALF8, nt - 1);
    BAR8; WAIT_L(0); MMA8(0, 0, At, B0); BAR8;
    LDB8(B1, 0, 1); BAR8; WAIT_L(0); MMA8(0, 1, At, B1); BAR8;
    LDA8(At, 0, 1); WAIT_V(4); BAR8; WAIT_L(0); MMA8(1, 0, At, B0); MMA8(1, 1, At, B1); BAR8; }
  { LDB8(B0, 1, 0); LDA8(At, 1, 0); WAIT_V(2); BAR8; WAIT_L(0); MMA8(0, 0, At, B0); BAR8;
    LDB8(B1, 1, 1); WAIT_V(0); BAR8; WAIT_L(0); MMA8(0, 1, At, B1); BAR8;
    LDA8(At, 1, 1); BAR8; WAIT_L(0); MMA8(1, 0, At, B0); MMA8(1, 1, At, B1); BAR8; }
  if (wr == 0) BAR8;
  __syncthreads();
  {
    us* sC = (us*)smem; constexpr int CS = 264;
    const int tid = tid512(), wid = tid >> 6, lane = tid & 63, wr = wid >> 2, wc = wid & 3, fr = lane & 15, fq = lane >> 4;
#pragma unroll
    for (int ai = 0; ai < 2; ++ai)
#pragma unroll
      for (int bj = 0; bj < 2; ++bj)
#pragma unroll
        for (int m = 0; m < 4; ++m)
#pragma unroll
          for (int n = 0; n < 2; ++n) {
            const f32x4_ v = acc[ai][bj][m][n];
            u32x2 w2 = {pk2(v[0], v[1]), pk2(v[2], v[3])};
            *(u32x2*)(sC + (ai * 128 + wr * 64 + m * 16 + fr) * CS + bj * 128 + wc * 32 + n * 16 + fq * 4) = w2;
          }
    __syncthreads();
    us* outp = (us*)g.out + (size_t)g.m0 * g.ldo + g.n0;
#pragma unroll 4
    for (int k = 0; k < 16; ++k) {
      const int q = tid + 512 * k, row = q >> 5, cc = q & 31;
      *(u32x4*)(outp + (size_t)row * g.ldo + cc * 8) = *(const u32x4*)(sC + row * CS + cc * 8);
    }
  }
#undef SA8
#undef SB8
#undef STAGE8
#undef LDA8
#undef LDB8
#undef MMA8
#undef WAIT_V
#undef WAIT_L
#undef BAR8
#undef SCHED8
}

template <class F>
DI void for_tiles_xcd(int RT, int CT, int G, int bid, F f) {
  if ((G & 7) == 0) {
    const int x = bid & 7, rows = (RT - x + 7) >> 3, n = rows * CT, nfull = CT >> 3;
    for (int j = bid >> 3; j < n; j += G >> 3) {
      int rl, ct;
      if (j < nfull * rows * 8) { int pnl = j / (rows * 8), rem = j - pnl * rows * 8; rl = rem >> 3; ct = pnl * 8 + (rem & 7); }
      else { int j2 = j - nfull * rows * 8, wd = CT - nfull * 8; rl = j2 / wd; ct = nfull * 8 + (j2 - rl * wd); }
      f(rl * 8 + x, ct);
    }
  } else {
    for (int it = bid; it < RT * CT; it += G) f(it / CT, it % CT);
  }
}

DI void kr_task(const Params& p, long m0) {
  const int tid = tidx(), row = tid >> 1, blk = tid & 1; const long m = m0 + row;
  const us* src = (const us*)(p.ws + OFF_P) + m * INC + 2144 + blk * 16;
  float v[16], o[16]; unpack8(*(const u32x4*)src, v); unpack8(*(const u32x4*)(src + 8), v + 8);
  const bool isx = m < MX; const int t = isx ? (int)(m & 8191) : (int)((m - MX) & 255);
  const int b = isx ? (int)(m >> 13) : (int)((m - MX) >> 8), s = isx ? 256 + t : t;
  if (isx) {
    int pos = blk ? (t & 63) : (t >> 6);
    const float* rp = (const float*)(p.ws + OFF_ROPE) + pos * 16;
#pragma unroll
    for (int f = 0; f < 8; ++f) { float cs = rp[2 * f], sn = rp[2 * f + 1]; o[f] = v[f] * cs - v[f + 8] * sn; o[f + 8] = v[f] * sn + v[f + 8] * cs; }
  } else {
#pragma unroll
    for (int f = 0; f < 16; ++f) o[f] = v[f];
  }
  u32x4 w0 = pack8(o), w1 = pack8(o + 8);
#pragma unroll
  for (int hd = 0; hd < 4; ++hd) {
    us* dst = (us*)(p.ws + OFF_KB) + ((size_t)(b * 4 + hd) * SEQ + s) * 96 + 64 + blk * 16;
    *(u32x4*)dst = w0; *(u32x4*)(dst + 8) = w1;
  }
}

DI void sgu_task(const Params& p, int l, int chunk, int h, char* smem) {
  us* Vt = (us*)smem;
  const int tid = tidx(), w = tid >> 6, lane = tid & 63, r = lane & 31, hh = lane >> 5;
  const long m0 = (long)chunk * 128;
  const us* P = (const us*)(p.ws + OFF_P);
  __syncthreads();
  {
    int row = tid >> 1, dh = (tid & 1) * 32; float v[32]; float ss = 0;
    const us* src = P + (m0 + row) * INC + 256 + h * 64 + dh;
#pragma unroll
    for (int c = 0; c < 4; ++c) unpack8(*(const u32x4*)(src + c * 8), v + c * 8);
#pragma unroll
    for (int j = 0; j < 32; ++j) { v[j] = gelu_t(v[j]); ss += v[j] * v[j]; }
    ss += __shfl_xor(ss, 1);
    float rstd = rsqrtf(ss * (1.f / 64.f) + EPS);
    const float* gn = p.in[11] + l * 256 + h * 64 + dh;
#pragma unroll
    for (int j = 0; j < 32; ++j) Vt[(dh + j) * 136 + row] = f2bf(v[j] * rstd * gn[j]);
  }
  __syncthreads();
  const us* Wsp = wl(p, l) + W_SGU + (size_t)h * 16384 + (size_t)(w * 32 + r) * 128 + hh * 8;
  f32x16 a0, a1;
#pragma unroll
  for (int q = 0; q < 16; ++q) { a0[q] = 0.f; a1[q] = 0.f; }
#pragma unroll
  for (int ks = 0; ks < 8; ++ks) {
    bf16x8 af = *(const bf16x8*)(Wsp + ks * 16);
    bf16x8 b0 = *(const bf16x8*)(Vt + r * 136 + ks * 16 + hh * 8), b1 = *(const bf16x8*)(Vt + (32 + r) * 136 + ks * 16 + hh * 8);
    a0 = MFMA(af, b0, a0); a1 = MFMA(af, b1, a1);
  }
  us* out = (us*)(p.ws + OFF_MIXIN);
#pragma unroll
  for (int i = 0; i < 16; ++i) {
    int t = w * 32 + crow(i, hh); float bs = p.in[13][l * 512 + h * 128 + t];
    const us* pu = P + (m0 + t) * INC + h * 64;
    float u0 = gelu_t(bf2f(pu[r])), u1 = gelu_t(bf2f(pu[32 + r]));
    out[(m0 + t) * 1024 + h * 64 + r] = f2bf(u0 * (a0[i] + bs));
    out[(m0 + t) * 1024 + h * 64 + 32 + r] = f2bf(u1 * (a1[i] + bs));
  }
}

DI void gla_gate_dir(const Params& p, int l, const us* Prow0, int h, int d, float* sW, float* G) {
  const int tid = tidx(), w = tid >> 6, lane = tid & 63, r = lane & 31, hh = lane >> 5, mt = w >> 1, nt = w & 1;
  {
    const bf16x8 a = *(const bf16x8*)(Prow0 + (size_t)(mt * 32 + r) * INC + 1536 + d * 16 + hh * 8);
    const bf16x8 bw = *(const bf16x8*)(wl(p, l) + W_WG + (size_t)(d * 256 + h * 64 + nt * 32 + r) * 16 + hh * 8);
    f32x16 z;
#pragma unroll
    for (int q = 0; q < 16; ++q) z[q] = 0.f;
    z = MFMA(a, bw, z);
    const float bg = p.in[15][l * 512 + d * 256 + h * 64 + nt * 32 + r];
#pragma unroll
    for (int i = 0; i < 16; ++i) G[(mt * 32 + crow(i, hh)) * 64 + nt * 32 + r] = logsig(z[i] + bg) * (1.f / 16.f);
  }
  __syncthreads();
  {
    const int ch = tid & 63, seg = tid >> 6;
    float v[16];
#pragma unroll
    for (int k = 0; k < 16; ++k) v[k] = G[(seg * 16 + k) * 64 + ch];
    if (d == 0) {
#pragma unroll
      for (int k = 1; k < 16; ++k) v[k] += v[k - 1];
      sW[seg * 64 + ch] = v[15];
    } else {
#pragma unroll
      for (int k = 14; k >= 0; --k) v[k] += v[k + 1];
      sW[seg * 64 + ch] = v[0];
    }
    __syncthreads();
    float off = 0.f;
    if (d == 0) { for (int q = 0; q < 3; ++q) off += (q < seg) ? sW[q * 64 + ch] : 0.f; }
    else { for (int q = 1; q < 4; ++q) off += (q > seg) ? sW[q * 64 + ch] : 0.f; }
#pragma unroll
    for (int k = 0; k < 16; ++k) G[(seg * 16 + k) * 64 + ch] = v[k] + off;
  }
  __syncthreads();
}
DI size_t gla_idx(int b, int c, int h, int d) { return (size_t)(((b * NCHK + c) * 4 + h) * 2 + d); }

DI void gla1_task(const Params& p, int l, int b, int c, int h, char* smem) {
  float* G0 = (float*)smem; float* G1 = G0 + 4096; float* sW = G1 + 4096;
  us* KeT = (us*)(sW + 1024);
  us* Vt = KeT + 2 * 64 * 72;
  const int tid = tidx(), w = tid >> 6, lane = tid & 63, r = lane & 31, hh = lane >> 5;
  const long m0 = seqrow(b, c * 64);
  const us* P0 = (const us*)(p.ws + OFF_P) + m0 * INC;
  __syncthreads();
  gla_gate_dir(p, l, P0, h, 0, sW, G0);
  gla_gate_dir(p, l, P0, h, 1, sW, G1);
  {
    int t = tid >> 2, q4 = tid & 3; float kk[16], vv[16];
    const us* sk = P0 + (size_t)t * INC + 768 + h * 64 + q4 * 16;
    const us* sv = P0 + (size_t)t * INC + 1024 + h * 64 + q4 * 16;
    unpack8(*(const u32x4*)sk, kk); unpack8(*(const u32x4*)(sk + 8), kk + 8);
    unpack8(*(const u32x4*)sv, vv); unpack8(*(const u32x4*)(sv + 8), vv + 8);
#pragma unroll
    for (int cc = 0; cc < 16; ++cc) {
      int ch = q4 * 16 + cc;
      KeT[ch * 72 + t] = f2bf(kk[cc] * __expf(G0[63 * 64 + ch] - G0[t * 64 + ch]));
      KeT[(64 + ch) * 72 + t] = f2bf(kk[cc] * __expf(G1[ch] - G1[t * 64 + ch]));
      Vt[ch * 72 + t] = f2bf(vv[cc]);
    }
    if (tid < 128) {
      int d = tid >> 6, ch = tid & 63;
      ((float*)(p.ws + OFF_DEC))[gla_idx(b, c, h, d) * 64 + ch] = __expf(d ? G1[ch] : G0[63 * 64 + ch]);
    }
  }
  __syncthreads();
  {
    const int d = w >> 1, mt = w & 1;
    float* kv = (float*)(p.ws + OFF_KV) + gla_idx(b, c, h, d) * 4096;
#pragma unroll
    for (int nt = 0; nt < 2; ++nt) {
      f32x16 acc;
#pragma unroll
      for (int q = 0; q < 16; ++q) acc[q] = 0.f;
#pragma unroll
      for (int ks = 0; ks < 4; ++ks) {
        bf16x8 a = *(const bf16x8*)(Vt + (mt * 32 + r) * 72 + ks * 16 + hh * 8);
        bf16x8 bb = *(const bf16x8*)(KeT + (d * 64 + nt * 32 + r) * 72 + ks * 16 + hh * 8);
        acc = MFMA(a, bb, acc);
      }
#pragma unroll
      for (int i = 0; i < 16; ++i) kv[(mt * 32 + crow(i, hh)) * 64 + nt * 32 + r] = acc[i];
    }
  }
}
DI int gla_order(int d, int j) { return d == 0 ? j : (j < 4 ? 3 - j : 135 - j); }
DI void gla2_task(const Params& p, int it) {
  const int gid = it * 256 + tidx();
  const int e = gid & 4095, d = (gid >> 12) & 1, h = (gid >> 13) & 3, b = gid >> 15, k = e & 63;
  float* KV = (float*)(p.ws + OFF_KV); const float* DEC = (const float*)(p.ws + OFF_DEC);
  float s = 0;
  for (int j0 = 0; j0 < NCHK; j0 += 33) {
    float kv[33], dc[33];
#pragma unroll
    for (int q = 0; q < 33; ++q) { const size_t ix = gla_idx(b, gla_order(d, j0 + q), h, d); kv[q] = KV[ix * 4096 + e]; dc[q] = DEC[ix * 64 + k]; }
#pragma unroll
    for (int q = 0; q < 33; ++q) { const size_t ix = gla_idx(b, gla_order(d, j0 + q), h, d); KV[ix * 4096 + e] = s; s = dc[q] * s + kv[q]; }
  }
}
DI void gla3_task(const Params& p, int l, int b, int c, int h, char* smem) {
  float* G = (float*)smem;
  us* Qin = (us*)(smem + 17408);
  us* Kin = Qin + 64 * 72; us* Vt = Kin + 64 * 72; us* ST = Vt + 64 * 72; us* Sc = ST + 64 * 72;
  float* sW = (float*)Sc;
  const int tid = tidx(), w = tid >> 6, lane = tid & 63, r = lane & 31, hh = lane >> 5;
  const long m0 = seqrow(b, c * 64);
  const us* P0 = (const us*)(p.ws + OFF_P) + m0 * INC;
  const int t_ = tid >> 2, q4 = tid & 3;
  __syncthreads();
  {
    float vv[16]; const us* sv = P0 + (size_t)t_ * INC + 1024 + h * 64 + q4 * 16;
    unpack8(*(const u32x4*)sv, vv); unpack8(*(const u32x4*)(sv + 8), vv + 8);
#pragma unroll
    for (int cc = 0; cc < 16; ++cc) Vt[(q4 * 16 + cc) * 72 + t_] = f2bf(vv[cc]);
  }
  f32x16 oacc;
#pragma unroll
  for (int q = 0; q < 16; ++q) oacc[q] = 0.f;
  const int mt = w >> 1, nt = w & 1;
  for (int d = 0; d < 2; ++d) {
    gla_gate_dir(p, l, P0, h, d, sW, G);
    {
      float qq[16], kk[16], qo[16], ko[16];
      const us* sq = P0 + (size_t)t_ * INC + 512 + h * 64 + q4 * 16;
      const us* sk = P0 + (size_t)t_ * INC + 768 + h * 64 + q4 * 16;
      unpack8(*(const u32x4*)sq, qq); unpack8(*(const u32x4*)(sq + 8), qq + 8);
      unpack8(*(const u32x4*)sk, kk); unpack8(*(const u32x4*)(sk + 8), kk + 8);
#pragma unroll
      for (int cc = 0; cc < 16; ++cc) { float gg = G[t_ * 64 + q4 * 16 + cc]; qo[cc] = qq[cc] * 0.125f * __expf(gg); ko[cc] = kk[cc] * __expf(-gg); }
      *(u32x4*)(Qin + t_ * 72 + q4 * 16) = pack8(qo); *(u32x4*)(Qin + t_ * 72 + q4 * 16 + 8) = pack8(qo + 8);
      *(u32x4*)(Kin + t_ * 72 + q4 * 16) = pack8(ko); *(u32x4*)(Kin + t_ * 72 + q4 * 16 + 8) = pack8(ko + 8);
      const float* ss = (const float*)(p.ws + OFF_KV) + gla_idx(b, c, h, d) * 4096 + tid * 16;
      float sf[16];
#pragma unroll
      for (int j = 0; j < 4; ++j) { f32x4 t4 = *(const f32x4*)(ss + j * 4); sf[4 * j] = t4[0]; sf[4 * j + 1] = t4[1]; sf[4 * j + 2] = t4[2]; sf[4 * j + 3] = t4[3]; }
      const int v_ = tid >> 2, k0 = (tid & 3) * 16;
      *(u32x4*)(ST + v_ * 72 + k0) = pack8(sf); *(u32x4*)(ST + v_ * 72 + k0 + 8) = pack8(sf + 8);
    }
    __syncthreads();
    {
      const int tt = mt, st = nt;
      const bool need = d == 0 ? st <= tt : st >= tt;
      f32x16 sc;
#pragma unroll
      for (int q = 0; q < 16; ++q) sc[q] = 0.f;
      if (need) {
#pragma unroll
        for (int ks = 0; ks < 4; ++ks) {
          bf16x8 a = *(const bf16x8*)(Qin + (tt * 32 + r) * 72 + ks * 16 + hh * 8);
          bf16x8 bb = *(const bf16x8*)(Kin + (st * 32 + r) * 72 + ks * 16 + hh * 8);
          sc = MFMA(a, bb, sc);
        }
      }
#pragma unroll
      for (int i = 0; i < 16; ++i) {
        int trow = tt * 32 + crow(i, hh), scol = st * 32 + r;
        bool keep = d == 0 ? scol <= trow : scol >= trow;
        Sc[trow * 72 + scol] = f2bf(keep ? sc[i] : 0.f);
      }
    }
    __syncthreads();
#pragma unroll
    for (int ks = 0; ks < 4; ++ks) {
      bf16x8 a = *(const bf16x8*)(Sc + (mt * 32 + r) * 72 + ks * 16 + hh * 8);
      bf16x8 bb = *(const bf16x8*)(Vt + (nt * 32 + r) * 72 + ks * 16 + hh * 8);
      oacc = MFMA(a, bb, oacc);
    }
#pragma unroll
    for (int ks = 0; ks < 4; ++ks) {
      bf16x8 a = *(const bf16x8*)(Qin + (mt * 32 + r) * 72 + ks * 16 + hh * 8);
      bf16x8 bb = *(const bf16x8*)(ST + (nt * 32 + r) * 72 + ks * 16 + hh * 8);
      oacc = MFMA(a, bb, oacc);
    }
    __syncthreads();
  }
  float* Ob = (float*)smem;
#pragma unroll
  for (int i = 0; i < 16; ++i) Ob[(mt * 32 + crow(i, hh)) * 68 + nt * 32 + r] = oacc[i];
  __syncthreads();
  {
    float o[16], rr[16]; float ss = 0;
#pragma unroll
    for (int cc = 0; cc < 16; ++cc) { o[cc] = Ob[t_ * 68 + q4 * 16 + cc]; ss += o[cc] * o[cc]; }
    ss += __shfl_xor(ss, 1); ss += __shfl_xor(ss, 2);
    float rstd = rsqrtf(ss * (1.f / 64.f) + EPS);
    const us* sr = P0 + (size_t)t_ * INC + 1280 + h * 64 + q4 * 16;
    unpack8(*(const u32x4*)sr, rr); unpack8(*(const u32x4*)(sr + 8), rr + 8);
    const float* gn = p.in[16] + l * 256 + h * 64 + q4 * 16;
#pragma unroll
    for (int cc = 0; cc < 16; ++cc) o[cc] = o[cc] * rstd * gn[cc] * silu_(rr[cc]);
    us* dst = (us*)(p.ws + OFF_MIXIN) + (m0 + t_) * 1024 + 256 + h * 64 + q4 * 16;
    *(u32x4*)dst = pack8(o); *(u32x4*)(dst + 8) = pack8(o + 8);
  }
}

DI size_t hl_idx(int b, int c, int d, int g, int pp) { return ((size_t)(((b * NCHK + c) * 2 + d) * 16 + g) * 64 + pp) * 2; }
template <bool OUT>
DI void s5_task(const Params& p, int l, int b, int c, int gp, char* smem) {
  us* Hb = (us*)smem;
  float* Yb = (float*)(smem + 4 * 32 * 136 * 2);
  const int tid = tidx(), w = tid >> 6, lane = tid & 63, r = lane & 31, hh = lane >> 5;
  const long m0 = seqrow(b, c * 64);
  const us* P0 = (const us*)(p.ws + OFF_P) + m0 * INC;
  const int gl = w >> 1, d = w & 1, g = gp * 2 + gl, pp = lane;
  const float* sf = s5f(p, l);
  const float lr = sf[S_LAMB + ((d * 16 + g) * 64 + pp) * 2], li = sf[S_LAMB + ((d * 16 + g) * 64 + pp) * 2 + 1];
  const f32x2_ la = {lr, lr}, lb = {-li, li};
  float hr = 0.f, hi = 0.f;
  float* HL = (float*)(p.ws + OFF_HL) + hl_idx(b, c, d, g, pp);
  if (OUT) { hr = HL[0]; hi = HL[1]; }
  const us* cm = wl(p, l) + W_CM + ((size_t)(d * 16 + g) * 16 + (r & 15)) * 128 + hh * 8;
  const us* bm = wl(p, l) + W_BM + ((size_t)(d * 16 + g) * 128 + r) * 16 + hh * 8;
  us* hb = Hb + w * 32 * 136;
  __syncthreads();
  for (int half = 0; half < 2; ++half) {
    const int tbase = d ? (1 - half) * 32 : half * 32;
    {
      const bf16x8 a = *(const bf16x8*)(P0 + (size_t)(tbase + r) * INC + 1568 + g * 16 + hh * 8);
#pragma unroll
      for (int nt = 0; nt < 4; ++nt) {
        const bf16x8 bb = *(const bf16x8*)(bm + nt * 32 * 16);
        f32x16 z;
#pragma unroll
        for (int q = 0; q < 16; ++q) z[q] = 0.f;
        z = MFMA(a, bb, z);
#pragma unroll
        for (int i = 0; i < 16; ++i) hb[crow(i, hh) * 136 + nt * 32 + r] = f2bf(z[i]);
      }
    }
    __syncthreads();
    for (int jj = 0; jj < 32; ++jj) {
      const int tl = d ? 31 - jj : jj;
      const f32x2_ bu = {bf2f(hb[tl * 136 + pp]), bf2f(hb[tl * 136 + 64 + pp])};
      { f32x2_ h = {hr, hi}, hs = {hi, hr}; f32x2_ nh = la * h + lb * hs + bu; hr = nh[0]; hi = nh[1]; }
      if (OUT) { hb[tl * 136 + pp] = f2bf(hr); hb[tl * 136 + 64 + pp] = f2bf(hi); }
    }
    if (OUT) {
      __syncthreads();
      f32x16 acc;
#pragma unroll
      for (int q = 0; q < 16; ++q) acc[q] = 0.f;
#pragma unroll
      for (int ks = 0; ks < 8; ++ks) {
        bf16x8 a = *(const bf16x8*)(hb + r * 136 + ks * 16 + hh * 8);
        bf16x8 bb = *(const bf16x8*)(cm + ks * 16);
        if (r >= 16) bb = (bf16x8){0, 0, 0, 0, 0, 0, 0, 0};
        acc = MFMA(a, bb, acc);
      }
      if (r < 16) {
#pragma unroll
        for (int i = 0; i < 16; ++i) Yb[(w * 64 + tbase + crow(i, hh)) * 17 + r] = acc[i];
      }
    }
    __syncthreads();
  }
  if (!OUT) { HL[0] = hr; HL[1] = hi; return; }
  {
    const int gl2 = tid >> 7, t = (tid >> 1) & 63, o8 = (tid & 1) * 8, g2 = gp * 2 + gl2; float y[8], u8[8];
    unpack8(*(const u32x4*)(P0 + (size_t)t * INC + 1568 + g2 * 16 + o8), u8);
#pragma unroll
    for (int o = 0; o < 8; ++o) {
      float v = Yb[((gl2 * 2 + 0) * 64 + t) * 17 + o8 + o] + Yb[((gl2 * 2 + 1) * 64 + t) * 17 + o8 + o]
              + p.in[24][l * 256 + g2 * 16 + o8 + o] * u8[o];
      y[o] = gelu_t(v);
    }
    *(u32x4*)((us*)(p.ws + OFF_Y) + (m0 + t) * 256 + g2 * 16 + o8) = pack8(y);
  }
}
DI void s5b_task(const Params& p, int l, int it) {
  const int gid = it * 256 + tidx();
  const int pp = gid & 63, g = (gid >> 6) & 15, d = (gid >> 10) & 1, b = gid >> 11;
  const float* sf = s5f(p, l);
  const float tr = sf[S_LAMT + ((d * 16 + g) * 64 + pp) * 2], ti = sf[S_LAMT + ((d * 16 + g) * 64 + pp) * 2 + 1];
  float* HL = (float*)(p.ws + OFF_HL);
  float hr = 0.f, hi = 0.f;
  for (int j0 = 0; j0 < NCHK; j0 += 33) {
    f32x2_ xv[33];
#pragma unroll
    for (int q = 0; q < 33; ++q) xv[q] = *(const f32x2_*)(HL + hl_idx(b, gla_order(d, j0 + q), d, g, pp));
#pragma unroll
    for (int q = 0; q < 33; ++q) {
      f32x2_ o = {hr, hi};
      *(f32x2_*)(HL + hl_idx(b, gla_order(d, j0 + q), d, g, pp)) = o;
      float nr = tr * hr - ti * hi + xv[q][0], ni = tr * hi + ti * hr + xv[q][1]; hr = nr; hi = ni;
    }
  }
}

DI void attn_task(const Params& p, int b, int h, int qs0, int nkeys, char* smem) {
  constexpr int KSZ = 64 * 104, VSZ = 64 * 68;
  us* sK = (us*)smem;
  us* sV = sK + 3 * KSZ;
  const int tid = tid512(), w = tid >> 6, lane = tid & 63, r = lane & 31, hh = lane >> 5;
  const us* Kg = (const us*)(p.ws + OFF_KB) + (size_t)(b * 4 + h) * SEQ * 96;
  const us* Vg = (const us*)(p.ws + OFF_VT) + (size_t)(b * 4 + h) * 64 * SEQ;
  const us* Qg = (const us*)(p.ws + OFF_QB) + ((size_t)(b * 4 + h) * SEQ + qs0 + w * 32 + r) * 96 + hh * 8;
  bf16x8 qf[6];
#pragma unroll
  for (int ks = 0; ks < 6; ++ks) qf[ks] = *(const bf16x8*)(Qg + ks * 16);
  u32x4 rk[2], rv;
  const int kq1 = tid + 512 < 768 ? tid + 512 : tid;
  const int vrow = tid >> 3, vcc = tid & 7;
  const int kw0 = (tid / 12) * 104 + (tid % 12) * 8, kw1 = (kq1 / 12) * 104 + (kq1 % 12) * 8, vw = vrow * 68 + vcc * 8;
#define AGLOAD(kt) { rk[0] = *(const u32x4*)(Kg + (size_t)(kt) * 64 * 96 + tid * 8); rk[1] = *(const u32x4*)(Kg + (size_t)(kt) * 64 * 96 + kq1 * 8); \
    rv = *(const u32x4*)(Vg + (size_t)vrow * SEQ + (kt) * 64 + vcc * 8); }
#define ASWRITE(buf) { *(u32x4*)(sK + (buf) * KSZ + kw0) = rk[0]; *(u32x4*)(sK + (buf) * KSZ + kw1) = rk[1]; \
    us* dv = sV + (buf) * VSZ + vw; u32x2 lo = {rv[0], rv[1]}, hi2 = {rv[2], rv[3]}; *(u32x2*)dv = lo; *(u32x2*)(dv + 4) = hi2; }
  f32x16 o0, o1, negm, sc0, sc1;
#pragma unroll
  for (int q = 0; q < 16; ++q) { o0[q] = 0.f; o1[q] = 0.f; sc0[q] = 0.f; sc1[q] = 0.f; }
  float lsum = 0.f;
  const int NT = nkeys / 64;
  __syncthreads();
  AGLOAD(0); ASWRITE(0); AGLOAD(1); ASWRITE(1); AGLOAD(2);
  __syncthreads();
  {
    const us* k0 = sK + r * 104 + hh * 8;
#pragma unroll
    for (int ks = 0; ks < 6; ++ks) {
      bf16x8 a0 = *(const bf16x8*)(k0 + ks * 16), a1 = *(const bf16x8*)(k0 + 32 * 104 + ks * 16);
      sc0 = MFMA(a0, qf[ks], sc0); sc1 = MFMA(a1, qf[ks], sc1);
    }
    float mx = sc0[0];
#pragma unroll
    for (int i = 1; i < 16; ++i) mx = fmaxf(mx, sc0[i]);
#pragma unroll
    for (int i = 0; i < 16; ++i) mx = fmaxf(mx, sc1[i]);
    mx = fmaxf(mx, __shfl_xor(mx, 32));
#pragma unroll
    for (int q = 0; q < 16; ++q) { negm[q] = -mx; sc0[q] -= mx; sc1[q] -= mx; }
  }
  int bc = 0, bn = 1, bw = 2;
  for (int kt = 0; kt < NT; ++kt) {
    __syncthreads();
    ASWRITE(bw);
    { const int kl = kt + 3 < NT ? kt + 3 : NT - 1; AGLOAD(kl); }
    float mx = sc0[0];
#pragma unroll
    for (int i = 1; i < 16; ++i) mx = fmaxf(mx, sc0[i]);
#pragma unroll
    for (int i = 0; i < 16; ++i) mx = fmaxf(mx, sc1[i]);
    mx = fmaxf(mx, __shfl_xor(mx, 32));
    if (__builtin_amdgcn_ballot_w64(mx > 8.f)) {
      const float dl = fmaxf(mx, 0.f), alpha = __builtin_amdgcn_exp2f(-dl);
#pragma unroll
      for (int i = 0; i < 16; ++i) { o0[i] *= alpha; o1[i] *= alpha; sc0[i] -= dl; sc1[i] -= dl; negm[i] -= dl; }
      lsum *= alpha;
    }
    f32x16 sn0, sn1;
    {
      const us* k0 = sK + bn * KSZ + r * 104 + hh * 8;
      {
        bf16x8 a0 = *(const bf16x8*)(k0), a1 = *(const bf16x8*)(k0 + 32 * 104);
        sn0 = MFMA(a0, qf[0], negm); sn1 = MFMA(a1, qf[0], negm);
      }
#pragma unroll
      for (int ks = 1; ks < 6; ++ks) {
        bf16x8 a0 = *(const bf16x8*)(k0 + ks * 16), a1 = *(const bf16x8*)(k0 + 32 * 104 + ks * 16);
        sn0 = MFMA(a0, qf[ks], sn0); sn1 = MFMA(a1, qf[ks], sn1);
      }
    }
    float ps = 0.f;
#pragma unroll
    for (int i = 0; i < 16; ++i) { sc0[i] = __builtin_amdgcn_exp2f(sc0[i]); ps += sc0[i]; }
#pragma unroll
    for (int i = 0; i < 16; ++i) { sc1[i] = __builtin_amdgcn_exp2f(sc1[i]); ps += sc1[i]; }
    lsum += ps;
    bf16x8 pf[4];
    {
      u32x4 t0 = {pk2(sc0[0], sc0[1]), pk2(sc0[2], sc0[3]), pk2(sc0[4], sc0[5]), pk2(sc0[6], sc0[7])};
      u32x4 t1 = {pk2(sc0[8], sc0[9]), pk2(sc0[10], sc0[11]), pk2(sc0[12], sc0[13]), pk2(sc0[14], sc0[15])};
      u32x4 t2 = {pk2(sc1[0], sc1[1]), pk2(sc1[2], sc1[3]), pk2(sc1[4], sc1[5]), pk2(sc1[6], sc1[7])};
      u32x4 t3 = {pk2(sc1[8], sc1[9]), pk2(sc1[10], sc1[11]), pk2(sc1[12], sc1[13]), pk2(sc1[14], sc1[15])};
      pf[0] = __builtin_bit_cast(bf16x8, t0); pf[1] = __builtin_bit_cast(bf16x8, t1);
      pf[2] = __builtin_bit_cast(bf16x8, t2); pf[3] = __builtin_bit_cast(bf16x8, t3);
    }
    {
      const us* v0 = sV + bc * VSZ + r * 68 + 4 * hh;
#pragma unroll
      for (int kk = 0; kk < 4; ++kk) {
        u32x2 l0 = *(const u32x2*)(v0 + 16 * kk), h0 = *(const u32x2*)(v0 + 16 * kk + 8);
        u32x2 l1 = *(const u32x2*)(v0 + 32 * 68 + 16 * kk), h1 = *(const u32x2*)(v0 + 32 * 68 + 16 * kk + 8);
        u32x4 a0 = {l0[0], l0[1], h0[0], h0[1]}, a1 = {l1[0], l1[1], h1[0], h1[1]};
        o0 = MFMA(__builtin_bit_cast(bf16x8, a0), pf[kk], o0);
        o1 = MFMA(__builtin_bit_cast(bf16x8, a1), pf[kk], o1);
      }
    }
    sc0 = sn0; sc1 = sn1;
    { const int t = bc; bc = bn; bn = bw; bw = t; }
  }
#undef AGLOAD
#undef ASWRITE
  lsum += __shfl_xor(lsum, 32);
  const float inv = 1.f / lsum;
  const long m = seqrow(b, qs0 + w * 32 + r);
  us* dst = (us*)(p.ws + OFF_MIXIN) + m * 1024 + 768 + h * 64;
#pragma unroll
  for (int gq = 0; gq < 4; ++gq) {
    u32x2 w0 = {pk2(o0[4 * gq] * inv, o0[4 * gq + 1] * inv), pk2(o0[4 * gq + 2] * inv, o0[4 * gq + 3] * inv)};
    u32x2 w1 = {pk2(o1[4 * gq] * inv, o1[4 * gq + 1] * inv), pk2(o1[4 * gq + 2] * inv, o1[4 * gq + 3] * inv)};
    *(u32x2*)(dst + 8 * gq + 4 * hh) = w0;
    *(u32x2*)(dst + 32 + 8 * gq + 4 * hh) = w1;
  }
}

DI void convact_task(const Params& p, int l, int it, int nrows) {
  const int T = it * 256 + tidx();
  if (T >= (nrows / 8) * 352) return;
  const int rb = T / 352, oct = T - rb * 352, c0 = oct * 8, i0 = rb * 8;
  const int slo = i0 < 8192 ? 0 : 8192, shi = i0 < 8192 ? 8192 : 8448;
  const us* Z = (const us*)(p.ws + OFF_ZPRE);
  const float* cw = p.in[33] + (size_t)l * 3 * DFF2; const float* cb = p.in[34] + (size_t)l * DFF2;
  float wa[3][8], wg[3][8], ba[8], bg[8];
#pragma unroll
  for (int j = 0; j < 3; ++j) {
    f32x4 a0 = *(const f32x4*)(cw + j * DFF2 + c0), a1 = *(const f32x4*)(cw + j * DFF2 + c0 + 4);
    f32x4 g0 = *(const f32x4*)(cw + j * DFF2 + DFF + c0), g1 = *(const f32x4*)(cw + j * DFF2 + DFF + c0 + 4);
#pragma unroll
    for (int q = 0; q < 4; ++q) { wa[j][q] = a0[q]; wa[j][4 + q] = a1[q]; wg[j][q] = g0[q]; wg[j][4 + q] = g1[q]; }
  }
  {
    f32x4 a0 = *(const f32x4*)(cb + c0), a1 = *(const f32x4*)(cb + c0 + 4), g0 = *(const f32x4*)(cb + DFF + c0), g1 = *(const f32x4*)(cb + DFF + c0 + 4);
#pragma unroll
    for (int q = 0; q < 4; ++q) { ba[q] = a0[q]; ba[4 + q] = a1[q]; bg[q] = g0[q]; bg[4 + q] = g1[q]; }
  }
  u32x4 ra_[10], rg_[10];
#pragma unroll
  for (int k = 0; k < 10; ++k) {
    const int i = i0 - 1 + k;
    if (i >= slo && i < shi) { ra_[k] = *(const u32x4*)(Z + (size_t)i * DFF2 + c0); rg_[k] = *(const u32x4*)(Z + (size_t)i * DFF2 + DFF + c0); }
    else { ra_[k] = (u32x4){0u, 0u, 0u, 0u}; rg_[k] = (u32x4){0u, 0u, 0u, 0u}; }
  }
  us* A = (us*)(p.ws + OFF_ACT);
  float za[3][8], zg[3][8];
  unpack8(ra_[0], za[0]); unpack8(rg_[0], zg[0]); unpack8(ra_[1], za[1]); unpack8(rg_[1], zg[1]);
#pragma unroll
  for (int ii = 0; ii < 8; ++ii) {
    const int i = i0 + ii;
    unpack8(ra_[ii + 2], za[2]); unpack8(rg_[ii + 2], zg[2]);
    float o[8];
#pragma unroll
    for (int q = 0; q < 8; ++q) {
      float a = ba[q] + wa[0][q] * za[0][q] + wa[1][q] * za[1][q] + wa[2][q] * za[2][q];
      float gg = bg[q] + wg[0][q] * zg[0][q] + wg[1][q] * zg[1][q] + wg[2][q] * zg[2][q];
      o[q] = gelu_t(a) * gg;
    }
    *(u32x4*)(A + (size_t)i * DFF + c0) = pack8(o);
#pragma unroll
    for (int q = 0; q < 8; ++q) { za[0][q] = za[1][q]; za[1][q] = za[2][q]; zg[0][q] = zg[1][q]; zg[1][q] = zg[2][q]; }
  }
}

constexpr int SCHED_WORDS = 1024;
DI int gl_n(int RT, int CT, int x) { return ((RT - x + 7) >> 3) * CT; }
DI void gl_tile(int RT, int CT, int x, int j, int& rt, int& ct) {
  const int rows = (RT - x + 7) >> 3, nfull = CT >> 3; int rl;
  if (j < nfull * rows * 8) { int pnl = j / (rows * 8), rem = j - pnl * rows * 8; rl = rem >> 3; ct = pnl * 8 + (rem & 7); }
  else { int j2 = j - nfull * rows * 8, wd = CT - nfull * 8; rl = j2 / wd; ct = nfull * 8 + (j2 - rl * wd); }
  rt = rl * 8 + x;
}
DI int ml_n(int n, int x) { return (n - x + 7) >> 3; }
template <class NX, class RUN>
DI void run_phase(unsigned*& ctr, int G, int bid, volatile int* s_bc, NX nx, RUN run) {
  const int x0 = bid & 7, per = G >> 3;
  const int x = x0; int j = bid >> 3;
  for (;;) {
    if (j < nx(x)) {
      int nj = 0;
      if (threadIdx.x == 0) nj = per + (int)atomicAdd(&ctr[x], 1u);
      run(x, j);
      __syncthreads();
      if (threadIdx.x == 0) *s_bc = nj;
      __syncthreads();
      j = *s_bc;
    } else break;
  }
  ctr += 8;
}

DI long chunk_row(int ch, int i) { return i < 8192 ? (long)ch * 8192 + i : (long)MX + ch * 256 + (i - 8192); }


template <class RUN>
DI void run_tiles(unsigned*& ctr, int n, int G, int bid, volatile int* s_bc, RUN run) {
  int it = bid;
  while (it < n) {
    int nx = 0;
    if (threadIdx.x == 0) nx = G + (int)atomicAdd(ctr, 1u);
    run(it);
    __syncthreads();
    if (threadIdx.x == 0) *s_bc = nx;
    __syncthreads();
    it = *s_bc;
  }
  ctr += 1;
}

constexpr int HLDS = 64512;
constexpr int LDS_BYTES = 147456;
static_assert(2 * HLDS <= LDS_BYTES, "lds");

__global__ void __launch_bounds__(512) fwd_mega(Params p) {
  cg::grid_group grid = cg::this_grid();
  extern __shared__ __attribute__((aligned(16))) char dsm[];
  __shared__ uint4 xb_words;
  const int G = gridDim.x, bid = blockIdx.x, wv8 = __builtin_amdgcn_readfirstlane(threadIdx.x >> 6), half = wv8 >> 2;
  char* smem = dsm + half * HLDS;
  const int vb = bid * 2 + half, V = 2 * G;
  if (threadIdx.x == 0) xb_words = make_uint4(0u, 0u, 0u, 0u);
  __syncthreads();
  const XcdBarrier xb = xcd_barrier_post((unsigned*)(p.ws + OFF_BAR), (volatile LAS unsigned*)&xb_words);
#define HALF_LOOP(n, IT, ...) { const int n_ = (n); const int iters_ = (n_ + V - 1) / V; for (int k_ = 0; k_ < iters_; ++k_) { int IT = vb + k_ * V; IT = IT < n_ ? IT : n_ - 1; __VA_ARGS__ } }
#define HALF_LOOP_NB(n, IT, ...) { const int n_ = (n); for (int IT = vb; IT < n_; IT += V) { __VA_ARGS__ } }

  HALF_LOOP(2 * NCONV_LAYER, it, conv_task(p, it, smem);)
  HALF_LOOP(384, it, mod_task(p, it, smem);)
  HALF_LOOP_NB(16, it, s5pre_task(p, it);)
  HALF_LOOP_NB(4, it, rope_task(p, it);)
  HALF_LOOP_NB(128, it, sguw_task(p, it);)
  HALF_LOOP_NB(64, it, wgt_task(p, it);)
  grid.sync();
  for (int it = bid; it < MT / 8; it += G) row_task<0>(p, 0, (long)it * 8 + wv8, nullptr);
  xcd_barrier(xb);

  unsigned* ctr = (unsigned*)(p.ws + OFF_SCHED);
  volatile int* s_bc = (volatile int*)&xb_words.z;
  for (int l = 0; l < 2; ++l) {
    const us* W = wl(p, l);
    const int RT = l == 0 ? 264 : 256;
    run_tiles(ctr, 132 * 9, G, bid, s_bc, [&](int it) {
      const int rt = it / 9, ct = it - rt * 9;
      GArgs g{(const us*)(p.ws + OFF_HX) + (size_t)rt * 256 * D, D, W + W_IN + (size_t)ct * 256 * D, D, (long)rt * 256, ct * 256, p.ws + OFF_P, INC, l};
      gemm_big(g, ct == 8 ? 128 : 256, dsm);
    });
    xcd_barrier(xb);
    {
      const int p0 = (4 * NCHK * 8) >> 1, p1 = p0 + ((4 * NCHK * 4) >> 1), p2 = p1 + ((RT * 4) >> 1), p3 = p2 + ((264 * 3) >> 1), p4 = p3 + ((264 * 4) >> 1);
      for (int P = bid; P < p4; P += G) {
        if (P < p0) { const int q = 2 * P + half; s5_task<false>(p, l, q / (NCHK * 8), (q / 8) % NCHK, q & 7, smem); }
        else if (P < p1) { const int q = 2 * (P - p0) + half; gla1_task(p, l, q / (NCHK * 4), (q / 4) % NCHK, q & 3, smem); }
        else if (P < p2) { const int q = 2 * (P - p1) + half; sgu_task(p, l, q >> 2, q & 3, smem); }
        else if (P < p3) { const int q = 2 * (P - p2) + half, rt = q / 3, ct = q % 3;
          GArgs g{(const us*)(p.ws + OFF_P) + (size_t)rt * 128 * INC + 1824, INC, W + W_UQ + (size_t)ct * 128 * 224, 224, (long)rt * 128, ct * 128, nullptr, 0, l};
          gemm_tile<32, 2, true>(p, g, smem); }
        else { const int q = 2 * (P - p3) + half, rt = q >> 2, ct = q & 3;
          GArgs g{(const us*)(p.ws + OFF_P) + (size_t)rt * 128 * INC + 2048, INC, W + W_UKV + (size_t)ct * 128 * 96, 96, (long)rt * 128, ct * 128, nullptr, 0, l};
          gemm_tile<32, 3, true>(p, g, smem);
          if (ct == 0) kr_task(p, (long)rt * 128); }
      }
    }
    xcd_barrier(xb);
    HALF_LOOP_NB(512, it, gla2_task(p, it);)
    HALF_LOOP_NB(32, it, s5b_task(p, l, it);)
    xcd_barrier(xb);
    if ((G & 7) == 0) {
      const int x = bid & 7;
      for (int j = bid >> 3; j < 64; j += G >> 3) { int pair = 2 * x + (j >> 5), qb = j & 31; for (int rp = 0; rp < REP_ATT; ++rp) attn_task(p, pair >> 2, pair & 3, 256 + qb * 256, SEQ, dsm); }
    } else {
      for (int it = bid; it < 512; it += G) attn_task(p, it >> 7, (it >> 5) & 3, 256 + (it & 31) * 256, SEQ, dsm);
    }
    if (l == 0) for (int it = bid; it < 16; it += G) attn_task(p, it >> 2, it & 3, 0, 256, dsm);
    {
      const int c0 = l == 0 ? 0 : 4, nc = NCHK - c0;
      const int p0 = (4 * nc * 8) >> 1, p1 = p0 + ((4 * nc * 4) >> 1);
      for (int P = bid; P < p1; P += G) {
        if (P < p0) { const int q = 2 * P + half; s5_task<true>(p, l, q / (nc * 8), c0 + (q / 8) % nc, q & 7, smem); }
        else { const int q = 2 * (P - p0) + half; gla3_task(p, l, q / (nc * 4), c0 + (q / 4) % nc, q & 3, smem); }
      }
    }
    xcd_barrier(xb);
    HALF_LOOP(RT * 2, it, { int rt = it >> 1, ct = it & 1;
      GArgs g{(const us*)(p.ws + OFF_Y) + (size_t)rt * 128 * 256, 256, W + W_GLU + (size_t)ct * 128 * 256, 256, (long)rt * 128, ct * 128, nullptr, 0, l};
      gemm_tile<32, 4, false>(p, g, smem); })
    xcd_barrier(xb);
    run_tiles(ctr, (RT / 2) * 4, G, bid, s_bc, [&](int it) {
      const int rt = it >> 2, ct = it & 3;
      GArgs g{(const us*)(p.ws + OFF_MIXIN) + (size_t)rt * 256 * D, D, W + W_OUT + (size_t)ct * 256 * D, D, (long)rt * 256, ct * 256, p.ws + OFF_MIXOUT, D, l};
      gemm_big(g, 256, dsm);
    });
    xcd_barrier(xb);
    for (int it = bid; it < RT * 16; it += G) { long m = (long)it * 8 + wv8; row_task<1>(p, l, m, (const us*)(p.ws + OFF_MIXOUT) + m * 1024); }
    xcd_barrier(xb);
    const int CR2 = l == 0 ? 33 : 32, CROWS = CR2 * 256, NF2 = (CROWS / 8 * 352 + 255) / 256;
    for (int ch = 0; ch <= 4; ++ch) {
      {
        const bool hasF3 = ch > 0, hasF1 = ch < 4;
        const int n3 = hasF3 ? CR2 * 4 : 0, n1 = hasF1 ? CR2 * 22 : 0;
        run_tiles(ctr, n3 + n1, G, bid, s_bc, [&](int it) {
          GArgs g;
          if (it < n3) {
            const int rt = it >> 2, ct = it & 3;
            g = GArgs{(const us*)(p.ws + OFF_ACT) + (size_t)rt * 256 * DFF, DFF, W + W_DN + (size_t)ct * 256 * DFF, DFF, (long)rt * 256, ct * 256, p.ws + OFF_FFNOUT, D, l};
          } else {
            const int q = it - n3, rt = q / 22, ct = q - rt * 22;
            g = GArgs{(const us*)(p.ws + OFF_HX) + (size_t)chunk_row(ch, rt * 256) * D, D, W + W_UP + (size_t)ct * 256 * D, D, (long)rt * 256, ct * 256, p.ws + OFF_ZPRE, DFF2, l};
          }
          gemm_8p(g, dsm);
        });
      }
      xcd_barrier(xb);
      if (ch < 4) HALF_LOOP_NB(NF2, it, convact_task(p, l, it, CROWS);)
      if (ch > 0) for (int it = bid; it < CROWS / 8; it += G) { int i = it * 8 + wv8; row_task<2>(p, l, chunk_row(ch - 1, i), (const us*)(p.ws + OFF_FFNOUT) + (size_t)i * 1024); }
      xcd_barrier(xb);
    }
  }
#undef HALF_LOOP
#undef HALF_LOOP_NB
}

extern "C" void kernel_launch(void* const* d_in, const int* in_sizes, int n_in, void* d_out, int out_size,
                              void* d_ws, size_t ws_size, hipStream_t stream) {
  static int grid_blocks = 0;
  if (!grid_blocks) {
    int dev = 0, cus = 0, per_cu = 0;
    (void)hipGetDevice(&dev);
    (void)hipDeviceGetAttribute(&cus, hipDeviceAttributeMultiprocessorCount, dev);
    if (hipFuncSetAttribute((const void*)fwd_mega, hipFuncAttributeMaxDynamicSharedMemorySize, LDS_BYTES) != hipSuccess)
      fprintf(stderr, "kernel_launch: hipFuncSetAttribute(%d B LDS) failed\n", LDS_BYTES);
    (void)hipOccupancyMaxActiveBlocksPerMultiprocessor(&per_cu, fwd_mega, 512, LDS_BYTES);
    if (per_cu < 1) fprintf(stderr, "kernel_launch: occupancy query returned %d\n", per_cu);
    grid_blocks = cus;
    if (ws_size < OFF_END) fprintf(stderr, "kernel_launch: ws too small: %zu < %zu\n", ws_size, (size_t)OFF_END);
  }
  if (n_in != 36 || ws_size < OFF_END) return;
  Params p{};
  for (int i = 0; i < 36; ++i) p.in[i] = (const float*)d_in[i];
  p.out = (float*)d_out; p.ws = (char*)d_ws;
  void* args[] = {&p};
  (void)hipMemsetAsync((char*)d_ws + OFF_BAR, 0, (XCD_BAR_WORDS + SCHED_WORDS) * 4, stream);
  hipError_t e = hipLaunchCooperativeKernel((void*)fwd_mega, dim3(grid_blocks), dim3(512), args, LDS_BYTES, stream);
  if (e != hipSuccess) fprintf(stderr, "cooperative launch failed: %s (grid %d)\n", hipGetErrorString(e), grid_blocks);
}
```

```cpp
#include <hip/hip_runtime.h>
#include <hip/hip_cooperative_groups.h>
#include <cstdio>
#include <cstdint>
namespace cg = cooperative_groups;

typedef unsigned short us;
using bf16x8 = __attribute__((ext_vector_type(8))) short;
using f32x16 = __attribute__((ext_vector_type(16))) float;
using f32x4  = __attribute__((ext_vector_type(4))) float;
using u32x4  = __attribute__((ext_vector_type(4))) unsigned;
using u32x2  = __attribute__((ext_vector_type(2))) unsigned;
#define DI __device__ __forceinline__
#define MFMA(a, b, c) __builtin_amdgcn_mfma_f32_32x32x16_bf16((a), (b), (c), 0, 0, 0)

#ifndef REP_F3N
#define REP_F3N 1
#endif
#ifndef REP_F1N
#define REP_F1N 1
#endif
#ifndef REP_GEMM
#define REP_GEMM 1
#endif
#ifndef REP_M1
#define REP_M1 1
#endif
#ifndef REP_M3
#define REP_M3 1
#endif
#ifndef REP_ATT
#define REP_ATT 1
#endif
#ifndef REP_GLA3
#define REP_GLA3 1
#endif
#ifndef REP_S5C
#define REP_S5C 1
#endif
#ifndef REP_F2
#define REP_F2 1
#endif
#ifndef REP_P0
#define REP_P0 1
#endif
#ifndef EXTRA_SYNC
#define EXTRA_SYNC 0
#endif
constexpr int D = 1024, MX = 32768, MC = 1024, MT = MX + MC, INC = 2176, DFF = 2816, DFF2 = 5632;
constexpr int SEQ = 8448, NCHK = 132;
constexpr float EPS = 1e-6f;
constexpr float QSCALE = 0.10206207261596577f * 1.4426950408889634f;

constexpr size_t W_IN = 0, W_OUT = W_IN + (size_t)INC * D, W_UP = W_OUT + (size_t)D * D, W_DN = W_UP + (size_t)DFF2 * D,
                 W_UQ = W_DN + (size_t)D * DFF, W_UKV = W_UQ + 384 * 224, W_GLU = W_UKV + 512 * 96, W_SGU = W_GLU + 256 * 256,
                 W_CM = W_SGU + 4 * 128 * 128, W_WG = W_CM + 2 * 16 * 16 * 128, W_BM = W_WG + 2 * 256 * 16, W_LAYER = W_BM + 2 * 16 * 128 * 16;
constexpr size_t S_LAMB = 0, S_LAMT = 4096, S_BBAR = 8192, S_LAYER = 8192 + 65536;

constexpr size_t al256(size_t x) { return (x + 255) / 256 * 256; }
constexpr size_t OFF_WB = 0;
constexpr size_t OFF_S5F = al256(OFF_WB + 2 * W_LAYER * 2);
constexpr size_t OFF_MOD = al256(OFF_S5F + 2 * S_LAYER * 4);
constexpr size_t OFF_ROPE = al256(OFF_MOD + 2 * 5 * 6144 * 4);
constexpr size_t OFF_CTXS = al256(OFF_ROPE + 128 * 8 * 2 * 4);
constexpr size_t OFF_HX = al256(OFF_CTXS + (size_t)MC * D * 4);
constexpr size_t OFF_P = al256(OFF_HX + (size_t)MT * D * 2);
constexpr size_t OFF_MIXIN = al256(OFF_P + (size_t)MT * INC * 2);
constexpr size_t OFF_QB = al256(OFF_MIXIN + (size_t)MT * D * 2);
constexpr size_t OFF_KB = al256(OFF_QB + (size_t)16 * SEQ * 96 * 2);
constexpr size_t OFF_VT = al256(OFF_KB + (size_t)16 * SEQ * 96 * 2);
constexpr size_t OFF_KV = al256(OFF_VT + (size_t)16 * 64 * SEQ * 2);
constexpr size_t OFF_DEC = al256(OFF_KV + (size_t)4 * NCHK * 4 * 2 * 4096 * 4);
constexpr size_t OFF_HL = al256(OFF_DEC + (size_t)4 * NCHK * 4 * 2 * 64 * 4);
constexpr size_t OFF_Y = al256(OFF_HL + (size_t)4 * NCHK * 2 * 16 * 64 * 2 * 4);
constexpr size_t OFF_BAR = al256(OFF_Y + (size_t)MT * 256 * 2);
constexpr size_t OFF_SCHED = OFF_BAR + 3456 * 4;
constexpr size_t OFF_END = al256(OFF_SCHED + 1024 * 4);
constexpr size_t OFF_MIXOUT = OFF_P;
constexpr size_t OFF_ZPRE = OFF_P;
constexpr size_t OFF_ACT = OFF_MIXIN;
constexpr size_t OFF_FFNOUT = OFF_QB;
static_assert((size_t)MT * D * 4 <= (size_t)MT * INC * 2, "mixout alias");
static_assert((size_t)8448 * 1024 * 4 <= 2 * (size_t)16 * SEQ * 96 * 2, "ffnout alias");

struct Params { const float* in[36]; float* out; char* ws; };

DI float bf2f(us v) { return __uint_as_float(((unsigned)v) << 16); }
typedef float f32x2_ __attribute__((ext_vector_type(2)));
typedef __bf16 bf16x2_ __attribute__((ext_vector_type(2)));
DI unsigned pk2(float lo, float hi) { f32x2_ v = {lo, hi}; bf16x2_ b = __builtin_convertvector(v, bf16x2_); return __builtin_bit_cast(unsigned, b); }
DI us f2bf(float x) { return (us)(pk2(x, x) & 0xffffu); }
DI float lo_bf(unsigned w) { return __uint_as_float(w << 16); }
DI float hi_bf(unsigned w) { return __uint_as_float(w & 0xffff0000u); }
DI int tid512() { int t; asm volatile("v_mov_b32 %0, %1" : "=v"(t) : "v"(threadIdx.x)); return t; }
DI int tidx() { return tid512() & 255; }
DI int crow(int i, int hh) { return (i & 3) + 8 * (i >> 2) + 4 * hh; }
DI float sigmoidf_(float x) { return __builtin_amdgcn_rcpf(1.f + __expf(-x)); }
DI float gelu_t(float x) { float u = 0.7978845608028654f * (x + 0.044715f * x * x * x); return x * __builtin_amdgcn_rcpf(1.f + __expf(-2.f * u)); }
DI float silu_(float x) { return x * __builtin_amdgcn_rcpf(1.f + __expf(-x)); }
DI float logsig(float z) { return fminf(z, 0.f) - __logf(1.f + __expf(-fabsf(z))); }
DI void unpack8(u32x4 w, float* f) {
  f[0] = lo_bf(w[0]); f[1] = hi_bf(w[0]); f[2] = lo_bf(w[1]); f[3] = hi_bf(w[1]);
  f[4] = lo_bf(w[2]); f[5] = hi_bf(w[2]); f[6] = lo_bf(w[3]); f[7] = hi_bf(w[3]);
}
DI u32x4 pack8(const float* f) { u32x4 w = {pk2(f[0], f[1]), pk2(f[2], f[3]), pk2(f[4], f[5]), pk2(f[6], f[7])}; return w; }
DI long seqrow(int b, int s) { return s < 256 ? (long)MX + b * 256 + s : (long)b * 8192 + (s - 256); }
DI float wave_sum(float v) {
  v += __shfl_xor(v, 1); v += __shfl_xor(v, 2); v += __shfl_xor(v, 4); v += __shfl_xor(v, 8); v += __shfl_xor(v, 16); v += __shfl_xor(v, 32);
  return v;
}
DI const us* wl(const Params& p, int l) { return (const us*)(p.ws + OFF_WB) + (size_t)l * W_LAYER; }
DI const float* s5f(const Params& p, int l) { return (const float*)(p.ws + OFF_S5F) + (size_t)l * S_LAYER; }
DI const float* modv(const Params& p, int l, int v, int idx) { return (const float*)(p.ws + OFF_MOD) + ((size_t)(l * 5 + v) * 6 + idx) * 1024; }
DI float* stream_row(const Params& p, long m) { return m < MX ? p.out + m * 1024 : (float*)(p.ws + OFF_CTXS) + (m - MX) * 1024; }
DI const float* input_row(const Params& p, long m) { return m < MX ? p.in[0] + m * 1024 : p.in[2] + (m - MX) * 1024; }


#define XB_TMO      128
#define XB_XCNT(j)  (256  + 64 * (j))
#define XB_XSUB(j)  (1280 + 64 * (j))
#define XB_XGEN(j)  (2304 + 64 * (j))
#define XB_TOP      3328
#define XB_TOPGEN   3392
#define XCD_BAR_WORDS 3456
#define XB_SPIN_CAP (1u << 20)
#define LAS __attribute__((address_space(3)))
DI unsigned xb_ld(unsigned* p)              { return __hip_atomic_load(p, __ATOMIC_RELAXED, __HIP_MEMORY_SCOPE_AGENT); }
DI unsigned xb_add(unsigned* p, unsigned v) { return __hip_atomic_fetch_add(p, v, __ATOMIC_RELAXED, __HIP_MEMORY_SCOPE_AGENT); }
DI unsigned xb_xcc_id() { return (unsigned)__builtin_amdgcn_s_getreg((3 << 11) | 20) & 0xFu; }
#define XB_SPIN(cond, bar) do { unsigned _sp = 0; while (cond) { __builtin_amdgcn_s_sleep(1); \
    if ((++_sp & 255u) == 0u) { if (xb_ld(&(bar)[XB_TMO])) break; if (_sp > XB_SPIN_CAP) { atomicAdd(&(bar)[XB_TMO], 1u); break; } } } } while (0)
struct XcdBarrier { unsigned* bar; unsigned x; volatile LAS unsigned* st; };
DI XcdBarrier xcd_barrier_post(unsigned* bar, volatile LAS unsigned* st) {
  XcdBarrier b; b.bar = bar; b.x = (unsigned)__builtin_amdgcn_readfirstlane((int)xb_xcc_id()); b.st = st;
  if (threadIdx.x == 0) (void)xb_add(&bar[XB_XCNT(b.x)], 1u);
  return b;
}
DI void xcd_barrier_complete(unsigned* bar, unsigned x, unsigned& nloc, unsigned& nx) {
  const unsigned G = gridDim.x * gridDim.y * gridDim.z;
  unsigned sum, cnt, mine, sp = 0u;
  for (;;) {
    sum = 0u; cnt = 0u; mine = 0u;
#pragma unroll
    for (unsigned j = 0; j < 16; ++j) { const unsigned c = xb_ld(&bar[XB_XCNT(j)]); sum += c; cnt += (c > 0u) ? 1u : 0u; mine = (j == x) ? c : mine; }
    if (sum == G) break;
    __builtin_amdgcn_s_sleep(1);
    if ((++sp & 255u) == 0u) { if (xb_ld(&bar[XB_TMO])) break; if (sp > XB_SPIN_CAP) { atomicAdd(&bar[XB_TMO], 1u); break; } }
  }
  nloc = mine > 0u ? mine : 1u; nx = cnt > 0u ? cnt : 1u;
}
DI void xcd_barrier(const XcdBarrier& b) {
  asm volatile("s_waitcnt vmcnt(0)" ::: "memory");
  __syncthreads();
  if (threadIdx.x == 0) {
    unsigned* bar = b.bar;
    unsigned bx = b.x; asm volatile("" : "+s"(bx));
    __builtin_amdgcn_s_waitcnt(0);
    unsigned nloc = b.st[0], nx = b.st[1];
    if (nloc == 0u) { xcd_barrier_complete(bar, bx, nloc, nx); b.st[0] = nloc; b.st[1] = nx; }
    const unsigned old = xb_add(&bar[XB_XSUB(bx)], 1u);
    const unsigned gen = old / nloc;
    if (old + 1u == (gen + 1u) * nloc) {
      __builtin_amdgcn_fence(__ATOMIC_RELEASE, "agent");
      asm volatile("s_waitcnt vmcnt(0)" ::: "memory");
      const unsigned og = xb_add(&bar[XB_TOP], 1u);
      const unsigned tg = og / nx;
      if (og + 1u == (tg + 1u) * nx) xb_add(&bar[XB_TOPGEN], 1u);
      else XB_SPIN(xb_ld(&bar[XB_TOPGEN]) == tg, bar);
      __builtin_amdgcn_fence(__ATOMIC_ACQUIRE, "agent");
      xb_add(&bar[XB_XGEN(bx)], 1u);
      asm volatile("s_waitcnt vmcnt(0)" ::: "memory");
    } else {
      XB_SPIN(xb_ld(&bar[XB_XGEN(bx)]) == gen, bar);
      __builtin_amdgcn_fence(__ATOMIC_ACQUIRE, "agent");
      asm volatile("s_waitcnt vmcnt(0)" ::: "memory");
    }
  }
  __syncthreads();
}

DI void conv_tile(const float* src, us* dst, int K, int N, const float* scale, int tile, char* smem) {
  float* t = (float*)smem;
  const int tid = tidx(), tn = N / 128, tk = tile / tn, tc = tile % tn;
  __syncthreads();
  {
    const int k = tid >> 3, c4 = (tid & 7) * 4;
    const float s = scale ? scale[tk * 32 + k] : 1.f;
    const float* sp = src + (size_t)(tk * 32 + k) * N + tc * 128 + c4;
    f32x4 v0 = *(const f32x4*)(sp), v1 = *(const f32x4*)(sp + 32), v2 = *(const f32x4*)(sp + 64), v3 = *(const f32x4*)(sp + 96);
    float* tp = t + k * 129 + c4;
#pragma unroll
    for (int q = 0; q < 4; ++q) { tp[q] = v0[q] * s; tp[32 + q] = v1[q] * s; tp[64 + q] = v2[q] * s; tp[96 + q] = v3[q] * s; }
  }
  __syncthreads();
  {
    const int n = tid >> 1, k16 = (tid & 1) * 16; float f[16];
#pragma unroll
    for (int j = 0; j < 16; ++j) f[j] = t[(k16 + j) * 129 + n];
    us* dp = dst + (size_t)(tc * 128 + n) * K + tk * 32 + k16;
    *(u32x4*)dp = pack8(f); *(u32x4*)(dp + 8) = pack8(f + 8);
  }
}
constexpr int NCONV_LAYER = 32 * 17 + 32 * 8 + 32 * 44 + 88 * 8 + 7 * 3 + 3 * 4 + 8 * 2;
DI void conv_task(const Params& p, int it, char* smem) {
  int l = it / NCONV_LAYER; it -= l * NCONV_LAYER;
  us* wb = (us*)(p.ws + OFF_WB) + (size_t)l * W_LAYER;
  int nt;
  nt = 32 * 17;  if (it < nt) { conv_tile(p.in[10] + (size_t)l * 1024 * 2176, wb + W_IN, 1024, 2176, nullptr, it, smem); return; } it -= nt;
  nt = 32 * 8;   if (it < nt) { conv_tile(p.in[31] + (size_t)l * 1024 * 1024, wb + W_OUT, 1024, 1024, nullptr, it, smem); return; } it -= nt;
  nt = 32 * 44;  if (it < nt) { conv_tile(p.in[32] + (size_t)l * 1024 * 5632, wb + W_UP, 1024, 5632, nullptr, it, smem); return; } it -= nt;
  nt = 88 * 8;   if (it < nt) { conv_tile(p.in[35] + (size_t)l * 2816 * 1024, wb + W_DN, 2816, 1024, nullptr, it, smem); return; } it -= nt;
  nt = 7 * 3;    if (it < nt) { conv_tile(p.in[28] + (size_t)l * 224 * 384, wb + W_UQ, 224, 384, p.in[27] + l * 224, it, smem); return; } it -= nt;
  nt = 3 * 4;    if (it < nt) { conv_tile(p.in[30] + (size_t)l * 96 * 512, wb + W_UKV, 96, 512, p.in[29] + l * 96, it, smem); return; } it -= nt;
  conv_tile(p.in[25] + (size_t)l * 256 * 256, wb + W_GLU, 256, 256, nullptr, it, smem);
}
DI void mod_task(const Params& p, int it, char* smem) {
  float* sc = (float*)smem;
  float* red = sc + 5 * 1024;
  const int tid = tidx(), l = it / 192, jb = it % 192;
  __syncthreads();
  for (int e = tid; e < 5 * 1024; e += 256) {
    int v = e >> 10, k = e & 1023; float c = v < 4 ? p.in[1][v * 1024 + k] : p.in[3][k];
    sc[e] = silu_(c);
  }
  __syncthreads();
  const int col = tid & 31, ks = tid >> 5;
  const float* w = p.in[4] + (size_t)l * 1024 * 6144 + jb * 32 + col;
  float a0 = 0, a1 = 0, a2 = 0, a3 = 0, a4 = 0;
#pragma unroll 8
  for (int k = ks * 128; k < ks * 128 + 128; ++k) {
    float wv = w[(size_t)k * 6144];
    a0 += sc[k] * wv; a1 += sc[1024 + k] * wv; a2 += sc[2048 + k] * wv; a3 += sc[3072 + k] * wv; a4 += sc[4096 + k] * wv;
  }
  float* rp = red + (ks * 32 + col) * 5;
  rp[0] = a0; rp[1] = a1; rp[2] = a2; rp[3] = a3; rp[4] = a4;
  __syncthreads();
  if (tid < 160) {
    int v = tid >> 5, c = tid & 31; float s = 0;
    for (int q = 0; q < 8; ++q) s += red[(q * 32 + c) * 5 + v];
    int j = jb * 32 + c;
    ((float*)(p.ws + OFF_MOD))[(size_t)(l * 5 + v) * 6144 + j] = s + p.in[5][l * 6144 + j];
  }
}
DI void s5pre_task(const Params& p, int it) {
  int gid = it * 256 + tidx();
  int pp = gid & 63, g = (gid >> 6) & 15, d = (gid >> 10) & 1, l = gid >> 11;
  int idx = ((l * 2 + d) * 16 + g) * 64 + pp;
  float are = p.in[17][idx], aim = p.in[18][idx];
  float dt = expf(p.in[19][(l * 2 + d) * 16 + g]);
  float mag = expf(are * dt), lr = mag * cosf(aim * dt), li = mag * sinf(aim * dt);
  float magT = expf(are * dt * 64.f), tr = magT * cosf(aim * dt * 64.f), ti = magT * sinf(aim * dt * 64.f);
  float nr = lr - 1.f, ni = li, den = are * are + aim * aim;
  float cr = (nr * are + ni * aim) / den, ci = (ni * are - nr * aim) / den;
  float* sf = (float*)(p.ws + OFF_S5F) + (size_t)l * S_LAYER;
  int o2 = ((d * 16 + g) * 64 + pp);
  sf[S_LAMB + o2 * 2] = lr; sf[S_LAMB + o2 * 2 + 1] = li;
  sf[S_LAMT + o2 * 2] = tr; sf[S_LAMT + o2 * 2 + 1] = ti;
  for (int i = 0; i < 16; ++i) {
    float br = p.in[20][(size_t)idx * 16 + i], bi = p.in[21][(size_t)idx * 16 + i];
    sf[S_BBAR + ((size_t)o2 * 16 + i) * 2] = cr * br - ci * bi;
    sf[S_BBAR + ((size_t)o2 * 16 + i) * 2 + 1] = cr * bi + ci * br;
    us* bm = (us*)(p.ws + OFF_WB) + (size_t)l * W_LAYER + W_BM + (size_t)(d * 16 + g) * 128 * 16;
    bm[pp * 16 + i] = f2bf(cr * br - ci * bi);
    bm[(64 + pp) * 16 + i] = f2bf(cr * bi + ci * br);
  }
  us* cm = (us*)(p.ws + OFF_WB) + (size_t)l * W_LAYER + W_CM;
  for (int o = 0; o < 16; ++o) {
    size_t ci_ = ((size_t)((l * 2 + d) * 16 + g) * 16 + o) * 64 + pp;
    cm[((size_t)(d * 16 + g) * 16 + o) * 128 + pp] = f2bf(p.in[22][ci_]);
    cm[((size_t)(d * 16 + g) * 16 + o) * 128 + 64 + pp] = f2bf(-p.in[23][ci_]);
  }
}
DI void rope_task(const Params& p, int it) {
  int gid = it * 256 + tidx();
  int pos = gid >> 3, f = gid & 7;
  float inv = powf(10000.f, -(float)f / 8.f), ang = (float)pos * inv;
  float* r = (float*)(p.ws + OFF_ROPE);
  r[gid * 2] = cosf(ang); r[gid * 2 + 1] = sinf(ang);
}
DI void wgt_task(const Params& p, int it) {
  int gid = it * 256 + tidx();
  int rr = gid & 15, c = (gid >> 4) & 255, d = (gid >> 12) & 1, l = gid >> 13;
  ((us*)(p.ws + OFF_WB))[(size_t)l * W_LAYER + W_WG + (d * 256 + c) * 16 + rr] = f2bf(p.in[14][((l * 2 + d) * 16 + rr) * 256 + c]);
}
DI void sguw_task(const Params& p, int it) {
  int gid = it * 256 + tidx();
  int l = gid >> 14, e = (gid & 16383) * 4;
  f32x4 v = *(const f32x4*)(p.in[12] + (size_t)l * 65536 + e);
  u32x2 w = {pk2(v[0], v[1]), pk2(v[2], v[3])};
  *(u32x2*)((us*)(p.ws + OFF_WB) + (size_t)l * W_LAYER + W_SGU + e) = w;
}

template <int MODE>
DI void row_task(const Params& p, int l, long m, const us* yrow) {
  const int lane = tidx() & 63, v = m < MX ? (int)(m >> 13) : 4;
  float x[16];
  if (MODE == 0) {
    const float* src = input_row(p, m);
#pragma unroll
    for (int j = 0; j < 4; ++j) { f32x4 t = *(const f32x4*)(src + (j * 64 + lane) * 4); x[4 * j] = t[0]; x[4 * j + 1] = t[1]; x[4 * j + 2] = t[2]; x[4 * j + 3] = t[3]; }
  } else {
    float y[16]; float ss = 0;
    const float* xo = (MODE == 1 && l == 0) ? input_row(p, m) : stream_row(p, m);
#pragma unroll
    for (int j = 0; j < 4; ++j) {
      u32x2 t = *(const u32x2*)(yrow + (j * 64 + lane) * 4); y[4 * j] = lo_bf(t[0]); y[4 * j + 1] = hi_bf(t[0]); y[4 * j + 2] = lo_bf(t[1]); y[4 * j + 3] = hi_bf(t[1]);
      f32x4 u = *(const f32x4*)(xo + (j * 64 + lane) * 4); x[4 * j] = u[0]; x[4 * j + 1] = u[1]; x[4 * j + 2] = u[2]; x[4 * j + 3] = u[3];
    }
#pragma unroll
    for (int j = 0; j < 16; ++j) ss += y[j] * y[j];
    ss = wave_sum(ss);
    float rstd = rsqrtf(ss * (1.f / 1024.f) + EPS);
    const float* gp = (MODE == 1 ? p.in[7] : p.in[9]) + l * 1024;
    const float* gt = modv(p, l, v, MODE == 1 ? 2 : 5);
    float* dst = stream_row(p, m);
#pragma unroll
    for (int j = 0; j < 4; ++j) {
      int c = (j * 64 + lane) * 4;
      f32x4 g4 = *(const f32x4*)(gp + c), t4 = *(const f32x4*)(gt + c), o;
#pragma unroll
      for (int q = 0; q < 4; ++q) { x[4 * j + q] += t4[q] * (y[4 * j + q] * rstd * g4[q]); o[q] = x[4 * j + q]; }
      *(f32x4*)(dst + c) = o;
    }
    if (MODE == 2 && l == 1) return;
  }
  const int ln = (MODE == 2) ? 1 : l;
  const float* g = (MODE == 1 ? p.in[8] : p.in[6]) + ln * 1024;
  const float* sh = modv(p, ln, v, MODE == 1 ? 3 : 0);
  const float* sc = modv(p, ln, v, MODE == 1 ? 4 : 1);
  float ss = 0;
#pragma unroll
  for (int j = 0; j < 16; ++j) ss += x[j] * x[j];
  ss = wave_sum(ss);
  float rstd = rsqrtf(ss * (1.f / 1024.f) + EPS);
  us* hx = (us*)(p.ws + OFF_HX) + m * 1024;
#pragma unroll
  for (int j = 0; j < 4; ++j) {
    int c = (j * 64 + lane) * 4;
    f32x4 g4 = *(const f32x4*)(g + c), s4 = *(const f32x4*)(sh + c), c4 = *(const f32x4*)(sc + c); float h[4];
#pragma unroll
    for (int q = 0; q < 4; ++q) h[q] = (x[4 * j + q] * rstd * g4[q]) * (1.f + c4[q]) + s4[q];
    u32x2 w = {pk2(h[0], h[1]), pk2(h[2], h[3])};
    *(u32x2*)(hx + c) = w;
  }
}

struct GArgs { const us* A; int lda; const us* W; int K; long m0; int n0; void* out; int ldo; int l; };
template <int BK, int EPI, bool ROWSS>
DI void gemm_tile(const Params& p, const GArgs& g, char* smem) {
  constexpr int LS = BK + 8, CPR = BK / 8, NCH = 128 * CPR / 256;
  us* sA = (us*)smem; us* sB = sA + 2 * 128 * LS; float* rstd = (float*)(sB + 2 * 128 * LS);
  const int tid = tidx(), w = tid >> 6, lane = tid & 63, r = lane & 31, hh = lane >> 5, wm = w >> 1, wn = w & 1;
  __syncthreads();
  if (ROWSS) {
    int row = tid >> 1, half = tid & 1; float ss = 0;
    const us* ap = g.A + (size_t)row * g.lda + half * (g.K / 2);
    for (int c = 0; c < g.K / 16; ++c) { float f[8]; unpack8(*(const u32x4*)(ap + c * 8), f);
#pragma unroll
      for (int j = 0; j < 8; ++j) ss += f[j] * f[j]; }
    ss += __shfl_xor(ss, 1);
    if (!half) rstd[row] = rsqrtf(ss / (float)g.K + EPS);
  }
  u32x4 ra[NCH], rb[NCH];
  f32x16 acc[2][2];
#pragma unroll
  for (int i = 0; i < 2; ++i)
#pragma unroll
    for (int j = 0; j < 2; ++j)
#pragma unroll
      for (int q = 0; q < 16; ++q) acc[i][j][q] = 0.f;
#define GLOAD(kt) _Pragma("unroll") for (int j = 0; j < NCH; ++j) { int q = tid + 256 * j, row = q / CPR, cc = q % CPR; \
    ra[j] = *(const u32x4*)(g.A + (size_t)row * g.lda + (kt) * BK + cc * 8); rb[j] = *(const u32x4*)(g.W + (size_t)row * g.K + (kt) * BK + cc * 8); }
#define SWRITE(buf) _Pragma("unroll") for (int j = 0; j < NCH; ++j) { int q = tid + 256 * j, row = q / CPR, cc = q % CPR; \
    *(u32x4*)(sA + (buf) * 128 * LS + row * LS + cc * 8) = ra[j]; *(u32x4*)(sB + (buf) * 128 * LS + row * LS + cc * 8) = rb[j]; }
  GLOAD(0); SWRITE(0); __syncthreads();
  const int KT = g.K / BK;
  for (int kt = 0; kt < KT; ++kt) {
    if (kt + 1 < KT) { GLOAD(kt + 1); }
    const us* a0 = sA + (kt & 1) * 128 * LS + (wm * 64 + r) * LS + hh * 8;
    const us* b0 = sB + (kt & 1) * 128 * LS + (wn * 64 + r) * LS + hh * 8;
#pragma unroll
    for (int ks = 0; ks < BK / 16; ++ks) {
      bf16x8 af0 = *(const bf16x8*)(a0 + ks * 16), af1 = *(const bf16x8*)(a0 + 32 * LS + ks * 16);
      bf16x8 bf0 = *(const bf16x8*)(b0 + ks * 16), bf1 = *(const bf16x8*)(b0 + 32 * LS + ks * 16);
      acc[0][0] = MFMA(af0, bf0, acc[0][0]); acc[0][1] = MFMA(af0, bf1, acc[0][1]);
      acc[1][0] = MFMA(af1, bf0, acc[1][0]); acc[1][1] = MFMA(af1, bf1, acc[1][1]);
    }
    if (kt + 1 < KT) { SWRITE((kt + 1) & 1); }
    __syncthreads();
  }
#undef GLOAD
#undef SWRITE
#pragma unroll
  for (int si = 0; si < 2; ++si)
#pragma unroll
    for (int sj = 0; sj < 2; ++sj) {
      const int col = wn * 64 + sj * 32 + r, n = g.n0 + col;
#pragma unroll
      for (int i = 0; i < 16; ++i) {
        const int row = wm * 64 + si * 32 + crow(i, hh);
        const long m = g.m0 + row;
        float v = acc[si][sj][i];
        if (EPI == 0) { ((us*)g.out)[m * g.ldo + n] = f2bf(v); }
        else if (EPI == 1) { ((float*)g.out)[m * g.ldo + n] = v; }
        else if (EPI == 2) {
          v *= rstd[row] * QSCALE;
          float pv = __shfl_xor(v, 8);
          const int head = n / 96, j = n - head * 96;
          const bool isx = m < MX; const int t = isx ? (int)(m & 8191) : (int)((m - MX) & 255);
          const int b = isx ? (int)(m >> 13) : (int)((m - MX) >> 8);
          if (isx && j >= 64) {
            int jj = (j - 64) & 15, blk = (j - 64) >> 4, f = jj & 7, pos = blk ? (t & 63) : (t >> 6);
            const float* rp = (const float*)(p.ws + OFF_ROPE) + (pos * 8 + f) * 2; float cs = rp[0], sn = rp[1];
            v = (jj < 8) ? v * cs - pv * sn : pv * sn + v * cs;
          }
          const int s = isx ? 256 + t : t;
          ((us*)(p.ws + OFF_QB))[((size_t)(b * 4 + head) * SEQ + s) * 96 + j] = f2bf(v);
        } else if (EPI == 3) {
          v *= rstd[row];
          const int head = n >> 7, j = n & 127;
          const bool isx = m < MX; const int t = isx ? (int)(m & 8191) : (int)((m - MX) & 255);
          const int b = isx ? (int)(m >> 13) : (int)((m - MX) >> 8);
          const int s = isx ? 256 + t : t;
          if (j < 64) ((us*)(p.ws + OFF_KB))[((size_t)(b * 4 + head) * SEQ + s) * 96 + j] = f2bf(v);
          else if ((i & 3) == 3) {
            const float r1 = rstd[row - 1], r2 = rstd[row - 2], r3 = rstd[row - 3];
            u32x2 w2 = {pk2(acc[si][sj][i - 3] * r3, acc[si][sj][i - 2] * r2), pk2(acc[si][sj][i - 1] * r1, v)};
            *(u32x2*)((us*)(p.ws + OFF_VT) + ((size_t)(b * 4 + head) * 64 + (j - 64)) * SEQ + s - 3) = w2;
          }
        } else if (EPI == 4) {
          float y = bf2f(((const us*)(p.ws + OFF_Y))[m * 256 + n]);
          v += p.in[26][g.l * 256 + n];
          ((us*)(p.ws + OFF_MIXIN))[m * 1024 + 512 + n] = f2bf(y * sigmoidf_(v));
        }
      }
    }
}


using f32x4_ = __attribute__((ext_vector_type(4))) float;
#define MFMA16(a, b, c) __builtin_amdgcn_mfma_f32_16x16x32_bf16((a), (b), (c), 0, 0, 0)
DI void gemm_big(const GArgs& g, int ncv, char* smem) {
  constexpr int ST = 256 * 64;
  us* sA = (us*)smem; us* sB = sA + 2 * ST;
  const int tid = tid512(), w = tid >> 6, lane = tid & 63, l16 = lane & 15, lq = lane >> 4, wm = w >> 2, wn = w & 3;
  u32x4 ra[4], rb[4];
  f32x4_ acc[8][4];
#pragma unroll
  for (int i = 0; i < 8; ++i)
#pragma unroll
    for (int j = 0; j < 4; ++j) { acc[i][j][0] = 0.f; acc[i][j][1] = 0.f; acc[i][j][2] = 0.f; acc[i][j][3] = 0.f; }
  const int srow = tid >> 3, sch = tid & 7;
  const us* gA = g.A + (size_t)srow * g.lda + sch * 8;
  const us* gB = g.W + (size_t)srow * g.K + sch * 8;
  const int swr = srow * 64 + ((sch ^ (srow & 7)) << 3);
#define GLOAD(kt) { _Pragma("unroll") for (int j = 0; j < 4; ++j) { ra[j] = *(const u32x4*)(gA + (size_t)(64 * j) * g.lda + (kt) * 64); rb[j] = *(const u32x4*)(gB + (size_t)(64 * j) * g.K + (kt) * 64); } }
#define SWRITE(buf) { _Pragma("unroll") for (int j = 0; j < 4; ++j) { *(u32x4*)(sA + (buf) * ST + swr + j * 4096) = ra[j]; *(u32x4*)(sB + (buf) * ST + swr + j * 4096) = rb[j]; } }
  const int KT = g.K / 64;
  const bool act = wn * 64 < ncv;
  const int fo0 = l16 * 64 + ((lq ^ (l16 & 7)) << 3), fo1 = l16 * 64 + (((4 + lq) ^ (l16 & 7)) << 3);
  __syncthreads();
  GLOAD(0); SWRITE(0); GLOAD(KT > 1 ? 1 : 0);
  for (int kt = 0; kt < KT; ++kt) {
    __syncthreads();
    SWRITE((kt + 1) & 1);
    { const int kl = kt + 2 < KT ? kt + 2 : KT - 1; GLOAD(kl); }
    if (act) {
      const us* a0 = sA + (kt & 1) * ST + wm * 128 * 64;
      const us* b0 = sB + (kt & 1) * ST + wn * 64 * 64;
#pragma unroll
      for (int ks = 0; ks < 2; ++ks) {
        const int fo = ks ? fo1 : fo0;
        bf16x8 fb[4];
#pragma unroll
        for (int j = 0; j < 4; ++j) fb[j] = *(const bf16x8*)(b0 + j * 1024 + fo);
#pragma unroll
        for (int i = 0; i < 8; ++i) {
          bf16x8 fa = *(const bf16x8*)(a0 + i * 1024 + fo);
#pragma unroll
          for (int j = 0; j < 4; ++j) acc[i][j] = MFMA16(fb[j], fa, acc[i][j]);
        }
      }
    }
  }
#undef GLOAD
#undef SWRITE
  __syncthreads();
  {
    us* sC = (us*)smem; constexpr int CS = 264;
    if (act) {
#pragma unroll
      for (int i = 0; i < 8; ++i)
#pragma unroll
        for (int j = 0; j < 4; ++j) {
          u32x2 w2 = {pk2(acc[i][j][0], acc[i][j][1]), pk2(acc[i][j][2], acc[i][j][3])};
          *(u32x2*)(sC + (wm * 128 + i * 16 + l16) * CS + wn * 64 + j * 16 + lq * 4) = w2;
        }
    }
    __syncthreads();
    us* outp = (us*)g.out + (size_t)g.m0 * g.ldo + g.n0;
#pragma unroll 4
    for (int k = 0; k < 16; ++k) {
      const int q = tid + 512 * k, row = q >> 5, cc = q & 31;
      if (cc * 8 < ncv) *(u32x4*)(outp + (size_t)row * g.ldo + cc * 8) = *(const u32x4*)(sC + row * CS + cc * 8);
    }
  }
}

DI int lds_byte8(int r, int c) { int st = (r >> 4) * 2 + (c >> 5), rr = r & 15, cc = c & 31, ob = rr * 64 + cc * 2; return st * 1024 + (ob ^ (((ob >> 9) & 1) << 5)); }
DI void stage_rc8(int b, int& R, int& C) { int st = b / 1024, sb = b % 1024, swz = sb ^ (((sb >> 9) & 1) << 5); R = (st >> 1) * 16 + swz / 64; C = (st & 1) * 32 + (swz % 64) / 2; }
DI void gemm_8p(const GArgs& g, char* smem) {
  constexpr int BK8 = 64, HALF8 = 128, HT8 = HALF8 * BK8;
  us* shm = (us*)smem;
  const int tid = tid512();
  const us* __restrict__ A = g.A; const us* __restrict__ Bt = g.W;
  const unsigned lda = (unsigned)g.lda, ldb = (unsigned)g.K;
#define SA8(b, h) (shm + ((b) * 2 + (h)) * HT8)
#define SB8(b, h) (shm + (4 + (b) * 2 + (h)) * HT8)
#define STAGE8(P, BASE, LD, br, kt) do { const unsigned _g = (unsigned)(br) * (unsigned)(LD) + (unsigned)(kt) * BK8; \
    for (int _i = 0; _i < 2; ++_i) { int _b = tid * 16 + _i * 8192; int _r, _c; stage_rc8(_b, _r, _c); \
      __builtin_amdgcn_global_load_lds((const unsigned*)((BASE) + (size_t)(_g + (unsigned)_r * (unsigned)(LD) + (unsigned)_c)), \
        (__attribute__((address_space(3))) unsigned*)((char*)(P) + _b), 16, 0, 0); } } while (0)
#define LDA8(dst, b, h) for (int m = 0; m < 4; ++m) for (int k = 0; k < 2; ++k) \
    dst[m][k] = *reinterpret_cast<const bf16x8*>((char*)SA8(b, h) + lds_byte8(wr * 64 + m * 16 + fr, k * 32 + fq * 8))
#define LDB8(dst, b, h) for (int n = 0; n < 2; ++n) for (int k = 0; k < 2; ++k) \
    dst[n][k] = *reinterpret_cast<const bf16x8*>((char*)SB8(b, h) + lds_byte8(wc * 32 + n * 16 + fr, k * 32 + fq * 8))
#define MMA8(ai, bj, At_, Bt_) do { __builtin_amdgcn_s_setprio(1); \
    for (int m = 0; m < 4; ++m) for (int n = 0; n < 2; ++n) for (int k = 0; k < 2; ++k) \
      acc[ai][bj][m][n] = __builtin_amdgcn_mfma_f32_16x16x32_bf16(Bt_[n][k], At_[m][k], acc[ai][bj][m][n], 0, 0, 0); \
    __builtin_amdgcn_s_setprio(0); } while (0)
#define WAIT_V(n) asm volatile("s_waitcnt vmcnt(" #n ")" ::: "memory")
#define WAIT_L(n) asm volatile("s_waitcnt lgkmcnt(" #n ")" ::: "memory")
#define BAR8 __builtin_amdgcn_s_barrier()
#define SCHED8 __builtin_amdgcn_sched_barrier(0)
  const int wid = tid >> 6, lane = tid & 63, wr = wid >> 2, wc = wid & 3, fr = lane & 15, fq = lane >> 4;
  f32x4_ acc[2][2][4][2];
#pragma unroll
  for (int a_ = 0; a_ < 2; ++a_)
#pragma unroll
    for (int b_ = 0; b_ < 2; ++b_)
#pragma unroll
      for (int m = 0; m < 4; ++m)
#pragma unroll
        for (int n = 0; n < 2; ++n) acc[a_][b_][m][n] = (f32x4_){0.f, 0.f, 0.f, 0.f};
  bf16x8 At[4][2], B0[2][2], B1[2][2];
  const int nt = g.K / BK8;
  __syncthreads();
  STAGE8(SB8(0, 0), Bt, ldb, 0, 0); STAGE8(SA8(0, 0), A, lda, 0, 0);
  STAGE8(SB8(0, 1), Bt, ldb, HALF8, 0); STAGE8(SA8(0, 1), A, lda, HALF8, 0);
  if (wr == 1) BAR8;
  WAIT_V(4); BAR8;
  STAGE8(SB8(1, 0), Bt, ldb, 0, 1); STAGE8(SA8(1, 0), A, lda, 0, 1); STAGE8(SB8(1, 1), Bt, ldb, HALF8, 1);
  WAIT_V(6); BAR8;
  for (int t = 0; t < nt - 2; t += 2) {
    LDB8(B0, 0, 0); SCHED8; LDA8(At, 0, 0); STAGE8(SA8(1, 1), A, lda, HALF8, t + 1);
    WAIT_L(8); BAR8; WAIT_L(0); MMA8(0, 0, At, B0); BAR8; SCHED8;
    LDB8(B1, 0, 1); STAGE8(SB8(0, 0), Bt, ldb, 0, t + 2);
    BAR8; WAIT_L(0); MMA8(0, 1, At, B1); BAR8;
    LDA8(At, 0, 1); STAGE8(SA8(0, 0), A, lda, 0, t + 2);
    BAR8; WAIT_L(0); MMA8(1, 0, At, B0); BAR8; SCHED8;
    STAGE8(SB8(0, 1), Bt, ldb, HALF8, t + 2);
    WAIT_V(6); BAR8; MMA8(1, 1, At, B1); BAR8;
    LDB8(B0, 1, 0); SCHED8; LDA8(At, 1, 0); STAGE8(SA8(0, 1), A, lda, HALF8, t + 2);
    WAIT_L(8); BAR8; WAIT_L(0); MMA8(0, 0, At, B0); BAR8; SCHED8;
    LDB8(B1, 1, 1); STAGE8(SB8(1, 0), Bt, ldb, 0, t + 3);
    BAR8; WAIT_L(0); MMA8(0, 1, At, B1); BAR8;
    LDA8(At, 1, 1); STAGE8(SA8(1, 0), A, lda, 0, t + 3);
    BAR8; WAIT_L(0); MMA8(1, 0, At, B0); BAR8; SCHED8;
    STAGE8(SB8(1, 1), Bt, ldb, HALF8, t + 3);
    WAIT_V(6); BAR8; MMA8(1, 1, At, B1); BAR8;
  }
  { LDB8(B0, 0, 0); LDA8(At, 0, 0); STAGE8(SA8(1, 1), A, lda, HALF8, nt - 1);
    BAR8; WAIT_L(0); MMA8(0, 0, At, B0); BAR8;
    LDB8(B1, 0, 1); BAR8; WAIT_L(0); MMA8(0, 1, At, B1); BAR8;
    LDA8(At, 0, 1); WAIT_V(4); BAR8; WAIT_L(0); MMA8(1, 0, At, B0); MMA8(1, 1, At, B1); BAR8; }
  { LDB8(B0, 1, 0); LDA8(At, 1, 0); WAIT_V(2); BAR8; WAIT_L(0); MMA8(0, 0, At, B0); BAR8;
    LDB8(B1, 1, 1); WAIT_V(0); BAR8; WAIT_L(0); MMA8(0, 1, At, B1); BAR8;
    LDA8(At, 1, 1); BAR8; WAIT_L(0); MMA8(1, 0, At, B0); MMA8(1, 1, At, B1); BAR8; }
  if (wr == 0) BAR8;
  __syncthreads();
  {
    us* sC = (us*)smem; constexpr int CS = 264;
    const int tid = tid512(), wid = tid >> 6, lane = tid & 63, wr = wid >> 2, wc = wid & 3, fr = lane & 15, fq = lane >> 4;
#pragma unroll
    for (int ai = 0; ai < 2; ++ai)
#pragma unroll
      for (int bj = 0; bj < 2; ++bj)
#pragma unroll
        for (int m = 0; m < 4; ++m)
#pragma unroll
          for (int n = 0; n < 2; ++n) {
            const f32x4_ v = acc[ai][bj][m][n];
            u32x2 w2 = {pk2(v[0], v[1]), pk2(v[2], v[3])};
            *(u32x2*)(sC + (ai * 128 + wr * 64 + m * 16 + fr) * CS + bj * 128 + wc * 32 + n * 16 + fq * 4) = w2;
          }
    __syncthreads();
    us* outp = (us*)g.out + (size_t)g.m0 * g.ldo + g.n0;
#pragma unroll 4
    for (int k = 0; k < 16; ++k) {
      const int q = tid + 512 * k, row = q >> 5, cc = q & 31;
      *(u32x4*)(outp + (size_t)row * g.ldo + cc * 8) = *(const u32x4*)(sC + row * CS + cc * 8);
    }
  }
#undef SA8
#undef SB8
#undef STAGE8
#undef LDA8
#undef LDB8
#undef MMA8
#undef WAIT_V
#undef WAIT_L
#undef BAR8
#undef SCHED8
}

template <class F>
DI void for_tiles_xcd(int RT, int CT, int G, int bid, F f) {
  if ((G & 7) == 0) {
    const int x = bid & 7, rows = (RT - x + 7) >> 3, n = rows * CT, nfull = CT >> 3;
    for (int j = bid >> 3; j < n; j += G >> 3) {
      int rl, ct;
      if (j < nfull * rows * 8) { int pnl = j / (rows * 8), rem = j - pnl * rows * 8; rl = rem >> 3; ct = pnl * 8 + (rem & 7); }
      else { int j2 = j - nfull * rows * 8, wd = CT - nfull * 8; rl = j2 / wd; ct = nfull * 8 + (j2 - rl * wd); }
      f(rl * 8 + x, ct);
    }
  } else {
    for (int it = bid; it < RT * CT; it += G) f(it / CT, it % CT);
  }
}

DI void kr_task(const Params& p, long m0) {
  const int tid = tidx(), row = tid >> 1, blk = tid & 1; const long m = m0 + row;
  const us* src = (const us*)(p.ws + OFF_P) + m * INC + 2144 + blk * 16;
  float v[16], o[16]; unpack8(*(const u32x4*)src, v); unpack8(*(const u32x4*)(src + 8), v + 8);
  const bool isx = m < MX; const int t = isx ? (int)(m & 8191) : (int)((m - MX) & 255);
  const int b = isx ? (int)(m >> 13) : (int)((m - MX) >> 8), s = isx ? 256 + t : t;
  if (isx) {
    int pos = blk ? (t & 63) : (t >> 6);
    const float* rp = (const float*)(p.ws + OFF_ROPE) + pos * 16;
#pragma unroll
    for (int f = 0; f < 8; ++f) { float cs = rp[2 * f], sn = rp[2 * f + 1]; o[f] = v[f] * cs - v[f + 8] * sn; o[f + 8] = v[f] * sn + v[f + 8] * cs; }
  } else {
#pragma unroll
    for (int f = 0; f < 16; ++f) o[f] = v[f];
  }
  u32x4 w0 = pack8(o), w1 = pack8(o + 8);
#pragma unroll
  for (int hd = 0; hd < 4; ++hd) {
    us* dst = (us*)(p.ws + OFF_KB) + ((size_t)(b * 4 + hd) * SEQ + s) * 96 + 64 + blk * 16;
    *(u32x4*)dst = w0; *(u32x4*)(dst + 8) = w1;
  }
}

DI void sgu_task(const Params& p, int l, int chunk, int h, char* smem) {
  us* Vt = (us*)smem;
  const int tid = tidx(), w = tid >> 6, lane = tid & 63, r = lane & 31, hh = lane >> 5;
  const long m0 = (long)chunk * 128;
  const us* P = (const us*)(p.ws + OFF_P);
  __syncthreads();
  {
    int row = tid >> 1, dh = (tid & 1) * 32; float v[32]; float ss = 0;
    const us* src = P + (m0 + row) * INC + 256 + h * 64 + dh;
#pragma unroll
    for (int c = 0; c < 4; ++c) unpack8(*(const u32x4*)(src + c * 8), v + c * 8);
#pragma unroll
    for (int j = 0; j < 32; ++j) { v[j] = gelu_t(v[j]); ss += v[j] * v[j]; }
    ss += __shfl_xor(ss, 1);
    float rstd = rsqrtf(ss * (1.f / 64.f) + EPS);
    const float* gn = p.in[11] + l * 256 + h * 64 + dh;
#pragma unroll
    for (int j = 0; j < 32; ++j) Vt[(dh + j) * 136 + row] = f2bf(v[j] * rstd * gn[j]);
  }
  __syncthreads();
  const us* Wsp = wl(p, l) + W_SGU + (size_t)h * 16384 + (size_t)(w * 32 + r) * 128 + hh * 8;
  f32x16 a0, a1;
#pragma unroll
  for (int q = 0; q < 16; ++q) { a0[q] = 0.f; a1[q] = 0.f; }
#pragma unroll
  for (int ks = 0; ks < 8; ++ks) {
    bf16x8 af = *(const bf16x8*)(Wsp + ks * 16);
    bf16x8 b0 = *(const bf16x8*)(Vt + r * 136 + ks * 16 + hh * 8), b1 = *(const bf16x8*)(Vt + (32 + r) * 136 + ks * 16 + hh * 8);
    a0 = MFMA(af, b0, a0); a1 = MFMA(af, b1, a1);
  }
  us* out = (us*)(p.ws + OFF_MIXIN);
#pragma unroll
  for (int i = 0; i < 16; ++i) {
    int t = w * 32 + crow(i, hh); float bs = p.in[13][l * 512 + h * 128 + t];
    const us* pu = P + (m0 + t) * INC + h * 64;
    float u0 = gelu_t(bf2f(pu[r])), u1 = gelu_t(bf2f(pu[32 + r]));
    out[(m0 + t) * 1024 + h * 64 + r] = f2bf(u0 * (a0[i] + bs));
    out[(m0 + t) * 1024 + h * 64 + 32 + r] = f2bf(u1 * (a1[i] + bs));
  }
}

DI void gla_gate_dir(const Params& p, int l, const us* Prow0, int h, int d, float* sW, float* G) {
  const int tid = tidx(), w = tid >> 6, lane = tid & 63, r = lane & 31, hh = lane >> 5, mt = w >> 1, nt = w & 1;
  {
    const bf16x8 a = *(const bf16x8*)(Prow0 + (size_t)(mt * 32 + r) * INC + 1536 + d * 16 + hh * 8);
    const bf16x8 bw = *(const bf16x8*)(wl(p, l) + W_WG + (size_t)(d * 256 + h * 64 + nt * 32 + r) * 16 + hh * 8);
    f32x16 z;
#pragma unroll
    for (int q = 0; q < 16; ++q) z[q] = 0.f;
    z = MFMA(a, bw, z);
    const float bg = p.in[15][l * 512 + d * 256 + h * 64 + nt * 32 + r];
#pragma unroll
    for (int i = 0; i < 16; ++i) G[(mt * 32 + crow(i, hh)) * 64 + nt * 32 + r] = logsig(z[i] + bg) * (1.f / 16.f);
  }
  __syncthreads();
  {
    const int ch = tid & 63, seg = tid >> 6;
    float v[16];
#pragma unroll
    for (int k = 0; k < 16; ++k) v[k] = G[(seg * 16 + k) * 64 + ch];
    if (d == 0) {
#pragma unroll
      for (int k = 1; k < 16; ++k) v[k] += v[k - 1];
      sW[seg * 64 + ch] = v[15];
    } else {
#pragma unroll
      for (int k = 14; k >= 0; --k) v[k] += v[k + 1];
      sW[seg * 64 + ch] = v[0];
    }
    __syncthreads();
    float off = 0.f;
    if (d == 0) { for (int q = 0; q < 3; ++q) off += (q < seg) ? sW[q * 64 + ch] : 0.f; }
    else { for (int q = 1; q < 4; ++q) off += (q > seg) ? sW[q * 64 + ch] : 0.f; }
#pragma unroll
    for (int k = 0; k < 16; ++k) G[(seg * 16 + k) * 64 + ch] = v[k] + off;
  }
  __syncthreads();
}
DI size_t gla_idx(int b, int c, int h, int d) { return (size_t)(((b * NCHK + c) * 4 + h) * 2 + d); }

DI void gla1_task(const Params& p, int l, int b, int c, int h, char* smem) {
  float* G0 = (float*)smem; float* G1 = G0 + 4096; float* sW = G1 + 4096;
  us* KeT = (us*)(sW + 1024);
  us* Vt = KeT + 2 * 64 * 72;
  const int tid = tidx(), w = tid >> 6, lane = tid & 63, r = lane & 31, hh = lane >> 5;
  const long m0 = seqrow(b, c * 64);
  const us* P0 = (const us*)(p.ws + OFF_P) + m0 * INC;
  __syncthreads();
  gla_gate_dir(p, l, P0, h, 0, sW, G0);
  gla_gate_dir(p, l, P0, h, 1, sW, G1);
  {
    int t = tid >> 2, q4 = tid & 3; float kk[16], vv[16];
    const us* sk = P0 + (size_t)t * INC + 768 + h * 64 + q4 * 16;
    const us* sv = P0 + (size_t)t * INC + 1024 + h * 64 + q4 * 16;
    unpack8(*(const u32x4*)sk, kk); unpack8(*(const u32x4*)(sk + 8), kk + 8);
    unpack8(*(const u32x4*)sv, vv); unpack8(*(const u32x4*)(sv + 8), vv + 8);
#pragma unroll
    for (int cc = 0; cc < 16; ++cc) {
      int ch = q4 * 16 + cc;
      KeT[ch * 72 + t] = f2bf(kk[cc] * __expf(G0[63 * 64 + ch] - G0[t * 64 + ch]));
      KeT[(64 + ch) * 72 + t] = f2bf(kk[cc] * __expf(G1[ch] - G1[t * 64 + ch]));
      Vt[ch * 72 + t] = f2bf(vv[cc]);
    }
    if (tid < 128) {
      int d = tid >> 6, ch = tid & 63;
      ((float*)(p.ws + OFF_DEC))[gla_idx(b, c, h, d) * 64 + ch] = __expf(d ? G1[ch] : G0[63 * 64 + ch]);
    }
  }
  __syncthreads();
  {
    const int d = w >> 1, mt = w & 1;
    float* kv = (float*)(p.ws + OFF_KV) + gla_idx(b, c, h, d) * 4096;
#pragma unroll
    for (int nt = 0; nt < 2; ++nt) {
      f32x16 acc;
#pragma unroll
      for (int q = 0; q < 16; ++q) acc[q] = 0.f;
#pragma unroll
      for (int ks = 0; ks < 4; ++ks) {
        bf16x8 a = *(const bf16x8*)(Vt + (mt * 32 + r) * 72 + ks * 16 + hh * 8);
        bf16x8 bb = *(const bf16x8*)(KeT + (d * 64 + nt * 32 + r) * 72 + ks * 16 + hh * 8);
        acc = MFMA(a, bb, acc);
      }
#pragma unroll
      for (int i = 0; i < 16; ++i) kv[(mt * 32 + crow(i, hh)) * 64 + nt * 32 + r] = acc[i];
    }
  }
}
DI int gla_order(int d, int j) { return d == 0 ? j : (j < 4 ? 3 - j : 135 - j); }
DI void gla2_task(const Params& p, int it) {
  const int gid = it * 256 + tidx();
  const int e = gid & 4095, d = (gid >> 12) & 1, h = (gid >> 13) & 3, b = gid >> 15, k = e & 63;
  float* KV = (float*)(p.ws + OFF_KV); const float* DEC = (const float*)(p.ws + OFF_DEC);
  float s = 0;
  for (int j0 = 0; j0 < NCHK; j0 += 33) {
    float kv[33], dc[33];
#pragma unroll
    for (int q = 0; q < 33; ++q) { const size_t ix = gla_idx(b, gla_order(d, j0 + q), h, d); kv[q] = KV[ix * 4096 + e]; dc[q] = DEC[ix * 64 + k]; }
#pragma unroll
    for (int q = 0; q < 33; ++q) { const size_t ix = gla_idx(b, gla_order(d, j0 + q), h, d); KV[ix * 4096 + e] = s; s = dc[q] * s + kv[q]; }
  }
}
DI void gla3_task(const Params& p, int l, int b, int c, int h, char* smem) {
  float* G = (float*)smem;
  us* Qin = (us*)(smem + 17408);
  us* Kin = Qin + 64 * 72; us* Vt = Kin + 64 * 72; us* ST = Vt + 64 * 72; us* Sc = ST + 64 * 72;
  float* sW = (float*)Sc;
  const int tid = tidx(), w = tid >> 6, lane = tid & 63, r = lane & 31, hh = lane >> 5;
  const long m0 = seqrow(b, c * 64);
  const us* P0 = (const us*)(p.ws + OFF_P) + m0 * INC;
  const int t_ = tid >> 2, q4 = tid & 3;
  __syncthreads();
  {
    float vv[16]; const us* sv = P0 + (size_t)t_ * INC + 1024 + h * 64 + q4 * 16;
    unpack8(*(const u32x4*)sv, vv); unpack8(*(const u32x4*)(sv + 8), vv + 8);
#pragma unroll
    for (int cc = 0; cc < 16; ++cc) Vt[(q4 * 16 + cc) * 72 + t_] = f2bf(vv[cc]);
  }
  f32x16 oacc;
#pragma unroll
  for (int q = 0; q < 16; ++q) oacc[q] = 0.f;
  const int mt = w >> 1, nt = w & 1;
  for (int d = 0; d < 2; ++d) {
    gla_gate_dir(p, l, P0, h, d, sW, G);
    {
      float qq[16], kk[16], qo[16], ko[16];
      const us* sq = P0 + (size_t)t_ * INC + 512 + h * 64 + q4 * 16;
      const us* sk = P0 + (size_t)t_ * INC + 768 + h * 64 + q4 * 16;
      unpack8(*(const u32x4*)sq, qq); unpack8(*(const u32x4*)(sq + 8), qq + 8);
      unpack8(*(const u32x4*)sk, kk); unpack8(*(const u32x4*)(sk + 8), kk + 8);
#pragma unroll
      for (int cc = 0; cc < 16; ++cc) { float gg = G[t_ * 64 + q4 * 16 + cc]; qo[cc] = qq[cc] * 0.125f * __expf(gg); ko[cc] = kk[cc] * __expf(-gg); }
      *(u32x4*)(Qin + t_ * 72 + q4 * 16) = pack8(qo); *(u32x4*)(Qin + t_ * 72 + q4 * 16 + 8) = pack8(qo + 8);
      *(u32x4*)(Kin + t_ * 72 + q4 * 16) = pack8(ko); *(u32x4*)(Kin + t_ * 72 + q4 * 16 + 8) = pack8(ko + 8);
      const float* ss = (const float*)(p.ws + OFF_KV) + gla_idx(b, c, h, d) * 4096 + tid * 16;
      float sf[16];
#pragma unroll
      for (int j = 0; j < 4; ++j) { f32x4 t4 = *(const f32x4*)(ss + j * 4); sf[4 * j] = t4[0]; sf[4 * j + 1] = t4[1]; sf[4 * j + 2] = t4[2]; sf[4 * j + 3] = t4[3]; }
      const int v_ = tid >> 2, k0 = (tid & 3) * 16;
      *(u32x4*)(ST + v_ * 72 + k0) = pack8(sf); *(u32x4*)(ST + v_ * 72 + k0 + 8) = pack8(sf + 8);
    }
    __syncthreads();
    {
      const int tt = mt, st = nt;
      const bool need = d == 0 ? st <= tt : st >= tt;
      f32x16 sc;
#pragma unroll
      for (int q = 0; q < 16; ++q) sc[q] = 0.f;
      if (need) {
#pragma unroll
        for (int ks = 0; ks < 4; ++ks) {
          bf16x8 a = *(const bf16x8*)(Qin + (tt * 32 + r) * 72 + ks * 16 + hh * 8);
          bf16x8 bb = *(const bf16x8*)(Kin + (st * 32 + r) * 72 + ks * 16 + hh * 8);
          sc = MFMA(a, bb, sc);
        }
      }
#pragma unroll
      for (int i = 0; i < 16; ++i) {
        int trow = tt * 32 + crow(i, hh), scol = st * 32 + r;
        bool keep = d == 0 ? scol <= trow : scol >= trow;
        Sc[trow * 72 + scol] = f2bf(keep ? sc[i] : 0.f);
      }
    }
    __syncthreads();
#pragma unroll
    for (int ks = 0; ks < 4; ++ks) {
      bf16x8 a = *(const bf16x8*)(Sc + (mt * 32 + r) * 72 + ks * 16 + hh * 8);
      bf16x8 bb = *(const bf16x8*)(Vt + (nt * 32 + r) * 72 + ks * 16 + hh * 8);
      oacc = MFMA(a, bb, oacc);
    }
#pragma unroll
    for (int ks = 0; ks < 4; ++ks) {
      bf16x8 a = *(const bf16x8*)(Qin + (mt * 32 + r) * 72 + ks * 16 + hh * 8);
      bf16x8 bb = *(const bf16x8*)(ST + (nt * 32 + r) * 72 + ks * 16 + hh * 8);
      oacc = MFMA(a, bb, oacc);
    }
    __syncthreads();
  }
  float* Ob = (float*)smem;
#pragma unroll
  for (int i = 0; i < 16; ++i) Ob[(mt * 32 + crow(i, hh)) * 68 + nt * 32 + r] = oacc[i];
  __syncthreads();
  {
    float o[16], rr[16]; float ss = 0;
#pragma unroll
    for (int cc = 0; cc < 16; ++cc) { o[cc] = Ob[t_ * 68 + q4 * 16 + cc]; ss += o[cc] * o[cc]; }
    ss += __shfl_xor(ss, 1); ss += __shfl_xor(ss, 2);
    float rstd = rsqrtf(ss * (1.f / 64.f) + EPS);
    const us* sr = P0 + (size_t)t_ * INC + 1280 + h * 64 + q4 * 16;
    unpack8(*(const u32x4*)sr, rr); unpack8(*(const u32x4*)(sr + 8), rr + 8);
    const float* gn = p.in[16] + l * 256 + h * 64 + q4 * 16;
#pragma unroll
    for (int cc = 0; cc < 16; ++cc) o[cc] = o[cc] * rstd * gn[cc] * silu_(rr[cc]);
    us* dst = (us*)(p.ws + OFF_MIXIN) + (m0 + t_) * 1024 + 256 + h * 64 + q4 * 16;
    *(u32x4*)dst = pack8(o); *(u32x4*)(dst + 8) = pack8(o + 8);
  }
}

DI size_t hl_idx(int b, int c, int d, int g, int pp) { return ((size_t)(((b * NCHK + c) * 2 + d) * 16 + g) * 64 + pp) * 2; }
template <bool OUT>
DI void s5_task(const Params& p, int l, int b, int c, int gp, char* smem) {
  us* Hb = (us*)smem;
  float* Yb = (float*)(smem + 4 * 32 * 136 * 2);
  const int tid = tidx(), w = tid >> 6, lane = tid & 63, r = lane & 31, hh = lane >> 5;
  const long m0 = seqrow(b, c * 64);
  const us* P0 = (const us*)(p.ws + OFF_P) + m0 * INC;
  const int gl = w >> 1, d = w & 1, g = gp * 2 + gl, pp = lane;
  const float* sf = s5f(p, l);
  const float lr = sf[S_LAMB + ((d * 16 + g) * 64 + pp) * 2], li = sf[S_LAMB + ((d * 16 + g) * 64 + pp) * 2 + 1];
  const f32x2_ la = {lr, lr}, lb = {-li, li};
  float hr = 0.f, hi = 0.f;
  float* HL = (float*)(p.ws + OFF_HL) + hl_idx(b, c, d, g, pp);
  if (OUT) { hr = HL[0]; hi = HL[1]; }
  const us* cm = wl(p, l) + W_CM + ((size_t)(d * 16 + g) * 16 + (r & 15)) * 128 + hh * 8;
  const us* bm = wl(p, l) + W_BM + ((size_t)(d * 16 + g) * 128 + r) * 16 + hh * 8;
  us* hb = Hb + w * 32 * 136;
  __syncthreads();
  for (int half = 0; half < 2; ++half) {
    const int tbase = d ? (1 - half) * 32 : half * 32;
    {
      const bf16x8 a = *(const bf16x8*)(P0 + (size_t)(tbase + r) * INC + 1568 + g * 16 + hh * 8);
#pragma unroll
      for (int nt = 0; nt < 4; ++nt) {
        const bf16x8 bb = *(const bf16x8*)(bm + nt * 32 * 16);
        f32x16 z;
#pragma unroll
        for (int q = 0; q < 16; ++q) z[q] = 0.f;
        z = MFMA(a, bb, z);
#pragma unroll
        for (int i = 0; i < 16; ++i) hb[crow(i, hh) * 136 + nt * 32 + r] = f2bf(z[i]);
      }
    }
    __syncthreads();
    for (int jj = 0; jj < 32; ++jj) {
      const int tl = d ? 31 - jj : jj;
      const f32x2_ bu = {bf2f(hb[tl * 136 + pp]), bf2f(hb[tl * 136 + 64 + pp])};
      { f32x2_ h = {hr, hi}, hs = {hi, hr}; f32x2_ nh = la * h + lb * hs + bu; hr = nh[0]; hi = nh[1]; }
      if (OUT) { hb[tl * 136 + pp] = f2bf(hr); hb[tl * 136 + 64 + pp] = f2bf(hi); }
    }
    if (OUT) {
      __syncthreads();
      f32x16 acc;
#pragma unroll
      for (int q = 0; q < 16; ++q) acc[q] = 0.f;
#pragma unroll
      for (int ks = 0; ks < 8; ++ks) {
        bf16x8 a = *(const bf16x8*)(hb + r * 136 + ks * 16 + hh * 8);
        bf16x8 bb = *(const bf16x8*)(cm + ks * 16);
        if (r >= 16) bb = (bf16x8){0, 0, 0, 0, 0, 0, 0, 0};
        acc = MFMA(a, bb, acc);
      }
      if (r < 16) {
#pragma unroll
        for (int i = 0; i < 16; ++i) Yb[(w * 64 + tbase + crow(i, hh)) * 17 + r] = acc[i];
      }
    }
    __syncthreads();
  }
  if (!OUT) { HL[0] = hr; HL[1] = hi; return; }
  {
    const int gl2 = tid >> 7, t = (tid >> 1) & 63, o8 = (tid & 1) * 8, g2 = gp * 2 + gl2; float y[8], u8[8];
    unpack8(*(const u32x4*)(P0 + (size_t)t * INC + 1568 + g2 * 16 + o8), u8);
#pragma unroll
    for (int o = 0; o < 8; ++o) {
      float v = Yb[((gl2 * 2 + 0) * 64 + t) * 17 + o8 + o] + Yb[((gl2 * 2 + 1) * 64 + t) * 17 + o8 + o]
              + p.in[24][l * 256 + g2 * 16 + o8 + o] * u8[o];
      y[o] = gelu_t(v);
    }
    *(u32x4*)((us*)(p.ws + OFF_Y) + (m0 + t) * 256 + g2 * 16 + o8) = pack8(y);
  }
}
DI void s5b_task(const Params& p, int l, int it) {
  const int gid = it * 256 + tidx();
  const int pp = gid & 63, g = (gid >> 6) & 15, d = (gid >> 10) & 1, b = gid >> 11;
  const float* sf = s5f(p, l);
  const float tr = sf[S_LAMT + ((d * 16 + g) * 64 + pp) * 2], ti = sf[S_LAMT + ((d * 16 + g) * 64 + pp) * 2 + 1];
  float* HL = (float*)(p.ws + OFF_HL);
  float hr = 0.f, hi = 0.f;
  for (int j0 = 0; j0 < NCHK; j0 += 33) {
    f32x2_ xv[33];
#pragma unroll
    for (int q = 0; q < 33; ++q) xv[q] = *(const f32x2_*)(HL + hl_idx(b, gla_order(d, j0 + q), d, g, pp));
#pragma unroll
    for (int q = 0; q < 33; ++q) {
      f32x2_ o = {hr, hi};
      *(f32x2_*)(HL + hl_idx(b, gla_order(d, j0 + q), d, g, pp)) = o;
      float nr = tr * hr - ti * hi + xv[q][0], ni = tr * hi + ti * hr + xv[q][1]; hr = nr; hi = ni;
    }
  }
}

DI void attn_task(const Params& p, int b, int h, int qs0, int nkeys, char* smem) {
  constexpr int KSZ = 64 * 104, VSZ = 64 * 68;
  us* sK = (us*)smem;
  us* sV = sK + 3 * KSZ;
  const int tid = tid512(), w = tid >> 6, lane = tid & 63, r = lane & 31, hh = lane >> 5;
  const us* Kg = (const us*)(p.ws + OFF_KB) + (size_t)(b * 4 + h) * SEQ * 96;
  const us* Vg = (const us*)(p.ws + OFF_VT) + (size_t)(b * 4 + h) * 64 * SEQ;
  const us* Qg = (const us*)(p.ws + OFF_QB) + ((size_t)(b * 4 + h) * SEQ + qs0 + w * 32 + r) * 96 + hh * 8;
  bf16x8 qf[6];
#pragma unroll
  for (int ks = 0; ks < 6; ++ks) qf[ks] = *(const bf16x8*)(Qg + ks * 16);
  u32x4 rk[2], rv;
  const int kq1 = tid + 512 < 768 ? tid + 512 : tid;
  const int vrow = tid >> 3, vcc = tid & 7;
  const int kw0 = (tid / 12) * 104 + (tid % 12) * 8, kw1 = (kq1 / 12) * 104 + (kq1 % 12) * 8, vw = vrow * 68 + vcc * 8;
#define AGLOAD(kt) { rk[0] = *(const u32x4*)(Kg + (size_t)(kt) * 64 * 96 + tid * 8); rk[1] = *(const u32x4*)(Kg + (size_t)(kt) * 64 * 96 + kq1 * 8); \
    rv = *(const u32x4*)(Vg + (size_t)vrow * SEQ + (kt) * 64 + vcc * 8); }
#define ASWRITE(buf) { *(u32x4*)(sK + (buf) * KSZ + kw0) = rk[0]; *(u32x4*)(sK + (buf) * KSZ + kw1) = rk[1]; \
    us* dv = sV + (buf) * VSZ + vw; u32x2 lo = {rv[0], rv[1]}, hi2 = {rv[2], rv[3]}; *(u32x2*)dv = lo; *(u32x2*)(dv + 4) = hi2; }
  f32x16 o0, o1, negm, sc0, sc1;
#pragma unroll
  for (int q = 0; q < 16; ++q) { o0[q] = 0.f; o1[q] = 0.f; sc0[q] = 0.f; sc1[q] = 0.f; }
  float lsum = 0.f;
  const int NT = nkeys / 64;
  __syncthreads();
  AGLOAD(0); ASWRITE(0); AGLOAD(1); ASWRITE(1); AGLOAD(2);
  __syncthreads();
  {
    const us* k0 = sK + r * 104 + hh * 8;
#pragma unroll
    for (int ks = 0; ks < 6; ++ks) {
      bf16x8 a0 = *(const bf16x8*)(k0 + ks * 16), a1 = *(const bf16x8*)(k0 + 32 * 104 + ks * 16);
      sc0 = MFMA(a0, qf[ks], sc0); sc1 = MFMA(a1, qf[ks], sc1);
    }
    float mx = sc0[0];
#pragma unroll
    for (int i = 1; i < 16; ++i) mx = fmaxf(mx, sc0[i]);
#pragma unroll
    for (int i = 0; i < 16; ++i) mx = fmaxf(mx, sc1[i]);
    mx = fmaxf(mx, __shfl_xor(mx, 32));
#pragma unroll
    for (int q = 0; q < 16; ++q) { negm[q] = -mx; sc0[q] -= mx; sc1[q] -= mx; }
  }
  int bc = 0, bn = 1, bw = 2;
  for (int kt = 0; kt < NT; ++kt) {
    __syncthreads();
    ASWRITE(bw);
    { const int kl = kt + 3 < NT ? kt + 3 : NT - 1; AGLOAD(kl); }
    float mx = sc0[0];
#pragma unroll
    for (int i = 1; i < 16; ++i) mx = fmaxf(mx, sc0[i]);
#pragma unroll
    for (int i = 0; i < 16; ++i) mx = fmaxf(mx, sc1[i]);
    mx = fmaxf(mx, __shfl_xor(mx, 32));
    if (__builtin_amdgcn_ballot_w64(mx > 8.f)) {
      const float dl = fmaxf(mx, 0.f), alpha = __builtin_amdgcn_exp2f(-dl);
#pragma unroll
      for (int i = 0; i < 16; ++i) { o0[i] *= alpha; o1[i] *= alpha; sc0[i] -= dl; sc1[i] -= dl; negm[i] -= dl; }
      lsum *= alpha;
    }
    f32x16 sn0, sn1;
    {
      const us* k0 = sK + bn * KSZ + r * 104 + hh * 8;
      {
        bf16x8 a0 = *(const bf16x8*)(k0), a1 = *(const bf16x8*)(k0 + 32 * 104);
        sn0 = MFMA(a0, qf[0], negm); sn1 = MFMA(a1, qf[0], negm);
      }
#pragma unroll
      for (int ks = 1; ks < 6; ++ks) {
        bf16x8 a0 = *(const bf16x8*)(k0 + ks * 16), a1 = *(const bf16x8*)(k0 + 32 * 104 + ks * 16);
        sn0 = MFMA(a0, qf[ks], sn0); sn1 = MFMA(a1, qf[ks], sn1);
      }
    }
    float ps = 0.f;
#pragma unroll
    for (int i = 0; i < 16; ++i) { sc0[i] = __builtin_amdgcn_exp2f(sc0[i]); ps += sc0[i]; }
#pragma unroll
    for (int i = 0; i < 16; ++i) { sc1[i] = __builtin_amdgcn_exp2f(sc1[i]); ps += sc1[i]; }
    lsum += ps;
    bf16x8 pf[4];
    {
      u32x4 t0 = {pk2(sc0[0], sc0[1]), pk2(sc0[2], sc0[3]), pk2(sc0[4], sc0[5]), pk2(sc0[6], sc0[7])};
      u32x4 t1 = {pk2(sc0[8], sc0[9]), pk2(sc0[10], sc0[11]), pk2(sc0[12], sc0[13]), pk2(sc0[14], sc0[15])};
      u32x4 t2 = {pk2(sc1[0], sc1[1]), pk2(sc1[2], sc1[3]), pk2(sc1[4], sc1[5]), pk2(sc1[6], sc1[7])};
      u32x4 t3 = {pk2(sc1[8], sc1[9]), pk2(sc1[10], sc1[11]), pk2(sc1[12], sc1[13]), pk2(sc1[14], sc1[15])};
      pf[0] = __builtin_bit_cast(bf16x8, t0); pf[1] = __builtin_bit_cast(bf16x8, t1);
      pf[2] = __builtin_bit_cast(bf16x8, t2); pf[3] = __builtin_bit_cast(bf16x8, t3);
    }
    {
      const us* v0 = sV + bc * VSZ + r * 68 + 4 * hh;
#pragma unroll
      for (int kk = 0; kk < 4; ++kk) {
        u32x2 l0 = *(const u32x2*)(v0 + 16 * kk), h0 = *(const u32x2*)(v0 + 16 * kk + 8);
        u32x2 l1 = *(const u32x2*)(v0 + 32 * 68 + 16 * kk), h1 = *(const u32x2*)(v0 + 32 * 68 + 16 * kk + 8);
        u32x4 a0 = {l0[0], l0[1], h0[0], h0[1]}, a1 = {l1[0], l1[1], h1[0], h1[1]};
        o0 = MFMA(__builtin_bit_cast(bf16x8, a0), pf[kk], o0);
        o1 = MFMA(__builtin_bit_cast(bf16x8, a1), pf[kk], o1);
      }
    }
    sc0 = sn0; sc1 = sn1;
    { const int t = bc; bc = bn; bn = bw; bw = t; }
  }
#undef AGLOAD
#undef ASWRITE
  lsum += __shfl_xor(lsum, 32);
  const float inv = 1.f / lsum;
  const long m = seqrow(b, qs0 + w * 32 + r);
  us* dst = (us*)(p.ws + OFF_MIXIN) + m * 1024 + 768 + h * 64;
#pragma unroll
  for (int gq = 0; gq < 4; ++gq) {
    u32x2 w0 = {pk2(o0[4 * gq] * inv, o0[4 * gq + 1] * inv), pk2(o0[4 * gq + 2] * inv, o0[4 * gq + 3] * inv)};
    u32x2 w1 = {pk2(o1[4 * gq] * inv, o1[4 * gq + 1] * inv), pk2(o1[4 * gq + 2] * inv, o1[4 * gq + 3] * inv)};
    *(u32x2*)(dst + 8 * gq + 4 * hh) = w0;
    *(u32x2*)(dst + 32 + 8 * gq + 4 * hh) = w1;
  }
}

DI void convact_task(const Params& p, int l, int it, int nrows) {
  const int T = it * 256 + tidx();
  if (T >= (nrows / 8) * 352) return;
  const int rb = T / 352, oct = T - rb * 352, c0 = oct * 8, i0 = rb * 8;
  const int slo = i0 < 8192 ? 0 : 8192, shi = i0 < 8192 ? 8192 : 8448;
  const us* Z = (const us*)(p.ws + OFF_ZPRE);
  const float* cw = p.in[33] + (size_t)l * 3 * DFF2; const float* cb = p.in[34] + (size_t)l * DFF2;
  float wa[3][8], wg[3][8], ba[8], bg[8];
#pragma unroll
  for (int j = 0; j < 3; ++j) {
    f32x4 a0 = *(const f32x4*)(cw + j * DFF2 + c0), a1 = *(const f32x4*)(cw + j * DFF2 + c0 + 4);
    f32x4 g0 = *(const f32x4*)(cw + j * DFF2 + DFF + c0), g1 = *(const f32x4*)(cw + j * DFF2 + DFF + c0 + 4);
#pragma unroll
    for (int q = 0; q < 4; ++q) { wa[j][q] = a0[q]; wa[j][4 + q] = a1[q]; wg[j][q] = g0[q]; wg[j][4 + q] = g1[q]; }
  }
  {
    f32x4 a0 = *(const f32x4*)(cb + c0), a1 = *(const f32x4*)(cb + c0 + 4), g0 = *(const f32x4*)(cb + DFF + c0), g1 = *(const f32x4*)(cb + DFF + c0 + 4);
#pragma unroll
    for (int q = 0; q < 4; ++q) { ba[q] = a0[q]; ba[4 + q] = a1[q]; bg[q] = g0[q]; bg[4 + q] = g1[q]; }
  }
  u32x4 ra_[10], rg_[10];
#pragma unroll
  for (int k = 0; k < 10; ++k) {
    const int i = i0 - 1 + k;
    if (i >= slo && i < shi) { ra_[k] = *(const u32x4*)(Z + (size_t)i * DFF2 + c0); rg_[k] = *(const u32x4*)(Z + (size_t)i * DFF2 + DFF + c0); }
    else { ra_[k] = (u32x4){0u, 0u, 0u, 0u}; rg_[k] = (u32x4){0u, 0u, 0u, 0u}; }
  }
  us* A = (us*)(p.ws + OFF_ACT);
  float za[3][8], zg[3][8];
  unpack8(ra_[0], za[0]); unpack8(rg_[0], zg[0]); unpack8(ra_[1], za[1]); unpack8(rg_[1], zg[1]);
#pragma unroll
  for (int ii = 0; ii < 8; ++ii) {
    const int i = i0 + ii;
    unpack8(ra_[ii + 2], za[2]); unpack8(rg_[ii + 2], zg[2]);
    float o[8];
#pragma unroll
    for (int q = 0; q < 8; ++q) {
      float a = ba[q] + wa[0][q] * za[0][q] + wa[1][q] * za[1][q] + wa[2][q] * za[2][q];
      float gg = bg[q] + wg[0][q] * zg[0][q] + wg[1][q] * zg[1][q] + wg[2][q] * zg[2][q];
      o[q] = gelu_t(a) * gg;
    }
    *(u32x4*)(A + (size_t)i * DFF + c0) = pack8(o);
#pragma unroll
    for (int q = 0; q < 8; ++q) { za[0][q] = za[1][q]; za[1][q] = za[2][q]; zg[0][q] = zg[1][q]; zg[1][q] = zg[2][q]; }
  }
}

constexpr int SCHED_WORDS = 1024;
DI int gl_n(int RT, int CT, int x) { return ((RT - x + 7) >> 3) * CT; }
DI void gl_tile(int RT, int CT, int x, int j, int& rt, int& ct) {
  const int rows = (RT - x + 7) >> 3, nfull = CT >> 3; int rl;
  if (j < nfull * rows * 8) { int pnl = j / (rows * 8), rem = j - pnl * rows * 8; rl = rem >> 3; ct = pnl * 8 + (rem & 7); }
  else { int j2 = j - nfull * rows * 8, wd = CT - nfull * 8; rl = j2 / wd; ct = nfull * 8 + (j2 - rl * wd); }
  rt = rl * 8 + x;
}
DI int ml_n(int n, int x) { return (n - x + 7) >> 3; }
template <class NX, class RUN>
DI void run_phase(unsigned*& ctr, int G, int bid, volatile int* s_bc, NX nx, RUN run) {
  const int x0 = bid & 7, per = G >> 3;
  const int x = x0; int j = bid >> 3;
  for (;;) {
    if (j < nx(x)) {
      int nj = 0;
      if (threadIdx.x == 0) nj = per + (int)atomicAdd(&ctr[x], 1u);
      run(x, j);
      __syncthreads();
      if (threadIdx.x == 0) *s_bc = nj;
      __syncthreads();
      j = *s_bc;
    } else break;
  }
  ctr += 8;
}

DI long chunk_row(int ch, int i) { return i < 8192 ? (long)ch * 8192 + i : (long)MX + ch * 256 + (i - 8192); }


template <class RUN>
DI void run_tiles(unsigned*& ctr, int n, int G, int bid, volatile int* s_bc, RUN run) {
  int it = bid;
  while (it < n) {
    int nx = 0;
    if (threadIdx.x == 0) nx = G + (int)atomicAdd(ctr, 1u);
    run(it);
    __syncthreads();
    if (threadIdx.x == 0) *s_bc = nx;
    __syncthreads();
    it = *s_bc;
  }
  ctr += 1;
}

constexpr int HLDS = 64512;
constexpr int LDS_BYTES = 147456;
static_assert(2 * HLDS <= LDS_BYTES, "lds");

__global__ void __launch_bounds__(512) fwd_mega(Params p) {
  cg::grid_group grid = cg::this_grid();
  extern __shared__ __attribute__((aligned(16))) char dsm[];
  __shared__ uint4 xb_words;
  const int G = gridDim.x, bid = blockIdx.x, wv8 = __builtin_amdgcn_readfirstlane(threadIdx.x >> 6), half = wv8 >> 2;
  char* smem = dsm + half * HLDS;
  const int vb = bid * 2 + half, V = 2 * G;
  if (threadIdx.x == 0) xb_words = make_uint4(0u, 0u, 0u, 0u);
  __syncthreads();
  const XcdBarrier xb = xcd_barrier_post((unsigned*)(p.ws + OFF_BAR), (volatile LAS unsigned*)&xb_words);
#define HALF_LOOP(n, IT, ...) { const int n_ = (n); const int iters_ = (n_ + V - 1) / V; for (int k_ = 0; k_ < iters_; ++k_) { int IT = vb + k_ * V; IT = IT < n_ ? IT : n_ - 1; __VA_ARGS__ } }
#define HALF_LOOP_NB(n, IT, ...) { const int n_ = (n); for (int IT = vb; IT < n_; IT += V) { __VA_ARGS__ } }

  HALF_LOOP(2 * NCONV_LAYER, it, conv_task(p, it, smem);)
  HALF_LOOP(384, it, mod_task(p, it, smem);)
  HALF_LOOP_NB(16, it, s5pre_task(p, it);)
  HALF_LOOP_NB(4, it, rope_task(p, it);)
  HALF_LOOP_NB(128, it, sguw_task(p, it);)
  HALF_LOOP_NB(64, it, wgt_task(p, it);)
  grid.sync();
  for (int it = bid; it < MT / 8; it += G) row_task<0>(p, 0, (long)it * 8 + wv8, nullptr);
  xcd_barrier(xb);

  unsigned* ctr = (unsigned*)(p.ws + OFF_SCHED);
  volatile int* s_bc = (volatile int*)&xb_words.z;
  for (int l = 0; l < 2; ++l) {
    const us* W = wl(p, l);
    const int RT = l == 0 ? 264 : 256;
    run_tiles(ctr, 132 * 9, G, bid, s_bc, [&](int it) {
      const int rt = it / 9, ct = it - rt * 9;
      GArgs g{(const us*)(p.ws + OFF_HX) + (size_t)rt * 256 * D, D, W + W_IN + (size_t)ct * 256 * D, D, (long)rt * 256, ct * 256, p.ws + OFF_P, INC, l};
      if (ct == 8) gemm_big(g, 128, dsm); else gemm_8p(g, dsm);
    });
    xcd_barrier(xb);
    {
      const int p0 = (4 * NCHK * 8) >> 1, p1 = p0 + ((4 * NCHK * 4) >> 1), p2 = p1 + ((RT * 4) >> 1), p3 = p2 + ((264 * 3) >> 1), p4 = p3 + ((264 * 4) >> 1);
      for (int P = bid; P < p4; P += G) {
        if (P < p0) { const int q = 2 * P + half; s5_task<false>(p, l, q / (NCHK * 8), (q / 8) % NCHK, q & 7, smem); }
        else if (P < p1) { const int q = 2 * (P - p0) + half; gla1_task(p, l, q / (NCHK * 4), (q / 4) % NCHK, q & 3, smem); }
        else if (P < p2) { const int q = 2 * (P - p1) + half; sgu_task(p, l, q >> 2, q & 3, smem); }
        else if (P < p3) { const int q = 2 * (P - p2) + half, rt = q / 3, ct = q % 3;
          GArgs g{(const us*)(p.ws + OFF_P) + (size_t)rt * 128 * INC + 1824, INC, W + W_UQ + (size_t)ct * 128 * 224, 224, (long)rt * 128, ct * 128, nullptr, 0, l};
          gemm_tile<32, 2, true>(p, g, smem); }
        else { const int q = 2 * (P - p3) + half, rt = q >> 2, ct = q & 3;
          GArgs g{(const us*)(p.ws + OFF_P) + (size_t)rt * 128 * INC + 2048, INC, W + W_UKV + (size_t)ct * 128 * 96, 96, (long)rt * 128, ct * 128, nullptr, 0, l};
          gemm_tile<32, 3, true>(p, g, smem);
          if (ct == 0) kr_task(p, (long)rt * 128); }
      }
    }
    xcd_barrier(xb);
    HALF_LOOP_NB(512, it, gla2_task(p, it);)
    HALF_LOOP_NB(32, it, s5b_task(p, l, it);)
    xcd_barrier(xb);
    if ((G & 7) == 0) {
      const int x = bid & 7;
      for (int j = bid >> 3; j < 64; j += G >> 3) { int pair = 2 * x + (j >> 5), qb = j & 31; for (int rp = 0; rp < REP_ATT; ++rp) attn_task(p, pair >> 2, pair & 3, 256 + qb * 256, SEQ, dsm); }
    } else {
      for (int it = bid; it < 512; it += G) attn_task(p, it >> 7, (it >> 5) & 3, 256 + (it & 31) * 256, SEQ, dsm);
    }
    if (l == 0) for (int it = bid; it < 16; it += G) attn_task(p, it >> 2, it & 3, 0, 256, dsm);
    {
      const int c0 = l == 0 ? 0 : 4, nc = NCHK - c0;
      const int p0 = (4 * nc * 8) >> 1, p1 = p0 + ((4 * nc * 4) >> 1);
      for (int P = bid; P < p1; P += G) {
        if (P < p0) { const int q = 2 * P + half; s5_task<true>(p, l, q / (nc * 8), c0 + (q / 8) % nc, q & 7, smem); }
        else { const int q = 2 * (P - p0) + half; gla3_task(p, l, q / (nc * 4), c0 + (q / 4) % nc, q & 3, smem); }
      }
    }
    xcd_barrier(xb);
    HALF_LOOP(RT * 2, it, { int rt = it >> 1, ct = it & 1;
      GArgs g{(const us*)(p.ws + OFF_Y) + (size_t)rt * 128 * 256, 256, W + W_GLU + (size_t)ct * 128 * 256, 256, (long)rt * 128, ct * 128, nullptr, 0, l};
      gemm_tile<32, 4, false>(p, g, smem); })
    xcd_barrier(xb);
    run_tiles(ctr, (RT / 2) * 4, G, bid, s_bc, [&](int it) {
      const int rt = it >> 2, ct = it & 3;
      GArgs g{(const us*)(p.ws + OFF_MIXIN) + (size_t)rt * 256 * D, D, W + W_OUT + (size_t)ct * 256 * D, D, (long)rt * 256, ct * 256, p.ws + OFF_MIXOUT, D, l};
      gemm_8p(g, dsm);
    });
    xcd_barrier(xb);
    for (int it = bid; it < RT * 16; it += G) { long m = (long)it * 8 + wv8; row_task<1>(p, l, m, (const us*)(p.ws + OFF_MIXOUT) + m * 1024); }
    xcd_barrier(xb);
    const int CR2 = l == 0 ? 33 : 32, CROWS = CR2 * 256, NF2 = (CROWS / 8 * 352 + 255) / 256;
    for (int ch = 0; ch <= 4; ++ch) {
      {
        const bool hasF3 = ch > 0, hasF1 = ch < 4;
        const int n3 = hasF3 ? CR2 * 4 : 0, n1 = hasF1 ? CR2 * 22 : 0;
        run_tiles(ctr, n3 + n1, G, bid, s_bc, [&](int it) {
          GArgs g;
          if (it < n3) {
            const int rt = it >> 2, ct = it & 3;
            g = GArgs{(const us*)(p.ws + OFF_ACT) + (size_t)rt * 256 * DFF, DFF, W + W_DN + (size_t)ct * 256 * DFF, DFF, (long)rt * 256, ct * 256, p.ws + OFF_FFNOUT, D, l};
          } else {
            const int q = it - n3, rt = q / 22, ct = q - rt * 22;
            g = GArgs{(const us*)(p.ws + OFF_HX) + (size_t)chunk_row(ch, rt * 256) * D, D, W + W_UP + (size_t)ct * 256 * D, D, (long)rt * 256, ct * 256, p.ws + OFF_ZPRE, DFF2, l};
          }
          gemm_8p(g, dsm);
        });
      }
      xcd_barrier(xb);
      if (ch < 4) HALF_LOOP_NB(NF2, it, convact_task(p, l, it, CROWS);)
      if (ch > 0) for (int it = bid; it < CROWS / 8; it += G) { int i = it * 8 + wv8; row_task<2>(p, l, chunk_row(ch - 1, i), (const us*)(p.ws + OFF_FFNOUT) + (size_t)i * 1024); }
      xcd_barrier(xb);
    }
  }
#undef HALF_LOOP
#undef HALF_LOOP_NB
}

extern "C" void kernel_launch(void* const* d_in, const int* in_sizes, int n_in, void* d_out, int out_size,
                              void* d_ws, size_t ws_size, hipStream_t stream) {
  static int grid_blocks = 0;
  if (!grid_blocks) {
    int dev = 0, cus = 0, per_cu = 0;
    (void)hipGetDevice(&dev);
    (void)hipDeviceGetAttribute(&cus, hipDeviceAttributeMultiprocessorCount, dev);
    if (hipFuncSetAttribute((const void*)fwd_mega, hipFuncAttributeMaxDynamicSharedMemorySize, LDS_BYTES) != hipSuccess)
      fprintf(stderr, "kernel_launch: hipFuncSetAttribute(%d B LDS) failed\n", LDS_BYTES);
    (void)hipOccupancyMaxActiveBlocksPerMultiprocessor(&per_cu, fwd_mega, 512, LDS_BYTES);
    if (per_cu < 1) fprintf(stderr, "kernel_launch: occupancy query returned %d\n", per_cu);
    grid_blocks = cus;
    if (ws_size < OFF_END) fprintf(stderr, "kernel_launch: ws too small: %zu < %zu\n", ws_size, (size_t)OFF_END);
  }
  if (n_in != 36 || ws_size < OFF_END) return;
  Params p{};
  for (int i = 0; i < 36; ++i) p.in[i] = (const float*)d_in[i];
  p.out = (float*)d_out; p.ws = (char*)d_ws;
  void* args[] = {&p};
  (void)hipMemsetAsync((char*)d_ws + OFF_BAR, 0, (XCD_BAR_WORDS + SCHED_WORDS) * 4, stream);
  hipError_t e = hipLaunchCooperativeKernel((void*)fwd_mega, dim3(grid_blocks), dim3(512), args, LDS_BYTES, stream);
  if (e != hipSuccess) fprintf(stderr, "cooperative launch failed: %s (grid %d)\n", hipGetErrorString(e), grid_blocks);
}
```

```cpp
#include <hip/hip_runtime.h>
#include <hip/hip_cooperative_groups.h>
#include <cstdio>
#include <cstdint>
namespace cg = cooperative_groups;

typedef unsigned short us;
using bf16x8 = __attribute__((ext_vector_type(8))) short;
using f32x16 = __attribute__((ext_vector_type(16))) float;
using f32x4  = __attribute__((ext_vector_type(4))) float;
using u32x4  = __attribute__((ext_vector_type(4))) unsigned;
using u32x2  = __attribute__((ext_vector_type(2))) unsigned;
#define DI __device__ __forceinline__
#define MFMA(a, b, c) __builtin_amdgcn_mfma_f32_32x32x16_bf16((a), (b), (c), 0, 0, 0)

#ifndef REP_F3N
#define REP_F3N 1
#endif
#ifndef REP_F1N
#define REP_F1N 1
#endif
#ifndef REP_GEMM
#define REP_GEMM 1
#endif
#ifndef REP_M1
#define REP_M1 1
#endif
#ifndef REP_M3
#define REP_M3 1
#endif
#ifndef REP_ATT
#define REP_ATT 1
#endif
#ifndef REP_GLA3
#define REP_GLA3 1
#endif
#ifndef REP_S5C
#define REP_S5C 1
#endif
#ifndef REP_F2
#define REP_F2 1
#endif
#ifndef REP_P0
#define REP_P0 1
#endif
#ifndef EXTRA_SYNC
#define EXTRA_SYNC 0
#endif
constexpr int D = 1024, MX = 32768, MC = 1024, MT = MX + MC, INC = 2176, DFF = 2816, DFF2 = 5632;
constexpr int SEQ = 8448, NCHK = 132;
constexpr float EPS = 1e-6f;
constexpr float QSCALE = 0.10206207261596577f * 1.4426950408889634f;

constexpr size_t W_IN = 0, W_OUT = W_IN + (size_t)INC * D, W_UP = W_OUT + (size_t)D * D, W_DN = W_UP + (size_t)DFF2 * D,
                 W_UQ = W_DN + (size_t)D * DFF, W_UKV = W_UQ + 384 * 224, W_GLU = W_UKV + 512 * 96, W_SGU = W_GLU + 256 * 256,
                 W_CM = W_SGU + 4 * 128 * 128, W_WG = W_CM + 2 * 16 * 16 * 128, W_BM = W_WG + 2 * 256 * 16, W_LAYER = W_BM + 2 * 16 * 128 * 16;
constexpr size_t S_LAMB = 0, S_LAMT = 4096, S_BBAR = 8192, S_LAYER = 8192 + 65536;

constexpr size_t al256(size_t x) { return (x + 255) / 256 * 256; }
constexpr size_t OFF_WB = 0;
constexpr size_t OFF_S5F = al256(OFF_WB + 2 * W_LAYER * 2);
constexpr size_t OFF_MOD = al256(OFF_S5F + 2 * S_LAYER * 4);
constexpr size_t OFF_ROPE = al256(OFF_MOD + 2 * 5 * 6144 * 4);
constexpr size_t OFF_CTXS = al256(OFF_ROPE + 128 * 8 * 2 * 4);
constexpr size_t OFF_HX = al256(OFF_CTXS + (size_t)MC * D * 4);
constexpr size_t OFF_P = al256(OFF_HX + (size_t)MT * D * 2);
constexpr size_t OFF_MIXIN = al256(OFF_P + (size_t)MT * INC * 2);
constexpr size_t OFF_QB = al256(OFF_MIXIN + (size_t)MT * D * 2);
constexpr size_t OFF_KB = al256(OFF_QB + (size_t)16 * SEQ * 96 * 2);
constexpr size_t OFF_VT = al256(OFF_KB + (size_t)16 * SEQ * 96 * 2);
constexpr size_t OFF_KV = al256(OFF_VT + (size_t)16 * 64 * SEQ * 2);
constexpr size_t OFF_DEC = al256(OFF_KV + (size_t)4 * NCHK * 4 * 2 * 4096 * 4);
constexpr size_t OFF_HL = al256(OFF_DEC + (size_t)4 * NCHK * 4 * 2 * 64 * 4);
constexpr size_t OFF_Y = al256(OFF_HL + (size_t)4 * NCHK * 2 * 16 * 64 * 2 * 4);
constexpr size_t OFF_BAR = al256(OFF_Y + (size_t)MT * 256 * 2);
constexpr size_t OFF_SCHED = OFF_BAR + 3456 * 4;
constexpr size_t OFF_END = al256(OFF_SCHED + 1024 * 4);
constexpr size_t OFF_MIXOUT = OFF_P;
constexpr size_t OFF_ZPRE = OFF_P;
constexpr size_t OFF_ACT = OFF_MIXIN;
constexpr size_t OFF_FFNOUT = OFF_QB;
static_assert((size_t)MT * D * 4 <= (size_t)MT * INC * 2, "mixout alias");
static_assert((size_t)8448 * 1024 * 4 <= 2 * (size_t)16 * SEQ * 96 * 2, "ffnout alias");

struct Params { const float* in[36]; float* out; char* ws; };

DI float bf2f(us v) { return __uint_as_float(((unsigned)v) << 16); }
typedef float f32x2_ __attribute__((ext_vector_type(2)));
typedef __bf16 bf16x2_ __attribute__((ext_vector_type(2)));
DI unsigned pk2(float lo, float hi) { f32x2_ v = {lo, hi}; bf16x2_ b = __builtin_convertvector(v, bf16x2_); return __builtin_bit_cast(unsigned, b); }
DI us f2bf(float x) { return (us)(pk2(x, x) & 0xffffu); }
DI float lo_bf(unsigned w) { return __uint_as_float(w << 16); }
DI float hi_bf(unsigned w) { return __uint_as_float(w & 0xffff0000u); }
DI int tid512() { int t; asm volatile("v_mov_b32 %0, %1" : "=v"(t) : "v"(threadIdx.x)); return t; }
DI int tidx() { return tid512() & 255; }
DI int crow(int i, int hh) { return (i & 3) + 8 * (i >> 2) + 4 * hh; }
DI float sigmoidf_(float x) { return __builtin_amdgcn_rcpf(1.f + __expf(-x)); }
DI float gelu_t(float x) { float u = 0.7978845608028654f * (x + 0.044715f * x * x * x); return x * __builtin_amdgcn_rcpf(1.f + __expf(-2.f * u)); }
DI float silu_(float x) { return x * __builtin_amdgcn_rcpf(1.f + __expf(-x)); }
DI float logsig(float z) { return fminf(z, 0.f) - __logf(1.f + __expf(-fabsf(z))); }
DI void unpack8(u32x4 w, float* f) {
  f[0] = lo_bf(w[0]); f[1] = hi_bf(w[0]); f[2] = lo_bf(w[1]); f[3] = hi_bf(w[1]);
  f[4] = lo_bf(w[2]); f[5] = hi_bf(w[2]); f[6] = lo_bf(w[3]); f[7] = hi_bf(w[3]);
}
DI u32x4 pack8(const float* f) { u32x4 w = {pk2(f[0], f[1]), pk2(f[2], f[3]), pk2(f[4], f[5]), pk2(f[6], f[7])}; return w; }
DI long seqrow(int b, int s) { return s < 256 ? (long)MX + b * 256 + s : (long)b * 8192 + (s - 256); }
DI float wave_sum(float v) {
  v += __shfl_xor(v, 1); v += __shfl_xor(v, 2); v += __shfl_xor(v, 4); v += __shfl_xor(v, 8); v += __shfl_xor(v, 16); v += __shfl_xor(v, 32);
  return v;
}
DI const us* wl(const Params& p, int l) { return (const us*)(p.ws + OFF_WB) + (size_t)l * W_LAYER; }
DI const float* s5f(const Params& p, int l) { return (const float*)(p.ws + OFF_S5F) + (size_t)l * S_LAYER; }
DI const float* modv(const Params& p, int l, int v, int idx) { return (const float*)(p.ws + OFF_MOD) + ((size_t)(l * 5 + v) * 6 + idx) * 1024; }
DI float* stream_row(const Params& p, long m) { return m < MX ? p.out + m * 1024 : (float*)(p.ws + OFF_CTXS) + (m - MX) * 1024; }
DI const float* input_row(const Params& p, long m) { return m < MX ? p.in[0] + m * 1024 : p.in[2] + (m - MX) * 1024; }


#define XB_TMO      128
#define XB_XCNT(j)  (256  + 64 * (j))
#define XB_XSUB(j)  (1280 + 64 * (j))
#define XB_XGEN(j)  (2304 + 64 * (j))
#define XB_TOP      3328
#define XB_TOPGEN   3392
#define XCD_BAR_WORDS 3456
#define XB_SPIN_CAP (1u << 20)
#define LAS __attribute__((address_space(3)))
DI unsigned xb_ld(unsigned* p)              { return __hip_atomic_load(p, __ATOMIC_RELAXED, __HIP_MEMORY_SCOPE_AGENT); }
DI unsigned xb_add(unsigned* p, unsigned v) { return __hip_atomic_fetch_add(p, v, __ATOMIC_RELAXED, __HIP_MEMORY_SCOPE_AGENT); }
DI unsigned xb_xcc_id() { return (unsigned)__builtin_amdgcn_s_getreg((3 << 11) | 20) & 0xFu; }
#define XB_SPIN(cond, bar) do { unsigned _sp = 0; while (cond) { __builtin_amdgcn_s_sleep(1); \
    if ((++_sp & 255u) == 0u) { if (xb_ld(&(bar)[XB_TMO])) break; if (_sp > XB_SPIN_CAP) { atomicAdd(&(bar)[XB_TMO], 1u); break; } } } } while (0)
struct XcdBarrier { unsigned* bar; unsigned x; volatile LAS unsigned* st; };
DI XcdBarrier xcd_barrier_post(unsigned* bar, volatile LAS unsigned* st) {
  XcdBarrier b; b.bar = bar; b.x = (unsigned)__builtin_amdgcn_readfirstlane((int)xb_xcc_id()); b.st = st;
  if (threadIdx.x == 0) (void)xb_add(&bar[XB_XCNT(b.x)], 1u);
  return b;
}
DI void xcd_barrier_complete(unsigned* bar, unsigned x, unsigned& nloc, unsigned& nx) {
  const unsigned G = gridDim.x * gridDim.y * gridDim.z;
  unsigned sum, cnt, mine, sp = 0u;
  for (;;) {
    sum = 0u; cnt = 0u; mine = 0u;
#pragma unroll
    for (unsigned j = 0; j < 16; ++j) { const unsigned c = xb_ld(&bar[XB_XCNT(j)]); sum += c; cnt += (c > 0u) ? 1u : 0u; mine = (j == x) ? c : mine; }
    if (sum == G) break;
    __builtin_amdgcn_s_sleep(1);
    if ((++sp & 255u) == 0u) { if (xb_ld(&bar[XB_TMO])) break; if (sp > XB_SPIN_CAP) { atomicAdd(&bar[XB_TMO], 1u); break; } }
  }
  nloc = mine > 0u ? mine : 1u; nx = cnt > 0u ? cnt : 1u;
}
DI void xcd_barrier(const XcdBarrier& b) {
  asm volatile("s_waitcnt vmcnt(0)" ::: "memory");
  __syncthreads();
  if (threadIdx.x == 0) {
    unsigned* bar = b.bar;
    unsigned bx = b.x; asm volatile("" : "+s"(bx));
    __builtin_amdgcn_s_waitcnt(0);
    unsigned nloc = b.st[0], nx = b.st[1];
    if (nloc == 0u) { xcd_barrier_complete(bar, bx, nloc, nx); b.st[0] = nloc; b.st[1] = nx; }
    const unsigned old = xb_add(&bar[XB_XSUB(bx)], 1u);
    const unsigned gen = old / nloc;
    if (old + 1u == (gen + 1u) * nloc) {
      __builtin_amdgcn_fence(__ATOMIC_RELEASE, "agent");
      asm volatile("s_waitcnt vmcnt(0)" ::: "memory");
      const unsigned og = xb_add(&bar[XB_TOP], 1u);
      const unsigned tg = og / nx;
      if (og + 1u == (tg + 1u) * nx) xb_add(&bar[XB_TOPGEN], 1u);
      else XB_SPIN(xb_ld(&bar[XB_TOPGEN]) == tg, bar);
      __builtin_amdgcn_fence(__ATOMIC_ACQUIRE, "agent");
      xb_add(&bar[XB_XGEN(bx)], 1u);
      asm volatile("s_waitcnt vmcnt(0)" ::: "memory");
    } else {
      XB_SPIN(xb_ld(&bar[XB_XGEN(bx)]) == gen, bar);
      __builtin_amdgcn_fence(__ATOMIC_ACQUIRE, "agent");
      asm volatile("s_waitcnt vmcnt(0)" ::: "memory");
    }
  }
  __syncthreads();
}

DI void conv_tile(const float* src, us* dst, int K, int N, const float* scale, int tile, char* smem) {
  float* t = (float*)smem;
  const int tid = tidx(), tn = N / 128, tk = tile / tn, tc = tile % tn;
  __syncthreads();
  {
    const int k = tid >> 3, c4 = (tid & 7) * 4;
    const float s = scale ? scale[tk * 32 + k] : 1.f;
    const float* sp = src + (size_t)(tk * 32 + k) * N + tc * 128 + c4;
    f32x4 v0 = *(const f32x4*)(sp), v1 = *(const f32x4*)(sp + 32), v2 = *(const f32x4*)(sp + 64), v3 = *(const f32x4*)(sp + 96);
    float* tp = t + k * 129 + c4;
#pragma unroll
    for (int q = 0; q < 4; ++q) { tp[q] = v0[q] * s; tp[32 + q] = v1[q] * s; tp[64 + q] = v2[q] * s; tp[96 + q] = v3[q] * s; }
  }
  __syncthreads();
  {
    const int n = tid >> 1, k16 = (tid & 1) * 16; float f[16];
#pragma unroll
    for (int j = 0; j < 16; ++j) f[j] = t[(k16 + j) * 129 + n];
    us* dp = dst + (size_t)(tc * 128 + n) * K + tk * 32 + k16;
    *(u32x4*)dp = pack8(f); *(u32x4*)(dp + 8) = pack8(f + 8);
  }
}
constexpr int NCONV_LAYER = 32 * 17 + 32 * 8 + 32 * 44 + 88 * 8 + 7 * 3 + 3 * 4 + 8 * 2;
DI void conv_task(const Params& p, int it, char* smem) {
  int l = it / NCONV_LAYER; it -= l * NCONV_LAYER;
  us* wb = (us*)(p.ws + OFF_WB) + (size_t)l * W_LAYER;
  int nt;
  nt = 32 * 17;  if (it < nt) { conv_tile(p.in[10] + (size_t)l * 1024 * 2176, wb + W_IN, 1024, 2176, nullptr, it, smem); return; } it -= nt;
  nt = 32 * 8;   if (it < nt) { conv_tile(p.in[31] + (size_t)l * 1024 * 1024, wb + W_OUT, 1024, 1024, nullptr, it, smem); return; } it -= nt;
  nt = 32 * 44;  if (it < nt) { conv_tile(p.in[32] + (size_t)l * 1024 * 5632, wb + W_UP, 1024, 5632, nullptr, it, smem); return; } it -= nt;
  nt = 88 * 8;   if (it < nt) { conv_tile(p.in[35] + (size_t)l * 2816 * 1024, wb + W_DN, 2816, 1024, nullptr, it, smem); return; } it -= nt;
  nt = 7 * 3;    if (it < nt) { conv_tile(p.in[28] + (size_t)l * 224 * 384, wb + W_UQ, 224, 384, p.in[27] + l * 224, it, smem); return; } it -= nt;
  nt = 3 * 4;    if (it < nt) { conv_tile(p.in[30] + (size_t)l * 96 * 512, wb + W_UKV, 96, 512, p.in[29] + l * 96, it, smem); return; } it -= nt;
  conv_tile(p.in[25] + (size_t)l * 256 * 256, wb + W_GLU, 256, 256, nullptr, it, smem);
}
DI void mod_task(const Params& p, int it, char* smem) {
  float* sc = (float*)smem;
  float* red = sc + 5 * 1024;
  const int tid = tidx(), l = it / 192, jb = it % 192;
  __syncthreads();
  for (int e = tid; e < 5 * 1024; e += 256) {
    int v = e >> 10, k = e & 1023; float c = v < 4 ? p.in[1][v * 1024 + k] : p.in[3][k];
    sc[e] = silu_(c);
  }
  __syncthreads();
  const int col = tid & 31, ks = tid >> 5;
  const float* w = p.in[4] + (size_t)l * 1024 * 6144 + jb * 32 + col;
  float a0 = 0, a1 = 0, a2 = 0, a3 = 0, a4 = 0;
#pragma unroll 8
  for (int k = ks * 128; k < ks * 128 + 128; ++k) {
    float wv = w[(size_t)k * 6144];
    a0 += sc[k] * wv; a1 += sc[1024 + k] * wv; a2 += sc[2048 + k] * wv; a3 += sc[3072 + k] * wv; a4 += sc[4096 + k] * wv;
  }
  float* rp = red + (ks * 32 + col) * 5;
  rp[0] = a0; rp[1] = a1; rp[2] = a2; rp[3] = a3; rp[4] = a4;
  __syncthreads();
  if (tid < 160) {
    int v = tid >> 5, c = tid & 31; float s = 0;
    for (int q = 0; q < 8; ++q) s += red[(q * 32 + c) * 5 + v];
    int j = jb * 32 + c;
    ((float*)(p.ws + OFF_MOD))[(size_t)(l * 5 + v) * 6144 + j] = s + p.in[5][l * 6144 + j];
  }
}
DI void s5pre_task(const Params& p, int it) {
  int gid = it * 256 + tidx();
  int pp = gid & 63, g = (gid >> 6) & 15, d = (gid >> 10) & 1, l = gid >> 11;
  int idx = ((l * 2 + d) * 16 + g) * 64 + pp;
  float are = p.in[17][idx], aim = p.in[18][idx];
  float dt = expf(p.in[19][(l * 2 + d) * 16 + g]);
  float mag = expf(are * dt), lr = mag * cosf(aim * dt), li = mag * sinf(aim * dt);
  float magT = expf(are * dt * 64.f), tr = magT * cosf(aim * dt * 64.f), ti = magT * sinf(aim * dt * 64.f);
  float nr = lr - 1.f, ni = li, den = are * are + aim * aim;
  float cr = (nr * are + ni * aim) / den, ci = (ni * are - nr * aim) / den;
  float* sf = (float*)(p.ws + OFF_S5F) + (size_t)l * S_LAYER;
  int o2 = ((d * 16 + g) * 64 + pp);
  sf[S_LAMB + o2 * 2] = lr; sf[S_LAMB + o2 * 2 + 1] = li;
  sf[S_LAMT + o2 * 2] = tr; sf[S_LAMT + o2 * 2 + 1] = ti;
  for (int i = 0; i < 16; ++i) {
    float br = p.in[20][(size_t)idx * 16 + i], bi = p.in[21][(size_t)idx * 16 + i];
    sf[S_BBAR + ((size_t)o2 * 16 + i) * 2] = cr * br - ci * bi;
    sf[S_BBAR + ((size_t)o2 * 16 + i) * 2 + 1] = cr * bi + ci * br;
    us* bm = (us*)(p.ws + OFF_WB) + (size_t)l * W_LAYER + W_BM + (size_t)(d * 16 + g) * 128 * 16;
    bm[pp * 16 + i] = f2bf(cr * br - ci * bi);
    bm[(64 + pp) * 16 + i] = f2bf(cr * bi + ci * br);
  }
  us* cm = (us*)(p.ws + OFF_WB) + (size_t)l * W_LAYER + W_CM;
  for (int o = 0; o < 16; ++o) {
    size_t ci_ = ((size_t)((l * 2 + d) * 16 + g) * 16 + o) * 64 + pp;
    cm[((size_t)(d * 16 + g) * 16 + o) * 128 + pp] = f2bf(p.in[22][ci_]);
    cm[((size_t)(d * 16 + g) * 16 + o) * 128 + 64 + pp] = f2bf(-p.in[23][ci_]);
  }
}
DI void rope_task(const Params& p, int it) {
  int gid = it * 256 + tidx();
  int pos = gid >> 3, f = gid & 7;
  float inv = powf(10000.f, -(float)f / 8.f), ang = (float)pos * inv;
  float* r = (float*)(p.ws + OFF_ROPE);
  r[gid * 2] = cosf(ang); r[gid * 2 + 1] = sinf(ang);
}
DI void wgt_task(const Params& p, int it) {
  int gid = it * 256 + tidx();
  int rr = gid & 15, c = (gid >> 4) & 255, d = (gid >> 12) & 1, l = gid >> 13;
  ((us*)(p.ws + OFF_WB))[(size_t)l * W_LAYER + W_WG + (d * 256 + c) * 16 + rr] = f2bf(p.in[14][((l * 2 + d) * 16 + rr) * 256 + c]);
}
DI void sguw_task(const Params& p, int it) {
  int gid = it * 256 + tidx();
  int l = gid >> 14, e = (gid & 16383) * 4;
  f32x4 v = *(const f32x4*)(p.in[12] + (size_t)l * 65536 + e);
  u32x2 w = {pk2(v[0], v[1]), pk2(v[2], v[3])};
  *(u32x2*)((us*)(p.ws + OFF_WB) + (size_t)l * W_LAYER + W_SGU + e) = w;
}

template <int MODE>
DI void row_task(const Params& p, int l, long m, const us* yrow) {
  const int lane = tidx() & 63, v = m < MX ? (int)(m >> 13) : 4;
  float x[16];
  if (MODE == 0) {
    const float* src = input_row(p, m);
#pragma unroll
    for (int j = 0; j < 4; ++j) { f32x4 t = *(const f32x4*)(src + (j * 64 + lane) * 4); x[4 * j] = t[0]; x[4 * j + 1] = t[1]; x[4 * j + 2] = t[2]; x[4 * j + 3] = t[3]; }
  } else {
    float y[16]; float ss = 0;
    const float* xo = (MODE == 1 && l == 0) ? input_row(p, m) : stream_row(p, m);
#pragma unroll
    for (int j = 0; j < 4; ++j) {
      u32x2 t = *(const u32x2*)(yrow + (j * 64 + lane) * 4); y[4 * j] = lo_bf(t[0]); y[4 * j + 1] = hi_bf(t[0]); y[4 * j + 2] = lo_bf(t[1]); y[4 * j + 3] = hi_bf(t[1]);
      f32x4 u = *(const f32x4*)(xo + (j * 64 + lane) * 4); x[4 * j] = u[0]; x[4 * j + 1] = u[1]; x[4 * j + 2] = u[2]; x[4 * j + 3] = u[3];
    }
#pragma unroll
    for (int j = 0; j < 16; ++j) ss += y[j] * y[j];
    ss = wave_sum(ss);
    float rstd = rsqrtf(ss * (1.f / 1024.f) + EPS);
    const float* gp = (MODE == 1 ? p.in[7] : p.in[9]) + l * 1024;
    const float* gt = modv(p, l, v, MODE == 1 ? 2 : 5);
    float* dst = stream_row(p, m);
#pragma unroll
    for (int j = 0; j < 4; ++j) {
      int c = (j * 64 + lane) * 4;
      f32x4 g4 = *(const f32x4*)(gp + c), t4 = *(const f32x4*)(gt + c), o;
#pragma unroll
      for (int q = 0; q < 4; ++q) { x[4 * j + q] += t4[q] * (y[4 * j + q] * rstd * g4[q]); o[q] = x[4 * j + q]; }
      *(f32x4*)(dst + c) = o;
    }
    if (MODE == 2 && l == 1) return;
  }
  const int ln = (MODE == 2) ? 1 : l;
  const float* g = (MODE == 1 ? p.in[8] : p.in[6]) + ln * 1024;
  const float* sh = modv(p, ln, v, MODE == 1 ? 3 : 0);
  const float* sc = modv(p, ln, v, MODE == 1 ? 4 : 1);
  float ss = 0;
#pragma unroll
  for (int j = 0; j < 16; ++j) ss += x[j] * x[j];
  ss = wave_sum(ss);
  float rstd = rsqrtf(ss * (1.f / 1024.f) + EPS);
  us* hx = (us*)(p.ws + OFF_HX) + m * 1024;
#pragma unroll
  for (int j = 0; j < 4; ++j) {
    int c = (j * 64 + lane) * 4;
    f32x4 g4 = *(const f32x4*)(g + c), s4 = *(const f32x4*)(sh + c), c4 = *(const f32x4*)(sc + c); float h[4];
#pragma unroll
    for (int q = 0; q < 4; ++q) h[q] = (x[4 * j + q] * rstd * g4[q]) * (1.f + c4[q]) + s4[q];
    u32x2 w = {pk2(h[0], h[1]), pk2(h[2], h[3])};
    *(u32x2*)(hx + c) = w;
  }
}

struct GArgs { const us* A; int lda; const us* W; int K; long m0; int n0; void* out; int ldo; int l; };
template <int BK, int EPI, bool ROWSS>
DI void gemm_tile(const Params& p, const GArgs& g, char* smem) {
  constexpr int LS = BK + 8, CPR = BK / 8, NCH = 128 * CPR / 256;
  us* sA = (us*)smem; us* sB = sA + 2 * 128 * LS; float* rstd = (float*)(sB + 2 * 128 * LS);
  const int tid = tidx(), w = tid >> 6, lane = tid & 63, r = lane & 31, hh = lane >> 5, wm = w >> 1, wn = w & 1;
  __syncthreads();
  if (ROWSS) {
    int row = tid >> 1, half = tid & 1; float ss = 0;
    const us* ap = g.A + (size_t)row * g.lda + half * (g.K / 2);
    for (int c = 0; c < g.K / 16; ++c) { float f[8]; unpack8(*(const u32x4*)(ap + c * 8), f);
#pragma unroll
      for (int j = 0; j < 8; ++j) ss += f[j] * f[j]; }
    ss += __shfl_xor(ss, 1);
    if (!half) rstd[row] = rsqrtf(ss / (float)g.K + EPS);
  }
  u32x4 ra[NCH], rb[NCH];
  f32x16 acc[2][2];
#pragma unroll
  for (int i = 0; i < 2; ++i)
#pragma unroll
    for (int j = 0; j < 2; ++j)
#pragma unroll
      for (int q = 0; q < 16; ++q) acc[i][j][q] = 0.f;
#define GLOAD(kt) _Pragma("unroll") for (int j = 0; j < NCH; ++j) { int q = tid + 256 * j, row = q / CPR, cc = q % CPR; \
    ra[j] = *(const u32x4*)(g.A + (size_t)row * g.lda + (kt) * BK + cc * 8); rb[j] = *(const u32x4*)(g.W + (size_t)row * g.K + (kt) * BK + cc * 8); }
#define SWRITE(buf) _Pragma("unroll") for (int j = 0; j < NCH; ++j) { int q = tid + 256 * j, row = q / CPR, cc = q % CPR; \
    *(u32x4*)(sA + (buf) * 128 * LS + row * LS + cc * 8) = ra[j]; *(u32x4*)(sB + (buf) * 128 * LS + row * LS + cc * 8) = rb[j]; }
  GLOAD(0); SWRITE(0); __syncthreads();
  const int KT = g.K / BK;
  for (int kt = 0; kt < KT; ++kt) {
    if (kt + 1 < KT) { GLOAD(kt + 1); }
    const us* a0 = sA + (kt & 1) * 128 * LS + (wm * 64 + r) * LS + hh * 8;
    const us* b0 = sB + (kt & 1) * 128 * LS + (wn * 64 + r) * LS + hh * 8;
#pragma unroll
    for (int ks = 0; ks < BK / 16; ++ks) {
      bf16x8 af0 = *(const bf16x8*)(a0 + ks * 16), af1 = *(const bf16x8*)(a0 + 32 * LS + ks * 16);
      bf16x8 bf0 = *(const bf16x8*)(b0 + ks * 16), bf1 = *(const bf16x8*)(b0 + 32 * LS + ks * 16);
      acc[0][0] = MFMA(af0, bf0, acc[0][0]); acc[0][1] = MFMA(af0, bf1, acc[0][1]);
      acc[1][0] = MFMA(af1, bf0, acc[1][0]); acc[1][1] = MFMA(af1, bf1, acc[1][1]);
    }
    if (kt + 1 < KT) { SWRITE((kt + 1) & 1); }
    __syncthreads();
  }
#undef GLOAD
#undef SWRITE
#pragma unroll
  for (int si = 0; si < 2; ++si)
#pragma unroll
    for (int sj = 0; sj < 2; ++sj) {
      const int col = wn * 64 + sj * 32 + r, n = g.n0 + col;
#pragma unroll
      for (int i = 0; i < 16; ++i) {
        const int row = wm * 64 + si * 32 + crow(i, hh);
        const long m = g.m0 + row;
        float v = acc[si][sj][i];
        if (EPI == 0) { ((us*)g.out)[m * g.ldo + n] = f2bf(v); }
        else if (EPI == 1) { ((float*)g.out)[m * g.ldo + n] = v; }
        else if (EPI == 2) {
          v *= rstd[row] * QSCALE;
          float pv = __shfl_xor(v, 8);
          const int head = n / 96, j = n - head * 96;
          const bool isx = m < MX; const int t = isx ? (int)(m & 8191) : (int)((m - MX) & 255);
          const int b = isx ? (int)(m >> 13) : (int)((m - MX) >> 8);
          if (isx && j >= 64) {
            int jj = (j - 64) & 15, blk = (j - 64) >> 4, f = jj & 7, pos = blk ? (t & 63) : (t >> 6);
            const float* rp = (const float*)(p.ws + OFF_ROPE) + (pos * 8 + f) * 2; float cs = rp[0], sn = rp[1];
            v = (jj < 8) ? v * cs - pv * sn : pv * sn + v * cs;
          }
          const int s = isx ? 256 + t : t;
          ((us*)(p.ws + OFF_QB))[((size_t)(b * 4 + head) * SEQ + s) * 96 + j] = f2bf(v);
        } else if (EPI == 3) {
          v *= rstd[row];
          const int head = n >> 7, j = n & 127;
          const bool isx = m < MX; const int t = isx ? (int)(m & 8191) : (int)((m - MX) & 255);
          const int b = isx ? (int)(m >> 13) : (int)((m - MX) >> 8);
          const int s = isx ? 256 + t : t;
          if (j < 64) ((us*)(p.ws + OFF_KB))[((size_t)(b * 4 + head) * SEQ + s) * 96 + j] = f2bf(v);
          else if ((i & 3) == 3) {
            const float r1 = rstd[row - 1], r2 = rstd[row - 2], r3 = rstd[row - 3];
            u32x2 w2 = {pk2(acc[si][sj][i - 3] * r3, acc[si][sj][i - 2] * r2), pk2(acc[si][sj][i - 1] * r1, v)};
            *(u32x2*)((us*)(p.ws + OFF_VT) + ((size_t)(b * 4 + head) * 64 + (j - 64)) * SEQ + s - 3) = w2;
          }
        } else if (EPI == 4) {
          float y = bf2f(((const us*)(p.ws + OFF_Y))[m * 256 + n]);
          v += p.in[26][g.l * 256 + n];
          ((us*)(p.ws + OFF_MIXIN))[m * 1024 + 512 + n] = f2bf(y * sigmoidf_(v));
        }
      }
    }
}


using f32x4_ = __attribute__((ext_vector_type(4))) float;
#define MFMA16(a, b, c) __builtin_amdgcn_mfma_f32_16x16x32_bf16((a), (b), (c), 0, 0, 0)
DI void gemm_big(const GArgs& g, int ncv, char* smem) {
  constexpr int ST = 256 * 64;
  us* sA = (us*)smem; us* sB = sA + 2 * ST;
  const int tid = tid512(), w = tid >> 6, lane = tid & 63, l16 = lane & 15, lq = lane >> 4, wm = w >> 2, wn = w & 3;
  u32x4 ra[4], rb[4];
  f32x4_ acc[8][4];
#pragma unroll
  for (int i = 0; i < 8; ++i)
#pragma unroll
    for (int j = 0; j < 4; ++j) { acc[i][j][0] = 0.f; acc[i][j][1] = 0.f; acc[i][j][2] = 0.f; acc[i][j][3] = 0.f; }
  const int srow = tid >> 3, sch = tid & 7;
  const us* gA = g.A + (size_t)srow * g.lda + sch * 8;
  const us* gB = g.W + (size_t)srow * g.K + sch * 8;
  const int swr = srow * 64 + ((sch ^ (srow & 7)) << 3);
#define GLOAD(kt) { _Pragma("unroll") for (int j = 0; j < 4; ++j) { ra[j] = *(const u32x4*)(gA + (size_t)(64 * j) * g.lda + (kt) * 64); rb[j] = *(const u32x4*)(gB + (size_t)(64 * j) * g.K + (kt) * 64); } }
#define SWRITE(buf) { _Pragma("unroll") for (int j = 0; j < 4; ++j) { *(u32x4*)(sA + (buf) * ST + swr + j * 4096) = ra[j]; *(u32x4*)(sB + (buf) * ST + swr + j * 4096) = rb[j]; } }
  const int KT = g.K / 64;
  const bool act = wn * 64 < ncv;
  const int fo0 = l16 * 64 + ((lq ^ (l16 & 7)) << 3), fo1 = l16 * 64 + (((4 + lq) ^ (l16 & 7)) << 3);
  __syncthreads();
  GLOAD(0); SWRITE(0); GLOAD(KT > 1 ? 1 : 0);
  for (int kt = 0; kt < KT; ++kt) {
    __syncthreads();
    SWRITE((kt + 1) & 1);
    { const int kl = kt + 2 < KT ? kt + 2 : KT - 1; GLOAD(kl); }
    if (act) {
      const us* a0 = sA + (kt & 1) * ST + wm * 128 * 64;
      const us* b0 = sB + (kt & 1) * ST + wn * 64 * 64;
#pragma unroll
      for (int ks = 0; ks < 2; ++ks) {
        const int fo = ks ? fo1 : fo0;
        bf16x8 fb[4];
#pragma unroll
        for (int j = 0; j < 4; ++j) fb[j] = *(const bf16x8*)(b0 + j * 1024 + fo);
#pragma unroll
        for (int i = 0; i < 8; ++i) {
          bf16x8 fa = *(const bf16x8*)(a0 + i * 1024 + fo);
#pragma unroll
          for (int j = 0; j < 4; ++j) acc[i][j] = MFMA16(fb[j], fa, acc[i][j]);
        }
      }
    }
  }
#undef GLOAD
#undef SWRITE
  __syncthreads();
  {
    us* sC = (us*)smem; constexpr int CS = 264;
    if (act) {
#pragma unroll
      for (int i = 0; i < 8; ++i)
#pragma unroll
        for (int j = 0; j < 4; ++j) {
          u32x2 w2 = {pk2(acc[i][j][0], acc[i][j][1]), pk2(acc[i][j][2], acc[i][j][3])};
          *(u32x2*)(sC + (wm * 128 + i * 16 + l16) * CS + wn * 64 + j * 16 + lq * 4) = w2;
        }
    }
    __syncthreads();
    us* outp = (us*)g.out + (size_t)g.m0 * g.ldo + g.n0;
#pragma unroll 4
    for (int k = 0; k < 16; ++k) {
      const int q = tid + 512 * k, row = q >> 5, cc = q & 31;
      if (cc * 8 < ncv) *(u32x4*)(outp + (size_t)row * g.ldo + cc * 8) = *(const u32x4*)(sC + row * CS + cc * 8);
    }
  }
}

DI int lds_byte8(int r, int c) { int st = (r >> 4) * 2 + (c >> 5), rr = r & 15, cc = c & 31, ob = rr * 64 + cc * 2; return st * 1024 + (ob ^ (((ob >> 9) & 1) << 5)); }
DI void stage_rc8(int b, int& R, int& C) { int st = b / 1024, sb = b % 1024, swz = sb ^ (((sb >> 9) & 1) << 5); R = (st >> 1) * 16 + swz / 64; C = (st & 1) * 32 + (swz % 64) / 2; }
DI void gemm_8p(const GArgs& g, char* smem, int ncv = 256) {
  constexpr int BK8 = 64, HALF8 = 128, HT8 = HALF8 * BK8;
  us* shm = (us*)smem;
  const int tid = tid512();
  const us* __restrict__ A = g.A; const us* __restrict__ Bt = g.W;
  const unsigned lda = (unsigned)g.lda, ldb = (unsigned)g.K;
#define SA8(b, h) (shm + ((b) * 2 + (h)) * HT8)
#define SB8(b, h) (shm + (4 + (b) * 2 + (h)) * HT8)
#define STAGE8(P, BASE, LD, br, kt) do { const unsigned _g = (unsigned)(br) * (unsigned)(LD) + (unsigned)(kt) * BK8; \
    for (int _i = 0; _i < 2; ++_i) { int _b = tid * 16 + _i * 8192; int _r, _c; stage_rc8(_b, _r, _c); \
      __builtin_amdgcn_global_load_lds((const unsigned*)((BASE) + (size_t)(_g + (unsigned)_r * (unsigned)(LD) + (unsigned)_c)), \
        (__attribute__((address_space(3))) unsigned*)((char*)(P) + _b), 16, 0, 0); } } while (0)
#define LDA8(dst, b, h) for (int m = 0; m < 4; ++m) for (int k = 0; k < 2; ++k) \
    dst[m][k] = *reinterpret_cast<const bf16x8*>((char*)SA8(b, h) + lds_byte8(wr * 64 + m * 16 + fr, k * 32 + fq * 8))
#define LDB8(dst, b, h) for (int n = 0; n < 2; ++n) for (int k = 0; k < 2; ++k) \
    dst[n][k] = *reinterpret_cast<const bf16x8*>((char*)SB8(b, h) + lds_byte8(wc * 32 + n * 16 + fr, k * 32 + fq * 8))
#define MMA8(ai, bj, At_, Bt_) do { __builtin_amdgcn_s_setprio(1); \
    for (int m = 0; m < 4; ++m) for (int n = 0; n < 2; ++n) for (int k = 0; k < 2; ++k) \
      acc[ai][bj][m][n] = __builtin_amdgcn_mfma_f32_16x16x32_bf16(Bt_[n][k], At_[m][k], acc[ai][bj][m][n], 0, 0, 0); \
    __builtin_amdgcn_s_setprio(0); } while (0)
#define WAIT_V(n) asm volatile("s_waitcnt vmcnt(" #n ")" ::: "memory")
#define WAIT_L(n) asm volatile("s_waitcnt lgkmcnt(" #n ")" ::: "memory")
#define BAR8 __builtin_amdgcn_s_barrier()
#define SCHED8 __builtin_amdgcn_sched_barrier(0)
  const int wid = tid >> 6, lane = tid & 63, wr = wid >> 2, wc = wid & 3, fr = lane & 15, fq = lane >> 4;
  f32x4_ acc[2][2][4][2];
#pragma unroll
  for (int a_ = 0; a_ < 2; ++a_)
#pragma unroll
    for (int b_ = 0; b_ < 2; ++b_)
#pragma unroll
      for (int m = 0; m < 4; ++m)
#pragma unroll
        for (int n = 0; n < 2; ++n) acc[a_][b_][m][n] = (f32x4_){0.f, 0.f, 0.f, 0.f};
  bf16x8 At[4][2], B0[2][2], B1[2][2];
  const int nt = g.K / BK8;
  __syncthreads();
  STAGE8(SB8(0, 0), Bt, ldb, 0, 0); STAGE8(SA8(0, 0), A, lda, 0, 0);
  STAGE8(SB8(0, 1), Bt, ldb, HALF8, 0); STAGE8(SA8(0, 1), A, lda, HALF8, 0);
  if (wr == 1) BAR8;
  WAIT_V(4); BAR8;
  STAGE8(SB8(1, 0), Bt, ldb, 0, 1); STAGE8(SA8(1, 0), A, lda, 0, 1); STAGE8(SB8(1, 1), Bt, ldb, HALF8, 1);
  WAIT_V(6); BAR8;
  for (int t = 0; t < nt - 2; t += 2) {
    LDB8(B0, 0, 0); SCHED8; LDA8(At, 0, 0); STAGE8(SA8(1, 1), A, lda, HALF8, t + 1);
    WAIT_L(8); BAR8; WAIT_L(0); MMA8(0, 0, At, B0); BAR8; SCHED8;
    LDB8(B1, 0, 1); STAGE8(SB8(0, 0), Bt, ldb, 0, t + 2);
    BAR8; WAIT_L(0); MMA8(0, 1, At, B1); BAR8;
    LDA8(At, 0, 1); STAGE8(SA8(0, 0), A, lda, 0, t + 2);
    BAR8; WAIT_L(0); MMA8(1, 0, At, B0); BAR8; SCHED8;
    STAGE8(SB8(0, 1), Bt, ldb, HALF8, t + 2);
    WAIT_V(6); BAR8; MMA8(1, 1, At, B1); BAR8;
    LDB8(B0, 1, 0); SCHED8; LDA8(At, 1, 0); STAGE8(SA8(0, 1), A, lda, HALF8, t + 2);
    WAIT_L(8); BAR8; WAIT_L(0); MMA8(0, 0, At, B0); BAR8; SCHED8;
    LDB8(B1, 1, 1); STAGE8(SB8(1, 0), Bt, ldb, 0, t + 3);
    BAR8; WAIT_L(0); MMA8(0, 1, At, B1); BAR8;
    LDA8(At, 1, 1); STAGE8(SA8(1, 0), A, lda, 0, t + 3);
    BAR8; WAIT_L(0); MMA8(1, 0, At, B0); BAR8; SCHED8;
    STAGE8(SB8(1, 1), Bt, ldb, HALF8, t + 3);
    WAIT_V(6); BAR8; MMA8(1, 1, At, B1); BAR8;
  }
  { LDB8(B0, 0, 0); LDA8(At, 0, 0); STAGE8(SA8(1, 1), A, lda, HALF8, nt - 1);
    BAR8; WAIT_L(0); MMA8(0, 0, At, B0); BAR8;
    LDB8(B1, 0, 1); BAR8; WAIT_L(0); MMA8(0, 1, At, B1); BAR8;
    LDA8(At, 0, 1); WAIT_V(4); BAR8; WAIT_L(0); MMA8(1, 0, At, B0); MMA8(1, 1, At, B1); BAR8; }
  { LDB8(B0, 1, 0); LDA8(At, 1, 0); WAIT_V(2); BAR8; WAIT_L(0); MMA8(0, 0, At, B0); BAR8;
    LDB8(B1, 1, 1); WAIT_V(0); BAR8; WAIT_L(0); MMA8(0, 1, At, B1); BAR8;
    LDA8(At, 1, 1); BAR8; WAIT_L(0); MMA8(1, 0, At, B0); MMA8(1, 1, At, B1); BAR8; }
  if (wr == 0) BAR8;
  __syncthreads();
  {
    us* sC = (us*)smem; constexpr int CS = 264;
    const int tid = tid512(), wid = tid >> 6, lane = tid & 63, wr = wid >> 2, wc = wid & 3, fr = lane & 15, fq = lane >> 4;
#pragma unroll
    for (int ai = 0; ai < 2; ++ai)
#pragma unroll
      for (int bj = 0; bj < 2; ++bj)
#pragma unroll
        for (int m = 0; m < 4; ++m)
#pragma unroll
          for (int n = 0; n < 2; ++n) {
            const f32x4_ v = acc[ai][bj][m][n];
            u32x2 w2 = {pk2(v[0], v[1]), pk2(v[2], v[3])};
            *(u32x2*)(sC + (ai * 128 + wr * 64 + m * 16 + fr) * CS + bj * 128 + wc * 32 + n * 16 + fq * 4) = w2;
          }
    __syncthreads();
    us* outp = (us*)g.out + (size_t)g.m0 * g.ldo + g.n0;
#pragma unroll 4
    for (int k = 0; k < 16; ++k) {
      const int q = tid + 512 * k, row = q >> 5, cc = q & 31;
      if (cc * 8 < ncv) *(u32x4*)(outp + (size_t)row * g.ldo + cc * 8) = *(const u32x4*)(sC + row * CS + cc * 8);
    }
  }
#undef SA8
#undef SB8
#undef STAGE8
#undef LDA8
#undef LDB8
#undef MMA8
#undef WAIT_V
#undef WAIT_L
#undef BAR8
#undef SCHED8
}

template <class F>
DI void for_tiles_xcd(int RT, int CT, int G, int bid, F f) {
  if ((G & 7) == 0) {
    const int x = bid & 7, rows = (RT - x + 7) >> 3, n = rows * CT, nfull = CT >> 3;
    for (int j = bid >> 3; j < n; j += G >> 3) {
      int rl, ct;
      if (j < nfull * rows * 8) { int pnl = j / (rows * 8), rem = j - pnl * rows * 8; rl = rem >> 3; ct = pnl * 8 + (rem & 7); }
      else { int j2 = j - nfull * rows * 8, wd = CT - nfull * 8; rl = j2 / wd; ct = nfull * 8 + (j2 - rl * wd); }
      f(rl * 8 + x, ct);
    }
  } else {
    for (int it = bid; it < RT * CT; it += G) f(it / CT, it % CT);
  }
}

DI void kr_task(const Params& p, long m0) {
  const int tid = tidx(), row = tid >> 1, blk = tid & 1; const long m = m0 + row;
  const us* src = (const us*)(p.ws + OFF_P) + m * INC + 2144 + blk * 16;
  float v[16], o[16]; unpack8(*(const u32x4*)src, v); unpack8(*(const u32x4*)(src + 8), v + 8);
  const bool isx = m < MX; const int t = isx ? (int)(m & 8191) : (int)((m - MX) & 255);
  const int b = isx ? (int)(m >> 13) : (int)((m - MX) >> 8), s = isx ? 256 + t : t;
  if (isx) {
    int pos = blk ? (t & 63) : (t >> 6);
    const float* rp = (const float*)(p.ws + OFF_ROPE) + pos * 16;
#pragma unroll
    for (int f = 0; f < 8; ++f) { float cs = rp[2 * f], sn = rp[2 * f + 1]; o[f] = v[f] * cs - v[f + 8] * sn; o[f + 8] = v[f] * sn + v[f + 8] * cs; }
  } else {
#pragma unroll
    for (int f = 0; f < 16; ++f) o[f] = v[f];
  }
  u32x4 w0 = pack8(o), w1 = pack8(o + 8);
#pragma unroll
  for (int hd = 0; hd < 4; ++hd) {
    us* dst = (us*)(p.ws + OFF_KB) + ((size_t)(b * 4 + hd) * SEQ + s) * 96 + 64 + blk * 16;
    *(u32x4*)dst = w0; *(u32x4*)(dst + 8) = w1;
  }
}

DI void sgu_task(const Params& p, int l, int chunk, int h, char* smem) {
  us* Vt = (us*)smem;
  const int tid = tidx(), w = tid >> 6, lane = tid & 63, r = lane & 31, hh = lane >> 5;
  const long m0 = (long)chunk * 128;
  const us* P = (const us*)(p.ws + OFF_P);
  __syncthreads();
  {
    int row = tid >> 1, dh = (tid & 1) * 32; float v[32]; float ss = 0;
    const us* src = P + (m0 + row) * INC + 256 + h * 64 + dh;
#pragma unroll
    for (int c = 0; c < 4; ++c) unpack8(*(const u32x4*)(src + c * 8), v + c * 8);
#pragma unroll
    for (int j = 0; j < 32; ++j) { v[j] = gelu_t(v[j]); ss += v[j] * v[j]; }
    ss += __shfl_xor(ss, 1);
    float rstd = rsqrtf(ss * (1.f / 64.f) + EPS);
    const float* gn = p.in[11] + l * 256 + h * 64 + dh;
#pragma unroll
    for (int j = 0; j < 32; ++j) Vt[(dh + j) * 136 + row] = f2bf(v[j] * rstd * gn[j]);
  }
  __syncthreads();
  const us* Wsp = wl(p, l) + W_SGU + (size_t)h * 16384 + (size_t)(w * 32 + r) * 128 + hh * 8;
  f32x16 a0, a1;
#pragma unroll
  for (int q = 0; q < 16; ++q) { a0[q] = 0.f; a1[q] = 0.f; }
#pragma unroll
  for (int ks = 0; ks < 8; ++ks) {
    bf16x8 af = *(const bf16x8*)(Wsp + ks * 16);
    bf16x8 b0 = *(const bf16x8*)(Vt + r * 136 + ks * 16 + hh * 8), b1 = *(const bf16x8*)(Vt + (32 + r) * 136 + ks * 16 + hh * 8);
    a0 = MFMA(af, b0, a0); a1 = MFMA(af, b1, a1);
  }
  us* out = (us*)(p.ws + OFF_MIXIN);
#pragma unroll
  for (int i = 0; i < 16; ++i) {
    int t = w * 32 + crow(i, hh); float bs = p.in[13][l * 512 + h * 128 + t];
    const us* pu = P + (m0 + t) * INC + h * 64;
    float u0 = gelu_t(bf2f(pu[r])), u1 = gelu_t(bf2f(pu[32 + r]));
    out[(m0 + t) * 1024 + h * 64 + r] = f2bf(u0 * (a0[i] + bs));
    out[(m0 + t) * 1024 + h * 64 + 32 + r] = f2bf(u1 * (a1[i] + bs));
  }
}

DI void gla_gate_dir(const Params& p, int l, const us* Prow0, int h, int d, float* sW, float* G) {
  const int tid = tidx(), w = tid >> 6, lane = tid & 63, r = lane & 31, hh = lane >> 5, mt = w >> 1, nt = w & 1;
  {
    const bf16x8 a = *(const bf16x8*)(Prow0 + (size_t)(mt * 32 + r) * INC + 1536 + d * 16 + hh * 8);
    const bf16x8 bw = *(const bf16x8*)(wl(p, l) + W_WG + (size_t)(d * 256 + h * 64 + nt * 32 + r) * 16 + hh * 8);
    f32x16 z;
#pragma unroll
    for (int q = 0; q < 16; ++q) z[q] = 0.f;
    z = MFMA(a, bw, z);
    const float bg = p.in[15][l * 512 + d * 256 + h * 64 + nt * 32 + r];
#pragma unroll
    for (int i = 0; i < 16; ++i) G[(mt * 32 + crow(i, hh)) * 64 + nt * 32 + r] = logsig(z[i] + bg) * (1.f / 16.f);
  }
  __syncthreads();
  {
    const int ch = tid & 63, seg = tid >> 6;
    float v[16];
#pragma unroll
    for (int k = 0; k < 16; ++k) v[k] = G[(seg * 16 + k) * 64 + ch];
    if (d == 0) {
#pragma unroll
      for (int k = 1; k < 16; ++k) v[k] += v[k - 1];
      sW[seg * 64 + ch] = v[15];
    } else {
#pragma unroll
      for (int k = 14; k >= 0; --k) v[k] += v[k + 1];
      sW[seg * 64 + ch] = v[0];
    }
    __syncthreads();
    float off = 0.f;
    if (d == 0) { for (int q = 0; q < 3; ++q) off += (q < seg) ? sW[q * 64 + ch] : 0.f; }
    else { for (int q = 1; q < 4; ++q) off += (q > seg) ? sW[q * 64 + ch] : 0.f; }
#pragma unroll
    for (int k = 0; k < 16; ++k) G[(seg * 16 + k) * 64 + ch] = v[k] + off;
  }
  __syncthreads();
}
DI size_t gla_idx(int b, int c, int h, int d) { return (size_t)(((b * NCHK + c) * 4 + h) * 2 + d); }

DI void gla1_task(const Params& p, int l, int b, int c, int h, char* smem) {
  float* G0 = (float*)smem; float* G1 = G0 + 4096; float* sW = G1 + 4096;
  us* KeT = (us*)(sW + 1024);
  us* Vt = KeT + 2 * 64 * 72;
  const int tid = tidx(), w = tid >> 6, lane = tid & 63, r = lane & 31, hh = lane >> 5;
  const long m0 = seqrow(b, c * 64);
  const us* P0 = (const us*)(p.ws + OFF_P) + m0 * INC;
  __syncthreads();
  gla_gate_dir(p, l, P0, h, 0, sW, G0);
  gla_gate_dir(p, l, P0, h, 1, sW, G1);
  {
    int t = tid >> 2, q4 = tid & 3; float kk[16], vv[16];
    const us* sk = P0 + (size_t)t * INC + 768 + h * 64 + q4 * 16;
    const us* sv = P0 + (size_t)t * INC + 1024 + h * 64 + q4 * 16;
    unpack8(*(const u32x4*)sk, kk); unpack8(*(const u32x4*)(sk + 8), kk + 8);
    unpack8(*(const u32x4*)sv, vv); unpack8(*(const u32x4*)(sv + 8), vv + 8);
#pragma unroll
    for (int cc = 0; cc < 16; ++cc) {
      int ch = q4 * 16 + cc;
      KeT[ch * 72 + t] = f2bf(kk[cc] * __expf(G0[63 * 64 + ch] - G0[t * 64 + ch]));
      KeT[(64 + ch) * 72 + t] = f2bf(kk[cc] * __expf(G1[ch] - G1[t * 64 + ch]));
      Vt[ch * 72 + t] = f2bf(vv[cc]);
    }
    if (tid < 128) {
      int d = tid >> 6, ch = tid & 63;
      ((float*)(p.ws + OFF_DEC))[gla_idx(b, c, h, d) * 64 + ch] = __expf(d ? G1[ch] : G0[63 * 64 + ch]);
    }
  }
  __syncthreads();
  {
    const int d = w >> 1, mt = w & 1;
    float* kv = (float*)(p.ws + OFF_KV) + gla_idx(b, c, h, d) * 4096;
#pragma unroll
    for (int nt = 0; nt < 2; ++nt) {
      f32x16 acc;
#pragma unroll
      for (int q = 0; q < 16; ++q) acc[q] = 0.f;
#pragma unroll
      for (int ks = 0; ks < 4; ++ks) {
        bf16x8 a = *(const bf16x8*)(Vt + (mt * 32 + r) * 72 + ks * 16 + hh * 8);
        bf16x8 bb = *(const bf16x8*)(KeT + (d * 64 + nt * 32 + r) * 72 + ks * 16 + hh * 8);
        acc = MFMA(a, bb, acc);
      }
#pragma unroll
      for (int i = 0; i < 16; ++i) kv[(mt * 32 + crow(i, hh)) * 64 + nt * 32 + r] = acc[i];
    }
  }
}
DI int gla_order(int d, int j) { return d == 0 ? j : (j < 4 ? 3 - j : 135 - j); }
DI void gla2_task(const Params& p, int it) {
  const int gid = it * 256 + tidx();
  const int e = gid & 4095, d = (gid >> 12) & 1, h = (gid >> 13) & 3, b = gid >> 15, k = e & 63;
  float* KV = (float*)(p.ws + OFF_KV); const float* DEC = (const float*)(p.ws + OFF_DEC);
  float s = 0;
  for (int j0 = 0; j0 < NCHK; j0 += 33) {
    float kv[33], dc[33];
#pragma unroll
    for (int q = 0; q < 33; ++q) { const size_t ix = gla_idx(b, gla_order(d, j0 + q), h, d); kv[q] = KV[ix * 4096 + e]; dc[q] = DEC[ix * 64 + k]; }
#pragma unroll
    for (int q = 0; q < 33; ++q) { const size_t ix = gla_idx(b, gla_order(d, j0 + q), h, d); KV[ix * 4096 + e] = s; s = dc[q] * s + kv[q]; }
  }
}
DI void gla3_task(const Params& p, int l, int b, int c, int h, char* smem) {
  float* G = (float*)smem;
  us* Qin = (us*)(smem + 17408);
  us* Kin = Qin + 64 * 72; us* Vt = Kin + 64 * 72; us* ST = Vt + 64 * 72; us* Sc = ST + 64 * 72;
  float* sW = (float*)Sc;
  const int tid = tidx(), w = tid >> 6, lane = tid & 63, r = lane & 31, hh = lane >> 5;
  const long m0 = seqrow(b, c * 64);
  const us* P0 = (const us*)(p.ws + OFF_P) + m0 * INC;
  const int t_ = tid >> 2, q4 = tid & 3;
  __syncthreads();
  {
    float vv[16]; const us* sv = P0 + (size_t)t_ * INC + 1024 + h * 64 + q4 * 16;
    unpack8(*(const u32x4*)sv, vv); unpack8(*(const u32x4*)(sv + 8), vv + 8);
#pragma unroll
    for (int cc = 0; cc < 16; ++cc) Vt[(q4 * 16 + cc) * 72 + t_] = f2bf(vv[cc]);
  }
  f32x16 oacc;
#pragma unroll
  for (int q = 0; q < 16; ++q) oacc[q] = 0.f;
  const int mt = w >> 1, nt = w & 1;
  for (int d = 0; d < 2; ++d) {
    gla_gate_dir(p, l, P0, h, d, sW, G);
    {
      float qq[16], kk[16], qo[16], ko[16];
      const us* sq = P0 + (size_t)t_ * INC + 512 + h * 64 + q4 * 16;
      const us* sk = P0 + (size_t)t_ * INC + 768 + h * 64 + q4 * 16;
      unpack8(*(const u32x4*)sq, qq); unpack8(*(const u32x4*)(sq + 8), qq + 8);
      unpack8(*(const u32x4*)sk, kk); unpack8(*(const u32x4*)(sk + 8), kk + 8);
#pragma unroll
      for (int cc = 0; cc < 16; ++cc) { float gg = G[t_ * 64 + q4 * 16 + cc]; qo[cc] = qq[cc] * 0.125f * __expf(gg); ko[cc] = kk[cc] * __expf(-gg); }
      *(u32x4*)(Qin + t_ * 72 + q4 * 16) = pack8(qo); *(u32x4*)(Qin + t_ * 72 + q4 * 16 + 8) = pack8(qo + 8);
      *(u32x4*)(Kin + t_ * 72 + q4 * 16) = pack8(ko); *(u32x4*)(Kin + t_ * 72 + q4 * 16 + 8) = pack8(ko + 8);
      const float* ss = (const float*)(p.ws + OFF_KV) + gla_idx(b, c, h, d) * 4096 + tid * 16;
      float sf[16];
#pragma unroll
      for (int j = 0; j < 4; ++j) { f32x4 t4 = *(const f32x4*)(ss + j * 4); sf[4 * j] = t4[0]; sf[4 * j + 1] = t4[1]; sf[4 * j + 2] = t4[2]; sf[4 * j + 3] = t4[3]; }
      const int v_ = tid >> 2, k0 = (tid & 3) * 16;
      *(u32x4*)(ST + v_ * 72 + k0) = pack8(sf); *(u32x4*)(ST + v_ * 72 + k0 + 8) = pack8(sf + 8);
    }
    __syncthreads();
    {
      const int tt = mt, st = nt;
      const bool need = d == 0 ? st <= tt : st >= tt;
      f32x16 sc;
#pragma unroll
      for (int q = 0; q < 16; ++q) sc[q] = 0.f;
      if (need) {
#pragma unroll
        for (int ks = 0; ks < 4; ++ks) {
          bf16x8 a = *(const bf16x8*)(Qin + (tt * 32 + r) * 72 + ks * 16 + hh * 8);
          bf16x8 bb = *(const bf16x8*)(Kin + (st * 32 + r) * 72 + ks * 16 + hh * 8);
          sc = MFMA(a, bb, sc);
        }
      }
#pragma unroll
      for (int i = 0; i < 16; ++i) {
        int trow = tt * 32 + crow(i, hh), scol = st * 32 + r;
        bool keep = d == 0 ? scol <= trow : scol >= trow;
        Sc[trow * 72 + scol] = f2bf(keep ? sc[i] : 0.f);
      }
    }
    __syncthreads();
#pragma unroll
    for (int ks = 0; ks < 4; ++ks) {
      bf16x8 a = *(const bf16x8*)(Sc + (mt * 32 + r) * 72 + ks * 16 + hh * 8);
      bf16x8 bb = *(const bf16x8*)(Vt + (nt * 32 + r) * 72 + ks * 16 + hh * 8);
      oacc = MFMA(a, bb, oacc);
    }
#pragma unroll
    for (int ks = 0; ks < 4; ++ks) {
      bf16x8 a = *(const bf16x8*)(Qin + (mt * 32 + r) * 72 + ks * 16 + hh * 8);
      bf16x8 bb = *(const bf16x8*)(ST + (nt * 32 + r) * 72 + ks * 16 + hh * 8);
      oacc = MFMA(a, bb, oacc);
    }
    __syncthreads();
  }
  float* Ob = (float*)smem;
#pragma unroll
  for (int i = 0; i < 16; ++i) Ob[(mt * 32 + crow(i, hh)) * 68 + nt * 32 + r] = oacc[i];
  __syncthreads();
  {
    float o[16], rr[16]; float ss = 0;
#pragma unroll
    for (int cc = 0; cc < 16; ++cc) { o[cc] = Ob[t_ * 68 + q4 * 16 + cc]; ss += o[cc] * o[cc]; }
    ss += __shfl_xor(ss, 1); ss += __shfl_xor(ss, 2);
    float rstd = rsqrtf(ss * (1.f / 64.f) + EPS);
    const us* sr = P0 + (size_t)t_ * INC + 1280 + h * 64 + q4 * 16;
    unpack8(*(const u32x4*)sr, rr); unpack8(*(const u32x4*)(sr + 8), rr + 8);
    const float* gn = p.in[16] + l * 256 + h * 64 + q4 * 16;
#pragma unroll
    for (int cc = 0; cc < 16; ++cc) o[cc] = o[cc] * rstd * gn[cc] * silu_(rr[cc]);
    us* dst = (us*)(p.ws + OFF_MIXIN) + (m0 + t_) * 1024 + 256 + h * 64 + q4 * 16;
    *(u32x4*)dst = pack8(o); *(u32x4*)(dst + 8) = pack8(o + 8);
  }
}

DI size_t hl_idx(int b, int c, int d, int g, int pp) { return ((size_t)(((b * NCHK + c) * 2 + d) * 16 + g) * 64 + pp) * 2; }
template <bool OUT>
DI void s5_task(const Params& p, int l, int b, int c, int gp, char* smem) {
  us* Hb = (us*)smem;
  float* Yb = (float*)(smem + 4 * 32 * 136 * 2);
  const int tid = tidx(), w = tid >> 6, lane = tid & 63, r = lane & 31, hh = lane >> 5;
  const long m0 = seqrow(b, c * 64);
  const us* P0 = (const us*)(p.ws + OFF_P) + m0 * INC;
  const int gl = w >> 1, d = w & 1, g = gp * 2 + gl, pp = lane;
  const float* sf = s5f(p, l);
  const float lr = sf[S_LAMB + ((d * 16 + g) * 64 + pp) * 2], li = sf[S_LAMB + ((d * 16 + g) * 64 + pp) * 2 + 1];
  const f32x2_ la = {lr, lr}, lb = {-li, li};
  float hr = 0.f, hi = 0.f;
  float* HL = (float*)(p.ws + OFF_HL) + hl_idx(b, c, d, g, pp);
  if (OUT) { hr = HL[0]; hi = HL[1]; }
  const us* cm = wl(p, l) + W_CM + ((size_t)(d * 16 + g) * 16 + (r & 15)) * 128 + hh * 8;
  const us* bm = wl(p, l) + W_BM + ((size_t)(d * 16 + g) * 128 + r) * 16 + hh * 8;
  us* hb = Hb + w * 32 * 136;
  __syncthreads();
  for (int half = 0; half < 2; ++half) {
    const int tbase = d ? (1 - half) * 32 : half * 32;
    {
      const bf16x8 a = *(const bf16x8*)(P0 + (size_t)(tbase + r) * INC + 1568 + g * 16 + hh * 8);
#pragma unroll
      for (int nt = 0; nt < 4; ++nt) {
        const bf16x8 bb = *(const bf16x8*)(bm + nt * 32 * 16);
        f32x16 z;
#pragma unroll
        for (int q = 0; q < 16; ++q) z[q] = 0.f;
        z = MFMA(a, bb, z);
#pragma unroll
        for (int i = 0; i < 16; ++i) hb[crow(i, hh) * 136 + nt * 32 + r] = f2bf(z[i]);
      }
    }
    __syncthreads();
    for (int jj = 0; jj < 32; ++jj) {
      const int tl = d ? 31 - jj : jj;
      const f32x2_ bu = {bf2f(hb[tl * 136 + pp]), bf2f(hb[tl * 136 + 64 + pp])};
      { f32x2_ h = {hr, hi}, hs = {hi, hr}; f32x2_ nh = la * h + lb * hs + bu; hr = nh[0]; hi = nh[1]; }
      if (OUT) { hb[tl * 136 + pp] = f2bf(hr); hb[tl * 136 + 64 + pp] = f2bf(hi); }
    }
    if (OUT) {
      __syncthreads();
      f32x16 acc;
#pragma unroll
      for (int q = 0; q < 16; ++q) acc[q] = 0.f;
#pragma unroll
      for (int ks = 0; ks < 8; ++ks) {
        bf16x8 a = *(const bf16x8*)(hb + r * 136 + ks * 16 + hh * 8);
        bf16x8 bb = *(const bf16x8*)(cm + ks * 16);
        if (r >= 16) bb = (bf16x8){0, 0, 0, 0, 0, 0, 0, 0};
        acc = MFMA(a, bb, acc);
      }
      if (r < 16) {
#pragma unroll
        for (int i = 0; i < 16; ++i) Yb[(w * 64 + tbase + crow(i, hh)) * 17 + r] = acc[i];
      }
    }
    __syncthreads();
  }
  if (!OUT) { HL[0] = hr; HL[1] = hi; return; }
  {
    const int gl2 = tid >> 7, t = (tid >> 1) & 63, o8 = (tid & 1) * 8, g2 = gp * 2 + gl2; float y[8], u8[8];
    unpack8(*(const u32x4*)(P0 + (size_t)t * INC + 1568 + g2 * 16 + o8), u8);
#pragma unroll
    for (int o = 0; o < 8; ++o) {
      float v = Yb[((gl2 * 2 + 0) * 64 + t) * 17 + o8 + o] + Yb[((gl2 * 2 + 1) * 64 + t) * 17 + o8 + o]
              + p.in[24][l * 256 + g2 * 16 + o8 + o] * u8[o];
      y[o] = gelu_t(v);
    }
    *(u32x4*)((us*)(p.ws + OFF_Y) + (m0 + t) * 256 + g2 * 16 + o8) = pack8(y);
  }
}
DI void s5b_task(const Params& p, int l, int it) {
  const int gid = it * 256 + tidx();
  const int pp = gid & 63, g = (gid >> 6) & 15, d = (gid >> 10) & 1, b = gid >> 11;
  const float* sf = s5f(p, l);
  const float tr = sf[S_LAMT + ((d * 16 + g) * 64 + pp) * 2], ti = sf[S_LAMT + ((d * 16 + g) * 64 + pp) * 2 + 1];
  float* HL = (float*)(p.ws + OFF_HL);
  float hr = 0.f, hi = 0.f;
  for (int j0 = 0; j0 < NCHK; j0 += 33) {
    f32x2_ xv[33];
#pragma unroll
    for (int q = 0; q < 33; ++q) xv[q] = *(const f32x2_*)(HL + hl_idx(b, gla_order(d, j0 + q), d, g, pp));
#pragma unroll
    for (int q = 0; q < 33; ++q) {
      f32x2_ o = {hr, hi};
      *(f32x2_*)(HL + hl_idx(b, gla_order(d, j0 + q), d, g, pp)) = o;
      float nr = tr * hr - ti * hi + xv[q][0], ni = tr * hi + ti * hr + xv[q][1]; hr = nr; hi = ni;
    }
  }
}

DI void attn_task(const Params& p, int b, int h, int qs0, int nkeys, char* smem) {
  constexpr int KSZ = 64 * 104, VSZ = 64 * 68;
  us* sK = (us*)smem;
  us* sV = sK + 3 * KSZ;
  const int tid = tid512(), w = tid >> 6, lane = tid & 63, r = lane & 31, hh = lane >> 5;
  const us* Kg = (const us*)(p.ws + OFF_KB) + (size_t)(b * 4 + h) * SEQ * 96;
  const us* Vg = (const us*)(p.ws + OFF_VT) + (size_t)(b * 4 + h) * 64 * SEQ;
  const us* Qg = (const us*)(p.ws + OFF_QB) + ((size_t)(b * 4 + h) * SEQ + qs0 + w * 32 + r) * 96 + hh * 8;
  bf16x8 qf[6];
#pragma unroll
  for (int ks = 0; ks < 6; ++ks) qf[ks] = *(const bf16x8*)(Qg + ks * 16);
  u32x4 rk[2], rv;
  const int kq1 = tid + 512 < 768 ? tid + 512 : tid;
  const int vrow = tid >> 3, vcc = tid & 7;
  const int kw0 = (tid / 12) * 104 + (tid % 12) * 8, kw1 = (kq1 / 12) * 104 + (kq1 % 12) * 8, vw = vrow * 68 + vcc * 8;
#define AGLOAD(kt) { rk[0] = *(const u32x4*)(Kg + (size_t)(kt) * 64 * 96 + tid * 8); rk[1] = *(const u32x4*)(Kg + (size_t)(kt) * 64 * 96 + kq1 * 8); \
    rv = *(const u32x4*)(Vg + (size_t)vrow * SEQ + (kt) * 64 + vcc * 8); }
#define ASWRITE(buf) { *(u32x4*)(sK + (buf) * KSZ + kw0) = rk[0]; *(u32x4*)(sK + (buf) * KSZ + kw1) = rk[1]; \
    us* dv = sV + (buf) * VSZ + vw; u32x2 lo = {rv[0], rv[1]}, hi2 = {rv[2], rv[3]}; *(u32x2*)dv = lo; *(u32x2*)(dv + 4) = hi2; }
  f32x16 o0, o1, negm, sc0, sc1;
#pragma unroll
  for (int q = 0; q < 16; ++q) { o0[q] = 0.f; o1[q] = 0.f; sc0[q] = 0.f; sc1[q] = 0.f; }
  float lsum = 0.f;
  const int NT = nkeys / 64;
  __syncthreads();
  AGLOAD(0); ASWRITE(0); AGLOAD(1); ASWRITE(1); AGLOAD(2);
  __syncthreads();
  {
    const us* k0 = sK + r * 104 + hh * 8;
#pragma unroll
    for (int ks = 0; ks < 6; ++ks) {
      bf16x8 a0 = *(const bf16x8*)(k0 + ks * 16), a1 = *(const bf16x8*)(k0 + 32 * 104 + ks * 16);
      sc0 = MFMA(a0, qf[ks], sc0); sc1 = MFMA(a1, qf[ks], sc1);
    }
    float mx = sc0[0];
#pragma unroll
    for (int i = 1; i < 16; ++i) mx = fmaxf(mx, sc0[i]);
#pragma unroll
    for (int i = 0; i < 16; ++i) mx = fmaxf(mx, sc1[i]);
    mx = fmaxf(mx, __shfl_xor(mx, 32));
#pragma unroll
    for (int q = 0; q < 16; ++q) { negm[q] = -mx; sc0[q] -= mx; sc1[q] -= mx; }
  }
  int bc = 0, bn = 1, bw = 2;
  for (int kt = 0; kt < NT; ++kt) {
    __syncthreads();
    ASWRITE(bw);
    { const int kl = kt + 3 < NT ? kt + 3 : NT - 1; AGLOAD(kl); }
    float mx = sc0[0];
#pragma unroll
    for (int i = 1; i < 16; ++i) mx = fmaxf(mx, sc0[i]);
#pragma unroll
    for (int i = 0; i < 16; ++i) mx = fmaxf(mx, sc1[i]);
    mx = fmaxf(mx, __shfl_xor(mx, 32));
    if (__builtin_amdgcn_ballot_w64(mx > 8.f)) {
      const float dl = fmaxf(mx, 0.f), alpha = __builtin_amdgcn_exp2f(-dl);
#pragma unroll
      for (int i = 0; i < 16; ++i) { o0[i] *= alpha; o1[i] *= alpha; sc0[i] -= dl; sc1[i] -= dl; negm[i] -= dl; }
      lsum *= alpha;
    }
    f32x16 sn0, sn1;
    {
      const us* k0 = sK + bn * KSZ + r * 104 + hh * 8;
      {
        bf16x8 a0 = *(const bf16x8*)(k0), a1 = *(const bf16x8*)(k0 + 32 * 104);
        sn0 = MFMA(a0, qf[0], negm); sn1 = MFMA(a1, qf[0], negm);
      }
#pragma unroll
      for (int ks = 1; ks < 6; ++ks) {
        bf16x8 a0 = *(const bf16x8*)(k0 + ks * 16), a1 = *(const bf16x8*)(k0 + 32 * 104 + ks * 16);
        sn0 = MFMA(a0, qf[ks], sn0); sn1 = MFMA(a1, qf[ks], sn1);
      }
    }
    float ps = 0.f;
#pragma unroll
    for (int i = 0; i < 16; ++i) { sc0[i] = __builtin_amdgcn_exp2f(sc0[i]); ps += sc0[i]; }
#pragma unroll
    for (int i = 0; i < 16; ++i) { sc1[i] = __builtin_amdgcn_exp2f(sc1[i]); ps += sc1[i]; }
    lsum += ps;
    bf16x8 pf[4];
    {
      u32x4 t0 = {pk2(sc0[0], sc0[1]), pk2(sc0[2], sc0[3]), pk2(sc0[4], sc0[5]), pk2(sc0[6], sc0[7])};
      u32x4 t1 = {pk2(sc0[8], sc0[9]), pk2(sc0[10], sc0[11]), pk2(sc0[12], sc0[13]), pk2(sc0[14], sc0[15])};
      u32x4 t2 = {pk2(sc1[0], sc1[1]), pk2(sc1[2], sc1[3]), pk2(sc1[4], sc1[5]), pk2(sc1[6], sc1[7])};
      u32x4 t3 = {pk2(sc1[8], sc1[9]), pk2(sc1[10], sc1[11]), pk2(sc1[12], sc1[13]), pk2(sc1[14], sc1[15])};
      pf[0] = __builtin_bit_cast(bf16x8, t0); pf[1] = __builtin_bit_cast(bf16x8, t1);
      pf[2] = __builtin_bit_cast(bf16x8, t2); pf[3] = __builtin_bit_cast(bf16x8, t3);
    }
    {
      const us* v0 = sV + bc * VSZ + r * 68 + 4 * hh;
#pragma unroll
      for (int kk = 0; kk < 4; ++kk) {
        u32x2 l0 = *(const u32x2*)(v0 + 16 * kk), h0 = *(const u32x2*)(v0 + 16 * kk + 8);
        u32x2 l1 = *(const u32x2*)(v0 + 32 * 68 + 16 * kk), h1 = *(const u32x2*)(v0 + 32 * 68 + 16 * kk + 8);
        u32x4 a0 = {l0[0], l0[1], h0[0], h0[1]}, a1 = {l1[0], l1[1], h1[0], h1[1]};
        o0 = MFMA(__builtin_bit_cast(bf16x8, a0), pf[kk], o0);
        o1 = MFMA(__builtin_bit_cast(bf16x8, a1), pf[kk], o1);
      }
    }
    sc0 = sn0; sc1 = sn1;
    { const int t = bc; bc = bn; bn = bw; bw = t; }
  }
#undef AGLOAD
#undef ASWRITE
  lsum += __shfl_xor(lsum, 32);
  const float inv = 1.f / lsum;
  const long m = seqrow(b, qs0 + w * 32 + r);
  us* dst = (us*)(p.ws + OFF_MIXIN) + m * 1024 + 768 + h * 64;
#pragma unroll
  for (int gq = 0; gq < 4; ++gq) {
    u32x2 w0 = {pk2(o0[4 * gq] * inv, o0[4 * gq + 1] * inv), pk2(o0[4 * gq + 2] * inv, o0[4 * gq + 3] * inv)};
    u32x2 w1 = {pk2(o1[4 * gq] * inv, o1[4 * gq + 1] * inv), pk2(o1[4 * gq + 2] * inv, o1[4 * gq + 3] * inv)};
    *(u32x2*)(dst + 8 * gq + 4 * hh) = w0;
    *(u32x2*)(dst + 32 + 8 * gq + 4 * hh) = w1;
  }
}

DI void convact_task(const Params& p, int l, int it, int nrows) {
  const int T = it * 256 + tidx();
  if (T >= (nrows / 8) * 352) return;
  const int rb = T / 352, oct = T - rb * 352, c0 = oct * 8, i0 = rb * 8;
  const int slo = i0 < 8192 ? 0 : 8192, shi = i0 < 8192 ? 8192 : 8448;
  const us* Z = (const us*)(p.ws + OFF_ZPRE);
  const float* cw = p.in[33] + (size_t)l * 3 * DFF2; const float* cb = p.in[34] + (size_t)l * DFF2;
  float wa[3][8], wg[3][8], ba[8], bg[8];
#pragma unroll
  for (int j = 0; j < 3; ++j) {
    f32x4 a0 = *(const f32x4*)(cw + j * DFF2 + c0), a1 = *(const f32x4*)(cw + j * DFF2 + c0 + 4);
    f32x4 g0 = *(const f32x4*)(cw + j * DFF2 + DFF + c0), g1 = *(const f32x4*)(cw + j * DFF2 + DFF + c0 + 4);
#pragma unroll
    for (int q = 0; q < 4; ++q) { wa[j][q] = a0[q]; wa[j][4 + q] = a1[q]; wg[j][q] = g0[q]; wg[j][4 + q] = g1[q]; }
  }
  {
    f32x4 a0 = *(const f32x4*)(cb + c0), a1 = *(const f32x4*)(cb + c0 + 4), g0 = *(const f32x4*)(cb + DFF + c0), g1 = *(const f32x4*)(cb + DFF + c0 + 4);
#pragma unroll
    for (int q = 0; q < 4; ++q) { ba[q] = a0[q]; ba[4 + q] = a1[q]; bg[q] = g0[q]; bg[4 + q] = g1[q]; }
  }
  u32x4 ra_[10], rg_[10];
#pragma unroll
  for (int k = 0; k < 10; ++k) {
    const int i = i0 - 1 + k;
    if (i >= slo && i < shi) { ra_[k] = *(const u32x4*)(Z + (size_t)i * DFF2 + c0); rg_[k] = *(const u32x4*)(Z + (size_t)i * DFF2 + DFF + c0); }
    else { ra_[k] = (u32x4){0u, 0u, 0u, 0u}; rg_[k] = (u32x4){0u, 0u, 0u, 0u}; }
  }
  us* A = (us*)(p.ws + OFF_ACT);
  float za[3][8], zg[3][8];
  unpack8(ra_[0], za[0]); unpack8(rg_[0], zg[0]); unpack8(ra_[1], za[1]); unpack8(rg_[1], zg[1]);
#pragma unroll
  for (int ii = 0; ii < 8; ++ii) {
    const int i = i0 + ii;
    unpack8(ra_[ii + 2], za[2]); unpack8(rg_[ii + 2], zg[2]);
    float o[8];
#pragma unroll
    for (int q = 0; q < 8; ++q) {
      float a = ba[q] + wa[0][q] * za[0][q] + wa[1][q] * za[1][q] + wa[2][q] * za[2][q];
      float gg = bg[q] + wg[0][q] * zg[0][q] + wg[1][q] * zg[1][q] + wg[2][q] * zg[2][q];
      o[q] = gelu_t(a) * gg;
    }
    *(u32x4*)(A + (size_t)i * DFF + c0) = pack8(o);
#pragma unroll
    for (int q = 0; q < 8; ++q) { za[0][q] = za[1][q]; za[1][q] = za[2][q]; zg[0][q] = zg[1][q]; zg[1][q] = zg[2][q]; }
  }
}

constexpr int SCHED_WORDS = 1024;
DI int gl_n(int RT, int CT, int x) { return ((RT - x + 7) >> 3) * CT; }
DI void gl_tile(int RT, int CT, int x, int j, int& rt, int& ct) {
  const int rows = (RT - x + 7) >> 3, nfull = CT >> 3; int rl;
  if (j < nfull * rows * 8) { int pnl = j / (rows * 8), rem = j - pnl * rows * 8; rl = rem >> 3; ct = pnl * 8 + (rem & 7); }
  else { int j2 = j - nfull * rows * 8, wd = CT - nfull * 8; rl = j2 / wd; ct = nfull * 8 + (j2 - rl * wd); }
  rt = rl * 8 + x;
}
DI int ml_n(int n, int x) { return (n - x + 7) >> 3; }
template <class NX, class RUN>
DI void run_phase(unsigned*& ctr, int G, int bid, volatile int* s_bc, NX nx, RUN run) {
  const int x0 = bid & 7, per = G >> 3;
  const int x = x0; int j = bid >> 3;
  for (;;) {
    if (j < nx(x)) {
      int nj = 0;
      if (threadIdx.x == 0) nj = per + (int)atomicAdd(&ctr[x], 1u);
      run(x, j);
      __syncthreads();
      if (threadIdx.x == 0) *s_bc = nj;
      __syncthreads();
      j = *s_bc;
    } else break;
  }
  ctr += 8;
}

DI long chunk_row(int ch, int i) { return i < 8192 ? (long)ch * 8192 + i : (long)MX + ch * 256 + (i - 8192); }


template <class RUN>
DI void run_tiles(unsigned*& ctr, int n, int G, int bid, volatile int* s_bc, RUN run) {
  int it = bid;
  while (it < n) {
    int nx = 0;
    if (threadIdx.x == 0) nx = G + (int)atomicAdd(ctr, 1u);
    run(it);
    __syncthreads();
    if (threadIdx.x == 0) *s_bc = nx;
    __syncthreads();
    it = *s_bc;
  }
  ctr += 1;
}

constexpr int HLDS = 64512;
constexpr int LDS_BYTES = 147456;
static_assert(2 * HLDS <= LDS_BYTES, "lds");

__global__ void __launch_bounds__(512) fwd_mega(Params p) {
  cg::grid_group grid = cg::this_grid();
  extern __shared__ __attribute__((aligned(16))) char dsm[];
  __shared__ uint4 xb_words;
  const int G = gridDim.x, bid = blockIdx.x, wv8 = __builtin_amdgcn_readfirstlane(threadIdx.x >> 6), half = wv8 >> 2;
  char* smem = dsm + half * HLDS;
  const int vb = bid * 2 + half, V = 2 * G;
  if (threadIdx.x == 0) xb_words = make_uint4(0u, 0u, 0u, 0u);
  __syncthreads();
  const XcdBarrier xb = xcd_barrier_post((unsigned*)(p.ws + OFF_BAR), (volatile LAS unsigned*)&xb_words);
#define HALF_LOOP(n, IT, ...) { const int n_ = (n); const int iters_ = (n_ + V - 1) / V; for (int k_ = 0; k_ < iters_; ++k_) { int IT = vb + k_ * V; IT = IT < n_ ? IT : n_ - 1; __VA_ARGS__ } }
#define HALF_LOOP_NB(n, IT, ...) { const int n_ = (n); for (int IT = vb; IT < n_; IT += V) { __VA_ARGS__ } }

  HALF_LOOP(2 * NCONV_LAYER, it, conv_task(p, it, smem);)
  HALF_LOOP(384, it, mod_task(p, it, smem);)
  HALF_LOOP_NB(16, it, s5pre_task(p, it);)
  HALF_LOOP_NB(4, it, rope_task(p, it);)
  HALF_LOOP_NB(128, it, sguw_task(p, it);)
  HALF_LOOP_NB(64, it, wgt_task(p, it);)
  grid.sync();
  for (int it = bid; it < MT / 8; it += G) row_task<0>(p, 0, (long)it * 8 + wv8, nullptr);
  xcd_barrier(xb);

  unsigned* ctr = (unsigned*)(p.ws + OFF_SCHED);
  volatile int* s_bc = (volatile int*)&xb_words.z;
  for (int l = 0; l < 2; ++l) {
    const us* W = wl(p, l);
    const int RT = l == 0 ? 264 : 256;
    run_tiles(ctr, 132 * 9, G, bid, s_bc, [&](int it) {
      const int rt = it / 9, ct = it - rt * 9;
      GArgs g{(const us*)(p.ws + OFF_HX) + (size_t)rt * 256 * D, D, W + W_IN + (size_t)ct * 256 * D, D, (long)rt * 256, ct * 256, p.ws + OFF_P, INC, l};
      gemm_8p(g, dsm, ct == 8 ? 128 : 256);
    });
    xcd_barrier(xb);
    {
      const int p0 = (4 * NCHK * 8) >> 1, p1 = p0 + ((4 * NCHK * 4) >> 1), p2 = p1 + ((RT * 4) >> 1), p3 = p2 + ((264 * 3) >> 1), p4 = p3 + ((264 * 4) >> 1);
      for (int P = bid; P < p4; P += G) {
        if (P < p0) { const int q = 2 * P + half; s5_task<false>(p, l, q / (NCHK * 8), (q / 8) % NCHK, q & 7, smem); }
        else if (P < p1) { const int q = 2 * (P - p0) + half; gla1_task(p, l, q / (NCHK * 4), (q / 4) % NCHK, q & 3, smem); }
        else if (P < p2) { const int q = 2 * (P - p1) + half; sgu_task(p, l, q >> 2, q & 3, smem); }
        else if (P < p3) { const int q = 2 * (P - p2) + half, rt = q / 3, ct = q % 3;
          GArgs g{(const us*)(p.ws + OFF_P) + (size_t)rt * 128 * INC + 1824, INC, W + W_UQ + (size_t)ct * 128 * 224, 224, (long)rt * 128, ct * 128, nullptr, 0, l};
          gemm_tile<32, 2, true>(p, g, smem); }
        else { const int q = 2 * (P - p3) + half, rt = q >> 2, ct = q & 3;
          GArgs g{(const us*)(p.ws + OFF_P) + (size_t)rt * 128 * INC + 2048, INC, W + W_UKV + (size_t)ct * 128 * 96, 96, (long)rt * 128, ct * 128, nullptr, 0, l};
          gemm_tile<32, 3, true>(p, g, smem);
          if (ct == 0) kr_task(p, (long)rt * 128); }
      }
    }
    xcd_barrier(xb);
    HALF_LOOP_NB(512, it, gla2_task(p, it);)
    HALF_LOOP_NB(32, it, s5b_task(p, l, it);)
    xcd_barrier(xb);
    if ((G & 7) == 0) {
      const int x = bid & 7;
      for (int j = bid >> 3; j < 64; j += G >> 3) { int pair = 2 * x + (j >> 5), qb = j & 31; for (int rp = 0; rp < REP_ATT; ++rp) attn_task(p, pair >> 2, pair & 3, 256 + qb * 256, SEQ, dsm); }
    } else {
      for (int it = bid; it < 512; it += G) attn_task(p, it >> 7, (it >> 5) & 3, 256 + (it & 31) * 256, SEQ, dsm);
    }
    if (l == 0) for (int it = bid; it < 16; it += G) attn_task(p, it >> 2, it & 3, 0, 256, dsm);
    {
      const int c0 = l == 0 ? 0 : 4, nc = NCHK - c0;
      const int p0 = (4 * nc * 8) >> 1, p1 = p0 + ((4 * nc * 4) >> 1);
      for (int P = bid; P < p1; P += G) {
        if (P < p0) { const int q = 2 * P + half; s5_task<true>(p, l, q / (nc * 8), c0 + (q / 8) % nc, q & 7, smem); }
        else { const int q = 2 * (P - p0) + half; gla3_task(p, l, q / (nc * 4), c0 + (q / 4) % nc, q & 3, smem); }
      }
    }
    xcd_barrier(xb);
    HALF_LOOP(RT * 2, it, { int rt = it >> 1, ct = it & 1;
      GArgs g{(const us*)(p.ws + OFF_Y) + (size_t)rt * 128 * 256, 256, W + W_GLU + (size_t)ct * 128 * 256, 256, (long)rt * 128, ct * 128, nullptr, 0, l};
      gemm_tile<32, 4, false>(p, g, smem); })
    xcd_barrier(xb);
    run_tiles(ctr, (RT / 2) * 4, G, bid, s_bc, [&](int it) {
      const int rt = it >> 2, ct = it & 3;
      GArgs g{(const us*)(p.ws + OFF_MIXIN) + (size_t)rt * 256 * D, D, W + W_OUT + (size_t)ct * 256 * D, D, (long)rt * 256, ct * 256, p.ws + OFF_MIXOUT, D, l};
      gemm_8p(g, dsm);
    });
    xcd_barrier(xb);
    for (int it = bid; it < RT * 16; it += G) { long m = (long)it * 8 + wv8; row_task<1>(p, l, m, (const us*)(p.ws + OFF_MIXOUT) + m * 1024); }
    xcd_barrier(xb);
    const int CR2 = l == 0 ? 33 : 32, CROWS = CR2 * 256, NF2 = (CROWS / 8 * 352 + 255) / 256;
    for (int ch = 0; ch <= 4; ++ch) {
      {
        const bool hasF3 = ch > 0, hasF1 = ch < 4;
        const int n3 = hasF3 ? CR2 * 4 : 0, n1 = hasF1 ? CR2 * 22 : 0;
        run_tiles(ctr, n3 + n1, G, bid, s_bc, [&](int it) {
          GArgs g;
          if (it < n3) {
            const int rt = it >> 2, ct = it & 3;
            g = GArgs{(const us*)(p.ws + OFF_ACT) + (size_t)rt * 256 * DFF, DFF, W + W_DN + (size_t)ct * 256 * DFF, DFF, (long)rt * 256, ct * 256, p.ws + OFF_FFNOUT, D, l};
          } else {
            const int q = it - n3, rt = q / 22, ct = q - rt * 22;
            g = GArgs{(const us*)(p.ws + OFF_HX) + (size_t)chunk_row(ch, rt * 256) * D, D, W + W_UP + (size_t)ct * 256 * D, D, (long)rt * 256, ct * 256, p.ws + OFF_ZPRE, DFF2, l};
          }
          gemm_8p(g, dsm);
        });
      }
      xcd_barrier(xb);
      if (ch < 4) HALF_LOOP_NB(NF2, it, convact_task(p, l, it, CROWS);)
      if (ch > 0) for (int it = bid; it < CROWS / 8; it += G) { int i = it * 8 + wv8; row_task<2>(p, l, chunk_row(ch - 1, i), (const us*)(p.ws + OFF_FFNOUT) + (size_t)i * 1024); }
      xcd_barrier(xb);
    }
  }
#undef HALF_LOOP
#undef HALF_LOOP_NB
}

extern "C" void kernel_launch(void* const* d_in, const int* in_sizes, int n_in, void* d_out, int out_size,
                              void* d_ws, size_t ws_size, hipStream_t stream) {
  static int grid_blocks = 0;
  if (!grid_blocks) {
    int dev = 0, cus = 0, per_cu = 0;
    (void)hipGetDevice(&dev);
    (void)hipDeviceGetAttribute(&cus, hipDeviceAttributeMultiprocessorCount, dev);
    if (hipFuncSetAttribute((const void*)fwd_mega, hipFuncAttributeMaxDynamicSharedMemorySize, LDS_BYTES) != hipSuccess)
      fprintf(stderr, "kernel_launch: hipFuncSetAttribute(%d B LDS) failed\n", LDS_BYTES);
    (void)hipOccupancyMaxActiveBlocksPerMultiprocessor(&per_cu, fwd_mega, 512, LDS_BYTES);
    if (per_cu < 1) fprintf(stderr, "kernel_launch: occupancy query returned %d\n", per_cu);
    grid_blocks = cus;
    if (ws_size < OFF_END) fprintf(stderr, "kernel_launch: ws too small: %zu < %zu\n", ws_size, (size_t)OFF_END);
  }
  if (n_in != 36 || ws_size < OFF_END) return;
  Params p{};
  for (int i = 0; i < 36; ++i) p.in[i] = (const float*)d_in[i];
  p.out = (float*)d_out; p.ws = (char*)d_ws;
  void* args[] = {&p};
  (void)hipMemsetAsync((char*)d_ws + OFF_BAR, 0, (XCD_BAR_WORDS + SCHED_WORDS) * 4, stream);
  hipError_t e = hipLaunchCooperativeKernel((void*)fwd_mega, dim3(grid_blocks), dim3(512), args, LDS_BYTES, stream);
  if (e != hipSuccess) fprintf(stderr, "cooperative launch failed: %s (grid %d)\n", hipGetErrorString(e), grid_blocks);
}
```

```cpp
#include <hip/hip_runtime.h>
#include <hip/hip_cooperative_groups.h>
#include <cstdio>
#include <cstdint>
namespace cg = cooperative_groups;

typedef unsigned short us;
using bf16x8 = __attribute__((ext_vector_type(8))) short;
using f32x16 = __attribute__((ext_vector_type(16))) float;
using f32x4  = __attribute__((ext_vector_type(4))) float;
using u32x4  = __attribute__((ext_vector_type(4))) unsigned;
using u32x2  = __attribute__((ext_vector_type(2))) unsigned;
#define DI __device__ __forceinline__
#define MFMA(a, b, c) __builtin_amdgcn_mfma_f32_32x32x16_bf16((a), (b), (c), 0, 0, 0)

#ifndef REP_F3N
#define REP_F3N 1
#endif
#ifndef REP_F1N
#define REP_F1N 1
#endif
#ifndef REP_GEMM
#define REP_GEMM 1
#endif
#ifndef REP_M1
#define REP_M1 1
#endif
#ifndef REP_M3
#define REP_M3 1
#endif
#ifndef REP_ATT
#define REP_ATT 1
#endif
#ifndef REP_GLA3
#define REP_GLA3 1
#endif
#ifndef REP_S5C
#define REP_S5C 1
#endif
#ifndef REP_F2
#define REP_F2 1
#endif
#ifndef REP_P0
#define REP_P0 1
#endif
#ifndef EXTRA_SYNC
#define EXTRA_SYNC 0
#endif
constexpr int D = 1024, MX = 32768, MC = 1024, MT = MX + MC, INC = 2176, DFF = 2816, DFF2 = 5632;
constexpr int SEQ = 8448, NCHK = 132;
constexpr float EPS = 1e-6f;
constexpr float QSCALE = 0.10206207261596577f * 1.4426950408889634f;

constexpr size_t W_IN = 0, W_OUT = W_IN + (size_t)INC * D, W_UP = W_OUT + (size_t)D * D, W_DN = W_UP + (size_t)DFF2 * D,
                 W_UQ = W_DN + (size_t)D * DFF, W_UKV = W_UQ + 384 * 224, W_GLU = W_UKV + 512 * 96, W_SGU = W_GLU + 256 * 256,
                 W_CM = W_SGU + 4 * 128 * 128, W_WG = W_CM + 2 * 16 * 16 * 128, W_BM = W_WG + 2 * 256 * 16, W_LAYER = W_BM + 2 * 16 * 128 * 16;
constexpr size_t S_LAMB = 0, S_LAMT = 4096, S_BBAR = 8192, S_LAYER = 8192 + 65536;

constexpr size_t al256(size_t x) { return (x + 255) / 256 * 256; }
constexpr size_t OFF_WB = 0;
constexpr size_t OFF_S5F = al256(OFF_WB + 2 * W_LAYER * 2);
constexpr size_t OFF_MOD = al256(OFF_S5F + 2 * S_LAYER * 4);
constexpr size_t OFF_ROPE = al256(OFF_MOD + 2 * 5 * 6144 * 4);
constexpr size_t OFF_CTXS = al256(OFF_ROPE + 128 * 8 * 2 * 4);
constexpr size_t OFF_HX = al256(OFF_CTXS + (size_t)MC * D * 4);
constexpr size_t OFF_P = al256(OFF_HX + (size_t)MT * D * 2);
constexpr size_t OFF_MIXIN = al256(OFF_P + (size_t)MT * INC * 2);
constexpr size_t OFF_QB = al256(OFF_MIXIN + (size_t)MT * D * 2);
constexpr size_t OFF_KB = al256(OFF_QB + (size_t)16 * SEQ * 96 * 2);
constexpr size_t OFF_VT = al256(OFF_KB + (size_t)16 * SEQ * 96 * 2);
constexpr size_t OFF_KV = al256(OFF_VT + (size_t)16 * 64 * SEQ * 2);
constexpr size_t OFF_DEC = al256(OFF_KV + (size_t)4 * NCHK * 4 * 2 * 4096 * 4);
constexpr size_t OFF_HL = al256(OFF_DEC + (size_t)4 * NCHK * 4 * 2 * 64 * 4);
constexpr size_t OFF_Y = al256(OFF_HL + (size_t)4 * NCHK * 2 * 16 * 64 * 2 * 4);
constexpr size_t OFF_BAR = al256(OFF_Y + (size_t)MT * 256 * 2);
constexpr size_t OFF_SCHED = OFF_BAR + 3456 * 4;
constexpr size_t OFF_END = al256(OFF_SCHED + 1024 * 4);
constexpr size_t OFF_MIXOUT = OFF_P;
constexpr size_t OFF_ZPRE = OFF_P;
constexpr size_t OFF_ACT = OFF_MIXIN;
constexpr size_t OFF_FFNOUT = OFF_QB;
static_assert((size_t)MT * D * 4 <= (size_t)MT * INC * 2, "mixout alias");
static_assert((size_t)8448 * 1024 * 4 <= 2 * (size_t)16 * SEQ * 96 * 2, "ffnout alias");

struct Params { const float* in[36]; float* out; char* ws; };

DI float bf2f(us v) { return __uint_as_float(((unsigned)v) << 16); }
typedef float f32x2_ __attribute__((ext_vector_type(2)));
typedef __bf16 bf16x2_ __attribute__((ext_vector_type(2)));
DI unsigned pk2(float lo, float hi) { f32x2_ v = {lo, hi}; bf16x2_ b = __builtin_convertvector(v, bf16x2_); return __builtin_bit_cast(unsigned, b); }
DI us f2bf(float x) { return (us)(pk2(x, x) & 0xffffu); }
DI float lo_bf(unsigned w) { return __uint_as_float(w << 16); }
DI float hi_bf(unsigned w) { return __uint_as_float(w & 0xffff0000u); }
DI int tid512() { int t; asm volatile("v_mov_b32 %0, %1" : "=v"(t) : "v"(threadIdx.x)); return t; }
DI int tidx() { return tid512() & 255; }
DI int crow(int i, int hh) { return (i & 3) + 8 * (i >> 2) + 4 * hh; }
DI float sigmoidf_(float x) { return __builtin_amdgcn_rcpf(1.f + __expf(-x)); }
DI float gelu_t(float x) { float u = 0.7978845608028654f * (x + 0.044715f * x * x * x); return x * __builtin_amdgcn_rcpf(1.f + __expf(-2.f * u)); }
DI float silu_(float x) { return x * __builtin_amdgcn_rcpf(1.f + __expf(-x)); }
DI float logsig(float z) { return fminf(z, 0.f) - __logf(1.f + __expf(-fabsf(z))); }
DI void unpack8(u32x4 w, float* f) {
  f[0] = lo_bf(w[0]); f[1] = hi_bf(w[0]); f[2] = lo_bf(w[1]); f[3] = hi_bf(w[1]);
  f[4] = lo_bf(w[2]); f[5] = hi_bf(w[2]); f[6] = lo_bf(w[3]); f[7] = hi_bf(w[3]);
}
DI u32x4 pack8(const float* f) { u32x4 w = {pk2(f[0], f[1]), pk2(f[2], f[3]), pk2(f[4], f[5]), pk2(f[6], f[7])}; return w; }
DI long seqrow(int b, int s) { return s < 256 ? (long)MX + b * 256 + s : (long)b * 8192 + (s - 256); }
DI float wave_sum(float v) {
  v += __shfl_xor(v, 1); v += __shfl_xor(v, 2); v += __shfl_xor(v, 4); v += __shfl_xor(v, 8); v += __shfl_xor(v, 16); v += __shfl_xor(v, 32);
  return v;
}
DI const us* wl(const Params& p, int l) { return (const us*)(p.ws + OFF_WB) + (size_t)l * W_LAYER; }
DI const float* s5f(const Params& p, int l) { return (const float*)(p.ws + OFF_S5F) + (size_t)l * S_LAYER; }
DI const float* modv(const Params& p, int l, int v, int idx) { return (const float*)(p.ws + OFF_MOD) + ((size_t)(l * 5 + v) * 6 + idx) * 1024; }
DI float* stream_row(const Params& p, long m) { return m < MX ? p.out + m * 1024 : (float*)(p.ws + OFF_CTXS) + (m - MX) * 1024; }
DI const float* input_row(const Params& p, long m) { return m < MX ? p.in[0] + m * 1024 : p.in[2] + (m - MX) * 1024; }


#define XB_TMO      128
#define XB_XCNT(j)  (256  + 64 * (j))
#define XB_XSUB(j)  (1280 + 64 * (j))
#define XB_XGEN(j)  (2304 + 64 * (j))
#define XB_TOP      3328
#define XB_TOPGEN   3392
#define XCD_BAR_WORDS 3456
#define XB_SPIN_CAP (1u << 20)
#define LAS __attribute__((address_space(3)))
DI unsigned xb_ld(unsigned* p)              { return __hip_atomic_load(p, __ATOMIC_RELAXED, __HIP_MEMORY_SCOPE_AGENT); }
DI unsigned xb_add(unsigned* p, unsigned v) { return __hip_atomic_fetch_add(p, v, __ATOMIC_RELAXED, __HIP_MEMORY_SCOPE_AGENT); }
DI unsigned xb_xcc_id() { return (unsigned)__builtin_amdgcn_s_getreg((3 << 11) | 20) & 0xFu; }
#define XB_SPIN(cond, bar) do { unsigned _sp = 0; while (cond) { __builtin_amdgcn_s_sleep(1); \
    if ((++_sp & 255u) == 0u) { if (xb_ld(&(bar)[XB_TMO])) break; if (_sp > XB_SPIN_CAP) { atomicAdd(&(bar)[XB_TMO], 1u); break; } } } } while (0)
struct XcdBarrier { unsigned* bar; unsigned x; volatile LAS unsigned* st; };
DI XcdBarrier xcd_barrier_post(unsigned* bar, volatile LAS unsigned* st) {
  XcdBarrier b; b.bar = bar; b.x = (unsigned)__builtin_amdgcn_readfirstlane((int)xb_xcc_id()); b.st = st;
  if (threadIdx.x == 0) (void)xb_add(&bar[XB_XCNT(b.x)], 1u);
  return b;
}
DI void xcd_barrier_complete(unsigned* bar, unsigned x, unsigned& nloc, unsigned& nx) {
  const unsigned G = gridDim.x * gridDim.y * gridDim.z;
  unsigned sum, cnt, mine, sp = 0u;
  for (;;) {
    sum = 0u; cnt = 0u; mine = 0u;
#pragma unroll
    for (unsigned j = 0; j < 16; ++j) { const unsigned c = xb_ld(&bar[XB_XCNT(j)]); sum += c; cnt += (c > 0u) ? 1u : 0u; mine = (j == x) ? c : mine; }
    if (sum == G) break;
    __builtin_amdgcn_s_sleep(1);
    if ((++sp & 255u) == 0u) { if (xb_ld(&bar[XB_TMO])) break; if (sp > XB_SPIN_CAP) { atomicAdd(&bar[XB_TMO], 1u); break; } }
  }
  nloc = mine > 0u ? mine : 1u; nx = cnt > 0u ? cnt : 1u;
}
DI void xcd_barrier(const XcdBarrier& b) {
  asm volatile("s_waitcnt vmcnt(0)" ::: "memory");
  __syncthreads();
  if (threadIdx.x == 0) {
    unsigned* bar = b.bar;
    unsigned bx = b.x; asm volatile("" : "+s"(bx));
    __builtin_amdgcn_s_waitcnt(0);
    unsigned nloc = b.st[0], nx = b.st[1];
    if (nloc == 0u) { xcd_barrier_complete(bar, bx, nloc, nx); b.st[0] = nloc; b.st[1] = nx; }
    const unsigned old = xb_add(&bar[XB_XSUB(bx)], 1u);
    const unsigned gen = old / nloc;
    if (old + 1u == (gen + 1u) * nloc) {
      __builtin_amdgcn_fence(__ATOMIC_RELEASE, "agent");
      asm volatile("s_waitcnt vmcnt(0)" ::: "memory");
      const unsigned og = xb_add(&bar[XB_TOP], 1u);
      const unsigned tg = og / nx;
      if (og + 1u == (tg + 1u) * nx) xb_add(&bar[XB_TOPGEN], 1u);
      else XB_SPIN(xb_ld(&bar[XB_TOPGEN]) == tg, bar);
      __builtin_amdgcn_fence(__ATOMIC_ACQUIRE, "agent");
      xb_add(&bar[XB_XGEN(bx)], 1u);
      asm volatile("s_waitcnt vmcnt(0)" ::: "memory");
    } else {
      XB_SPIN(xb_ld(&bar[XB_XGEN(bx)]) == gen, bar);
      __builtin_amdgcn_fence(__ATOMIC_ACQUIRE, "agent");
      asm volatile("s_waitcnt vmcnt(0)" ::: "memory");
    }
  }
  __syncthreads();
}

DI void conv_tile(const float* src, us* dst, int K, int N, const float* scale, int tile, char* smem) {
  float* t = (float*)smem;
  const int tid = tidx(), tn = N / 128, tk = tile / tn, tc = tile % tn;
  __syncthreads();
  {
    const int k = tid >> 3, c4 = (tid & 7) * 4;
    const float s = scale ? scale[tk * 32 + k] : 1.f;
    const float* sp = src + (size_t)(tk * 32 + k) * N + tc * 128 + c4;
    f32x4 v0 = *(const f32x4*)(sp), v1 = *(const f32x4*)(sp + 32), v2 = *(const f32x4*)(sp + 64), v3 = *(const f32x4*)(sp + 96);
    float* tp = t + k * 129 + c4;
#pragma unroll
    for (int q = 0; q < 4; ++q) { tp[q] = v0[q] * s; tp[32 + q] = v1[q] * s; tp[64 + q] = v2[q] * s; tp[96 + q] = v3[q] * s; }
  }
  __syncthreads();
  {
    const int n = tid >> 1, k16 = (tid & 1) * 16; float f[16];
#pragma unroll
    for (int j = 0; j < 16; ++j) f[j] = t[(k16 + j) * 129 + n];
    us* dp = dst + (size_t)(tc * 128 + n) * K + tk * 32 + k16;
    *(u32x4*)dp = pack8(f); *(u32x4*)(dp + 8) = pack8(f + 8);
  }
}
constexpr int NCONV_LAYER = 32 * 17 + 32 * 8 + 32 * 44 + 88 * 8 + 7 * 3 + 3 * 4 + 8 * 2;
DI void conv_task(const Params& p, int it, char* smem) {
  int l = it / NCONV_LAYER; it -= l * NCONV_LAYER;
  us* wb = (us*)(p.ws + OFF_WB) + (size_t)l * W_LAYER;
  int nt;
  nt = 32 * 17;  if (it < nt) { conv_tile(p.in[10] + (size_t)l * 1024 * 2176, wb + W_IN, 1024, 2176, nullptr, it, smem); return; } it -= nt;
  nt = 32 * 8;   if (it < nt) { conv_tile(p.in[31] + (size_t)l * 1024 * 1024, wb + W_OUT, 1024, 1024, nullptr, it, smem); return; } it -= nt;
  nt = 32 * 44;  if (it < nt) { conv_tile(p.in[32] + (size_t)l * 1024 * 5632, wb + W_UP, 1024, 5632, nullptr, it, smem); return; } it -= nt;
  nt = 88 * 8;   if (it < nt) { conv_tile(p.in[35] + (size_t)l * 2816 * 1024, wb + W_DN, 2816, 1024, nullptr, it, smem); return; } it -= nt;
  nt = 7 * 3;    if (it < nt) { conv_tile(p.in[28] + (size_t)l * 224 * 384, wb + W_UQ, 224, 384, p.in[27] + l * 224, it, smem); return; } it -= nt;
  nt = 3 * 4;    if (it < nt) { conv_tile(p.in[30] + (size_t)l * 96 * 512, wb + W_UKV, 96, 512, p.in[29] + l * 96, it, smem); return; } it -= nt;
  conv_tile(p.in[25] + (size_t)l * 256 * 256, wb + W_GLU, 256, 256, nullptr, it, smem);
}
DI void mod_task(const Params& p, int it, char* smem) {
  float* sc = (float*)smem;
  float* red = sc + 5 * 1024;
  const int tid = tidx(), l = it / 192, jb = it % 192;
  __syncthreads();
  for (int e = tid; e < 5 * 1024; e += 256) {
    int v = e >> 10, k = e & 1023; float c = v < 4 ? p.in[1][v * 1024 + k] : p.in[3][k];
    sc[e] = silu_(c);
  }
  __syncthreads();
  const int col = tid & 31, ks = tid >> 5;
  const float* w = p.in[4] + (size_t)l * 1024 * 6144 + jb * 32 + col;
  float a0 = 0, a1 = 0, a2 = 0, a3 = 0, a4 = 0;
#pragma unroll 8
  for (int k = ks * 128; k < ks * 128 + 128; ++k) {
    float wv = w[(size_t)k * 6144];
    a0 += sc[k] * wv; a1 += sc[1024 + k] * wv; a2 += sc[2048 + k] * wv; a3 += sc[3072 + k] * wv; a4 += sc[4096 + k] * wv;
  }
  float* rp = red + (ks * 32 + col) * 5;
  rp[0] = a0; rp[1] = a1; rp[2] = a2; rp[3] = a3; rp[4] = a4;
  __syncthreads();
  if (tid < 160) {
    int v = tid >> 5, c = tid & 31; float s = 0;
    for (int q = 0; q < 8; ++q) s += red[(q * 32 + c) * 5 + v];
    int j = jb * 32 + c;
    ((float*)(p.ws + OFF_MOD))[(size_t)(l * 5 + v) * 6144 + j] = s + p.in[5][l * 6144 + j];
  }
}
DI void s5pre_task(const Params& p, int it) {
  int gid = it * 256 + tidx();
  int pp = gid & 63, g = (gid >> 6) & 15, d = (gid >> 10) & 1, l = gid >> 11;
  int idx = ((l * 2 + d) * 16 + g) * 64 + pp;
  float are = p.in[17][idx], aim = p.in[18][idx];
  float dt = expf(p.in[19][(l * 2 + d) * 16 + g]);
  float mag = expf(are * dt), lr = mag * cosf(aim * dt), li = mag * sinf(aim * dt);
  float magT = expf(are * dt * 64.f), tr = magT * cosf(aim * dt * 64.f), ti = magT * sinf(aim * dt * 64.f);
  float nr = lr - 1.f, ni = li, den = are * are + aim * aim;
  float cr = (nr * are + ni * aim) / den, ci = (ni * are - nr * aim) / den;
  float* sf = (float*)(p.ws + OFF_S5F) + (size_t)l * S_LAYER;
  int o2 = ((d * 16 + g) * 64 + pp);
  sf[S_LAMB + o2 * 2] = lr; sf[S_LAMB + o2 * 2 + 1] = li;
  sf[S_LAMT + o2 * 2] = tr; sf[S_LAMT + o2 * 2 + 1] = ti;
  for (int i = 0; i < 16; ++i) {
    float br = p.in[20][(size_t)idx * 16 + i], bi = p.in[21][(size_t)idx * 16 + i];
    sf[S_BBAR + ((size_t)o2 * 16 + i) * 2] = cr * br - ci * bi;
    sf[S_BBAR + ((size_t)o2 * 16 + i) * 2 + 1] = cr * bi + ci * br;
    us* bm = (us*)(p.ws + OFF_WB) + (size_t)l * W_LAYER + W_BM + (size_t)(d * 16 + g) * 128 * 16;
    bm[pp * 16 + i] = f2bf(cr * br - ci * bi);
    bm[(64 + pp) * 16 + i] = f2bf(cr * bi + ci * br);
  }
  us* cm = (us*)(p.ws + OFF_WB) + (size_t)l * W_LAYER + W_CM;
  for (int o = 0; o < 16; ++o) {
    size_t ci_ = ((size_t)((l * 2 + d) * 16 + g) * 16 + o) * 64 + pp;
    cm[((size_t)(d * 16 + g) * 16 + o) * 128 + pp] = f2bf(p.in[22][ci_]);
    cm[((size_t)(d * 16 + g) * 16 + o) * 128 + 64 + pp] = f2bf(-p.in[23][ci_]);
  }
}
DI void rope_task(const Params& p, int it) {
  int gid = it * 256 + tidx();
  int pos = gid >> 3, f = gid & 7;
  float inv = powf(10000.f, -(float)f / 8.f), ang = (float)pos * inv;
  float* r = (float*)(p.ws + OFF_ROPE);
  r[gid * 2] = cosf(ang); r[gid * 2 + 1] = sinf(ang);
}
DI void wgt_task(const Params& p, int it) {
  int gid = it * 256 + tidx();
  int rr = gid & 15, c = (gid >> 4) & 255, d = (gid >> 12) & 1, l = gid >> 13;
  ((us*)(p.ws + OFF_WB))[(size_t)l * W_LAYER + W_WG + (d * 256 + c) * 16 + rr] = f2bf(p.in[14][((l * 2 + d) * 16 + rr) * 256 + c]);
}
DI void sguw_task(const Params& p, int it) {
  int gid = it * 256 + tidx();
  int l = gid >> 14, e = (gid & 16383) * 4;
  f32x4 v = *(const f32x4*)(p.in[12] + (size_t)l * 65536 + e);
  u32x2 w = {pk2(v[0], v[1]), pk2(v[2], v[3])};
  *(u32x2*)((us*)(p.ws + OFF_WB) + (size_t)l * W_LAYER + W_SGU + e) = w;
}

template <int MODE>
DI void row_task(const Params& p, int l, long m, const us* yrow) {
  const int lane = tidx() & 63, v = m < MX ? (int)(m >> 13) : 4;
  float x[16];
  if (MODE == 0) {
    const float* src = input_row(p, m);
#pragma unroll
    for (int j = 0; j < 4; ++j) { f32x4 t = *(const f32x4*)(src + (j * 64 + lane) * 4); x[4 * j] = t[0]; x[4 * j + 1] = t[1]; x[4 * j + 2] = t[2]; x[4 * j + 3] = t[3]; }
  } else {
    float y[16]; float ss = 0;
    const float* xo = (MODE == 1 && l == 0) ? input_row(p, m) : stream_row(p, m);
#pragma unroll
    for (int j = 0; j < 4; ++j) {
      u32x2 t = *(const u32x2*)(yrow + (j * 64 + lane) * 4); y[4 * j] = lo_bf(t[0]); y[4 * j + 1] = hi_bf(t[0]); y[4 * j + 2] = lo_bf(t[1]); y[4 * j + 3] = hi_bf(t[1]);
      f32x4 u = *(const f32x4*)(xo + (j * 64 + lane) * 4); x[4 * j] = u[0]; x[4 * j + 1] = u[1]; x[4 * j + 2] = u[2]; x[4 * j + 3] = u[3];
    }
#pragma unroll
    for (int j = 0; j < 16; ++j) ss += y[j] * y[j];
    ss = wave_sum(ss);
    float rstd = rsqrtf(ss * (1.f / 1024.f) + EPS);
    const float* gp = (MODE == 1 ? p.in[7] : p.in[9]) + l * 1024;
    const float* gt = modv(p, l, v, MODE == 1 ? 2 : 5);
    float* dst = stream_row(p, m);
#pragma unroll
    for (int j = 0; j < 4; ++j) {
      int c = (j * 64 + lane) * 4;
      f32x4 g4 = *(const f32x4*)(gp + c), t4 = *(const f32x4*)(gt + c), o;
#pragma unroll
      for (int q = 0; q < 4; ++q) { x[4 * j + q] += t4[q] * (y[4 * j + q] * rstd * g4[q]); o[q] = x[4 * j + q]; }
      *(f32x4*)(dst + c) = o;
    }
    if (MODE == 2 && l == 1) return;
  }
  const int ln = (MODE == 2) ? 1 : l;
  const float* g = (MODE == 1 ? p.in[8] : p.in[6]) + ln * 1024;
  const float* sh = modv(p, ln, v, MODE == 1 ? 3 : 0);
  const float* sc = modv(p, ln, v, MODE == 1 ? 4 : 1);
  float ss = 0;
#pragma unroll
  for (int j = 0; j < 16; ++j) ss += x[j] * x[j];
  ss = wave_sum(ss);
  float rstd = rsqrtf(ss * (1.f / 1024.f) + EPS);
  us* hx = (us*)(p.ws + OFF_HX) + m * 1024;
#pragma unroll
  for (int j = 0; j < 4; ++j) {
    int c = (j * 64 + lane) * 4;
    f32x4 g4 = *(const f32x4*)(g + c), s4 = *(const f32x4*)(sh + c), c4 = *(const f32x4*)(sc + c); float h[4];
#pragma unroll
    for (int q = 0; q < 4; ++q) h[q] = (x[4 * j + q] * rstd * g4[q]) * (1.f + c4[q]) + s4[q];
    u32x2 w = {pk2(h[0], h[1]), pk2(h[2], h[3])};
    *(u32x2*)(hx + c) = w;
  }
}

struct GArgs { const us* A; int lda; const us* W; int K; long m0; int n0; void* out; int ldo; int l; };
template <int BK, int EPI, bool ROWSS>
DI void gemm_tile(const Params& p, const GArgs& g, char* smem) {
  constexpr int LS = BK + 8, CPR = BK / 8, NCH = 128 * CPR / 256;
  us* sA = (us*)smem; us* sB = sA + 2 * 128 * LS; float* rstd = (float*)(sB + 2 * 128 * LS);
  const int tid = tidx(), w = tid >> 6, lane = tid & 63, r = lane & 31, hh = lane >> 5, wm = w >> 1, wn = w & 1;
  __syncthreads();
  if (ROWSS) {
    int row = tid >> 1, half = tid & 1; float ss = 0;
    const us* ap = g.A + (size_t)row * g.lda + half * (g.K / 2);
    for (int c = 0; c < g.K / 16; ++c) { float f[8]; unpack8(*(const u32x4*)(ap + c * 8), f);
#pragma unroll
      for (int j = 0; j < 8; ++j) ss += f[j] * f[j]; }
    ss += __shfl_xor(ss, 1);
    if (!half) rstd[row] = rsqrtf(ss / (float)g.K + EPS);
  }
  u32x4 ra[NCH], rb[NCH];
  f32x16 acc[2][2];
#pragma unroll
  for (int i = 0; i < 2; ++i)
#pragma unroll
    for (int j = 0; j < 2; ++j)
#pragma unroll
      for (int q = 0; q < 16; ++q) acc[i][j][q] = 0.f;
#define GLOAD(kt) _Pragma("unroll") for (int j = 0; j < NCH; ++j) { int q = tid + 256 * j, row = q / CPR, cc = q % CPR; \
    ra[j] = *(const u32x4*)(g.A + (size_t)row * g.lda + (kt) * BK + cc * 8); rb[j] = *(const u32x4*)(g.W + (size_t)row * g.K + (kt) * BK + cc * 8); }
#define SWRITE(buf) _Pragma("unroll") for (int j = 0; j < NCH; ++j) { int q = tid + 256 * j, row = q / CPR, cc = q % CPR; \
    *(u32x4*)(sA + (buf) * 128 * LS + row * LS + cc * 8) = ra[j]; *(u32x4*)(sB + (buf) * 128 * LS + row * LS + cc * 8) = rb[j]; }
  GLOAD(0); SWRITE(0); __syncthreads();
  const int KT = g.K / BK;
  for (int kt = 0; kt < KT; ++kt) {
    if (kt + 1 < KT) { GLOAD(kt + 1); }
    const us* a0 = sA + (kt & 1) * 128 * LS + (wm * 64 + r) * LS + hh * 8;
    const us* b0 = sB + (kt & 1) * 128 * LS + (wn * 64 + r) * LS + hh * 8;
#pragma unroll
    for (int ks = 0; ks < BK / 16; ++ks) {
      bf16x8 af0 = *(const bf16x8*)(a0 + ks * 16), af1 = *(const bf16x8*)(a0 + 32 * LS + ks * 16);
      bf16x8 bf0 = *(const bf16x8*)(b0 + ks * 16), bf1 = *(const bf16x8*)(b0 + 32 * LS + ks * 16);
      acc[0][0] = MFMA(af0, bf0, acc[0][0]); acc[0][1] = MFMA(af0, bf1, acc[0][1]);
      acc[1][0] = MFMA(af1, bf0, acc[1][0]); acc[1][1] = MFMA(af1, bf1, acc[1][1]);
    }
    if (kt + 1 < KT) { SWRITE((kt + 1) & 1); }
    __syncthreads();
  }
#undef GLOAD
#undef SWRITE
#pragma unroll
  for (int si = 0; si < 2; ++si)
#pragma unroll
    for (int sj = 0; sj < 2; ++sj) {
      const int col = wn * 64 + sj * 32 + r, n = g.n0 + col;
#pragma unroll
      for (int i = 0; i < 16; ++i) {
        const int row = wm * 64 + si * 32 + crow(i, hh);
        const long m = g.m0 + row;
        float v = acc[si][sj][i];
        if (EPI == 0) { ((us*)g.out)[m * g.ldo + n] = f2bf(v); }
        else if (EPI == 1) { ((float*)g.out)[m * g.ldo + n] = v; }
        else if (EPI == 2) {
          v *= rstd[row] * QSCALE;
          float pv = __shfl_xor(v, 8);
          const int head = n / 96, j = n - head * 96;
          const bool isx = m < MX; const int t = isx ? (int)(m & 8191) : (int)((m - MX) & 255);
          const int b = isx ? (int)(m >> 13) : (int)((m - MX) >> 8);
          if (isx && j >= 64) {
            int jj = (j - 64) & 15, blk = (j - 64) >> 4, f = jj & 7, pos = blk ? (t & 63) : (t >> 6);
            const float* rp = (const float*)(p.ws + OFF_ROPE) + (pos * 8 + f) * 2; float cs = rp[0], sn = rp[1];
            v = (jj < 8) ? v * cs - pv * sn : pv * sn + v * cs;
          }
          const int s = isx ? 256 + t : t;
          ((us*)(p.ws + OFF_QB))[((size_t)(b * 4 + head) * SEQ + s) * 96 + j] = f2bf(v);
        } else if (EPI == 3) {
          v *= rstd[row];
          const int head = n >> 7, j = n & 127;
          const bool isx = m < MX; const int t = isx ? (int)(m & 8191) : (int)((m - MX) & 255);
          const int b = isx ? (int)(m >> 13) : (int)((m - MX) >> 8);
          const int s = isx ? 256 + t : t;
          if (j < 64) ((us*)(p.ws + OFF_KB))[((size_t)(b * 4 + head) * SEQ + s) * 96 + j] = f2bf(v);
          else if ((i & 3) == 3) {
            const float r1 = rstd[row - 1], r2 = rstd[row - 2], r3 = rstd[row - 3];
            u32x2 w2 = {pk2(acc[si][sj][i - 3] * r3, acc[si][sj][i - 2] * r2), pk2(acc[si][sj][i - 1] * r1, v)};
            *(u32x2*)((us*)(p.ws + OFF_VT) + ((size_t)(b * 4 + head) * 64 + (j - 64)) * SEQ + s - 3) = w2;
          }
        } else if (EPI == 4) {
          float y = bf2f(((const us*)(p.ws + OFF_Y))[m * 256 + n]);
          v += p.in[26][g.l * 256 + n];
          ((us*)(p.ws + OFF_MIXIN))[m * 1024 + 512 + n] = f2bf(y * sigmoidf_(v));
        }
      }
    }
}


using f32x4_ = __attribute__((ext_vector_type(4))) float;
#define MFMA16(a, b, c) __builtin_amdgcn_mfma_f32_16x16x32_bf16((a), (b), (c), 0, 0, 0)
DI void gemm_big(const GArgs& g, int ncv, char* smem) {
  constexpr int ST = 256 * 64;
  us* sA = (us*)smem; us* sB = sA + 2 * ST;
  const int tid = tid512(), w = tid >> 6, lane = tid & 63, l16 = lane & 15, lq = lane >> 4, wm = w >> 2, wn = w & 3;
  u32x4 ra[4], rb[4];
  f32x4_ acc[8][4];
#pragma unroll
  for (int i = 0; i < 8; ++i)
#pragma unroll
    for (int j = 0; j < 4; ++j) { acc[i][j][0] = 0.f; acc[i][j][1] = 0.f; acc[i][j][2] = 0.f; acc[i][j][3] = 0.f; }
  const int srow = tid >> 3, sch = tid & 7;
  const us* gA = g.A + (size_t)srow * g.lda + sch * 8;
  const us* gB = g.W + (size_t)srow * g.K + sch * 8;
  const int swr = srow * 64 + ((sch ^ (srow & 7)) << 3);
#define GLOAD(kt) { _Pragma("unroll") for (int j = 0; j < 4; ++j) { ra[j] = *(const u32x4*)(gA + (size_t)(64 * j) * g.lda + (kt) * 64); rb[j] = *(const u32x4*)(gB + (size_t)(64 * j) * g.K + (kt) * 64); } }
#define SWRITE(buf) { _Pragma("unroll") for (int j = 0; j < 4; ++j) { *(u32x4*)(sA + (buf) * ST + swr + j * 4096) = ra[j]; *(u32x4*)(sB + (buf) * ST + swr + j * 4096) = rb[j]; } }
  const int KT = g.K / 64;
  const bool act = wn * 64 < ncv;
  const int fo0 = l16 * 64 + ((lq ^ (l16 & 7)) << 3), fo1 = l16 * 64 + (((4 + lq) ^ (l16 & 7)) << 3);
  __syncthreads();
  GLOAD(0); SWRITE(0); GLOAD(KT > 1 ? 1 : 0);
  for (int kt = 0; kt < KT; ++kt) {
    __syncthreads();
    SWRITE((kt + 1) & 1);
    { const int kl = kt + 2 < KT ? kt + 2 : KT - 1; GLOAD(kl); }
    if (act) {
      const us* a0 = sA + (kt & 1) * ST + wm * 128 * 64;
      const us* b0 = sB + (kt & 1) * ST + wn * 64 * 64;
#pragma unroll
      for (int ks = 0; ks < 2; ++ks) {
        const int fo = ks ? fo1 : fo0;
        bf16x8 fb[4];
#pragma unroll
        for (int j = 0; j < 4; ++j) fb[j] = *(const bf16x8*)(b0 + j * 1024 + fo);
#pragma unroll
        for (int i = 0; i < 8; ++i) {
          bf16x8 fa = *(const bf16x8*)(a0 + i * 1024 + fo);
#pragma unroll
          for (int j = 0; j < 4; ++j) acc[i][j] = MFMA16(fb[j], fa, acc[i][j]);
        }
      }
    }
  }
#undef GLOAD
#undef SWRITE
  __syncthreads();
  {
    us* sC = (us*)smem; constexpr int CS = 264;
    if (act) {
#pragma unroll
      for (int i = 0; i < 8; ++i)
#pragma unroll
        for (int j = 0; j < 4; ++j) {
          u32x2 w2 = {pk2(acc[i][j][0], acc[i][j][1]), pk2(acc[i][j][2], acc[i][j][3])};
          *(u32x2*)(sC + (wm * 128 + i * 16 + l16) * CS + wn * 64 + j * 16 + lq * 4) = w2;
        }
    }
    __syncthreads();
    us* outp = (us*)g.out + (size_t)g.m0 * g.ldo + g.n0;
#pragma unroll 4
    for (int k = 0; k < 16; ++k) {
      const int q = tid + 512 * k, row = q >> 5, cc = q & 31;
      if (cc * 8 < ncv) *(u32x4*)(outp + (size_t)row * g.ldo + cc * 8) = *(const u32x4*)(sC + row * CS + cc * 8);
    }
  }
}

DI int lds_byte8(int r, int c) { int st = (r >> 4) * 2 + (c >> 5), rr = r & 15, cc = c & 31, ob = rr * 64 + cc * 2; return st * 1024 + (ob ^ (((ob >> 9) & 1) << 5)); }
DI void stage_rc8(int b, int& R, int& C) { int st = b / 1024, sb = b % 1024, swz = sb ^ (((sb >> 9) & 1) << 5); R = (st >> 1) * 16 + swz / 64; C = (st & 1) * 32 + (swz % 64) / 2; }
DI void gemm_8p(const GArgs& g, char* smem, int ncv = 256) {
  constexpr int BK8 = 64, HALF8 = 128, HT8 = HALF8 * BK8;
  us* shm = (us*)smem;
  const int tid = tid512();
  const us* __restrict__ A = g.A; const us* __restrict__ Bt = g.W;
  const unsigned lda = (unsigned)g.lda, ldb = (unsigned)g.K;
#define SA8(b, h) (shm + ((b) * 2 + (h)) * HT8)
#define SB8(b, h) (shm + (4 + (b) * 2 + (h)) * HT8)
#define STAGE8(P, BASE, LD, br, kt) do { const unsigned _g = (unsigned)(br) * (unsigned)(LD) + (unsigned)(kt) * BK8; \
    for (int _i = 0; _i < 2; ++_i) { int _b = tid * 16 + _i * 8192; int _r, _c; stage_rc8(_b, _r, _c); \
      __builtin_amdgcn_global_load_lds((const unsigned*)((BASE) + (size_t)(_g + (unsigned)_r * (unsigned)(LD) + (unsigned)_c)), \
        (__attribute__((address_space(3))) unsigned*)((char*)(P) + _b), 16, 0, 0); } } while (0)
#define LDA8(dst, b, h) for (int m = 0; m < 4; ++m) for (int k = 0; k < 2; ++k) \
    dst[m][k] = *reinterpret_cast<const bf16x8*>((char*)SA8(b, h) + lds_byte8(wr * 64 + m * 16 + fr, k * 32 + fq * 8))
#define LDB8(dst, b, h) for (int n = 0; n < 2; ++n) for (int k = 0; k < 2; ++k) \
    dst[n][k] = *reinterpret_cast<const bf16x8*>((char*)SB8(b, h) + lds_byte8(wc * 32 + n * 16 + fr, k * 32 + fq * 8))
#define MMA8(ai, bj, At_, Bt_) do { __builtin_amdgcn_s_setprio(1); \
    for (int m = 0; m < 4; ++m) for (int n = 0; n < 2; ++n) for (int k = 0; k < 2; ++k) \
      acc[ai][bj][m][n] = __builtin_amdgcn_mfma_f32_16x16x32_bf16(Bt_[n][k], At_[m][k], acc[ai][bj][m][n], 0, 0, 0); \
    __builtin_amdgcn_s_setprio(0); } while (0)
#define WAIT_V(n) asm volatile("s_waitcnt vmcnt(" #n ")" ::: "memory")
#define WAIT_L(n) asm volatile("s_waitcnt lgkmcnt(" #n ")" ::: "memory")
#define BAR8 __builtin_amdgcn_s_barrier()
#define SCHED8 __builtin_amdgcn_sched_barrier(0)
  const int wid = tid >> 6, lane = tid & 63, wr = wid >> 2, wc = wid & 3, fr = lane & 15, fq = lane >> 4;
  f32x4_ acc[2][2][4][2];
#pragma unroll
  for (int a_ = 0; a_ < 2; ++a_)
#pragma unroll
    for (int b_ = 0; b_ < 2; ++b_)
#pragma unroll
      for (int m = 0; m < 4; ++m)
#pragma unroll
        for (int n = 0; n < 2; ++n) acc[a_][b_][m][n] = (f32x4_){0.f, 0.f, 0.f, 0.f};
  bf16x8 At[4][2], B0[2][2], B1[2][2];
  const int nt = g.K / BK8;
  __syncthreads();
  STAGE8(SB8(0, 0), Bt, ldb, 0, 0); STAGE8(SA8(0, 0), A, lda, 0, 0);
  STAGE8(SB8(0, 1), Bt, ldb, HALF8, 0); STAGE8(SA8(0, 1), A, lda, HALF8, 0);
  if (wr == 1) BAR8;
  WAIT_V(4); BAR8;
  STAGE8(SB8(1, 0), Bt, ldb, 0, 1); STAGE8(SA8(1, 0), A, lda, 0, 1); STAGE8(SB8(1, 1), Bt, ldb, HALF8, 1);
  WAIT_V(6); BAR8;
  for (int t = 0; t < nt - 2; t += 2) {
    LDB8(B0, 0, 0); SCHED8; LDA8(At, 0, 0); STAGE8(SA8(1, 1), A, lda, HALF8, t + 1);
    WAIT_L(8); BAR8; WAIT_L(0); MMA8(0, 0, At, B0); BAR8; SCHED8;
    LDB8(B1, 0, 1); STAGE8(SB8(0, 0), Bt, ldb, 0, t + 2);
    BAR8; WAIT_L(0); MMA8(0, 1, At, B1); BAR8;
    LDA8(At, 0, 1); STAGE8(SA8(0, 0), A, lda, 0, t + 2);
    BAR8; WAIT_L(0); MMA8(1, 0, At, B0); BAR8; SCHED8;
    STAGE8(SB8(0, 1), Bt, ldb, HALF8, t + 2);
    WAIT_V(6); BAR8; MMA8(1, 1, At, B1); BAR8;
    LDB8(B0, 1, 0); SCHED8; LDA8(At, 1, 0); STAGE8(SA8(0, 1), A, lda, HALF8, t + 2);
    WAIT_L(8); BAR8; WAIT_L(0); MMA8(0, 0, At, B0); BAR8; SCHED8;
    LDB8(B1, 1, 1); STAGE8(SB8(1, 0), Bt, ldb, 0, t + 3);
    BAR8; WAIT_L(0); MMA8(0, 1, At, B1); BAR8;
    LDA8(At, 1, 1); STAGE8(SA8(1, 0), A, lda, 0, t + 3);
    BAR8; WAIT_L(0); MMA8(1, 0, At, B0); BAR8; SCHED8;
    STAGE8(SB8(1, 1), Bt, ldb, HALF8, t + 3);
    WAIT_V(6); BAR8; MMA8(1, 1, At, B1); BAR8;
  }
  { LDB8(B0, 0, 0); LDA8(At, 0, 0); STAGE8(SA8(1, 1), A, lda, HALF8, nt - 1);
    BAR8; WAIT_L(0); MMA8(0, 0, At, B0); BAR8;
    LDB8(B1, 0, 1); BAR8; WAIT_L(0); MMA8(0, 1, At, B1); BAR8;
    LDA8(At, 0, 1); WAIT_V(4); BAR8; WAIT_L(0); MMA8(1, 0, At, B0); MMA8(1, 1, At, B1); BAR8; }
  { LDB8(B0, 1, 0); LDA8(At, 1, 0); WAIT_V(2); BAR8; WAIT_L(0); MMA8(0, 0, At, B0); BAR8;
    LDB8(B1, 1, 1); WAIT_V(0); BAR8; WAIT_L(0); MMA8(0, 1, At, B1); BAR8;
    LDA8(At, 1, 1); BAR8; WAIT_L(0); MMA8(1, 0, At, B0); MMA8(1, 1, At, B1); BAR8; }
  if (wr == 0) BAR8;
  __syncthreads();
  {
    us* sC = (us*)smem; constexpr int CS = 264;
    const int tid = tid512(), wid = tid >> 6, lane = tid & 63, wr = wid >> 2, wc = wid & 3, fr = lane & 15, fq = lane >> 4;
#pragma unroll
    for (int ai = 0; ai < 2; ++ai)
#pragma unroll
      for (int bj = 0; bj < 2; ++bj)
#pragma unroll
        for (int m = 0; m < 4; ++m)
#pragma unroll
          for (int n = 0; n < 2; ++n) {
            const f32x4_ v = acc[ai][bj][m][n];
            u32x2 w2 = {pk2(v[0], v[1]), pk2(v[2], v[3])};
            *(u32x2*)(sC + (ai * 128 + wr * 64 + m * 16 + fr) * CS + bj * 128 + wc * 32 + n * 16 + fq * 4) = w2;
          }
    __syncthreads();
    us* outp = (us*)g.out + (size_t)g.m0 * g.ldo + g.n0;
#pragma unroll 4
    for (int k = 0; k < 16; ++k) {
      const int q = tid + 512 * k, row = q >> 5, cc = q & 31;
      if (cc * 8 < ncv) *(u32x4*)(outp + (size_t)row * g.ldo + cc * 8) = *(const u32x4*)(sC + row * CS + cc * 8);
    }
  }
#undef SA8
#undef SB8
#undef STAGE8
#undef LDA8
#undef LDB8
#undef MMA8
#undef WAIT_V
#undef WAIT_L
#undef BAR8
#undef SCHED8
}

template <class F>
DI void for_tiles_xcd(int RT, int CT, int G, int bid, F f) {
  if ((G & 7) == 0) {
    const int x = bid & 7, rows = (RT - x + 7) >> 3, n = rows * CT, nfull = CT >> 3;
    for (int j = bid >> 3; j < n; j += G >> 3) {
      int rl, ct;
      if (j < nfull * rows * 8) { int pnl = j / (rows * 8), rem = j - pnl * rows * 8; rl = rem >> 3; ct = pnl * 8 + (rem & 7); }
      else { int j2 = j - nfull * rows * 8, wd = CT - nfull * 8; rl = j2 / wd; ct = nfull * 8 + (j2 - rl * wd); }
      f(rl * 8 + x, ct);
    }
  } else {
    for (int it = bid; it < RT * CT; it += G) f(it / CT, it % CT);
  }
}

DI void kr_task(const Params& p, long m0) {
  const int tid = tidx(), row = tid >> 1, blk = tid & 1; const long m = m0 + row;
  const us* src = (const us*)(p.ws + OFF_P) + m * INC + 2144 + blk * 16;
  float v[16], o[16]; unpack8(*(const u32x4*)src, v); unpack8(*(const u32x4*)(src + 8), v + 8);
  const bool isx = m < MX; const int t = isx ? (int)(m & 8191) : (int)((m - MX) & 255);
  const int b = isx ? (int)(m >> 13) : (int)((m - MX) >> 8), s = isx ? 256 + t : t;
  if (isx) {
    int pos = blk ? (t & 63) : (t >> 6);
    const float* rp = (const float*)(p.ws + OFF_ROPE) + pos * 16;
#pragma unroll
    for (int f = 0; f < 8; ++f) { float cs = rp[2 * f], sn = rp[2 * f + 1]; o[f] = v[f] * cs - v[f + 8] * sn; o[f + 8] = v[f] * sn + v[f + 8] * cs; }
  } else {
#pragma unroll
    for (int f = 0; f < 16; ++f) o[f] = v[f];
  }
  u32x4 w0 = pack8(o), w1 = pack8(o + 8);
#pragma unroll
  for (int hd = 0; hd < 4; ++hd) {
    us* dst = (us*)(p.ws + OFF_KB) + ((size_t)(b * 4 + hd) * SEQ + s) * 96 + 64 + blk * 16;
    *(u32x4*)dst = w0; *(u32x4*)(dst + 8) = w1;
  }
}

DI void sgu_task(const Params& p, int l, int chunk, int h, char* smem) {
  us* Vt = (us*)smem;
  const int tid = tidx(), w = tid >> 6, lane = tid & 63, r = lane & 31, hh = lane >> 5;
  const long m0 = (long)chunk * 128;
  const us* P = (const us*)(p.ws + OFF_P);
  __syncthreads();
  {
    int row = tid >> 1, dh = (tid & 1) * 32; float v[32]; float ss = 0;
    const us* src = P + (m0 + row) * INC + 256 + h * 64 + dh;
#pragma unroll
    for (int c = 0; c < 4; ++c) unpack8(*(const u32x4*)(src + c * 8), v + c * 8);
#pragma unroll
    for (int j = 0; j < 32; ++j) { v[j] = gelu_t(v[j]); ss += v[j] * v[j]; }
    ss += __shfl_xor(ss, 1);
    float rstd = rsqrtf(ss * (1.f / 64.f) + EPS);
    const float* gn = p.in[11] + l * 256 + h * 64 + dh;
#pragma unroll
    for (int j = 0; j < 32; ++j) Vt[(dh + j) * 136 + row] = f2bf(v[j] * rstd * gn[j]);
  }
  __syncthreads();
  const us* Wsp = wl(p, l) + W_SGU + (size_t)h * 16384 + (size_t)(w * 32 + r) * 128 + hh * 8;
  f32x16 a0, a1;
#pragma unroll
  for (int q = 0; q < 16; ++q) { a0[q] = 0.f; a1[q] = 0.f; }
#pragma unroll
  for (int ks = 0; ks < 8; ++ks) {
    bf16x8 af = *(const bf16x8*)(Wsp + ks * 16);
    bf16x8 b0 = *(const bf16x8*)(Vt + r * 136 + ks * 16 + hh * 8), b1 = *(const bf16x8*)(Vt + (32 + r) * 136 + ks * 16 + hh * 8);
    a0 = MFMA(af, b0, a0); a1 = MFMA(af, b1, a1);
  }
  us* out = (us*)(p.ws + OFF_MIXIN);
#pragma unroll
  for (int i = 0; i < 16; ++i) {
    int t = w * 32 + crow(i, hh); float bs = p.in[13][l * 512 + h * 128 + t];
    const us* pu = P + (m0 + t) * INC + h * 64;
    float u0 = gelu_t(bf2f(pu[r])), u1 = gelu_t(bf2f(pu[32 + r]));
    out[(m0 + t) * 1024 + h * 64 + r] = f2bf(u0 * (a0[i] + bs));
    out[(m0 + t) * 1024 + h * 64 + 32 + r] = f2bf(u1 * (a1[i] + bs));
  }
}

DI void gla_gate_dir(const Params& p, int l, const us* Prow0, int h, int d, float* sW, float* G) {
  const int tid = tidx(), w = tid >> 6, lane = tid & 63, r = lane & 31, hh = lane >> 5, mt = w >> 1, nt = w & 1;
  {
    const bf16x8 a = *(const bf16x8*)(Prow0 + (size_t)(mt * 32 + r) * INC + 1536 + d * 16 + hh * 8);
    const bf16x8 bw = *(const bf16x8*)(wl(p, l) + W_WG + (size_t)(d * 256 + h * 64 + nt * 32 + r) * 16 + hh * 8);
    f32x16 z;
#pragma unroll
    for (int q = 0; q < 16; ++q) z[q] = 0.f;
    z = MFMA(a, bw, z);
    const float bg = p.in[15][l * 512 + d * 256 + h * 64 + nt * 32 + r];
#pragma unroll
    for (int i = 0; i < 16; ++i) G[(mt * 32 + crow(i, hh)) * 64 + nt * 32 + r] = logsig(z[i] + bg) * (1.f / 16.f);
  }
  __syncthreads();
  {
    const int ch = tid & 63, seg = tid >> 6;
    float v[16];
#pragma unroll
    for (int k = 0; k < 16; ++k) v[k] = G[(seg * 16 + k) * 64 + ch];
    if (d == 0) {
#pragma unroll
      for (int k = 1; k < 16; ++k) v[k] += v[k - 1];
      sW[seg * 64 + ch] = v[15];
    } else {
#pragma unroll
      for (int k = 14; k >= 0; --k) v[k] += v[k + 1];
      sW[seg * 64 + ch] = v[0];
    }
    __syncthreads();
    float off = 0.f;
    if (d == 0) { for (int q = 0; q < 3; ++q) off += (q < seg) ? sW[q * 64 + ch] : 0.f; }
    else { for (int q = 1; q < 4; ++q) off += (q > seg) ? sW[q * 64 + ch] : 0.f; }
#pragma unroll
    for (int k = 0; k < 16; ++k) G[(seg * 16 + k) * 64 + ch] = v[k] + off;
  }
  __syncthreads();
}
DI size_t gla_idx(int b, int c, int h, int d) { return (size_t)(((b * NCHK + c) * 4 + h) * 2 + d); }

DI void gla1_task(const Params& p, int l, int b, int c, int h, char* smem) {
  float* G0 = (float*)smem; float* G1 = G0 + 4096; float* sW = G1 + 4096;
  us* KeT = (us*)(sW + 1024);
  us* Vt = KeT + 2 * 64 * 72;
  const int tid = tidx(), w = tid >> 6, lane = tid & 63, r = lane & 31, hh = lane >> 5;
  const long m0 = seqrow(b, c * 64);
  const us* P0 = (const us*)(p.ws + OFF_P) + m0 * INC;
  __syncthreads();
  gla_gate_dir(p, l, P0, h, 0, sW, G0);
  gla_gate_dir(p, l, P0, h, 1, sW, G1);
  {
    int t = tid >> 2, q4 = tid & 3; float kk[16], vv[16];
    const us* sk = P0 + (size_t)t * INC + 768 + h * 64 + q4 * 16;
    const us* sv = P0 + (size_t)t * INC + 1024 + h * 64 + q4 * 16;
    unpack8(*(const u32x4*)sk, kk); unpack8(*(const u32x4*)(sk + 8), kk + 8);
    unpack8(*(const u32x4*)sv, vv); unpack8(*(const u32x4*)(sv + 8), vv + 8);
#pragma unroll
    for (int cc = 0; cc < 16; ++cc) {
      int ch = q4 * 16 + cc;
      KeT[ch * 72 + t] = f2bf(kk[cc] * __expf(G0[63 * 64 + ch] - G0[t * 64 + ch]));
      KeT[(64 + ch) * 72 + t] = f2bf(kk[cc] * __expf(G1[ch] - G1[t * 64 + ch]));
      Vt[ch * 72 + t] = f2bf(vv[cc]);
    }
    if (tid < 128) {
      int d = tid >> 6, ch = tid & 63;
      ((float*)(p.ws + OFF_DEC))[gla_idx(b, c, h, d) * 64 + ch] = __expf(d ? G1[ch] : G0[63 * 64 + ch]);
    }
  }
  __syncthreads();
  {
    const int d = w >> 1, mt = w & 1;
    float* kv = (float*)(p.ws + OFF_KV) + gla_idx(b, c, h, d) * 4096;
#pragma unroll
    for (int nt = 0; nt < 2; ++nt) {
      f32x16 acc;
#pragma unroll
      for (int q = 0; q < 16; ++q) acc[q] = 0.f;
#pragma unroll
      for (int ks = 0; ks < 4; ++ks) {
        bf16x8 a = *(const bf16x8*)(Vt + (mt * 32 + r) * 72 + ks * 16 + hh * 8);
        bf16x8 bb = *(const bf16x8*)(KeT + (d * 64 + nt * 32 + r) * 72 + ks * 16 + hh * 8);
        acc = MFMA(a, bb, acc);
      }
#pragma unroll
      for (int i = 0; i < 16; ++i) kv[(mt * 32 + crow(i, hh)) * 64 + nt * 32 + r] = acc[i];
    }
  }
}
DI int gla_order(int d, int j) { return d == 0 ? j : (j < 4 ? 3 - j : 135 - j); }
DI void gla2_task(const Params& p, int it) {
  const int gid = it * 256 + tidx();
  const int e = gid & 4095, d = (gid >> 12) & 1, h = (gid >> 13) & 3, b = gid >> 15, k = e & 63;
  float* KV = (float*)(p.ws + OFF_KV); const float* DEC = (const float*)(p.ws + OFF_DEC);
  float s = 0;
  for (int j0 = 0; j0 < NCHK; j0 += 33) {
    float kv[33], dc[33];
#pragma unroll
    for (int q = 0; q < 33; ++q) { const size_t ix = gla_idx(b, gla_order(d, j0 + q), h, d); kv[q] = KV[ix * 4096 + e]; dc[q] = DEC[ix * 64 + k]; }
#pragma unroll
    for (int q = 0; q < 33; ++q) { const size_t ix = gla_idx(b, gla_order(d, j0 + q), h, d); KV[ix * 4096 + e] = s; s = dc[q] * s + kv[q]; }
  }
}
DI void gla3_task(const Params& p, int l, int b, int c, int h, char* smem) {
  float* G = (float*)smem;
  us* Qin = (us*)(smem + 17408);
  us* Kin = Qin + 64 * 72; us* Vt = Kin + 64 * 72; us* ST = Vt + 64 * 72; us* Sc = ST + 64 * 72;
  float* sW = (float*)Sc;
  const int tid = tidx(), w = tid >> 6, lane = tid & 63, r = lane & 31, hh = lane >> 5;
  const long m0 = seqrow(b, c * 64);
  const us* P0 = (const us*)(p.ws + OFF_P) + m0 * INC;
  const int t_ = tid >> 2, q4 = tid & 3;
  __syncthreads();
  {
    float vv[16]; const us* sv = P0 + (size_t)t_ * INC + 1024 + h * 64 + q4 * 16;
    unpack8(*(const u32x4*)sv, vv); unpack8(*(const u32x4*)(sv + 8), vv + 8);
#pragma unroll
    for (int cc = 0; cc < 16; ++cc) Vt[(q4 * 16 + cc) * 72 + t_] = f2bf(vv[cc]);
  }
  f32x16 oacc;
#pragma unroll
  for (int q = 0; q < 16; ++q) oacc[q] = 0.f;
  const int mt = w >> 1, nt = w & 1;
  for (int d = 0; d < 2; ++d) {
    gla_gate_dir(p, l, P0, h, d, sW, G);
    {
      float qq[16], kk[16], qo[16], ko[16];
      const us* sq = P0 + (size_t)t_ * INC + 512 + h * 64 + q4 * 16;
      const us* sk = P0 + (size_t)t_ * INC + 768 + h * 64 + q4 * 16;
      unpack8(*(const u32x4*)sq, qq); unpack8(*(const u32x4*)(sq + 8), qq + 8);
      unpack8(*(const u32x4*)sk, kk); unpack8(*(const u32x4*)(sk + 8), kk + 8);
#pragma unroll
      for (int cc = 0; cc < 16; ++cc) { float gg = G[t_ * 64 + q4 * 16 + cc]; qo[cc] = qq[cc] * 0.125f * __expf(gg); ko[cc] = kk[cc] * __expf(-gg); }
      *(u32x4*)(Qin + t_ * 72 + q4 * 16) = pack8(qo); *(u32x4*)(Qin + t_ * 72 + q4 * 16 + 8) = pack8(qo + 8);
      *(u32x4*)(Kin + t_ * 72 + q4 * 16) = pack8(ko); *(u32x4*)(Kin + t_ * 72 + q4 * 16 + 8) = pack8(ko + 8);
      const float* ss = (const float*)(p.ws + OFF_KV) + gla_idx(b, c, h, d) * 4096 + tid * 16;
      float sf[16];
#pragma unroll
      for (int j = 0; j < 4; ++j) { f32x4 t4 = *(const f32x4*)(ss + j * 4); sf[4 * j] = t4[0]; sf[4 * j + 1] = t4[1]; sf[4 * j + 2] = t4[2]; sf[4 * j + 3] = t4[3]; }
      const int v_ = tid >> 2, k0 = (tid & 3) * 16;
      *(u32x4*)(ST + v_ * 72 + k0) = pack8(sf); *(u32x4*)(ST + v_ * 72 + k0 + 8) = pack8(sf + 8);
    }
    __syncthreads();
    {
      const int tt = mt, st = nt;
      const bool need = d == 0 ? st <= tt : st >= tt;
      f32x16 sc;
#pragma unroll
      for (int q = 0; q < 16; ++q) sc[q] = 0.f;
      if (need) {
#pragma unroll
        for (int ks = 0; ks < 4; ++ks) {
          bf16x8 a = *(const bf16x8*)(Qin + (tt * 32 + r) * 72 + ks * 16 + hh * 8);
          bf16x8 bb = *(const bf16x8*)(Kin + (st * 32 + r) * 72 + ks * 16 + hh * 8);
          sc = MFMA(a, bb, sc);
        }
      }
#pragma unroll
      for (int i = 0; i < 16; ++i) {
        int trow = tt * 32 + crow(i, hh), scol = st * 32 + r;
        bool keep = d == 0 ? scol <= trow : scol >= trow;
        Sc[trow * 72 + scol] = f2bf(keep ? sc[i] : 0.f);
      }
    }
    __syncthreads();
#pragma unroll
    for (int ks = 0; ks < 4; ++ks) {
      bf16x8 a = *(const bf16x8*)(Sc + (mt * 32 + r) * 72 + ks * 16 + hh * 8);
      bf16x8 bb = *(const bf16x8*)(Vt + (nt * 32 + r) * 72 + ks * 16 + hh * 8);
      oacc = MFMA(a, bb, oacc);
    }
#pragma unroll
    for (int ks = 0; ks < 4; ++ks) {
      bf16x8 a = *(const bf16x8*)(Qin + (mt * 32 + r) * 72 + ks * 16 + hh * 8);
      bf16x8 bb = *(const bf16x8*)(ST + (nt * 32 + r) * 72 + ks * 16 + hh * 8);
      oacc = MFMA(a, bb, oacc);
    }
    __syncthreads();
  }
  float* Ob = (float*)smem;
#pragma unroll
  for (int i = 0; i < 16; ++i) Ob[(mt * 32 + crow(i, hh)) * 68 + nt * 32 + r] = oacc[i];
  __syncthreads();
  {
    float o[16], rr[16]; float ss = 0;
#pragma unroll
    for (int cc = 0; cc < 16; ++cc) { o[cc] = Ob[t_ * 68 + q4 * 16 + cc]; ss += o[cc] * o[cc]; }
    ss += __shfl_xor(ss, 1); ss += __shfl_xor(ss, 2);
    float rstd = rsqrtf(ss * (1.f / 64.f) + EPS);
    const us* sr = P0 + (size_t)t_ * INC + 1280 + h * 64 + q4 * 16;
    unpack8(*(const u32x4*)sr, rr); unpack8(*(const u32x4*)(sr + 8), rr + 8);
    const float* gn = p.in[16] + l * 256 + h * 64 + q4 * 16;
#pragma unroll
    for (int cc = 0; cc < 16; ++cc) o[cc] = o[cc] * rstd * gn[cc] * silu_(rr[cc]);
    us* dst = (us*)(p.ws + OFF_MIXIN) + (m0 + t_) * 1024 + 256 + h * 64 + q4 * 16;
    *(u32x4*)dst = pack8(o); *(u32x4*)(dst + 8) = pack8(o + 8);
  }
}

DI size_t hl_idx(int b, int c, int d, int g, int pp) { return ((size_t)(((b * NCHK + c) * 2 + d) * 16 + g) * 64 + pp) * 2; }
template <bool OUT>
DI void s5_task(const Params& p, int l, int b, int c, int gp, char* smem) {
  us* Hb = (us*)smem;
  float* Yb = (float*)(smem + 4 * 32 * 136 * 2);
  const int tid = tidx(), w = tid >> 6, lane = tid & 63, r = lane & 31, hh = lane >> 5;
  const long m0 = seqrow(b, c * 64);
  const us* P0 = (const us*)(p.ws + OFF_P) + m0 * INC;
  const int gl = w >> 1, d = w & 1, g = gp * 2 + gl, pp = lane;
  const float* sf = s5f(p, l);
  const float lr = sf[S_LAMB + ((d * 16 + g) * 64 + pp) * 2], li = sf[S_LAMB + ((d * 16 + g) * 64 + pp) * 2 + 1];
  const f32x2_ la = {lr, lr}, lb = {-li, li};
  float hr = 0.f, hi = 0.f;
  float* HL = (float*)(p.ws + OFF_HL) + hl_idx(b, c, d, g, pp);
  if (OUT) { hr = HL[0]; hi = HL[1]; }
  const us* cm = wl(p, l) + W_CM + ((size_t)(d * 16 + g) * 16 + (r & 15)) * 128 + hh * 8;
  const us* bm = wl(p, l) + W_BM + ((size_t)(d * 16 + g) * 128 + r) * 16 + hh * 8;
  us* hb = Hb + w * 32 * 136;
  __syncthreads();
  for (int half = 0; half < 2; ++half) {
    const int tbase = d ? (1 - half) * 32 : half * 32;
    {
      const bf16x8 a = *(const bf16x8*)(P0 + (size_t)(tbase + r) * INC + 1568 + g * 16 + hh * 8);
#pragma unroll
      for (int nt = 0; nt < 4; ++nt) {
        const bf16x8 bb = *(const bf16x8*)(bm + nt * 32 * 16);
        f32x16 z;
#pragma unroll
        for (int q = 0; q < 16; ++q) z[q] = 0.f;
        z = MFMA(a, bb, z);
#pragma unroll
        for (int i = 0; i < 16; ++i) hb[crow(i, hh) * 136 + nt * 32 + r] = f2bf(z[i]);
      }
    }
    __syncthreads();
    for (int jj = 0; jj < 32; ++jj) {
      const int tl = d ? 31 - jj : jj;
      const f32x2_ bu = {bf2f(hb[tl * 136 + pp]), bf2f(hb[tl * 136 + 64 + pp])};
      { f32x2_ h = {hr, hi}, hs = {hi, hr}; f32x2_ nh = la * h + lb * hs + bu; hr = nh[0]; hi = nh[1]; }
      if (OUT) { hb[tl * 136 + pp] = f2bf(hr); hb[tl * 136 + 64 + pp] = f2bf(hi); }
    }
    if (OUT) {
      __syncthreads();
      f32x16 acc;
#pragma unroll
      for (int q = 0; q < 16; ++q) acc[q] = 0.f;
#pragma unroll
      for (int ks = 0; ks < 8; ++ks) {
        bf16x8 a = *(const bf16x8*)(hb + r * 136 + ks * 16 + hh * 8);
        bf16x8 bb = *(const bf16x8*)(cm + ks * 16);
        if (r >= 16) bb = (bf16x8){0, 0, 0, 0, 0, 0, 0, 0};
        acc = MFMA(a, bb, acc);
      }
      if (r < 16) {
#pragma unroll
        for (int i = 0; i < 16; ++i) Yb[(w * 64 + tbase + crow(i, hh)) * 17 + r] = acc[i];
      }
    }
    __syncthreads();
  }
  if (!OUT) { HL[0] = hr; HL[1] = hi; return; }
  {
    const int gl2 = tid >> 7, t = (tid >> 1) & 63, o8 = (tid & 1) * 8, g2 = gp * 2 + gl2; float y[8], u8[8];
    unpack8(*(const u32x4*)(P0 + (size_t)t * INC + 1568 + g2 * 16 + o8), u8);
#pragma unroll
    for (int o = 0; o < 8; ++o) {
      float v = Yb[((gl2 * 2 + 0) * 64 + t) * 17 + o8 + o] + Yb[((gl2 * 2 + 1) * 64 + t) * 17 + o8 + o]
              + p.in[24][l * 256 + g2 * 16 + o8 + o] * u8[o];
      y[o] = gelu_t(v);
    }
    *(u32x4*)((us*)(p.ws + OFF_Y) + (m0 + t) * 256 + g2 * 16 + o8) = pack8(y);
  }
}
DI void s5b_task(const Params& p, int l, int it) {
  const int gid = it * 256 + tidx();
  const int pp = gid & 63, g = (gid >> 6) & 15, d = (gid >> 10) & 1, b = gid >> 11;
  const float* sf = s5f(p, l);
  const float tr = sf[S_LAMT + ((d * 16 + g) * 64 + pp) * 2], ti = sf[S_LAMT + ((d * 16 + g) * 64 + pp) * 2 + 1];
  float* HL = (float*)(p.ws + OFF_HL);
  float hr = 0.f, hi = 0.f;
  for (int j0 = 0; j0 < NCHK; j0 += 33) {
    f32x2_ xv[33];
#pragma unroll
    for (int q = 0; q < 33; ++q) xv[q] = *(const f32x2_*)(HL + hl_idx(b, gla_order(d, j0 + q), d, g, pp));
#pragma unroll
    for (int q = 0; q < 33; ++q) {
      f32x2_ o = {hr, hi};
      *(f32x2_*)(HL + hl_idx(b, gla_order(d, j0 + q), d, g, pp)) = o;
      float nr = tr * hr - ti * hi + xv[q][0], ni = tr * hi + ti * hr + xv[q][1]; hr = nr; hi = ni;
    }
  }
}

DI void attn_task(const Params& p, int b, int h, int qs0, int nkeys, char* smem) {
  constexpr int KSZ = 64 * 104, VSZ = 64 * 68;
  us* sK = (us*)smem;
  us* sV = sK + 3 * KSZ;
  const int tid = tid512(), w = tid >> 6, lane = tid & 63, r = lane & 31, hh = lane >> 5;
  const us* Kg = (const us*)(p.ws + OFF_KB) + (size_t)(b * 4 + h) * SEQ * 96;
  const us* Vg = (const us*)(p.ws + OFF_VT) + (size_t)(b * 4 + h) * 64 * SEQ;
  const us* Qg = (const us*)(p.ws + OFF_QB) + ((size_t)(b * 4 + h) * SEQ + qs0 + w * 32 + r) * 96 + hh * 8;
  bf16x8 qf[6];
#pragma unroll
  for (int ks = 0; ks < 6; ++ks) qf[ks] = *(const bf16x8*)(Qg + ks * 16);
  u32x4 rk[2], rv;
  const int kq1 = tid + 512 < 768 ? tid + 512 : tid;
  const int vrow = tid >> 3, vcc = tid & 7;
  const int kw0 = (tid / 12) * 104 + (tid % 12) * 8, kw1 = (kq1 / 12) * 104 + (kq1 % 12) * 8, vw = vrow * 68 + vcc * 8;
#define AGLOAD(kt) { rk[0] = *(const u32x4*)(Kg + (size_t)(kt) * 64 * 96 + tid * 8); rk[1] = *(const u32x4*)(Kg + (size_t)(kt) * 64 * 96 + kq1 * 8); \
    rv = *(const u32x4*)(Vg + (size_t)vrow * SEQ + (kt) * 64 + vcc * 8); }
#define ASWRITE(buf) { *(u32x4*)(sK + (buf) * KSZ + kw0) = rk[0]; *(u32x4*)(sK + (buf) * KSZ + kw1) = rk[1]; \
    us* dv = sV + (buf) * VSZ + vw; u32x2 lo = {rv[0], rv[1]}, hi2 = {rv[2], rv[3]}; *(u32x2*)dv = lo; *(u32x2*)(dv + 4) = hi2; }
  f32x16 o0, o1, negm, sc0, sc1;
#pragma unroll
  for (int q = 0; q < 16; ++q) { o0[q] = 0.f; o1[q] = 0.f; sc0[q] = 0.f; sc1[q] = 0.f; }
  float lsum = 0.f;
  const int NT = nkeys / 64;
  __syncthreads();
  AGLOAD(0); ASWRITE(0); AGLOAD(1); ASWRITE(1); AGLOAD(2);
  __syncthreads();
  {
    const us* k0 = sK + r * 104 + hh * 8;
#pragma unroll
    for (int ks = 0; ks < 6; ++ks) {
      bf16x8 a0 = *(const bf16x8*)(k0 + ks * 16), a1 = *(const bf16x8*)(k0 + 32 * 104 + ks * 16);
      sc0 = MFMA(a0, qf[ks], sc0); sc1 = MFMA(a1, qf[ks], sc1);
    }
    float mx = sc0[0];
#pragma unroll
    for (int i = 1; i < 16; ++i) mx = fmaxf(mx, sc0[i]);
#pragma unroll
    for (int i = 0; i < 16; ++i) mx = fmaxf(mx, sc1[i]);
    mx = fmaxf(mx, __shfl_xor(mx, 32));
#pragma unroll
    for (int q = 0; q < 16; ++q) { negm[q] = -mx; sc0[q] -= mx; sc1[q] -= mx; }
  }
  if (__builtin_amdgcn_readfirstlane(w) >= 4) __builtin_amdgcn_s_setprio(1);
  int bc = 0, bn = 1, bw = 2;
  for (int kt = 0; kt < NT; ++kt) {
    __syncthreads();
    ASWRITE(bw);
    { const int kl = kt + 3 < NT ? kt + 3 : NT - 1; AGLOAD(kl); }
    float mx = sc0[0];
#pragma unroll
    for (int i = 1; i < 16; ++i) mx = fmaxf(mx, sc0[i]);
#pragma unroll
    for (int i = 0; i < 16; ++i) mx = fmaxf(mx, sc1[i]);
    mx = fmaxf(mx, __shfl_xor(mx, 32));
    if (__builtin_amdgcn_ballot_w64(mx > 8.f)) {
      const float dl = fmaxf(mx, 0.f), alpha = __builtin_amdgcn_exp2f(-dl);
#pragma unroll
      for (int i = 0; i < 16; ++i) { o0[i] *= alpha; o1[i] *= alpha; sc0[i] -= dl; sc1[i] -= dl; negm[i] -= dl; }
      lsum *= alpha;
    }
    f32x16 sn0, sn1;
    {
      const us* k0 = sK + bn * KSZ + r * 104 + hh * 8;
      {
        bf16x8 a0 = *(const bf16x8*)(k0), a1 = *(const bf16x8*)(k0 + 32 * 104);
        sn0 = MFMA(a0, qf[0], negm); sn1 = MFMA(a1, qf[0], negm);
      }
#pragma unroll
      for (int ks = 1; ks < 6; ++ks) {
        bf16x8 a0 = *(const bf16x8*)(k0 + ks * 16), a1 = *(const bf16x8*)(k0 + 32 * 104 + ks * 16);
        sn0 = MFMA(a0, qf[ks], sn0); sn1 = MFMA(a1, qf[ks], sn1);
      }
    }
    float ps = 0.f;
#pragma unroll
    for (int i = 0; i < 16; ++i) { sc0[i] = __builtin_amdgcn_exp2f(sc0[i]); ps += sc0[i]; }
#pragma unroll
    for (int i = 0; i < 16; ++i) { sc1[i] = __builtin_amdgcn_exp2f(sc1[i]); ps += sc1[i]; }
    lsum += ps;
    bf16x8 pf[4];
    {
      u32x4 t0 = {pk2(sc0[0], sc0[1]), pk2(sc0[2], sc0[3]), pk2(sc0[4], sc0[5]), pk2(sc0[6], sc0[7])};
      u32x4 t1 = {pk2(sc0[8], sc0[9]), pk2(sc0[10], sc0[11]), pk2(sc0[12], sc0[13]), pk2(sc0[14], sc0[15])};
      u32x4 t2 = {pk2(sc1[0], sc1[1]), pk2(sc1[2], sc1[3]), pk2(sc1[4], sc1[5]), pk2(sc1[6], sc1[7])};
      u32x4 t3 = {pk2(sc1[8], sc1[9]), pk2(sc1[10], sc1[11]), pk2(sc1[12], sc1[13]), pk2(sc1[14], sc1[15])};
      pf[0] = __builtin_bit_cast(bf16x8, t0); pf[1] = __builtin_bit_cast(bf16x8, t1);
      pf[2] = __builtin_bit_cast(bf16x8, t2); pf[3] = __builtin_bit_cast(bf16x8, t3);
    }
    {
      const us* v0 = sV + bc * VSZ + r * 68 + 4 * hh;
#pragma unroll
      for (int kk = 0; kk < 4; ++kk) {
        u32x2 l0 = *(const u32x2*)(v0 + 16 * kk), h0 = *(const u32x2*)(v0 + 16 * kk + 8);
        u32x2 l1 = *(const u32x2*)(v0 + 32 * 68 + 16 * kk), h1 = *(const u32x2*)(v0 + 32 * 68 + 16 * kk + 8);
        u32x4 a0 = {l0[0], l0[1], h0[0], h0[1]}, a1 = {l1[0], l1[1], h1[0], h1[1]};
        o0 = MFMA(__builtin_bit_cast(bf16x8, a0), pf[kk], o0);
        o1 = MFMA(__builtin_bit_cast(bf16x8, a1), pf[kk], o1);
      }
    }
    sc0 = sn0; sc1 = sn1;
    { const int t = bc; bc = bn; bn = bw; bw = t; }
  }
#undef AGLOAD
#undef ASWRITE
  __builtin_amdgcn_s_setprio(0);
  lsum += __shfl_xor(lsum, 32);
  const float inv = 1.f / lsum;
  const long m = seqrow(b, qs0 + w * 32 + r);
  us* dst = (us*)(p.ws + OFF_MIXIN) + m * 1024 + 768 + h * 64;
#pragma unroll
  for (int gq = 0; gq < 4; ++gq) {
    u32x2 w0 = {pk2(o0[4 * gq] * inv, o0[4 * gq + 1] * inv), pk2(o0[4 * gq + 2] * inv, o0[4 * gq + 3] * inv)};
    u32x2 w1 = {pk2(o1[4 * gq] * inv, o1[4 * gq + 1] * inv), pk2(o1[4 * gq + 2] * inv, o1[4 * gq + 3] * inv)};
    *(u32x2*)(dst + 8 * gq + 4 * hh) = w0;
    *(u32x2*)(dst + 32 + 8 * gq + 4 * hh) = w1;
  }
}

DI void convact_task(const Params& p, int l, int it, int nrows) {
  const int T = it * 256 + tidx();
  if (T >= (nrows / 8) * 352) return;
  const int rb = T / 352, oct = T - rb * 352, c0 = oct * 8, i0 = rb * 8;
  const int slo = i0 < 8192 ? 0 : 8192, shi = i0 < 8192 ? 8192 : 8448;
  const us* Z = (const us*)(p.ws + OFF_ZPRE);
  const float* cw = p.in[33] + (size_t)l * 3 * DFF2; const float* cb = p.in[34] + (size_t)l * DFF2;
  float wa[3][8], wg[3][8], ba[8], bg[8];
#pragma unroll
  for (int j = 0; j < 3; ++j) {
    f32x4 a0 = *(const f32x4*)(cw + j * DFF2 + c0), a1 = *(const f32x4*)(cw + j * DFF2 + c0 + 4);
    f32x4 g0 = *(const f32x4*)(cw + j * DFF2 + DFF + c0), g1 = *(const f32x4*)(cw + j * DFF2 + DFF + c0 + 4);
#pragma unroll
    for (int q = 0; q < 4; ++q) { wa[j][q] = a0[q]; wa[j][4 + q] = a1[q]; wg[j][q] = g0[q]; wg[j][4 + q] = g1[q]; }
  }
  {
    f32x4 a0 = *(const f32x4*)(cb + c0), a1 = *(const f32x4*)(cb + c0 + 4), g0 = *(const f32x4*)(cb + DFF + c0), g1 = *(const f32x4*)(cb + DFF + c0 + 4);
#pragma unroll
    for (int q = 0; q < 4; ++q) { ba[q] = a0[q]; ba[4 + q] = a1[q]; bg[q] = g0[q]; bg[4 + q] = g1[q]; }
  }
  u32x4 ra_[10], rg_[10];
#pragma unroll
  for (int k = 0; k < 10; ++k) {
    const int i = i0 - 1 + k;
    if (i >= slo && i < shi) { ra_[k] = *(const u32x4*)(Z + (size_t)i * DFF2 + c0); rg_[k] = *(const u32x4*)(Z + (size_t)i * DFF2 + DFF + c0); }
    else { ra_[k] = (u32x4){0u, 0u, 0u, 0u}; rg_[k] = (u32x4){0u, 0u, 0u, 0u}; }
  }
  us* A = (us*)(p.ws + OFF_ACT);
  float za[3][8], zg[3][8];
  unpack8(ra_[0], za[0]); unpack8(rg_[0], zg[0]); unpack8(ra_[1], za[1]); unpack8(rg_[1], zg[1]);
#pragma unroll
  for (int ii = 0; ii < 8; ++ii) {
    const int i = i0 + ii;
    unpack8(ra_[ii + 2], za[2]); unpack8(rg_[ii + 2], zg[2]);
    float o[8];
#pragma unroll
    for (int q = 0; q < 8; ++q) {
      float a = ba[q] + wa[0][q] * za[0][q] + wa[1][q] * za[1][q] + wa[2][q] * za[2][q];
      float gg = bg[q] + wg[0][q] * zg[0][q] + wg[1][q] * zg[1][q] + wg[2][q] * zg[2][q];
      o[q] = gelu_t(a) * gg;
    }
    *(u32x4*)(A + (size_t)i * DFF + c0) = pack8(o);
#pragma unroll
    for (int q = 0; q < 8; ++q) { za[0][q] = za[1][q]; za[1][q] = za[2][q]; zg[0][q] = zg[1][q]; zg[1][q] = zg[2][q]; }
  }
}

constexpr int SCHED_WORDS = 1024;
DI int gl_n(int RT, int CT, int x) { return ((RT - x + 7) >> 3) * CT; }
DI void gl_tile(int RT, int CT, int x, int j, int& rt, int& ct) {
  const int rows = (RT - x + 7) >> 3, nfull = CT >> 3; int rl;
  if (j < nfull * rows * 8) { int pnl = j / (rows * 8), rem = j - pnl * rows * 8; rl = rem >> 3; ct = pnl * 8 + (rem & 7); }
  else { int j2 = j - nfull * rows * 8, wd = CT - nfull * 8; rl = j2 / wd; ct = nfull * 8 + (j2 - rl * wd); }
  rt = rl * 8 + x;
}
DI int ml_n(int n, int x) { return (n - x + 7) >> 3; }
template <class NX, class RUN>
DI void run_phase(unsigned*& ctr, int G, int bid, volatile int* s_bc, NX nx, RUN run) {
  const int x0 = bid & 7, per = G >> 3;
  const int x = x0; int j = bid >> 3;
  for (;;) {
    if (j < nx(x)) {
      int nj = 0;
      if (threadIdx.x == 0) nj = per + (int)atomicAdd(&ctr[x], 1u);
      run(x, j);
      __syncthreads();
      if (threadIdx.x == 0) *s_bc = nj;
      __syncthreads();
      j = *s_bc;
    } else break;
  }
  ctr += 8;
}

DI long chunk_row(int ch, int i) { return i < 8192 ? (long)ch * 8192 + i : (long)MX + ch * 256 + (i - 8192); }


template <class RUN>
DI void run_tiles(unsigned*& ctr, int n, int G, int bid, volatile int* s_bc, RUN run) {
  int it = bid;
  while (it < n) {
    int nx = 0;
    if (threadIdx.x == 0) nx = G + (int)atomicAdd(ctr, 1u);
    run(it);
    __syncthreads();
    if (threadIdx.x == 0) *s_bc = nx;
    __syncthreads();
    it = *s_bc;
  }
  ctr += 1;
}

constexpr int HLDS = 64512;
constexpr int LDS_BYTES = 147456;
static_assert(2 * HLDS <= LDS_BYTES, "lds");

__global__ void __launch_bounds__(512) fwd_mega(Params p) {
  cg::grid_group grid = cg::this_grid();
  extern __shared__ __attribute__((aligned(16))) char dsm[];
  __shared__ uint4 xb_words;
  const int G = gridDim.x, bid = blockIdx.x, wv8 = __builtin_amdgcn_readfirstlane(threadIdx.x >> 6), half = wv8 >> 2;
  char* smem = dsm + half * HLDS;
  const int vb = bid * 2 + half, V = 2 * G;
  if (threadIdx.x == 0) xb_words = make_uint4(0u, 0u, 0u, 0u);
  __syncthreads();
  const XcdBarrier xb = xcd_barrier_post((unsigned*)(p.ws + OFF_BAR), (volatile LAS unsigned*)&xb_words);
#define HALF_LOOP(n, IT, ...) { const int n_ = (n); const int iters_ = (n_ + V - 1) / V; for (int k_ = 0; k_ < iters_; ++k_) { int IT = vb + k_ * V; IT = IT < n_ ? IT : n_ - 1; __VA_ARGS__ } }
#define HALF_LOOP_NB(n, IT, ...) { const int n_ = (n); for (int IT = vb; IT < n_; IT += V) { __VA_ARGS__ } }

  HALF_LOOP(2 * NCONV_LAYER, it, conv_task(p, it, smem);)
  HALF_LOOP(384, it, mod_task(p, it, smem);)
  HALF_LOOP_NB(16, it, s5pre_task(p, it);)
  HALF_LOOP_NB(4, it, rope_task(p, it);)
  HALF_LOOP_NB(128, it, sguw_task(p, it);)
  HALF_LOOP_NB(64, it, wgt_task(p, it);)
  grid.sync();
  for (int it = bid; it < MT / 8; it += G) row_task<0>(p, 0, (long)it * 8 + wv8, nullptr);
  xcd_barrier(xb);

  unsigned* ctr = (unsigned*)(p.ws + OFF_SCHED);
  volatile int* s_bc = (volatile int*)&xb_words.z;
  for (int l = 0; l < 2; ++l) {
    const us* W = wl(p, l);
    const int RT = l == 0 ? 264 : 256;
    run_tiles(ctr, 132 * 9, G, bid, s_bc, [&](int it) {
      const int rt = it / 9, ct = it - rt * 9;
      GArgs g{(const us*)(p.ws + OFF_HX) + (size_t)rt * 256 * D, D, W + W_IN + (size_t)ct * 256 * D, D, (long)rt * 256, ct * 256, p.ws + OFF_P, INC, l};
      gemm_8p(g, dsm, ct == 8 ? 128 : 256);
    });
    xcd_barrier(xb);
    {
      const int p0 = (4 * NCHK * 8) >> 1, p1 = p0 + ((4 * NCHK * 4) >> 1), p2 = p1 + ((RT * 4) >> 1), p3 = p2 + ((264 * 3) >> 1), p4 = p3 + ((264 * 4) >> 1);
      for (int P = bid; P < p4; P += G) {
        if (P < p0) { const int q = 2 * P + half; s5_task<false>(p, l, q / (NCHK * 8), (q / 8) % NCHK, q & 7, smem); }
        else if (P < p1) { const int q = 2 * (P - p0) + half; gla1_task(p, l, q / (NCHK * 4), (q / 4) % NCHK, q & 3, smem); }
        else if (P < p2) { const int q = 2 * (P - p1) + half; sgu_task(p, l, q >> 2, q & 3, smem); }
        else if (P < p3) { const int q = 2 * (P - p2) + half, rt = q / 3, ct = q % 3;
          GArgs g{(const us*)(p.ws + OFF_P) + (size_t)rt * 128 * INC + 1824, INC, W + W_UQ + (size_t)ct * 128 * 224, 224, (long)rt * 128, ct * 128, nullptr, 0, l};
          gemm_tile<32, 2, true>(p, g, smem); }
        else { const int q = 2 * (P - p3) + half, rt = q >> 2, ct = q & 3;
          GArgs g{(const us*)(p.ws + OFF_P) + (size_t)rt * 128 * INC + 2048, INC, W + W_UKV + (size_t)ct * 128 * 96, 96, (long)rt * 128, ct * 128, nullptr, 0, l};
          gemm_tile<32, 3, true>(p, g, smem);
          if (ct == 0) kr_task(p, (long)rt * 128); }
      }
    }
    xcd_barrier(xb);
    HALF_LOOP_NB(512, it, gla2_task(p, it);)
    HALF_LOOP_NB(32, it, s5b_task(p, l, it);)
    xcd_barrier(xb);
    if ((G & 7) == 0) {
      const int x = bid & 7;
      for (int j = bid >> 3; j < 64; j += G >> 3) { int pair = 2 * x + (j >> 5), qb = j & 31; for (int rp = 0; rp < REP_ATT; ++rp) attn_task(p, pair >> 2, pair & 3, 256 + qb * 256, SEQ, dsm); }
    } else {
      for (int it = bid; it < 512; it += G) attn_task(p, it >> 7, (it >> 5) & 3, 256 + (it & 31) * 256, SEQ, dsm);
    }
    if (l == 0) for (int it = bid; it < 16; it += G) attn_task(p, it >> 2, it & 3, 0, 256, dsm);
    {
      const int c0 = l == 0 ? 0 : 4, nc = NCHK - c0;
      const int p0 = (4 * nc * 8) >> 1, p1 = p0 + ((4 * nc * 4) >> 1);
      for (int P = bid; P < p1; P += G) {
        if (P < p0) { const int q = 2 * P + half; s5_task<true>(p, l, q / (nc * 8), c0 + (q / 8) % nc, q & 7, smem); }
        else { const int q = 2 * (P - p0) + half; gla3_task(p, l, q / (nc * 4), c0 + (q / 4) % nc, q & 3, smem); }
      }
    }
    xcd_barrier(xb);
    HALF_LOOP(RT * 2, it, { int rt = it >> 1, ct = it & 1;
      GArgs g{(const us*)(p.ws + OFF_Y) + (size_t)rt * 128 * 256, 256, W + W_GLU + (size_t)ct * 128 * 256, 256, (long)rt * 128, ct * 128, nullptr, 0, l};
      gemm_tile<32, 4, false>(p, g, smem); })
    xcd_barrier(xb);
    run_tiles(ctr, (RT / 2) * 4, G, bid, s_bc, [&](int it) {
      const int rt = it >> 2, ct = it & 3;
      GArgs g{(const us*)(p.ws + OFF_MIXIN) + (size_t)rt * 256 * D, D, W + W_OUT + (size_t)ct * 256 * D, D, (long)rt * 256, ct * 256, p.ws + OFF_MIXOUT, D, l};
      gemm_8p(g, dsm);
    });
    xcd_barrier(xb);
    for (int it = bid; it < RT * 16; it += G) { long m = (long)it * 8 + wv8; row_task<1>(p, l, m, (const us*)(p.ws + OFF_MIXOUT) + m * 1024); }
    xcd_barrier(xb);
    const int CR2 = l == 0 ? 33 : 32, CROWS = CR2 * 256, NF2 = (CROWS / 8 * 352 + 255) / 256;
    for (int ch = 0; ch <= 4; ++ch) {
      {
        const bool hasF3 = ch > 0, hasF1 = ch < 4;
        const int n3 = hasF3 ? CR2 * 4 : 0, n1 = hasF1 ? CR2 * 22 : 0;
        run_tiles(ctr, n3 + n1, G, bid, s_bc, [&](int it) {
          GArgs g;
          if (it < n3) {
            const int rt = it >> 2, ct = it & 3;
            g = GArgs{(const us*)(p.ws + OFF_ACT) + (size_t)rt * 256 * DFF, DFF, W + W_DN + (size_t)ct * 256 * DFF, DFF, (long)rt * 256, ct * 256, p.ws + OFF_FFNOUT, D, l};
          } else {
            const int q = it - n3, rt = q / 22, ct = q - rt * 22;
            g = GArgs{(const us*)(p.ws + OFF_HX) + (size_t)chunk_row(ch, rt * 256) * D, D, W + W_UP + (size_t)ct * 256 * D, D, (long)rt * 256, ct * 256, p.ws + OFF_ZPRE, DFF2, l};
          }
          gemm_8p(g, dsm);
        });
      }
      xcd_barrier(xb);
      if (ch < 4) HALF_LOOP_NB(NF2, it, convact_task(p, l, it, CROWS);)
      if (ch > 0) for (int it = bid; it < CROWS / 8; it += G) { int i = it * 8 + wv8; row_task<2>(p, l, chunk_row(ch - 1, i), (const us*)(p.ws + OFF_FFNOUT) + (size_t)i * 1024); }
      xcd_barrier(xb);
    }
  }
#undef HALF_LOOP
#undef HALF_LOOP_NB
}

extern "C" void kernel_launch(void* const* d_in, const int* in_sizes, int n_in, void* d_out, int out_size,
                              void* d_ws, size_t ws_size, hipStream_t stream) {
  static int grid_blocks = 0;
  if (!grid_blocks) {
    int dev = 0, cus = 0, per_cu = 0;
    (void)hipGetDevice(&dev);
    (void)hipDeviceGetAttribute(&cus, hipDeviceAttributeMultiprocessorCount, dev);
    if (hipFuncSetAttribute((const void*)fwd_mega, hipFuncAttributeMaxDynamicSharedMemorySize, LDS_BYTES) != hipSuccess)
      fprintf(stderr, "kernel_launch: hipFuncSetAttribute(%d B LDS) failed\n", LDS_BYTES);
    (void)hipOccupancyMaxActiveBlocksPerMultiprocessor(&per_cu, fwd_mega, 512, LDS_BYTES);
    if (per_cu < 1) fprintf(stderr, "kernel_launch: occupancy query returned %d\n", per_cu);
    grid_blocks = cus;
    if (ws_size < OFF_END) fprintf(stderr, "kernel_launch: ws too small: %zu < %zu\n", ws_size, (size_t)OFF_END);
  }
  if (n_in != 36 || ws_size < OFF_END) return;
  Params p{};
  for (int i = 0; i < 36; ++i) p.in[i] = (const float*)d_in[i];
  p.out = (float*)d_out; p.ws = (char*)d_ws;
  void* args[] = {&p};
  (void)hipMemsetAsync((char*)d_ws + OFF_BAR, 0, (XCD_BAR_WORDS + SCHED_WORDS) * 4, stream);
  hipError_t e = hipLaunchCooperativeKernel((void*)fwd_mega, dim3(grid_blocks), dim3(512), args, LDS_BYTES, stream);
  if (e != hipSuccess) fprintf(stderr, "cooperative launch failed: %s (grid %d)\n", hipGetErrorString(e), grid_blocks);
}
```
